# Optimizing an MI355X kernel written in HIP

```python
import jax, jax.numpy as jnp
from jax import lax
import numpy as np

D_MODEL = 1024
BATCH = 4
SEQ = 8192
DEPTH = 1

POOL_WINDOWS = (2, 4, 8, 16)
POOL_WIDTH = D_MODEL // 2
POOL_GROUP = POOL_WIDTH // len(POOL_WINDOWS)
HEAD_DIM = 64
N_HEADS = (D_MODEL // 2) // HEAD_DIM
N_KV_HEADS = 2
ATTN_WIDTH = N_HEADS * HEAD_DIM
KV_WIDTH = N_KV_HEADS * HEAD_DIM
WINDOW = 128
BLOCK = 128
ROPE_THETA = 500000.0
ROT_DIM = HEAD_DIM // 4
MIX_WIDTH = POOL_WIDTH + ATTN_WIDTH
IN_WIDTH = POOL_WIDTH + ATTN_WIDTH + 2 * KV_WIDTH
D_FF = 2816
EPS = 1e-6
NEG_INF = -1e30

kernel_name = "hybrid_pool_swa_macaron_block"


def rms_norm(x, g):
    xf = x.astype(jnp.float32)
    y = xf * lax.rsqrt(jnp.mean(xf * xf, axis=-1, keepdims=True) + EPS)
    return (y * g.astype(jnp.float32)).astype(x.dtype)


def swiglu(h, w_gu, w_down):
    gate, up = jnp.split(h @ w_gu, 2, axis=-1)
    return (jax.nn.silu(gate) * up) @ w_down


def pool_mix(u, w_pool, pool_scale):
    B, S, C = u.shape
    uf = u.astype(jnp.float32)
    cs = jnp.concatenate([jnp.zeros((B, 1, C), jnp.float32), jnp.cumsum(uf, axis=1)], axis=1)
    t = jnp.arange(S)
    outs = []
    for g, w in enumerate(POOL_WINDOWS):
        lo, hi = g * POOL_GROUP, (g + 1) * POOL_GROUP
        start = jnp.maximum(t + 1 - w, 0)
        cnt = (t + 1 - start).astype(jnp.float32)
        csg = cs[:, :, lo:hi]
        mean = (csg[:, 1:] - csg[:, start]) / cnt[None, :, None]
        outs.append(mean - uf[:, :, lo:hi])
    d = jnp.stack(outs, axis=2).astype(u.dtype)
    y = jnp.einsum('bsgc,gcd->bsgd', d, w_pool).reshape(B, S, POOL_WIDTH)
    return y * pool_scale


def apply_partial_rope(x, cos, sin):
    half = ROT_DIM // 2
    x1, x2 = x[..., :half], x[..., half:ROT_DIM]
    rot = jnp.concatenate([x1 * cos - x2 * sin, x2 * cos + x1 * sin], axis=-1)
    return jnp.concatenate([rot, x[..., ROT_DIM:]], axis=-1)


def swa_with_sinks(q, k, v, sinks):
    B, S = q.shape[0], q.shape[1]
    nb = S // BLOCK
    G = N_HEADS // N_KV_HEADS
    qb = q.reshape(B, nb, BLOCK, N_KV_HEADS, G, HEAD_DIM)
    pad = ((0, 0), (BLOCK, 0), (0, 0), (0, 0))
    kp = jnp.pad(k, pad).reshape(B, nb + 1, BLOCK, N_KV_HEADS, HEAD_DIM)
    vp = jnp.pad(v, pad).reshape(B, nb + 1, BLOCK, N_KV_HEADS, HEAD_DIM)
    kb = jnp.concatenate([kp[:, :-1], kp[:, 1:]], axis=2)
    vb = jnp.concatenate([vp[:, :-1], vp[:, 1:]], axis=2)
    s = jnp.einsum('bnqkgd,bnjkd->bnkgqj', qb, kb,
                   preferred_element_type=jnp.float32) * (HEAD_DIM ** -0.5)
    qi = jnp.arange(BLOCK)[:, None]
    kj = jnp.arange(2 * BLOCK)[None, :]
    diff = qi + BLOCK - kj
    band = (diff >= 0) & (diff < WINDOW)
    key_abs = jnp.arange(nb)[:, None] * BLOCK - BLOCK + kj
    valid = band[None] & (key_abs >= 0)[:, None, :]
    s = jnp.where(valid[None, :, None, None], s, NEG_INF)
    sink = jnp.broadcast_to(sinks.astype(jnp.float32).reshape(1, 1, N_KV_HEADS, G, 1, 1),
                            s.shape[:-1] + (1,))
    p = jax.nn.softmax(jnp.concatenate([s, sink], axis=-1), axis=-1)[..., :-1]
    o = jnp.einsum('bnkgqj,bnjkd->bnqkgd', p.astype(v.dtype), vb)
    return o.reshape(B, S, ATTN_WIDTH)


def token_mixer(h, cos, sin, w_in, w_pool, pool_scale, sinks, g_pool, g_attn, w_out):
    B, S, _ = h.shape
    z = h @ w_in
    u = z[..., :POOL_WIDTH]
    q = z[..., POOL_WIDTH:MIX_WIDTH].reshape(B, S, N_HEADS, HEAD_DIM)
    k = z[..., MIX_WIDTH:MIX_WIDTH + KV_WIDTH].reshape(B, S, N_KV_HEADS, HEAD_DIM)
    v = z[..., MIX_WIDTH + KV_WIDTH:].reshape(B, S, N_KV_HEADS, HEAD_DIM)
    pool_out = pool_mix(u, w_pool, pool_scale)
    q = apply_partial_rope(q, cos, sin)
    k = apply_partial_rope(k, cos, sin)
    attn_out = swa_with_sinks(q, k, v, sinks)
    y = jnp.concatenate([rms_norm(pool_out, g_pool), rms_norm(attn_out, g_attn)], axis=-1)
    return y @ w_out


def setup_inputs(seed: int = 0) -> dict:
    key = jax.random.key(seed)
    ks = jax.random.split(key, 24)
    f32 = jnp.float32

    def w(k, shape, fan_in):
        return jax.random.normal(k, shape, f32) * fan_in ** -0.5

    def gain(k, n):
        return 1.0 + 0.05 * jax.random.normal(k, (DEPTH, n), f32)

    x = jax.random.normal(ks[0], (BATCH, SEQ, D_MODEL), f32)
    offset = jax.random.randint(ks[1], (BATCH, 1), 0, 4096, jnp.int32)
    positions = offset + jnp.arange(SEQ, dtype=jnp.int32)[None, :]
    return {
        "x": x,
        "positions": positions,
        "ffn1_pre": gain(ks[2], D_MODEL),
        "ffn1_w_gu": w(ks[3], (DEPTH, D_MODEL, 2 * D_FF), D_MODEL),
        "ffn1_w_down": w(ks[4], (DEPTH, D_FF, D_MODEL), D_FF),
        "ffn1_post": gain(ks[5], D_MODEL),
        "mix_pre": gain(ks[6], D_MODEL),
        "w_in": w(ks[7], (DEPTH, D_MODEL, IN_WIDTH), D_MODEL),
        "w_pool": w(ks[8], (DEPTH, len(POOL_WINDOWS), POOL_GROUP, POOL_GROUP), POOL_GROUP),
        "pool_scale": 0.5 + 0.05 * jax.random.normal(ks[9], (DEPTH, POOL_WIDTH), f32),
        "sinks": 0.5 * jax.random.normal(ks[10], (DEPTH, N_HEADS), f32),
        "g_pool": gain(ks[11], POOL_WIDTH),
        "g_attn": gain(ks[12], ATTN_WIDTH),
        "w_out": w(ks[13], (DEPTH, MIX_WIDTH, D_MODEL), MIX_WIDTH),
        "mix_post": gain(ks[14], D_MODEL),
        "ffn2_pre": gain(ks[15], D_MODEL),
        "ffn2_w_gu": w(ks[16], (DEPTH, D_MODEL, 2 * D_FF), D_MODEL),
        "ffn2_w_down": w(ks[17], (DEPTH, D_FF, D_MODEL), D_FF),
        "ffn2_post": gain(ks[18], D_MODEL),
    }


def reference(x, positions, ffn1_pre, ffn1_w_gu, ffn1_w_down, ffn1_post,
              mix_pre, w_in, w_pool, pool_scale, sinks, g_pool, g_attn, w_out, mix_post,
              ffn2_pre, ffn2_w_gu, ffn2_w_down, ffn2_post):
    inv_freq = ROPE_THETA ** (-jnp.arange(0, ROT_DIM, 2, dtype=jnp.float32) / ROT_DIM)
    ang = positions.astype(jnp.float32)[..., None] * inv_freq
    cos = jnp.cos(ang)[:, :, None, :].astype(x.dtype)
    sin = jnp.sin(ang)[:, :, None, :].astype(x.dtype)
    for l in range(DEPTH):
        h = swiglu(rms_norm(x, ffn1_pre[l]), ffn1_w_gu[l], ffn1_w_down[l])
        x = x + 0.5 * rms_norm(h, ffn1_post[l])
        h = token_mixer(rms_norm(x, mix_pre[l]), cos, sin, w_in[l], w_pool[l], pool_scale[l],
                        sinks[l], g_pool[l], g_attn[l], w_out[l])
        x = x + rms_norm(h, mix_post[l])
        h = swiglu(rms_norm(x, ffn2_pre[l]), ffn2_w_gu[l], ffn2_w_down[l])
        x = x + 0.5 * rms_norm(h, ffn2_post[l])
    return x
```

```cpp
#include <hip/hip_runtime.h>
#include <hip/hip_cooperative_groups.h>
#include <cstdio>
#include <cstdint>
namespace cg = cooperative_groups;
namespace pg8 {
#define PG8_LAS __attribute__((address_space(3)))
typedef unsigned short bf16_t;
typedef short bf16x8 __attribute__((ext_vector_type(8)));
typedef float f32x4 __attribute__((ext_vector_type(4)));
typedef unsigned u32x4 __attribute__((ext_vector_type(4)));
constexpr int BM = 256, BK = 64, HALF = 128, HTB = HALF * BK * 2  , STAGE_BYTES = 8 * HTB, NXCD = 8, WGM = 8;

__host__ __device__ __forceinline__ int lds_byte(int r, int c) { const int st = (r >> 4) * 2 + (c >> 5), rr = r & 15, cc = c & 31, ob = rr * 64 + cc * 2; return st * 1024 + (ob ^ (((ob >> 9) & 1) << 5)); }
__host__ __device__ __forceinline__ void stage_rc(int b, int& R, int& C) { const int st = b / 1024, sb = b % 1024, swz = sb ^ (((sb >> 9) & 1) << 5); R = (st >> 1) * 16 + swz / 64; C = (st & 1) * 32 + (swz % 64) / 2; }
__host__ __device__ __forceinline__ int perm32(int rho) { const int n = rho >> 4, i = rho & 15; return 8 * (i >> 2) + 4 * n + (i & 3); }

struct Unit { int pm, pn; };
struct Gemm { const bf16_t* A; const bf16_t* Bt; int M, N, K; };

struct StaticOrder {
    int nM, nN, nwg, G, c;
    __host__ __device__ void init(int M, int N, int G_, int c_) { nM = M / BM; nN = N / BM; nwg = nM * nN; G = G_; c = c_; }
    __host__ __device__ bool next(int i, Unit& u) const {
        const long L = (long)i * G + c; if (L >= nwg) return false;
        int wgid = (int)L; { const int q = nwg / NXCD, r = nwg % NXCD, xcd = wgid % NXCD, off = wgid / NXCD; wgid = (xcd < r ? xcd * (q + 1) : r * (q + 1) + (xcd - r) * q) + off; }
        const int nig = WGM * nN, gid = wgid / nig, fm = gid * WGM, gsz = (nM - fm) < WGM ? (nM - fm) : WGM;
        u.pm = fm + ((wgid % nig) % gsz); u.pn = (wgid % nig) / gsz; return true;
    }
    __device__ __forceinline__ void a_ready(const Unit&) const {}
    __device__ __forceinline__ void done(const Unit&) const {}
};

__device__ __forceinline__ unsigned cvt_pk_bf16(float lo, float hi) { unsigned r; asm volatile("v_cvt_pk_bf16_f32 %0, %1, %2" : "=v"(r) : "v"(lo), "v"(hi)); return r; }
typedef float f32x2 __attribute__((ext_vector_type(2)));
__device__ __forceinline__ f32x2 gelu_pk(f32x2 v) {
    const f32x2 av = __builtin_elementwise_abs(v), d = av * 0.2316418882f + 1.0f;
    f32x2 t; t.x = __builtin_amdgcn_rcpf(d.x); t.y = __builtin_amdgcn_rcpf(d.y);
    f32x2 q = t * 0.5307027145f + (-0.7265760135f); q = q * t + 0.7107068705f; q = q * t + (-0.142248368f); q = q * t + 0.127414796f; q = q * t;
    const f32x2 s = (v * v) * (-0.72134752044f);
    f32x2 e; e.x = __builtin_amdgcn_exp2f(s.x); e.y = __builtin_amdgcn_exp2f(s.y);
    const f32x2 m = v * (q * e), r = v - m;
    f32x2 o; o.x = v.x < 0.f ? m.x : r.x; o.y = v.y < 0.f ? m.y : r.y; return o;
}

template <int ACT  > struct EpiBf16 {
    static constexpr bool PERM = true, AFTER_DRAIN = false; static_assert(ACT == 0 || ACT == 1, "EpiBf16: ACT is 0 (none) or 1 (gelu_pk)");
    bf16_t* O; int ldc; const float* bias; int split_cols; size_t split_stride; float scale0;
    __device__ __forceinline__ void operator()(const f32x4 (&acc)[2][2][4][2], const Unit& u, int wr, int wc, int fr, int fq) const {
        const int row0 = u.pm * BM + wr * 64 + fr; int colt = u.pn * BM; bf16_t* base = O;
        float sc = 1.f; if (split_cols) { const int t = colt / split_cols; base += (size_t)t * split_stride; colt -= t * split_cols; if (t == 0) sc = scale0; }
        const int col0 = colt + wc * 32 + 8 * fq, bcol0 = u.pn * BM + wc * 32 + 8 * fq;
        f32x4 bv[2][2];
#pragma unroll
        for (int bj = 0; bj < 2; ++bj)
#pragma unroll
            for (int n = 0; n < 2; ++n) bv[bj][n] = bias ? *(const f32x4*)(bias + bcol0 + bj * HALF + 4 * n) : (f32x4){0.f, 0.f, 0.f, 0.f};
#pragma unroll
        for (int ai = 0; ai < 2; ++ai)
#pragma unroll
            for (int m = 0; m < 4; ++m) { bf16_t* rowp = base + (size_t)(row0 + ai * HALF + m * 16) * ldc + col0;
#pragma unroll
                for (int bj = 0; bj < 2; ++bj) { f32x4 v0 = acc[ai][bj][m][0] + bv[bj][0], v1 = acc[ai][bj][m][1] + bv[bj][1];
                    if (ACT == 1) { f32x2 a = gelu_pk((f32x2){v0[0], v0[1]}), b = gelu_pk((f32x2){v0[2], v0[3]}), c = gelu_pk((f32x2){v1[0], v1[1]}), d = gelu_pk((f32x2){v1[2], v1[3]});
                        v0 = (f32x4){a.x, a.y, b.x, b.y}; v1 = (f32x4){c.x, c.y, d.x, d.y}; }
                    v0 = v0 * sc; v1 = v1 * sc; u32x4 w; w.x = cvt_pk_bf16(v0[0], v0[1]); w.y = cvt_pk_bf16(v0[2], v0[3]); w.z = cvt_pk_bf16(v1[0], v1[1]); w.w = cvt_pk_bf16(v1[2], v1[3]);
                    *(u32x4*)(rowp + bj * HALF) = w; } }
    }
};
typedef __bf16 bf16x2_t __attribute__((ext_vector_type(2)));
__device__ __forceinline__ unsigned cvtpk(float lo, float hi) { f32x2 v = {lo, hi}; bf16x2_t b = __builtin_convertvector(v, bf16x2_t); return __builtin_bit_cast(unsigned, b); }
__device__ __forceinline__ float silu_mul(float g, float u) { const float e = __builtin_amdgcn_exp2f(-1.4426950408889634f * g); return g * __builtin_amdgcn_rcpf(1.0f + e) * u; }

struct EpiSwiGLU {
    static constexpr bool PERM = true, AFTER_DRAIN = false;
    bf16_t* O; int ldc;
    __device__ __forceinline__ void operator()(const f32x4 (&acc)[2][2][4][2], const Unit& u, int wr, int wc, int fr, int fq) const {
        const int row0 = u.pm * BM + wr * 64 + fr, col0 = u.pn * HALF + wc * 32 + 8 * fq;
#pragma unroll
        for (int ai = 0; ai < 2; ++ai)
#pragma unroll
            for (int m = 0; m < 4; ++m) { bf16_t* rowp = O + (size_t)(row0 + ai * HALF + m * 16) * ldc + col0;
                const f32x4 g0 = acc[ai][0][m][0], g1 = acc[ai][0][m][1], u0 = acc[ai][1][m][0], u1 = acc[ai][1][m][1];
                u32x4 w; w.x = cvtpk(silu_mul(g0[0], u0[0]), silu_mul(g0[1], u0[1])); w.y = cvtpk(silu_mul(g0[2], u0[2]), silu_mul(g0[3], u0[3]));
                w.z = cvtpk(silu_mul(g1[0], u1[0]), silu_mul(g1[1], u1[1])); w.w = cvtpk(silu_mul(g1[2], u1[2]), silu_mul(g1[3], u1[3]));
                *(u32x4*)rowp = w; }
    }
};
struct EpiZ {
    static constexpr bool PERM = true, AFTER_DRAIN = false;
    bf16_t* Z; bf16_t* Vt; const float* cs; float qscale; int seq;
    __device__ __forceinline__ void operator()(const f32x4 (&acc)[2][2][4][2], const Unit& u, int wr, int wc, int fr, int fq) const {
        const int row0 = u.pm * BM + wr * 64 + fr, cl = wc * 32 + 8 * fq;
#pragma unroll
        for (int bj = 0; bj < 2; ++bj) {
            const int colh = u.pn * BM + bj * HALF;
            const bool isV = (colh == 1152);
            const bool rope = (colh >= 512) && (colh < 1152) && ((wc & 1) == 0) && (fq < 2);
            const float sc = (colh >= 512 && colh < 1024) ? qscale : 1.0f;
#pragma unroll
            for (int ai = 0; ai < 2; ++ai)
#pragma unroll
                for (int m = 0; m < 4; ++m) { const int row = row0 + ai * HALF + m * 16;
                    f32x4 v0 = acc[ai][bj][m][0], v1 = acc[ai][bj][m][1];
                    if (isV) {
                        const int b = row / seq, s = row - b * seq;
#pragma unroll
                        for (int i = 0; i < 4; ++i) { const int c0 = cl + i, c1 = cl + 4 + i;
                            Vt[((size_t)((b * 2 + (c0 >> 6)) * 64 + (c0 & 63))) * seq + s] = (bf16_t)(cvtpk(v0[i], 0.f) & 0xffffu);
                            Vt[((size_t)((b * 2 + (c1 >> 6)) * 64 + (c1 & 63))) * seq + s] = (bf16_t)(cvtpk(v1[i], 0.f) & 0xffffu); }
                    } else {
                        if (rope) { const f32x4 c = *(const f32x4*)(cs + (size_t)row * 16 + 4 * fq), sn = *(const f32x4*)(cs + (size_t)row * 16 + 8 + 4 * fq);
                            const f32x4 n0 = v0 * c - v1 * sn, n1 = v1 * c + v0 * sn; v0 = n0; v1 = n1; }
                        v0 = v0 * sc; v1 = v1 * sc;
                        u32x4 w; w.x = cvtpk(v0[0], v0[1]); w.y = cvtpk(v0[2], v0[3]); w.z = cvtpk(v1[0], v1[1]); w.w = cvtpk(v1[2], v1[3]);
                        *(u32x4*)(Z + (size_t)row * 1280 + colh + cl) = w; }
                }
        }
    }
};
template <class Epi, class Sched, bool ALIGN_EPI = false, bool SP2 = false>
__device__ __forceinline__ void gemm_phase(PG8_LAS unsigned char* lds, const Gemm g, const Sched& S, const Epi& E) {
    const int tid = threadIdx.x, wid = __builtin_amdgcn_readfirstlane(tid >> 6), lane = tid & 63, wr = wid >> 2, wc = wid & 3, fr = lane & 15, fq = lane >> 4;
    const int K = g.K, nt = K / BK;
    unsigned voffA[2], voffB[2];
#pragma unroll
    for (int i = 0; i < 2; ++i) { int R, C; stage_rc(tid * 16 + i * 8192, R, C); const int Rb = Epi::PERM ? ((R & ~31) + perm32(R & 31)) : R;
        voffA[i] = (unsigned)(R * K + C) * 2u; voffB[i] = (unsigned)(Rb * K + C) * 2u; }
    const size_t kstep = (size_t)(BK * 2);
    const size_t hstep = (size_t)HALF * K * 2;
    const size_t tstep = 2 * hstep;
    const unsigned ldsw = (unsigned)wid * 1024u;
    const int aoff = lds_byte(wr * 64 + fr, fq * 8), boff = lds_byte(wc * 32 + fr, fq * 8);
#define PG8_SA(b, h) (((b) * 2 + (h)) * HTB)
#define PG8_SB(b, h) ((4 + (b) * 2 + (h)) * HTB)
#define PG8_STAGE(bufoff, gbase, voff) do { _Pragma("unroll") for (int _i = 0; _i < 2; ++_i) \
        __builtin_amdgcn_global_load_lds((const unsigned*)((const char*)(gbase) + (voff)[_i]), (PG8_LAS unsigned*)(lds + (bufoff) + ldsw + _i * 8192), 16, 0, 0); } while (0)
#define PG8_LDA(dst, b, h) do { _Pragma("unroll") for (int m = 0; m < 4; ++m) _Pragma("unroll") for (int k = 0; k < 2; ++k) dst[m][k] = *(const PG8_LAS bf16x8*)(lds + PG8_SA(b, h) + aoff + m * 2048 + k * 1024); } while (0)
#define PG8_LDB(dst, b, h) do { _Pragma("unroll") for (int n = 0; n < 2; ++n) _Pragma("unroll") for (int k = 0; k < 2; ++k) dst[n][k] = *(const PG8_LAS bf16x8*)(lds + PG8_SB(b, h) + boff + n * 2048 + k * 1024); } while (0)
#define PG8_MMA(ai, bj, At, Bt) do { __builtin_amdgcn_s_setprio(1); _Pragma("unroll") for (int m = 0; m < 4; ++m) _Pragma("unroll") for (int n = 0; n < 2; ++n) _Pragma("unroll") for (int k = 0; k < 2; ++k) \
        acc[ai][bj][m][n] = __builtin_amdgcn_mfma_f32_16x16x32_bf16(Bt[n][k], At[m][k], acc[ai][bj][m][n], 0, 0, 0); __builtin_amdgcn_s_setprio(0); } while (0)
#define PG8_WAIT_V(n) asm volatile("s_waitcnt vmcnt(" #n ")" ::: "memory")
#define PG8_WAIT_L(n) asm volatile("s_waitcnt lgkmcnt(" #n ")" ::: "memory")
#define PG8_BAR __builtin_amdgcn_s_barrier()
#define PG8_SCHED __builtin_amdgcn_sched_barrier(0)
    Unit cur, nxt; int ui = 0;
    if (!S.next(0, cur)) return;
    f32x4 acc[2][2][4][2];
#pragma unroll
    for (int a = 0; a < 2; ++a)
#pragma unroll
        for (int b = 0; b < 2; ++b)
#pragma unroll
            for (int m = 0; m < 4; ++m)
#pragma unroll
                for (int n = 0; n < 2; ++n) acc[a][b][m][n] = (f32x4){0.f, 0.f, 0.f, 0.f};
    bf16x8 At[4][2], B0[2][2], B1[2][2];
    const char* cA = (const char*)g.A + (size_t)cur.pm * tstep; const char* cB = (const char*)g.Bt + (size_t)cur.pn * tstep;
    S.a_ready(cur);
    if constexpr (SP2) {
        PG8_STAGE(PG8_SB(0, 0), cB, voffB); PG8_STAGE(PG8_SB(0, 1), cB + hstep, voffB); PG8_STAGE(PG8_SA(0, 0), cA, voffA); PG8_STAGE(PG8_SA(0, 1), cA + hstep, voffA);
        if (wr == 1) PG8_BAR;
        PG8_WAIT_V(2); PG8_BAR;
        PG8_STAGE(PG8_SB(1, 0), cB + kstep, voffB); PG8_STAGE(PG8_SA(1, 0), cA + kstep, voffA); PG8_STAGE(PG8_SB(1, 1), cB + hstep + kstep, voffB);
        PG8_WAIT_V(6); PG8_BAR;
    } else {
        PG8_STAGE(PG8_SB(0, 0), cB, voffB); PG8_STAGE(PG8_SA(0, 0), cA, voffA); PG8_STAGE(PG8_SB(0, 1), cB + hstep, voffB); PG8_STAGE(PG8_SA(0, 1), cA + hstep, voffA);
        if (wr == 1) PG8_BAR;
        PG8_WAIT_V(4); PG8_BAR;
        PG8_STAGE(PG8_SB(1, 0), cB + kstep, voffB); PG8_STAGE(PG8_SA(1, 0), cA + kstep, voffA); PG8_STAGE(PG8_SB(1, 1), cB + hstep + kstep, voffB);
        PG8_WAIT_V(6); PG8_BAR;
    }
    for (;;) {
        const bool has_next = S.next(ui + 1, nxt);
        const char* nA = has_next ? (const char*)g.A + (size_t)nxt.pm * tstep : cA; const char* nB = has_next ? (const char*)g.Bt + (size_t)nxt.pn * tstep : cB;
        for (int t = 0; t < nt; t += 2) {
            const bool last = (t == nt - 2);
            const char* a1 = cA + (size_t)(t + 1) * kstep;
            const char* a2 = last ? nA : cA + (size_t)(t + 2) * kstep; const char* b2 = last ? nB : cB + (size_t)(t + 2) * kstep;
            const char* a3 = a2 + kstep; const char* b3 = b2 + kstep;
            if (last && has_next) S.a_ready(nxt);
            if constexpr (SP2) {
            PG8_LDB(B0, 0, 0); PG8_LDB(B1, 0, 1); PG8_SCHED; PG8_LDA(At, 0, 0); PG8_STAGE(PG8_SA(1, 1), a1 + hstep, voffA);
            PG8_WAIT_V(8); PG8_WAIT_L(0); PG8_BAR; PG8_MMA(0, 0, At, B0); PG8_MMA(0, 1, At, B1); PG8_BAR; PG8_SCHED;
            PG8_LDA(At, 0, 1); PG8_STAGE(PG8_SB(0, 0), b2, voffB); PG8_STAGE(PG8_SB(0, 1), b2 + hstep, voffB); PG8_STAGE(PG8_SA(0, 0), a2, voffA);
            PG8_WAIT_V(8); PG8_WAIT_L(0); PG8_BAR; PG8_MMA(1, 0, At, B0); PG8_MMA(1, 1, At, B1); PG8_BAR; PG8_SCHED;
            PG8_LDB(B0, 1, 0); PG8_LDB(B1, 1, 1); PG8_SCHED; PG8_LDA(At, 1, 0); PG8_STAGE(PG8_SA(0, 1), a2 + hstep, voffA);
            PG8_WAIT_V(8); PG8_WAIT_L(0); PG8_BAR; PG8_MMA(0, 0, At, B0); PG8_MMA(0, 1, At, B1); PG8_BAR; PG8_SCHED;
            PG8_LDA(At, 1, 1); PG8_STAGE(PG8_SB(1, 0), b3, voffB); PG8_STAGE(PG8_SB(1, 1), b3 + hstep, voffB); PG8_STAGE(PG8_SA(1, 0), a3, voffA);
            PG8_WAIT_V(8); PG8_WAIT_L(0); PG8_BAR; PG8_MMA(1, 0, At, B0); PG8_MMA(1, 1, At, B1); PG8_BAR; PG8_SCHED;
            } else {
            PG8_LDB(B0, 0, 0); PG8_SCHED; PG8_LDA(At, 0, 0); PG8_STAGE(PG8_SA(1, 1), a1 + hstep, voffA);
            PG8_WAIT_L(8); PG8_BAR; PG8_WAIT_L(0); PG8_MMA(0, 0, At, B0); PG8_BAR; PG8_SCHED;
            PG8_LDB(B1, 0, 1); PG8_STAGE(PG8_SB(0, 0), b2, voffB);
            PG8_BAR; PG8_WAIT_L(0); PG8_MMA(0, 1, At, B1); PG8_BAR;
            PG8_LDA(At, 0, 1); PG8_STAGE(PG8_SA(0, 0), a2, voffA);
            PG8_BAR; PG8_WAIT_L(0); PG8_MMA(1, 0, At, B0); PG8_BAR; PG8_SCHED;
            PG8_STAGE(PG8_SB(0, 1), b2 + hstep, voffB);
            PG8_WAIT_V(6); PG8_BAR; PG8_MMA(1, 1, At, B1); PG8_BAR;
            PG8_LDB(B0, 1, 0); PG8_SCHED; PG8_LDA(At, 1, 0); PG8_STAGE(PG8_SA(0, 1), a2 + hstep, voffA);
            PG8_WAIT_L(8); PG8_BAR; PG8_WAIT_L(0); PG8_MMA(0, 0, At, B0); PG8_BAR; PG8_SCHED;
            PG8_LDB(B1, 1, 1); PG8_STAGE(PG8_SB(1, 0), b3, voffB);
            PG8_BAR; PG8_WAIT_L(0); PG8_MMA(0, 1, At, B1); PG8_BAR;
            PG8_LDA(At, 1, 1); PG8_STAGE(PG8_SA(1, 0), a3, voffA);
            PG8_BAR; PG8_WAIT_L(0); PG8_MMA(1, 0, At, B0); PG8_BAR; PG8_SCHED;
            PG8_STAGE(PG8_SB(1, 1), b3 + hstep, voffB);
            PG8_WAIT_V(6); PG8_BAR; PG8_MMA(1, 1, At, B1); PG8_BAR;
            }
        }
        if constexpr (ALIGN_EPI) { if (wr == 0) PG8_BAR; }
        if constexpr (!Epi::AFTER_DRAIN) { E(acc, cur, wr, wc, fr, fq); S.done(cur); }
        if (!has_next) break;
#pragma unroll
        for (int a = 0; a < 2; ++a)
#pragma unroll
            for (int b = 0; b < 2; ++b)
#pragma unroll
                for (int m = 0; m < 4; ++m)
#pragma unroll
                    for (int n = 0; n < 2; ++n) acc[a][b][m][n] = (f32x4){0.f, 0.f, 0.f, 0.f};
        cur = nxt; cA = nA; cB = nB; ++ui;
        if constexpr (ALIGN_EPI) { if (wr == 1) PG8_BAR; }
    }
    PG8_WAIT_V(0);
    if constexpr (!ALIGN_EPI) { if (wr == 0) PG8_BAR; }
    PG8_BAR;
    if constexpr (Epi::AFTER_DRAIN) { E.fused(acc, cur, wr, wc, fr, fq, lds, wid, lane); S.done(cur); }
#undef PG8_SA
#undef PG8_SB
#undef PG8_STAGE
#undef PG8_LDA
#undef PG8_LDB
#undef PG8_MMA
#undef PG8_WAIT_V
#undef PG8_WAIT_L
#undef PG8_BAR
#undef PG8_SCHED
}
}
constexpr int BATCH = 4, SEQ = 8192, D = 1024, M = BATCH * SEQ, FF = 2816, NGU = 2 * FF, NIN = 1280, NBLK = M / 128, NB_SEQ = SEQ / 128;
constexpr float EPS = 1e-6f;
constexpr float QSCALE = 0.125f * 1.4426950408889634f;
constexpr float LOG2E = 1.4426950408889634f;
constexpr int NWAVES = 8, NTHREADS = 512;
constexpr size_t MiB = 1u << 20;
constexpr size_t WS_WGU1 = 0, WS_WGU2 = 11 * MiB, WS_WD1 = 22 * MiB, WS_WD2 = 28 * MiB, WS_WIN = 34 * MiB, WS_WOUT = 37 * MiB, WS_WPOOL = 39 * MiB, WS_CS = 40 * MiB;
constexpr size_t WS_CTL = 46 * MiB, CTL_BYTES = 16384;
constexpr size_t WS_A = 48 * MiB, WS_HD = 112 * MiB, WS_H = 176 * MiB, WS_Z = 176 * MiB, WS_VT = 256 * MiB, WS_Y = 264 * MiB, WS_END = 352 * MiB;
static_assert((size_t)NGU * D * 2 <= 11 * MiB && (size_t)D * FF * 2 <= 6 * MiB && (size_t)NIN * D * 2 <= 3 * MiB && (size_t)M * 16 * 4 <= 8 * MiB, "ws map");
static_assert(WS_Z + (size_t)M * NIN * 2 <= WS_VT && WS_VT + (size_t)M * 128 * 2 <= WS_Y && WS_Y + (size_t)M * D * 2 <= WS_END && WS_H + (size_t)M * FF * 2 <= WS_END, "ws map 2");
constexpr int LDS_BYTES = 147456;
constexpr int KL_OFF = 0, KL_PITCH = 144, VL_OFF = 36864, VL_PITCH = 520, DL_OFF = 36864 + 33280, DL_PITCH = 272, SS_OFF = DL_OFF + 34816;
static_assert(SS_OFF + 16 * 128 * 4 <= 131072, "mixer LDS");
constexpr int MISC_OFF = 131072 + 320;

#define LAS __attribute__((address_space(3)))
typedef unsigned short bf16;
typedef unsigned u32x4 __attribute__((ext_vector_type(4)));
typedef unsigned u32x2 __attribute__((ext_vector_type(2)));
typedef float f32x4 __attribute__((ext_vector_type(4)));
typedef float f32x16 __attribute__((ext_vector_type(16)));
typedef short bf16x8 __attribute__((ext_vector_type(8)));
using pg8::cvtpk;
__device__ __forceinline__ float bflo(unsigned w) { return __uint_as_float(w << 16); }
__device__ __forceinline__ float bfhi(unsigned w) { return __uint_as_float(w & 0xffff0000u); }
__device__ __forceinline__ float wave_sum(float v) {
#pragma unroll
    for (int o = 1; o < 64; o <<= 1) v += __shfl_xor(v, o);
    return v;
}
__device__ __forceinline__ float half_sum32(float v) {
#pragma unroll
    for (int o = 1; o < 32; o <<= 1) v += __shfl_xor(v, o);
    return v;
}
__device__ __forceinline__ int crow(int r, int hi) { return (r & 3) + 8 * (r >> 2) + 4 * hi; }

struct Args {
    const float* x; const int* pos;
    const float *ffn1_pre, *ffn1_wgu, *ffn1_wd, *ffn1_post, *mix_pre, *w_in, *w_pool, *pool_scale, *sinks, *g_pool, *g_attn, *w_out, *mix_post, *ffn2_pre, *ffn2_wgu, *ffn2_wd, *ffn2_post;
    float* out; unsigned char* ws; int ph_lo, ph_hi;
};

__device__ __forceinline__ int dest_row(int mode, int n) {
    if (mode == 1) { return n < FF ? ((n >> 7) * 256 + (n & 127)) : ((((n - FF) >> 7) * 256) + 128 + ((n - FF) & 127)); }
    if (mode == 2) { if (n >= 512 && n < 1152) { const int d = n & 63; const int p = (d >= 4 && d < 8) ? d + 4 : ((d >= 8 && d < 12) ? d - 4 : d); return (n - d) + p; } return n; }
    return n;
}
__device__ __forceinline__ void transpose_item(const float* W, int K, int N, bf16* WT, int mode, LAS float* scr, int item, int lane) {
    const int nblk = N / 32, kb = item / nblk, nb = item % nblk, k0 = 64 * kb, n0 = 32 * nb;
#pragma unroll 8
    for (int i = 0; i < 32; ++i) { const int kk = 2 * i + (lane >> 5); scr[kk * 33 + (lane & 31)] = W[(size_t)(k0 + kk) * N + n0 + (lane & 31)]; }
    asm volatile("s_waitcnt lgkmcnt(0)" ::: "memory");
    const int c = lane & 7;
#pragma unroll
    for (int j = 0; j < 4; ++j) { const int n = (lane >> 3) + 8 * j; const LAS float* s = scr + (8 * c) * 33 + n;
        u32x4 o; o.x = cvtpk(s[0 * 33], s[1 * 33]); o.y = cvtpk(s[2 * 33], s[3 * 33]); o.z = cvtpk(s[4 * 33], s[5 * 33]); o.w = cvtpk(s[6 * 33], s[7 * 33]);
        *(u32x4*)(WT + (size_t)dest_row(mode, n0 + n) * K + k0 + 8 * c) = o; }
    asm volatile("s_waitcnt lgkmcnt(0)" ::: "memory");
}
__device__ __forceinline__ void sincos_f(float a, float& sn, float& cn) {
    const double ad = (double)a; const double q = __builtin_rint(ad * 0.63661977236758134308);
    const float r = (float)__builtin_fma(-q, 1.57079632679489661923, ad); const int qi = ((int)q) & 3;
    const float z = r * r;
    const float s = r + r * z * (-1.6666654611e-1f + z * (8.3321608736e-3f + z * (-1.9515295891e-4f)));
    const float c = 1.0f - 0.5f * z + z * z * (4.166664568298827e-2f + z * (-1.388731625493765e-3f + z * 2.443315711809948e-5f));
    sn = (qi == 0) ? s : (qi == 1) ? c : (qi == 2) ? -s : -c;
    cn = (qi == 0) ? c : (qi == 1) ? -s : (qi == 2) ? -c : s;
}
__device__ __forceinline__ float inv_freq(int i) {
    return i == 0 ? 1.0f : i == 1 ? 0.19392274474868576f : i == 2 ? 0.03760603093086393f : i == 3 ? 0.007292664737217109f : i == 4 ? 0.001414213562373095f : i == 5 ? 0.0002742481756762073f : i == 6 ? 5.318295896944988e-05f : 1.031338537721246e-05f;
}
__device__ __forceinline__ void prenorm_rows(const float* x, const float* g, bf16* a, int gw, int NGW, int lane) {
    f32x4 gv[4];
#pragma unroll
    for (int j = 0; j < 4; ++j) gv[j] = *((const f32x4*)g + lane + 64 * j);
    for (int m = gw; m < M; m += NGW) {
        const f32x4* xr = (const f32x4*)(x + (size_t)m * D) + lane; f32x4 v[4]; float s = 0.f;
#pragma unroll
        for (int j = 0; j < 4; ++j) { v[j] = xr[64 * j]; s += (v[j].x * v[j].x + v[j].y * v[j].y) + (v[j].z * v[j].z + v[j].w * v[j].w); }
        const float r = 1.0f / sqrtf(wave_sum(s) * (1.0f / D) + EPS);
        u32x2* o = (u32x2*)(a + (size_t)m * D) + lane;
#pragma unroll
        for (int j = 0; j < 4; ++j) { const f32x4 y = v[j] * r * gv[j]; u32x2 w; w.x = cvtpk(y.x, y.y); w.y = cvtpk(y.z, y.w); o[64 * j] = w; }
    }
}
template <bool HAS_A>
__device__ __forceinline__ void thin_rows(const float* xi, float* xo, const bf16* h, const float* gpost, const float* gpre, bf16* a, float coef, int gw, int NGW, int lane) {
    for (int m = gw; m < M; m += NGW) {
        const f32x4* xr = (const f32x4*)(xi + (size_t)m * D) + lane; const u32x2* hr = (const u32x2*)(h + (size_t)m * D) + lane;
        f32x4 v[4], hv[4]; float s = 0.f;
#pragma unroll
        for (int j = 0; j < 4; ++j) { v[j] = xr[64 * j]; const u32x2 w = hr[64 * j]; hv[j] = (f32x4){bflo(w.x), bfhi(w.x), bflo(w.y), bfhi(w.y)};
            s += (hv[j].x * hv[j].x + hv[j].y * hv[j].y) + (hv[j].z * hv[j].z + hv[j].w * hv[j].w); }
        const float r1 = coef / sqrtf(wave_sum(s) * (1.0f / D) + EPS);
        float s2 = 0.f;
#pragma unroll
        for (int j = 0; j < 4; ++j) { const f32x4 gp = *((const f32x4*)gpost + lane + 64 * j); v[j] = v[j] + hv[j] * r1 * gp;
            s2 += (v[j].x * v[j].x + v[j].y * v[j].y) + (v[j].z * v[j].z + v[j].w * v[j].w); }
        f32x4* xw = (f32x4*)(xo + (size_t)m * D) + lane;
#pragma unroll
        for (int j = 0; j < 4; ++j) xw[64 * j] = v[j];
        if (HAS_A) {
            const float r2 = 1.0f / sqrtf(wave_sum(s2) * (1.0f / D) + EPS);
            u32x2* o = (u32x2*)(a + (size_t)m * D) + lane;
#pragma unroll
            for (int j = 0; j < 4; ++j) { const f32x4 gq = *((const f32x4*)gpre + lane + 64 * j); const f32x4 y = v[j] * r2 * gq; u32x2 w; w.x = cvtpk(y.x, y.y); w.y = cvtpk(y.z, y.w); o[64 * j] = w; }
        }
    }
}
#define XB_TMO      128
#define XB_XCNT(j)  (256  + 64 * (j))
#define XB_XSUB(j)  (1280 + 64 * (j))
#define XB_XGEN(j)  (2304 + 64 * (j))
#define XB_TOP      3328
#define XB_TOPGEN   3392
#define XCD_BAR_WORDS 3456
#define XB_SPIN_CAP (1u << 18)

__device__ __forceinline__ unsigned xb_ld(unsigned* p)              { return __hip_atomic_load(p, __ATOMIC_RELAXED, __HIP_MEMORY_SCOPE_AGENT); }
__device__ __forceinline__ unsigned xb_add(unsigned* p, unsigned v) { return __hip_atomic_fetch_add(p, v, __ATOMIC_RELAXED, __HIP_MEMORY_SCOPE_AGENT); }
__device__ __forceinline__ unsigned xb_xcc_id() { return (unsigned)__builtin_amdgcn_s_getreg((3 << 11) | 20) & 0xFu; }
#define XB_SPIN(cond, bar) do { unsigned _sp = 0; while (cond) { __builtin_amdgcn_s_sleep(1); \
    if ((++_sp & 255u) == 0u) { if (xb_ld(&(bar)[XB_TMO])) break; if (_sp > XB_SPIN_CAP) { atomicAdd(&(bar)[XB_TMO], 1u); break; } } } } while (0)

struct XcdBarrier {
    unsigned* bar; unsigned x;
    volatile LAS unsigned* st;
};

__device__ __forceinline__ XcdBarrier xcd_barrier_post(unsigned* bar, volatile LAS unsigned* st) {
    XcdBarrier b; b.bar = bar; b.x = xb_xcc_id(); b.st = st;
    if (threadIdx.x == 0) (void)xb_add(&bar[XB_XCNT(b.x)], 1u);
    return b;
}
__device__ __forceinline__ void xcd_barrier_complete(unsigned* bar, unsigned x, unsigned& nloc, unsigned& nx) {
    const unsigned G = gridDim.x * gridDim.y * gridDim.z;
    unsigned sum, cnt, mine, sp = 0u;
    for (;;) {
        sum = 0u; cnt = 0u; mine = 0u;
#pragma unroll
        for (unsigned j = 0; j < 16; ++j) { const unsigned c = xb_ld(&bar[XB_XCNT(j)]); sum += c; cnt += (c > 0u) ? 1u : 0u; mine = (j == x) ? c : mine; }
        if (sum == G) break;
        __builtin_amdgcn_s_sleep(1);
        if ((++sp & 255u) == 0u) { if (xb_ld(&bar[XB_TMO])) break; if (sp > XB_SPIN_CAP) { atomicAdd(&bar[XB_TMO], 1u); break; } }
    }
    nloc = mine > 0u ? mine : 1u; nx = cnt > 0u ? cnt : 1u;
}

__device__ __forceinline__ void xcd_barrier(const XcdBarrier& b) {
    asm volatile("s_waitcnt vmcnt(0)" ::: "memory");
    __syncthreads();
    if (threadIdx.x == 0) {
        unsigned* bar = b.bar;
        __builtin_amdgcn_s_waitcnt(0);
        unsigned nloc = b.st[0], nx = b.st[1];
        if (nloc == 0u) { xcd_barrier_complete(bar, b.x, nloc, nx); b.st[0] = nloc; b.st[1] = nx; }
        const unsigned old = xb_add(&bar[XB_XSUB(b.x)], 1u);
        const unsigned gen = old / nloc;
        if (old + 1u == (gen + 1u) * nloc) {
            __builtin_amdgcn_fence(__ATOMIC_RELEASE, "agent");
            asm volatile("s_waitcnt vmcnt(0)" ::: "memory");
            const unsigned og = xb_add(&bar[XB_TOP], 1u);
            const unsigned tg = og / nx;
            if (og + 1u == (tg + 1u) * nx) xb_add(&bar[XB_TOPGEN], 1u);
            else XB_SPIN(xb_ld(&bar[XB_TOPGEN]) == tg, bar);
            __builtin_amdgcn_fence(__ATOMIC_ACQUIRE, "agent");
            xb_add(&bar[XB_XGEN(b.x)], 1u);
            asm volatile("s_waitcnt vmcnt(0)" ::: "memory");
        } else {
            XB_SPIN(xb_ld(&bar[XB_XGEN(b.x)]) == gen, bar);
            __builtin_amdgcn_fence(__ATOMIC_ACQUIRE, "agent");
            asm volatile("s_waitcnt vmcnt(0)" ::: "memory");
        }
    }
    __syncthreads();
}
#define MFMA32(a, b, c) __builtin_amdgcn_mfma_f32_32x32x16_bf16((a), (b), (c), 0, 0, 0)
__device__ __forceinline__ void load8(const bf16* p, float (&f)[8]) { const u32x4 w = *(const u32x4*)p;
    f[0] = bflo(w.x); f[1] = bfhi(w.x); f[2] = bflo(w.y); f[3] = bfhi(w.y); f[4] = bflo(w.z); f[5] = bfhi(w.z); f[6] = bflo(w.w); f[7] = bfhi(w.w); }

__device__ __forceinline__ void mixer_block(LAS unsigned char* lds, int blk, const bf16* Z, const bf16* Vt, const bf16* WpT, const float* pool_scale, const float* sinks,
                                            const float* g_pool, const float* g_attn, bf16* Y, int tid, int wid, int lane) {
    const int b = blk / NB_SEQ, n = blk % NB_SEQ;
    const int r32 = lane & 31, hi = lane >> 5, rg = wid & 3, ch = wid >> 2;
    LAS float* SS = (LAS float*)(lds + SS_OFF);
    const size_t rowbase = (size_t)blk * 128;
    for (int g = 0; g < 4; ++g) {
        const int w = 2 << g;
        {
            const int c8 = tid & 15, t0 = (tid >> 4) * 4;
            const bf16* ub = Z + rowbase * NIN + g * 128 + c8 * 8;
            float s[8], uv[8];
#pragma unroll
            for (int i = 0; i < 8; ++i) s[i] = 0.f;
            for (int j = t0 - w + 1; j < t0; ++j) if (n * 128 + j >= 0) { load8(ub + (ptrdiff_t)j * NIN, uv);
#pragma unroll
                for (int i = 0; i < 8; ++i) s[i] += uv[i]; }
            for (int t = t0; t < t0 + 4; ++t) {
                load8(ub + (ptrdiff_t)t * NIN, uv);
#pragma unroll
                for (int i = 0; i < 8; ++i) s[i] += uv[i];
                const int sp = n * 128 + t; const int cnt = (sp + 1 < w) ? sp + 1 : w; const float inv = 1.0f / (float)cnt;
                u32x4 o; o.x = cvtpk(s[0] * inv - uv[0], s[1] * inv - uv[1]); o.y = cvtpk(s[2] * inv - uv[2], s[3] * inv - uv[3]);
                o.z = cvtpk(s[4] * inv - uv[4], s[5] * inv - uv[5]); o.w = cvtpk(s[6] * inv - uv[6], s[7] * inv - uv[7]);
                *(LAS u32x4*)(lds + DL_OFF + t * DL_PITCH + c8 * 16) = o;
                const int jo = t - w + 1;
                if (n * 128 + jo >= 0) { load8(ub + (ptrdiff_t)jo * NIN, uv);
#pragma unroll
                    for (int i = 0; i < 8; ++i) s[i] -= uv[i]; }
            }
        }
        __syncthreads();
        {
            f32x16 a0, a1;
#pragma unroll
            for (int i = 0; i < 16; ++i) { a0[i] = 0.f; a1[i] = 0.f; }
            const bf16* wp = WpT + (size_t)g * 16384 + (size_t)(64 * ch + r32) * 128 + 8 * hi;
#pragma unroll
            for (int ks = 0; ks < 8; ++ks) {
                const bf16x8 A = *(const LAS bf16x8*)(lds + DL_OFF + (32 * rg + r32) * DL_PITCH + (16 * ks + 8 * hi) * 2);
                const bf16x8 B0 = *(const bf16x8*)(wp + 16 * ks), B1 = *(const bf16x8*)(wp + 32 * 128 + 16 * ks);
                a0 = MFMA32(A, B0, a0); a1 = MFMA32(A, B1, a1);
            }
            const int c0 = g * 128 + 64 * ch + r32;
            const float ps0 = pool_scale[c0], ps1 = pool_scale[c0 + 32];
#pragma unroll
            for (int r = 0; r < 16; ++r) { const int row = 32 * rg + crow(r, hi); const float v0 = a0[r] * ps0, v1 = a1[r] * ps1;
                const float q = half_sum32(v0 * v0 + v1 * v1);
                if (r32 == 0) SS[(g * 2 + ch) * 128 + row] = q;
                bf16* yp = Y + (rowbase + row) * D + c0; yp[0] = (bf16)(cvtpk(v0, 0.f) & 0xffffu); yp[32] = (bf16)(cvtpk(v1, 0.f) & 0xffffu); }
        }
        __syncthreads();
    }
    for (int kh = 0; kh < 2; ++kh) {
        for (int i = tid; i < 2048; i += NTHREADS) {
            const int key = i >> 3, c = i & 7; const bool valid = (n > 0) || (key >= 128);
            u32x4 v = (u32x4){0u, 0u, 0u, 0u};
            if (valid) v = *(const u32x4*)(Z + (rowbase + key - 128) * NIN + 1024 + kh * 64 + c * 8);
            *(LAS u32x4*)(lds + KL_OFF + key * KL_PITCH + c * 16) = v;
        }
        for (int i = tid; i < 2048; i += NTHREADS) {
            const int d = i >> 5, c = i & 31; const bool valid = (n > 0) || (c >= 16);
            u32x4 v = (u32x4){0u, 0u, 0u, 0u};
            if (valid) v = *(const u32x4*)(Vt + ((size_t)((b * 2 + kh) * 64 + d)) * SEQ + n * 128 - 128 + c * 8);
            LAS u32x2* dst = (LAS u32x2*)(lds + VL_OFF + d * VL_PITCH + c * 16);
            dst[0] = (u32x2){v.x, v.y}; dst[1] = (u32x2){v.z, v.w};
        }
        __syncthreads();
        for (int gi = 0; gi < 2; ++gi) {
            const int h = kh * 4 + 2 * ch + gi;
            const bf16* qp = Z + (rowbase + 32 * rg + r32) * NIN + 512 + h * 64 + 8 * hi;
            bf16x8 qr[4];
#pragma unroll
            for (int d0 = 0; d0 < 4; ++d0) qr[d0] = *(const bf16x8*)(qp + 16 * d0);
            f32x16 S[5];
#pragma unroll
            for (int t = 0; t < 5; ++t) {
#pragma unroll
                for (int i = 0; i < 16; ++i) S[t][i] = 0.f;
#pragma unroll
                for (int d0 = 0; d0 < 4; ++d0) { const bf16x8 kf = *(const LAS bf16x8*)(lds + KL_OFF + (32 * (rg + t) + r32) * KL_PITCH + (16 * d0 + 8 * hi) * 2);
                    S[t] = MFMA32(kf, qr[d0], S[t]); }
            }
            const int qi = 32 * rg + r32;
            const float sinkl = sinks[h] * LOG2E;
            float mx = sinkl;
#pragma unroll
            for (int t = 0; t < 5; ++t)
#pragma unroll
                for (int r = 0; r < 16; ++r) { const int kj = 32 * (rg + t) + crow(r, hi);
                    const bool valid = (kj > qi) && (kj <= qi + 128) && ((n > 0) || (kj >= 128));
                    const float sv = valid ? S[t][r] : -1e30f; S[t][r] = sv; mx = fmaxf(mx, sv); }
            mx = fmaxf(mx, __shfl_xor(mx, 32));
            float sum = 0.f;
#pragma unroll
            for (int t = 0; t < 5; ++t)
#pragma unroll
                for (int r = 0; r < 16; ++r) { const float p = __builtin_amdgcn_exp2f(S[t][r] - mx); S[t][r] = p; sum += p; }
            sum += __shfl_xor(sum, 32);
            sum += __builtin_amdgcn_exp2f(sinkl - mx);
            const float linv = 1.0f / sum;
            f32x16 o0, o1;
#pragma unroll
            for (int i = 0; i < 16; ++i) { o0[i] = 0.f; o1[i] = 0.f; }
#pragma unroll
            for (int t = 0; t < 5; ++t)
#pragma unroll
                for (int s = 0; s < 2; ++s) {
                    u32x4 pw; pw.x = cvtpk(S[t][8 * s + 0], S[t][8 * s + 1]); pw.y = cvtpk(S[t][8 * s + 2], S[t][8 * s + 3]); pw.z = cvtpk(S[t][8 * s + 4], S[t][8 * s + 5]); pw.w = cvtpk(S[t][8 * s + 6], S[t][8 * s + 7]);
                    const bf16x8 pa = __builtin_bit_cast(bf16x8, pw);
                    const int keyb = 32 * (rg + t) + 16 * s + 4 * hi;
                    const LAS unsigned char* vb = lds + VL_OFF + r32 * VL_PITCH + keyb * 2;
                    const u32x2 l0 = *(const LAS u32x2*)(vb), h0 = *(const LAS u32x2*)(vb + 16);
                    const u32x2 l1 = *(const LAS u32x2*)(vb + 32 * VL_PITCH), h1 = *(const LAS u32x2*)(vb + 32 * VL_PITCH + 16);
                    const bf16x8 v0 = __builtin_bit_cast(bf16x8, ((u32x4){l0.x, l0.y, h0.x, h0.y})), v1 = __builtin_bit_cast(bf16x8, ((u32x4){l1.x, l1.y, h1.x, h1.y}));
                    o0 = MFMA32(pa, v0, o0); o1 = MFMA32(pa, v1, o1);
                }
#pragma unroll
            for (int r = 0; r < 16; ++r) { const int row = 32 * rg + crow(r, hi); const float li = __shfl(linv, crow(r, hi));
                const float v0 = o0[r] * li, v1 = o1[r] * li;
                const float q = half_sum32(v0 * v0 + v1 * v1);
                if (r32 == 0) SS[(8 + h) * 128 + row] = q;
                bf16* yp = Y + (rowbase + row) * D + 512 + h * 64 + r32; yp[0] = (bf16)(cvtpk(v0, 0.f) & 0xffffu); yp[32] = (bf16)(cvtpk(v1, 0.f) & 0xffffu); }
        }
        __syncthreads();
    }
    for (int i = tid; i < 128 * 128; i += NTHREADS) {
        const int row = i >> 7, c = i & 127, col = c * 8, half = col >> 9;
        float ss = 0.f;
#pragma unroll
        for (int k = 0; k < 8; ++k) ss += SS[(half * 8 + k) * 128 + row];
        const float rs = 1.0f / sqrtf(ss * (1.0f / 512.0f) + EPS);
        const float* gp = (half ? g_attn : g_pool) + (col & 511);
        const f32x4 g0 = *(const f32x4*)gp, g1 = *(const f32x4*)(gp + 4);
        bf16* yp = Y + (rowbase + row) * D + col; float f[8]; load8(yp, f);
        u32x4 o; o.x = cvtpk(f[0] * rs * g0.x, f[1] * rs * g0.y); o.y = cvtpk(f[2] * rs * g0.z, f[3] * rs * g0.w); o.z = cvtpk(f[4] * rs * g1.x, f[5] * rs * g1.y); o.w = cvtpk(f[6] * rs * g1.z, f[7] * rs * g1.w);
        *(u32x4*)yp = o;
    }
    __syncthreads();
}
__global__ void __launch_bounds__(NTHREADS, 2) hybrid_fwd(Args args) {
    extern __shared__ __attribute__((aligned(16))) unsigned char lds_raw[];
    LAS unsigned char* lds = (LAS unsigned char*)lds_raw;
    cg::grid_group grid = cg::this_grid();
    const int tid = threadIdx.x, lane = tid & 63, wid = __builtin_amdgcn_readfirstlane(tid >> 6);
    const int G = gridDim.x, bx = blockIdx.x;
    const int vcu = (G % 8 == 0) ? (bx % 8) * (G / 8) + bx / 8 : bx;
    const int gw = vcu * NWAVES + wid, NGW = G * NWAVES;
    unsigned char* ws = args.ws;
    bf16 *Wgu1 = (bf16*)(ws + WS_WGU1), *Wgu2 = (bf16*)(ws + WS_WGU2), *Wd1 = (bf16*)(ws + WS_WD1), *Wd2 = (bf16*)(ws + WS_WD2), *Win = (bf16*)(ws + WS_WIN), *Wout = (bf16*)(ws + WS_WOUT), *WpT = (bf16*)(ws + WS_WPOOL);
    float* CS = (float*)(ws + WS_CS);
    bf16 *A = (bf16*)(ws + WS_A), *HD = (bf16*)(ws + WS_HD), *H = (bf16*)(ws + WS_H), *Z = (bf16*)(ws + WS_Z), *Vt = (bf16*)(ws + WS_VT), *Y = (bf16*)(ws + WS_Y);
    const int lo = args.ph_lo, hi = args.ph_hi;
#define IN(k) (lo <= (k) && (k) < hi)
#define SEAM(k) do { if (IN(k) && IN((k) + 1)) { if ((k) == 0) grid.sync(); else xcd_barrier(bar); } } while (0)
    if (tid < 32) ((LAS unsigned*)(lds + MISC_OFF))[tid] = 0u;
    __syncthreads();
    XcdBarrier bar; bar.bar = (unsigned*)(ws + WS_CTL); bar.x = 0; bar.st = nullptr;
    if (hi - lo > 1) bar = xcd_barrier_post((unsigned*)(ws + WS_CTL), (volatile LAS unsigned*)(lds + MISC_OFF) + 8);

    if (IN(0)) {
        LAS float* scr = (LAS float*)(lds + wid * 16384);
        constexpr int I_GU = (D / 64) * (NGU / 32), I_DN = (FF / 64) * (D / 32), I_IN = (D / 64) * (NIN / 32), I_OUT = (D / 64) * (D / 32), I_PL = 4 * 2 * 4;
        constexpr int NITEMS = 2 * I_GU + 2 * I_DN + I_IN + I_OUT + I_PL;
        for (int it = gw; it < NITEMS; it += NGW) {
            int r = it;
            if (r < I_GU) { transpose_item(args.ffn1_wgu, D, NGU, Wgu1, 1, scr, r, lane); continue; } r -= I_GU;
            if (r < I_GU) { transpose_item(args.ffn2_wgu, D, NGU, Wgu2, 1, scr, r, lane); continue; } r -= I_GU;
            if (r < I_DN) { transpose_item(args.ffn1_wd, FF, D, Wd1, 0, scr, r, lane); continue; } r -= I_DN;
            if (r < I_DN) { transpose_item(args.ffn2_wd, FF, D, Wd2, 0, scr, r, lane); continue; } r -= I_DN;
            if (r < I_IN) { transpose_item(args.w_in, D, NIN, Win, 2, scr, r, lane); continue; } r -= I_IN;
            if (r < I_OUT) { transpose_item(args.w_out, D, D, Wout, 0, scr, r, lane); continue; } r -= I_OUT;
            { const int g = r >> 3; transpose_item(args.w_pool + (size_t)g * 16384, 128, 128, WpT + (size_t)g * 16384, 0, scr, r & 7, lane); }
        }
        for (int idx = vcu * NTHREADS + tid; idx < M * 8; idx += G * NTHREADS) {
            const int row = idx >> 3, i = idx & 7; const float ang = (float)args.pos[row] * inv_freq(i);
            float sn, cn; sincos_f(ang, sn, cn); CS[(size_t)row * 16 + i] = cn; CS[(size_t)row * 16 + 8 + i] = sn;
        }
        prenorm_rows(args.x, args.ffn1_pre, A, gw, NGW, lane);
    }
    SEAM(0);
    if (IN(1)) {
        pg8::Gemm g{A, Wgu1, M, NGU, D}; pg8::StaticOrder S; S.init(M, NGU, G, bx); pg8::EpiSwiGLU E{H, FF};
        pg8::gemm_phase<pg8::EpiSwiGLU, pg8::StaticOrder, true, true>(lds, g, S, E);
    }
    SEAM(1);
    if (IN(2)) {
        pg8::Gemm g{H, Wd1, M, D, FF}; pg8::StaticOrder S; S.init(M, D, G, bx); pg8::EpiBf16<0> E{HD, D, nullptr, 0, 0, 1.f};
        pg8::gemm_phase<pg8::EpiBf16<0>, pg8::StaticOrder, true, true>(lds, g, S, E);
    }
    SEAM(2);
    if (IN(3)) thin_rows<true>(args.x, args.out, HD, args.ffn1_post, args.mix_pre, A, 0.5f, gw, NGW, lane);
    SEAM(3);
    if (IN(4)) {
        pg8::Gemm g{A, Win, M, NIN, D}; pg8::StaticOrder S; S.init(M, NIN, G, bx); pg8::EpiZ E{Z, Vt, CS, QSCALE, SEQ};
        pg8::gemm_phase<pg8::EpiZ, pg8::StaticOrder, true, true>(lds, g, S, E);
    }
    SEAM(4);
    if (IN(5)) { for (int blk = vcu; blk < NBLK; blk += G) mixer_block(lds, blk, Z, Vt, WpT, args.pool_scale, args.sinks, args.g_pool, args.g_attn, Y, tid, wid, lane); }
    SEAM(5);
    if (IN(6)) {
        pg8::Gemm g{Y, Wout, M, D, D}; pg8::StaticOrder S; S.init(M, D, G, bx); pg8::EpiBf16<0> E{HD, D, nullptr, 0, 0, 1.f};
        pg8::gemm_phase<pg8::EpiBf16<0>, pg8::StaticOrder, true, true>(lds, g, S, E);
    }
    SEAM(6);
    if (IN(7)) thin_rows<true>(args.out, args.out, HD, args.mix_post, args.ffn2_pre, A, 1.0f, gw, NGW, lane);
    SEAM(7);
    if (IN(8)) {
        pg8::Gemm g{A, Wgu2, M, NGU, D}; pg8::StaticOrder S; S.init(M, NGU, G, bx); pg8::EpiSwiGLU E{H, FF};
        pg8::gemm_phase<pg8::EpiSwiGLU, pg8::StaticOrder, true, true>(lds, g, S, E);
    }
    SEAM(8);
    if (IN(9)) {
        pg8::Gemm g{H, Wd2, M, D, FF}; pg8::StaticOrder S; S.init(M, D, G, bx); pg8::EpiBf16<0> E{HD, D, nullptr, 0, 0, 1.f};
        pg8::gemm_phase<pg8::EpiBf16<0>, pg8::StaticOrder, true, true>(lds, g, S, E);
    }
    SEAM(9);
    if (IN(10)) thin_rows<false>(args.out, args.out, HD, args.ffn2_post, nullptr, nullptr, 0.5f, gw, NGW, lane);
#undef IN
#undef SEAM
}

#ifndef MK_N_LAUNCHES
#define MK_N_LAUNCHES 1
#endif
extern "C" void kernel_launch(void* const* d_in, const int* in_sizes, int n_in, void* d_out, int out_size, void* d_ws, size_t ws_size, hipStream_t stream) {
    static int grid = 0;
    if (grid == 0) {
        if (n_in != 19 || in_sizes[0] != M * D || out_size != M * D || ws_size < WS_END) { fprintf(stderr, "kernel_launch: unexpected shapes (n_in %d, in0 %d, out %d, ws %zu)\n", n_in, n_in > 0 ? in_sizes[0] : -1, out_size, ws_size); grid = -1; return; }
        int dev = 0, cus = 0, per_cu = 0;
        if (hipGetDevice(&dev) != hipSuccess || hipDeviceGetAttribute(&cus, hipDeviceAttributeMultiprocessorCount, dev) != hipSuccess) { grid = -1; return; }
        if (hipFuncSetAttribute((const void*)hybrid_fwd, hipFuncAttributeMaxDynamicSharedMemorySize, LDS_BYTES) != hipSuccess) { fprintf(stderr, "kernel_launch: hipFuncSetAttribute failed\n"); grid = -1; return; }
        if (hipOccupancyMaxActiveBlocksPerMultiprocessor(&per_cu, (const void*)hybrid_fwd, NTHREADS, LDS_BYTES) != hipSuccess || per_cu < 1) { fprintf(stderr, "kernel_launch: occupancy query says %d\n", per_cu); per_cu = 1; }
        (void)hipGetLastError();
        grid = cus * 1;
    }
    if (grid < 0) return;
    if (hipMemsetAsync((char*)d_ws + WS_CTL, 0, CTL_BYTES, stream) != hipSuccess) { fprintf(stderr, "kernel_launch: memset failed\n"); return; }
    Args a{};
    a.x = (const float*)d_in[0]; a.pos = (const int*)d_in[1];
    a.ffn1_pre = (const float*)d_in[2]; a.ffn1_wgu = (const float*)d_in[3]; a.ffn1_wd = (const float*)d_in[4]; a.ffn1_post = (const float*)d_in[5];
    a.mix_pre = (const float*)d_in[6]; a.w_in = (const float*)d_in[7]; a.w_pool = (const float*)d_in[8]; a.pool_scale = (const float*)d_in[9]; a.sinks = (const float*)d_in[10];
    a.g_pool = (const float*)d_in[11]; a.g_attn = (const float*)d_in[12]; a.w_out = (const float*)d_in[13]; a.mix_post = (const float*)d_in[14];
    a.ffn2_pre = (const float*)d_in[15]; a.ffn2_wgu = (const float*)d_in[16]; a.ffn2_wd = (const float*)d_in[17]; a.ffn2_post = (const float*)d_in[18];
    a.out = (float*)d_out; a.ws = (unsigned char*)d_ws;
    constexpr int NPH = 11;
#if MK_N_LAUNCHES == 1
    a.ph_lo = 0; a.ph_hi = NPH;
    { void* kargs[] = {&a}; hipError_t e = hipLaunchCooperativeKernel((const void*)hybrid_fwd, dim3(grid), dim3(NTHREADS), kargs, LDS_BYTES, stream);
      if (e != hipSuccess) fprintf(stderr, "kernel_launch: cooperative launch failed: %s (grid %d)\n", hipGetErrorString(e), grid); }
#else
    for (int p = 0; p < NPH; ++p) { a.ph_lo = p; a.ph_hi = p + 1; void* kargs[] = {&a};
        hipError_t e = hipLaunchCooperativeKernel((const void*)hybrid_fwd, dim3(grid), dim3(NTHREADS), kargs, LDS_BYTES, stream);
        if (e != hipSuccess) { fprintf(stderr, "kernel_launch: launch %d failed: %s\n", p, hipGetErrorString(e)); break; } }
#endif
}
```

```cpp
#include <hip/hip_runtime.h>
#include <hip/hip_cooperative_groups.h>
#include <cstdio>
#include <cstdint>
namespace cg = cooperative_groups;
namespace pg8 {
#define PG8_LAS __attribute__((address_space(3)))
typedef unsigned short bf16_t;
typedef short bf16x8 __attribute__((ext_vector_type(8)));
typedef float f32x4 __attribute__((ext_vector_type(4)));
typedef unsigned u32x4 __attribute__((ext_vector_type(4)));
constexpr int BM = 256, BK = 64, HALF = 128, HTB = HALF * BK * 2  , STAGE_BYTES = 8 * HTB, NXCD = 8, WGM = 8;

__host__ __device__ __forceinline__ int lds_byte(int r, int c) { const int st = (r >> 4) * 2 + (c >> 5), rr = r & 15, cc = c & 31, ob = rr * 64 + cc * 2; return st * 1024 + (ob ^ (((ob >> 9) & 1) << 5)); }
__host__ __device__ __forceinline__ void stage_rc(int b, int& R, int& C) { const int st = b / 1024, sb = b % 1024, swz = sb ^ (((sb >> 9) & 1) << 5); R = (st >> 1) * 16 + swz / 64; C = (st & 1) * 32 + (swz % 64) / 2; }
__host__ __device__ __forceinline__ int perm32(int rho) { const int n = rho >> 4, i = rho & 15; return 8 * (i >> 2) + 4 * n + (i & 3); }

struct Unit { int pm, pn; };
struct Gemm { const bf16_t* A; const bf16_t* Bt; int M, N, K; };

struct StaticOrder {
    int nM, nN, nwg, G, c;
    __host__ __device__ void init(int M, int N, int G_, int c_) { nM = M / BM; nN = N / BM; nwg = nM * nN; G = G_; c = c_; }
    __host__ __device__ bool next(int i, Unit& u) const {
        const long L = (long)i * G + c; if (L >= nwg) return false;
        int wgid = (int)L; { const int q = nwg / NXCD, r = nwg % NXCD, xcd = wgid % NXCD, off = wgid / NXCD; wgid = (xcd < r ? xcd * (q + 1) : r * (q + 1) + (xcd - r) * q) + off; }
        const int nig = WGM * nN, gid = wgid / nig, fm = gid * WGM, gsz = (nM - fm) < WGM ? (nM - fm) : WGM;
        u.pm = fm + ((wgid % nig) % gsz); u.pn = (wgid % nig) / gsz; return true;
    }
    __device__ __forceinline__ void a_ready(const Unit&) const {}
    __device__ __forceinline__ void done(const Unit&) const {}
};

__device__ __forceinline__ unsigned cvt_pk_bf16(float lo, float hi) { unsigned r; asm volatile("v_cvt_pk_bf16_f32 %0, %1, %2" : "=v"(r) : "v"(lo), "v"(hi)); return r; }
typedef float f32x2 __attribute__((ext_vector_type(2)));
__device__ __forceinline__ f32x2 gelu_pk(f32x2 v) {
    const f32x2 av = __builtin_elementwise_abs(v), d = av * 0.2316418882f + 1.0f;
    f32x2 t; t.x = __builtin_amdgcn_rcpf(d.x); t.y = __builtin_amdgcn_rcpf(d.y);
    f32x2 q = t * 0.5307027145f + (-0.7265760135f); q = q * t + 0.7107068705f; q = q * t + (-0.142248368f); q = q * t + 0.127414796f; q = q * t;
    const f32x2 s = (v * v) * (-0.72134752044f);
    f32x2 e; e.x = __builtin_amdgcn_exp2f(s.x); e.y = __builtin_amdgcn_exp2f(s.y);
    const f32x2 m = v * (q * e), r = v - m;
    f32x2 o; o.x = v.x < 0.f ? m.x : r.x; o.y = v.y < 0.f ? m.y : r.y; return o;
}

template <int ACT  > struct EpiBf16 {
    static constexpr bool PERM = true, AFTER_DRAIN = false; static_assert(ACT == 0 || ACT == 1, "EpiBf16: ACT is 0 (none) or 1 (gelu_pk)");
    bf16_t* O; int ldc; const float* bias; int split_cols; size_t split_stride; float scale0;
    __device__ __forceinline__ void operator()(const f32x4 (&acc)[2][2][4][2], const Unit& u, int wr, int wc, int fr, int fq) const {
        const int row0 = u.pm * BM + wr * 64 + fr; int colt = u.pn * BM; bf16_t* base = O;
        float sc = 1.f; if (split_cols) { const int t = colt / split_cols; base += (size_t)t * split_stride; colt -= t * split_cols; if (t == 0) sc = scale0; }
        const int col0 = colt + wc * 32 + 8 * fq, bcol0 = u.pn * BM + wc * 32 + 8 * fq;
        f32x4 bv[2][2];
#pragma unroll
        for (int bj = 0; bj < 2; ++bj)
#pragma unroll
            for (int n = 0; n < 2; ++n) bv[bj][n] = bias ? *(const f32x4*)(bias + bcol0 + bj * HALF + 4 * n) : (f32x4){0.f, 0.f, 0.f, 0.f};
#pragma unroll
        for (int ai = 0; ai < 2; ++ai)
#pragma unroll
            for (int m = 0; m < 4; ++m) { bf16_t* rowp = base + (size_t)(row0 + ai * HALF + m * 16) * ldc + col0;
#pragma unroll
                for (int bj = 0; bj < 2; ++bj) { f32x4 v0 = acc[ai][bj][m][0] + bv[bj][0], v1 = acc[ai][bj][m][1] + bv[bj][1];
                    if (ACT == 1) { f32x2 a = gelu_pk((f32x2){v0[0], v0[1]}), b = gelu_pk((f32x2){v0[2], v0[3]}), c = gelu_pk((f32x2){v1[0], v1[1]}), d = gelu_pk((f32x2){v1[2], v1[3]});
                        v0 = (f32x4){a.x, a.y, b.x, b.y}; v1 = (f32x4){c.x, c.y, d.x, d.y}; }
                    v0 = v0 * sc; v1 = v1 * sc; u32x4 w; w.x = cvt_pk_bf16(v0[0], v0[1]); w.y = cvt_pk_bf16(v0[2], v0[3]); w.z = cvt_pk_bf16(v1[0], v1[1]); w.w = cvt_pk_bf16(v1[2], v1[3]);
                    *(u32x4*)(rowp + bj * HALF) = w; } }
    }
};
typedef __bf16 bf16x2_t __attribute__((ext_vector_type(2)));
__device__ __forceinline__ unsigned cvtpk(float lo, float hi) { f32x2 v = {lo, hi}; bf16x2_t b = __builtin_convertvector(v, bf16x2_t); return __builtin_bit_cast(unsigned, b); }
__device__ __forceinline__ float silu_mul(float g, float u) { const float e = __builtin_amdgcn_exp2f(-1.4426950408889634f * g); return g * __builtin_amdgcn_rcpf(1.0f + e) * u; }

struct EpiSwiGLU {
    static constexpr bool PERM = true, AFTER_DRAIN = false;
    bf16_t* O; int ldc;
    __device__ __forceinline__ void operator()(const f32x4 (&acc)[2][2][4][2], const Unit& u, int wr, int wc, int fr, int fq) const {
        const int row0 = u.pm * BM + wr * 64 + fr, col0 = u.pn * HALF + wc * 32 + 8 * fq;
#pragma unroll
        for (int ai = 0; ai < 2; ++ai)
#pragma unroll
            for (int m = 0; m < 4; ++m) { bf16_t* rowp = O + (size_t)(row0 + ai * HALF + m * 16) * ldc + col0;
                const f32x4 g0 = acc[ai][0][m][0], g1 = acc[ai][0][m][1], u0 = acc[ai][1][m][0], u1 = acc[ai][1][m][1];
                u32x4 w; w.x = cvtpk(silu_mul(g0[0], u0[0]), silu_mul(g0[1], u0[1])); w.y = cvtpk(silu_mul(g0[2], u0[2]), silu_mul(g0[3], u0[3]));
                w.z = cvtpk(silu_mul(g1[0], u1[0]), silu_mul(g1[1], u1[1])); w.w = cvtpk(silu_mul(g1[2], u1[2]), silu_mul(g1[3], u1[3]));
                *(u32x4*)rowp = w; }
    }
};
struct EpiZ {
    static constexpr bool PERM = true, AFTER_DRAIN = false;
    bf16_t* Z; bf16_t* Vt; const float* cs; float qscale; int seq;
    __device__ __forceinline__ void operator()(const f32x4 (&acc)[2][2][4][2], const Unit& u, int wr, int wc, int fr, int fq) const {
        const int row0 = u.pm * BM + wr * 64 + fr, cl = wc * 32 + 8 * fq;
#pragma unroll
        for (int bj = 0; bj < 2; ++bj) {
            const int colh = u.pn * BM + bj * HALF;
            const bool isV = (colh == 1152);
            const bool rope = (colh >= 512) && (colh < 1152) && ((wc & 1) == 0) && (fq < 2);
            const float sc = (colh >= 512 && colh < 1024) ? qscale : 1.0f;
#pragma unroll
            for (int ai = 0; ai < 2; ++ai)
#pragma unroll
                for (int m = 0; m < 4; ++m) { const int row = row0 + ai * HALF + m * 16;
                    f32x4 v0 = acc[ai][bj][m][0], v1 = acc[ai][bj][m][1];
                    if (isV) {
                        const int b = row / seq, s = row - b * seq;
#pragma unroll
                        for (int i = 0; i < 4; ++i) { const int c0 = cl + i, c1 = cl + 4 + i;
                            Vt[((size_t)((b * 2 + (c0 >> 6)) * 64 + (c0 & 63))) * seq + s] = (bf16_t)(cvtpk(v0[i], 0.f) & 0xffffu);
                            Vt[((size_t)((b * 2 + (c1 >> 6)) * 64 + (c1 & 63))) * seq + s] = (bf16_t)(cvtpk(v1[i], 0.f) & 0xffffu); }
                    } else {
                        if (rope) { const f32x4 c = *(const f32x4*)(cs + (size_t)row * 16 + 4 * fq), sn = *(const f32x4*)(cs + (size_t)row * 16 + 8 + 4 * fq);
                            const f32x4 n0 = v0 * c - v1 * sn, n1 = v1 * c + v0 * sn; v0 = n0; v1 = n1; }
                        v0 = v0 * sc; v1 = v1 * sc;
                        u32x4 w; w.x = cvtpk(v0[0], v0[1]); w.y = cvtpk(v0[2], v0[3]); w.z = cvtpk(v1[0], v1[1]); w.w = cvtpk(v1[2], v1[3]);
                        *(u32x4*)(Z + (size_t)row * 1280 + colh + cl) = w; }
                }
        }
    }
};
template <class Epi, class Sched, bool ALIGN_EPI = false, bool SP2 = false>
__device__ __forceinline__ void gemm_phase(PG8_LAS unsigned char* lds, const Gemm g, const Sched& S, const Epi& E) {
    const int tid = threadIdx.x, wid = __builtin_amdgcn_readfirstlane(tid >> 6), lane = tid & 63, wr = wid >> 2, wc = wid & 3, fr = lane & 15, fq = lane >> 4;
    const int K = g.K, nt = K / BK;
    unsigned voffA[2], voffB[2];
#pragma unroll
    for (int i = 0; i < 2; ++i) { int R, C; stage_rc(tid * 16 + i * 8192, R, C); const int Rb = Epi::PERM ? ((R & ~31) + perm32(R & 31)) : R;
        voffA[i] = (unsigned)(R * K + C) * 2u; voffB[i] = (unsigned)(Rb * K + C) * 2u; }
    const size_t kstep = (size_t)(BK * 2);
    const size_t hstep = (size_t)HALF * K * 2;
    const size_t tstep = 2 * hstep;
    const unsigned ldsw = (unsigned)wid * 1024u;
    const int aoff = lds_byte(wr * 64 + fr, fq * 8), boff = lds_byte(wc * 32 + fr, fq * 8);
#define PG8_SA(b, h) (((b) * 2 + (h)) * HTB)
#define PG8_SB(b, h) ((4 + (b) * 2 + (h)) * HTB)
#define PG8_STAGE(bufoff, gbase, voff) do { _Pragma("unroll") for (int _i = 0; _i < 2; ++_i) \
        __builtin_amdgcn_global_load_lds((const unsigned*)((const char*)(gbase) + (voff)[_i]), (PG8_LAS unsigned*)(lds + (bufoff) + ldsw + _i * 8192), 16, 0, 0); } while (0)
#define PG8_LDA(dst, b, h) do { _Pragma("unroll") for (int m = 0; m < 4; ++m) _Pragma("unroll") for (int k = 0; k < 2; ++k) dst[m][k] = *(const PG8_LAS bf16x8*)(lds + PG8_SA(b, h) + aoff + m * 2048 + k * 1024); } while (0)
#define PG8_LDB(dst, b, h) do { _Pragma("unroll") for (int n = 0; n < 2; ++n) _Pragma("unroll") for (int k = 0; k < 2; ++k) dst[n][k] = *(const PG8_LAS bf16x8*)(lds + PG8_SB(b, h) + boff + n * 2048 + k * 1024); } while (0)
#define PG8_MMA(ai, bj, At, Bt) do { __builtin_amdgcn_s_setprio(1); _Pragma("unroll") for (int m = 0; m < 4; ++m) _Pragma("unroll") for (int n = 0; n < 2; ++n) _Pragma("unroll") for (int k = 0; k < 2; ++k) \
        acc[ai][bj][m][n] = __builtin_amdgcn_mfma_f32_16x16x32_bf16(Bt[n][k], At[m][k], acc[ai][bj][m][n], 0, 0, 0); __builtin_amdgcn_s_setprio(0); } while (0)
#define PG8_WAIT_V(n) asm volatile("s_waitcnt vmcnt(" #n ")" ::: "memory")
#define PG8_WAIT_L(n) asm volatile("s_waitcnt lgkmcnt(" #n ")" ::: "memory")
#define PG8_BAR __builtin_amdgcn_s_barrier()
#define PG8_SCHED __builtin_amdgcn_sched_barrier(0)
    Unit cur, nxt; int ui = 0;
    if (!S.next(0, cur)) return;
    f32x4 acc[2][2][4][2];
#pragma unroll
    for (int a = 0; a < 2; ++a)
#pragma unroll
        for (int b = 0; b < 2; ++b)
#pragma unroll
            for (int m = 0; m < 4; ++m)
#pragma unroll
                for (int n = 0; n < 2; ++n) acc[a][b][m][n] = (f32x4){0.f, 0.f, 0.f, 0.f};
    bf16x8 At[4][2], B0[2][2], B1[2][2];
    const char* cA = (const char*)g.A + (size_t)cur.pm * tstep; const char* cB = (const char*)g.Bt + (size_t)cur.pn * tstep;
    S.a_ready(cur);
    if constexpr (SP2) {
        PG8_STAGE(PG8_SB(0, 0), cB, voffB); PG8_STAGE(PG8_SB(0, 1), cB + hstep, voffB); PG8_STAGE(PG8_SA(0, 0), cA, voffA); PG8_STAGE(PG8_SA(0, 1), cA + hstep, voffA);
        if (wr == 1) PG8_BAR;
        PG8_WAIT_V(2); PG8_BAR;
        PG8_STAGE(PG8_SB(1, 0), cB + kstep, voffB); PG8_STAGE(PG8_SA(1, 0), cA + kstep, voffA); PG8_STAGE(PG8_SB(1, 1), cB + hstep + kstep, voffB);
        PG8_WAIT_V(6); PG8_BAR;
    } else {
        PG8_STAGE(PG8_SB(0, 0), cB, voffB); PG8_STAGE(PG8_SA(0, 0), cA, voffA); PG8_STAGE(PG8_SB(0, 1), cB + hstep, voffB); PG8_STAGE(PG8_SA(0, 1), cA + hstep, voffA);
        if (wr == 1) PG8_BAR;
        PG8_WAIT_V(4); PG8_BAR;
        PG8_STAGE(PG8_SB(1, 0), cB + kstep, voffB); PG8_STAGE(PG8_SA(1, 0), cA + kstep, voffA); PG8_STAGE(PG8_SB(1, 1), cB + hstep + kstep, voffB);
        PG8_WAIT_V(6); PG8_BAR;
    }
    for (;;) {
        const bool has_next = S.next(ui + 1, nxt);
        const char* nA = has_next ? (const char*)g.A + (size_t)nxt.pm * tstep : cA; const char* nB = has_next ? (const char*)g.Bt + (size_t)nxt.pn * tstep : cB;
        for (int t = 0; t < nt; t += 2) {
            const bool last = (t == nt - 2);
            const char* a1 = cA + (size_t)(t + 1) * kstep;
            const char* a2 = last ? nA : cA + (size_t)(t + 2) * kstep; const char* b2 = last ? nB : cB + (size_t)(t + 2) * kstep;
            const char* a3 = a2 + kstep; const char* b3 = b2 + kstep;
            if (last && has_next) S.a_ready(nxt);
            if constexpr (SP2) {
            PG8_LDB(B0, 0, 0); PG8_LDB(B1, 0, 1); PG8_SCHED; PG8_LDA(At, 0, 0); PG8_STAGE(PG8_SA(1, 1), a1 + hstep, voffA);
            PG8_WAIT_V(8); PG8_WAIT_L(0); PG8_BAR; PG8_MMA(0, 0, At, B0); PG8_MMA(0, 1, At, B1); PG8_BAR; PG8_SCHED;
            PG8_LDA(At, 0, 1); PG8_STAGE(PG8_SB(0, 0), b2, voffB); PG8_STAGE(PG8_SB(0, 1), b2 + hstep, voffB); PG8_STAGE(PG8_SA(0, 0), a2, voffA);
            PG8_WAIT_V(8); PG8_WAIT_L(0); PG8_BAR; PG8_MMA(1, 0, At, B0); PG8_MMA(1, 1, At, B1); PG8_BAR; PG8_SCHED;
            PG8_LDB(B0, 1, 0); PG8_LDB(B1, 1, 1); PG8_SCHED; PG8_LDA(At, 1, 0); PG8_STAGE(PG8_SA(0, 1), a2 + hstep, voffA);
            PG8_WAIT_V(8); PG8_WAIT_L(0); PG8_BAR; PG8_MMA(0, 0, At, B0); PG8_MMA(0, 1, At, B1); PG8_BAR; PG8_SCHED;
            PG8_LDA(At, 1, 1); PG8_STAGE(PG8_SB(1, 0), b3, voffB); PG8_STAGE(PG8_SB(1, 1), b3 + hstep, voffB); PG8_STAGE(PG8_SA(1, 0), a3, voffA);
            PG8_WAIT_V(8); PG8_WAIT_L(0); PG8_BAR; PG8_MMA(1, 0, At, B0); PG8_MMA(1, 1, At, B1); PG8_BAR; PG8_SCHED;
            } else {
            PG8_LDB(B0, 0, 0); PG8_SCHED; PG8_LDA(At, 0, 0); PG8_STAGE(PG8_SA(1, 1), a1 + hstep, voffA);
            PG8_WAIT_L(8); PG8_BAR; PG8_WAIT_L(0); PG8_MMA(0, 0, At, B0); PG8_BAR; PG8_SCHED;
            PG8_LDB(B1, 0, 1); PG8_STAGE(PG8_SB(0, 0), b2, voffB);
            PG8_BAR; PG8_WAIT_L(0); PG8_MMA(0, 1, At, B1); PG8_BAR;
            PG8_LDA(At, 0, 1); PG8_STAGE(PG8_SA(0, 0), a2, voffA);
            PG8_BAR; PG8_WAIT_L(0); PG8_MMA(1, 0, At, B0); PG8_BAR; PG8_SCHED;
            PG8_STAGE(PG8_SB(0, 1), b2 + hstep, voffB);
            PG8_WAIT_V(6); PG8_BAR; PG8_MMA(1, 1, At, B1); PG8_BAR;
            PG8_LDB(B0, 1, 0); PG8_SCHED; PG8_LDA(At, 1, 0); PG8_STAGE(PG8_SA(0, 1), a2 + hstep, voffA);
            PG8_WAIT_L(8); PG8_BAR; PG8_WAIT_L(0); PG8_MMA(0, 0, At, B0); PG8_BAR; PG8_SCHED;
            PG8_LDB(B1, 1, 1); PG8_STAGE(PG8_SB(1, 0), b3, voffB);
            PG8_BAR; PG8_WAIT_L(0); PG8_MMA(0, 1, At, B1); PG8_BAR;
            PG8_LDA(At, 1, 1); PG8_STAGE(PG8_SA(1, 0), a3, voffA);
            PG8_BAR; PG8_WAIT_L(0); PG8_MMA(1, 0, At, B0); PG8_BAR; PG8_SCHED;
            PG8_STAGE(PG8_SB(1, 1), b3 + hstep, voffB);
            PG8_WAIT_V(6); PG8_BAR; PG8_MMA(1, 1, At, B1); PG8_BAR;
            }
        }
        if constexpr (ALIGN_EPI) { if (wr == 0) PG8_BAR; }
        if constexpr (!Epi::AFTER_DRAIN) { E(acc, cur, wr, wc, fr, fq); S.done(cur); }
        if (!has_next) break;
#pragma unroll
        for (int a = 0; a < 2; ++a)
#pragma unroll
            for (int b = 0; b < 2; ++b)
#pragma unroll
                for (int m = 0; m < 4; ++m)
#pragma unroll
                    for (int n = 0; n < 2; ++n) acc[a][b][m][n] = (f32x4){0.f, 0.f, 0.f, 0.f};
        cur = nxt; cA = nA; cB = nB; ++ui;
        if constexpr (ALIGN_EPI) { if (wr == 1) PG8_BAR; }
    }
    PG8_WAIT_V(0);
    if constexpr (!ALIGN_EPI) { if (wr == 0) PG8_BAR; }
    PG8_BAR;
    if constexpr (Epi::AFTER_DRAIN) { E.fused(acc, cur, wr, wc, fr, fq, lds, wid, lane); S.done(cur); }
#undef PG8_SA
#undef PG8_SB
#undef PG8_STAGE
#undef PG8_LDA
#undef PG8_LDB
#undef PG8_MMA
#undef PG8_WAIT_V
#undef PG8_WAIT_L
#undef PG8_BAR
#undef PG8_SCHED
}
}
constexpr int BATCH = 4, SEQ = 8192, D = 1024, M = BATCH * SEQ, FF = 2816, NGU = 2 * FF, NIN = 1280, NBLK = M / 128, NB_SEQ = SEQ / 128;
constexpr float EPS = 1e-6f;
constexpr float QSCALE = 0.125f * 1.4426950408889634f;
constexpr float LOG2E = 1.4426950408889634f;
constexpr int NWAVES = 8, NTHREADS = 512;
constexpr size_t MiB = 1u << 20;
constexpr size_t WS_WGU1 = 0, WS_WGU2 = 11 * MiB, WS_WD1 = 22 * MiB, WS_WD2 = 28 * MiB, WS_WIN = 34 * MiB, WS_WOUT = 37 * MiB, WS_WPOOL = 39 * MiB, WS_CS = 40 * MiB;
constexpr size_t WS_CTL = 46 * MiB, CTL_BYTES = 16384;
constexpr size_t WS_A = 48 * MiB, WS_HD = 112 * MiB, WS_H = 176 * MiB, WS_Z = 176 * MiB, WS_VT = 256 * MiB, WS_Y = 264 * MiB, WS_XR = 352 * MiB, WS_END = 416 * MiB;
static_assert((size_t)NGU * D * 2 <= 11 * MiB && (size_t)D * FF * 2 <= 6 * MiB && (size_t)NIN * D * 2 <= 3 * MiB && (size_t)M * 16 * 4 <= 8 * MiB, "ws map");
static_assert(WS_Z + (size_t)M * NIN * 2 <= WS_VT && WS_VT + (size_t)M * 128 * 2 <= WS_Y && WS_Y + (size_t)M * D * 2 <= WS_END && WS_H + (size_t)M * FF * 2 <= WS_XR && WS_XR + (size_t)M * D * 2 <= WS_END, "ws map 2");
constexpr int LDS_BYTES = 147456;
constexpr int KL_OFF = 0, KL_PITCH = 144, VL_OFF = 36864, VL_PITCH = 520, DL_OFF = 36864 + 33280, DL_PITCH = 272, SS_OFF = DL_OFF + 34816;
constexpr int UL_OFF = 0, UL_PITCH = 272, UL_ROWS = 143;
static_assert(UL_OFF + UL_ROWS * UL_PITCH <= DL_OFF, "U tile overlays K|V only");
static_assert(SS_OFF + 16 * 128 * 4 <= 131072, "mixer LDS");
constexpr int MISC_OFF = 131072 + 320;

#define LAS __attribute__((address_space(3)))
typedef unsigned short bf16;
typedef unsigned u32x4 __attribute__((ext_vector_type(4)));
typedef unsigned u32x2 __attribute__((ext_vector_type(2)));
typedef float f32x4 __attribute__((ext_vector_type(4)));
typedef float f32x16 __attribute__((ext_vector_type(16)));
typedef short bf16x8 __attribute__((ext_vector_type(8)));
using pg8::cvtpk;
__device__ __forceinline__ float bflo(unsigned w) { return __uint_as_float(w << 16); }
__device__ __forceinline__ float bfhi(unsigned w) { return __uint_as_float(w & 0xffff0000u); }
__device__ __forceinline__ float wave_sum(float v) {
#pragma unroll
    for (int o = 1; o < 64; o <<= 1) v += __shfl_xor(v, o);
    return v;
}
__device__ __forceinline__ float half_sum32(float v) {
#pragma unroll
    for (int o = 1; o < 32; o <<= 1) v += __shfl_xor(v, o);
    return v;
}
__device__ __forceinline__ int crow(int r, int hi) { return (r & 3) + 8 * (r >> 2) + 4 * hi; }

struct Args {
    const float* x; const int* pos;
    const float *ffn1_pre, *ffn1_wgu, *ffn1_wd, *ffn1_post, *mix_pre, *w_in, *w_pool, *pool_scale, *sinks, *g_pool, *g_attn, *w_out, *mix_post, *ffn2_pre, *ffn2_wgu, *ffn2_wd, *ffn2_post;
    float* out; unsigned char* ws; int ph_lo, ph_hi;
};

__device__ __forceinline__ int dest_row(int mode, int n) {
    if (mode == 1) { return n < FF ? ((n >> 7) * 256 + (n & 127)) : ((((n - FF) >> 7) * 256) + 128 + ((n - FF) & 127)); }
    if (mode == 2) { if (n >= 512 && n < 1152) { const int d = n & 63; const int p = (d >= 4 && d < 8) ? d + 4 : ((d >= 8 && d < 12) ? d - 4 : d); return (n - d) + p; } return n; }
    return n;
}
__device__ __forceinline__ void transpose_item(const float* W, int K, int N, bf16* WT, int mode, LAS float* scr, int item, int lane) {
    const int nblk = N / 32, kb = item / nblk, nb = item % nblk, k0 = 64 * kb, n0 = 32 * nb;
#pragma unroll 8
    for (int i = 0; i < 32; ++i) { const int kk = 2 * i + (lane >> 5); scr[kk * 33 + (lane & 31)] = W[(size_t)(k0 + kk) * N + n0 + (lane & 31)]; }
    asm volatile("s_waitcnt lgkmcnt(0)" ::: "memory");
    const int c = lane & 7;
#pragma unroll
    for (int j = 0; j < 4; ++j) { const int n = (lane >> 3) + 8 * j; const LAS float* s = scr + (8 * c) * 33 + n;
        u32x4 o; o.x = cvtpk(s[0 * 33], s[1 * 33]); o.y = cvtpk(s[2 * 33], s[3 * 33]); o.z = cvtpk(s[4 * 33], s[5 * 33]); o.w = cvtpk(s[6 * 33], s[7 * 33]);
        *(u32x4*)(WT + (size_t)dest_row(mode, n0 + n) * K + k0 + 8 * c) = o; }
    asm volatile("s_waitcnt lgkmcnt(0)" ::: "memory");
}
__device__ __forceinline__ void sincos_f(float a, float& sn, float& cn) {
    const double ad = (double)a; const double q = __builtin_rint(ad * 0.63661977236758134308);
    const float r = (float)__builtin_fma(-q, 1.57079632679489661923, ad); const int qi = ((int)q) & 3;
    const float z = r * r;
    const float s = r + r * z * (-1.6666654611e-1f + z * (8.3321608736e-3f + z * (-1.9515295891e-4f)));
    const float c = 1.0f - 0.5f * z + z * z * (4.166664568298827e-2f + z * (-1.388731625493765e-3f + z * 2.443315711809948e-5f));
    sn = (qi == 0) ? s : (qi == 1) ? c : (qi == 2) ? -s : -c;
    cn = (qi == 0) ? c : (qi == 1) ? -s : (qi == 2) ? -c : s;
}
__device__ __forceinline__ float inv_freq(int i) {
    return i == 0 ? 1.0f : i == 1 ? 0.19392274474868576f : i == 2 ? 0.03760603093086393f : i == 3 ? 0.007292664737217109f : i == 4 ? 0.001414213562373095f : i == 5 ? 0.0002742481756762073f : i == 6 ? 5.318295896944988e-05f : 1.031338537721246e-05f;
}
__device__ __forceinline__ void prenorm_rows(const float* x, const float* g, bf16* a, int gw, int NGW, int lane) {
    f32x4 gv[4];
#pragma unroll
    for (int j = 0; j < 4; ++j) gv[j] = *((const f32x4*)g + lane + 64 * j);
    for (int m = gw; m < M; m += NGW) {
        const f32x4* xr = (const f32x4*)(x + (size_t)m * D) + lane; f32x4 v[4]; float s = 0.f;
#pragma unroll
        for (int j = 0; j < 4; ++j) { v[j] = xr[64 * j]; s += (v[j].x * v[j].x + v[j].y * v[j].y) + (v[j].z * v[j].z + v[j].w * v[j].w); }
        const float r = 1.0f / sqrtf(wave_sum(s) * (1.0f / D) + EPS);
        u32x2* o = (u32x2*)(a + (size_t)m * D) + lane;
#pragma unroll
        for (int j = 0; j < 4; ++j) { const f32x4 y = v[j] * r * gv[j]; u32x2 w; w.x = cvtpk(y.x, y.y); w.y = cvtpk(y.z, y.w); o[64 * j] = w; }
    }
}
template <bool HAS_A, bool XI_BF, bool XO_BF>
__device__ __forceinline__ void thin_rows(const void* xi, void* xo, const bf16* h, const float* gpost, const float* gpre, bf16* a, float coef, int gw, int NGW, int lane) {
    for (int m = gw; m < M; m += NGW) {
        const u32x2* hr = (const u32x2*)(h + (size_t)m * D) + lane;
        f32x4 v[4], hv[4]; float s = 0.f;
#pragma unroll
        for (int j = 0; j < 4; ++j) {
            if (XI_BF) { const u32x2 w = ((const u32x2*)((const bf16*)xi + (size_t)m * D) + lane)[64 * j]; v[j] = (f32x4){bflo(w.x), bfhi(w.x), bflo(w.y), bfhi(w.y)}; }
            else v[j] = ((const f32x4*)((const float*)xi + (size_t)m * D) + lane)[64 * j];
            const u32x2 w = hr[64 * j]; hv[j] = (f32x4){bflo(w.x), bfhi(w.x), bflo(w.y), bfhi(w.y)};
            s += (hv[j].x * hv[j].x + hv[j].y * hv[j].y) + (hv[j].z * hv[j].z + hv[j].w * hv[j].w); }
        const float r1 = coef / sqrtf(wave_sum(s) * (1.0f / D) + EPS);
        float s2 = 0.f;
#pragma unroll
        for (int j = 0; j < 4; ++j) { const f32x4 gp = *((const f32x4*)gpost + lane + 64 * j); v[j] = v[j] + hv[j] * r1 * gp;
            s2 += (v[j].x * v[j].x + v[j].y * v[j].y) + (v[j].z * v[j].z + v[j].w * v[j].w); }
#pragma unroll
        for (int j = 0; j < 4; ++j) {
            if (XO_BF) { u32x2 w; w.x = cvtpk(v[j].x, v[j].y); w.y = cvtpk(v[j].z, v[j].w); ((u32x2*)((bf16*)xo + (size_t)m * D) + lane)[64 * j] = w; }
            else ((f32x4*)((float*)xo + (size_t)m * D) + lane)[64 * j] = v[j]; }
        if (HAS_A) {
            const float r2 = 1.0f / sqrtf(wave_sum(s2) * (1.0f / D) + EPS);
            u32x2* o = (u32x2*)(a + (size_t)m * D) + lane;
#pragma unroll
            for (int j = 0; j < 4; ++j) { const f32x4 gq = *((const f32x4*)gpre + lane + 64 * j); const f32x4 y = v[j] * r2 * gq; u32x2 w; w.x = cvtpk(y.x, y.y); w.y = cvtpk(y.z, y.w); o[64 * j] = w; }
        }
    }
}
#define XB_TMO      128
#define XB_XCNT(j)  (256  + 64 * (j))
#define XB_XSUB(j)  (1280 + 64 * (j))
#define XB_XGEN(j)  (2304 + 64 * (j))
#define XB_TOP      3328
#define XB_TOPGEN   3392
#define XCD_BAR_WORDS 3456
#define XB_SPIN_CAP (1u << 18)

__device__ __forceinline__ unsigned xb_ld(unsigned* p)              { return __hip_atomic_load(p, __ATOMIC_RELAXED, __HIP_MEMORY_SCOPE_AGENT); }
__device__ __forceinline__ unsigned xb_add(unsigned* p, unsigned v) { return __hip_atomic_fetch_add(p, v, __ATOMIC_RELAXED, __HIP_MEMORY_SCOPE_AGENT); }
__device__ __forceinline__ unsigned xb_xcc_id() { return (unsigned)__builtin_amdgcn_s_getreg((3 << 11) | 20) & 0xFu; }
#define XB_SPIN(cond, bar) do { unsigned _sp = 0; while (cond) { __builtin_amdgcn_s_sleep(1); \
    if ((++_sp & 255u) == 0u) { if (xb_ld(&(bar)[XB_TMO])) break; if (_sp > XB_SPIN_CAP) { atomicAdd(&(bar)[XB_TMO], 1u); break; } } } } while (0)

struct XcdBarrier {
    unsigned* bar; unsigned x;
    volatile LAS unsigned* st;
};

__device__ __forceinline__ XcdBarrier xcd_barrier_post(unsigned* bar, volatile LAS unsigned* st) {
    XcdBarrier b; b.bar = bar; b.x = xb_xcc_id(); b.st = st;
    if (threadIdx.x == 0) (void)xb_add(&bar[XB_XCNT(b.x)], 1u);
    return b;
}
__device__ __forceinline__ void xcd_barrier_complete(unsigned* bar, unsigned x, unsigned& nloc, unsigned& nx) {
    const unsigned G = gridDim.x * gridDim.y * gridDim.z;
    unsigned sum, cnt, mine, sp = 0u;
    for (;;) {
        sum = 0u; cnt = 0u; mine = 0u;
#pragma unroll
        for (unsigned j = 0; j < 16; ++j) { const unsigned c = xb_ld(&bar[XB_XCNT(j)]); sum += c; cnt += (c > 0u) ? 1u : 0u; mine = (j == x) ? c : mine; }
        if (sum == G) break;
        __builtin_amdgcn_s_sleep(1);
        if ((++sp & 255u) == 0u) { if (xb_ld(&bar[XB_TMO])) break; if (sp > XB_SPIN_CAP) { atomicAdd(&bar[XB_TMO], 1u); break; } }
    }
    nloc = mine > 0u ? mine : 1u; nx = cnt > 0u ? cnt : 1u;
}

__device__ __forceinline__ void xcd_barrier(const XcdBarrier& b) {
    asm volatile("s_waitcnt vmcnt(0)" ::: "memory");
    __syncthreads();
    if (threadIdx.x == 0) {
        unsigned* bar = b.bar;
        __builtin_amdgcn_s_waitcnt(0);
        unsigned nloc = b.st[0], nx = b.st[1];
        if (nloc == 0u) { xcd_barrier_complete(bar, b.x, nloc, nx); b.st[0] = nloc; b.st[1] = nx; }
        const unsigned old = xb_add(&bar[XB_XSUB(b.x)], 1u);
        const unsigned gen = old / nloc;
        if (old + 1u == (gen + 1u) * nloc) {
            __builtin_amdgcn_fence(__ATOMIC_RELEASE, "agent");
            asm volatile("s_waitcnt vmcnt(0)" ::: "memory");
            const unsigned og = xb_add(&bar[XB_TOP], 1u);
            const unsigned tg = og / nx;
            if (og + 1u == (tg + 1u) * nx) xb_add(&bar[XB_TOPGEN], 1u);
            else XB_SPIN(xb_ld(&bar[XB_TOPGEN]) == tg, bar);
            __builtin_amdgcn_fence(__ATOMIC_ACQUIRE, "agent");
            xb_add(&bar[XB_XGEN(b.x)], 1u);
            asm volatile("s_waitcnt vmcnt(0)" ::: "memory");
        } else {
            XB_SPIN(xb_ld(&bar[XB_XGEN(b.x)]) == gen, bar);
            __builtin_amdgcn_fence(__ATOMIC_ACQUIRE, "agent");
            asm volatile("s_waitcnt vmcnt(0)" ::: "memory");
        }
    }
    __syncthreads();
}
#define MFMA32(a, b, c) __builtin_amdgcn_mfma_f32_32x32x16_bf16((a), (b), (c), 0, 0, 0)
__device__ __forceinline__ void load8(const bf16* p, float (&f)[8]) { const u32x4 w = *(const u32x4*)p;
    f[0] = bflo(w.x); f[1] = bfhi(w.x); f[2] = bflo(w.y); f[3] = bfhi(w.y); f[4] = bflo(w.z); f[5] = bfhi(w.z); f[6] = bflo(w.w); f[7] = bfhi(w.w); }

__device__ __forceinline__ void mixer_block(LAS unsigned char* lds, int blk, const bf16* Z, const bf16* Vt, const bf16* WpT, const float* pool_scale, const float* sinks,
                                            const float* g_pool, const float* g_attn, bf16* Y, int tid, int wid, int lane) {
    const int b = blk / NB_SEQ, n = blk % NB_SEQ;
    const int r32 = lane & 31, hi = lane >> 5, rg = wid & 3, ch = wid >> 2;
    LAS float* SS = (LAS float*)(lds + SS_OFF);
    const size_t rowbase = (size_t)blk * 128;
    u32x4 pre[5];
#define POOL_LOAD(gg) do { _Pragma("unroll") for (int k = 0; k < 5; ++k) { const int i = tid + NTHREADS * k, jr = i >> 4, c = i & 15; pre[k] = (u32x4){0u, 0u, 0u, 0u}; \
        if (jr < UL_ROWS && n * 128 + jr - 15 >= 0) pre[k] = *(const u32x4*)(Z + (ptrdiff_t)((ptrdiff_t)rowbase + jr - 15) * NIN + (gg) * 128 + c * 8); } } while (0)
    POOL_LOAD(0);
#pragma unroll 1
    for (int g = 0; g < 4; ++g) {
        const int w = 2 << g;
#pragma unroll
        for (int k = 0; k < 5; ++k) { const int i = tid + NTHREADS * k, jr = i >> 4, c = i & 15; if (jr < UL_ROWS) *(LAS u32x4*)(lds + UL_OFF + jr * UL_PITCH + c * 16) = pre[k]; }
        __syncthreads();
        if (g < 3) POOL_LOAD(g + 1);
        {
            const int c8 = tid & 15, t0 = (tid >> 4) * 4;
            const LAS unsigned char* ub = lds + UL_OFF + 15 * UL_PITCH + c8 * 16;
            float s[8], uv[8];
#pragma unroll
            for (int i = 0; i < 8; ++i) s[i] = 0.f;
#define LDU(row) do { const u32x4 w_ = *(const LAS u32x4*)(ub + (row) * UL_PITCH); uv[0] = bflo(w_.x); uv[1] = bfhi(w_.x); uv[2] = bflo(w_.y); uv[3] = bfhi(w_.y); uv[4] = bflo(w_.z); uv[5] = bfhi(w_.z); uv[6] = bflo(w_.w); uv[7] = bfhi(w_.w); } while (0)
            for (int j = t0 - w + 1; j < t0; ++j) { LDU(j);
#pragma unroll
                for (int i = 0; i < 8; ++i) s[i] += uv[i]; }
#pragma unroll
            for (int tt = 0; tt < 4; ++tt) { const int t = t0 + tt;
                LDU(t);
#pragma unroll
                for (int i = 0; i < 8; ++i) s[i] += uv[i];
                const int sp = n * 128 + t; const int cnt = (sp + 1 < w) ? sp + 1 : w; const float inv = 1.0f / (float)cnt;
                u32x4 o; o.x = cvtpk(s[0] * inv - uv[0], s[1] * inv - uv[1]); o.y = cvtpk(s[2] * inv - uv[2], s[3] * inv - uv[3]);
                o.z = cvtpk(s[4] * inv - uv[4], s[5] * inv - uv[5]); o.w = cvtpk(s[6] * inv - uv[6], s[7] * inv - uv[7]);
                *(LAS u32x4*)(lds + DL_OFF + t * DL_PITCH + c8 * 16) = o;
                LDU(t - w + 1);
#pragma unroll
                for (int i = 0; i < 8; ++i) s[i] -= uv[i]; }
#undef LDU
        }
        __syncthreads();
        {
            f32x16 a0, a1;
#pragma unroll
            for (int i = 0; i < 16; ++i) { a0[i] = 0.f; a1[i] = 0.f; }
            const bf16* wp = WpT + (size_t)g * 16384 + (size_t)(64 * ch + r32) * 128 + 8 * hi;
#pragma unroll
            for (int ks = 0; ks < 8; ++ks) {
                const bf16x8 A = *(const LAS bf16x8*)(lds + DL_OFF + (32 * rg + r32) * DL_PITCH + (16 * ks + 8 * hi) * 2);
                const bf16x8 B0 = *(const bf16x8*)(wp + 16 * ks), B1 = *(const bf16x8*)(wp + 32 * 128 + 16 * ks);
                a0 = MFMA32(A, B0, a0); a1 = MFMA32(A, B1, a1);
            }
            const int c0 = g * 128 + 64 * ch + r32;
            const float ps0 = pool_scale[c0], ps1 = pool_scale[c0 + 32];
            bf16* ybase = Y + (rowbase + 32 * rg + 4 * hi) * D + c0; asm volatile("" : "+v"(ybase));
            LAS float* ssb = SS + (g * 2 + ch) * 128 + 32 * rg + 4 * hi;
#pragma unroll
            for (int r = 0; r < 16; ++r) { const int ro = (r & 3) + 8 * (r >> 2); const float v0 = a0[r] * ps0, v1 = a1[r] * ps1;
                const float q = half_sum32(v0 * v0 + v1 * v1);
                if (r32 == 0) ssb[ro] = q;
                bf16* yp = ybase + ro * D; yp[0] = (bf16)(cvtpk(v0, 0.f) & 0xffffu); yp[32] = (bf16)(cvtpk(v1, 0.f) & 0xffffu); }
        }
    }
#undef POOL_LOAD
#pragma unroll 1
    for (int kh = 0; kh < 2; ++kh) {
        const bf16* qp = Z + (rowbase + 32 * rg + r32) * NIN + 512 + (kh * 4 + 2 * ch) * 64 + 8 * hi;
        bf16x8 qr[4];
#pragma unroll
        for (int d0 = 0; d0 < 4; ++d0) qr[d0] = *(const bf16x8*)(qp + 16 * d0);
#pragma unroll
        for (int i = tid; i < 2048; i += NTHREADS) {
            const int key = i >> 3, c = i & 7; const bool valid = (n > 0) || (key >= 128);
            u32x4 v = (u32x4){0u, 0u, 0u, 0u};
            if (valid) v = *(const u32x4*)(Z + (rowbase + key - 128) * NIN + 1024 + kh * 64 + c * 8);
            *(LAS u32x4*)(lds + KL_OFF + key * KL_PITCH + c * 16) = v;
        }
#pragma unroll
        for (int i = tid; i < 2048; i += NTHREADS) {
            const int d = i >> 5, c = i & 31; const bool valid = (n > 0) || (c >= 16);
            u32x4 v = (u32x4){0u, 0u, 0u, 0u};
            if (valid) v = *(const u32x4*)(Vt + ((size_t)((b * 2 + kh) * 64 + d)) * SEQ + n * 128 - 128 + c * 8);
            LAS u32x2* dst = (LAS u32x2*)(lds + VL_OFF + d * VL_PITCH + c * 16);
            dst[0] = (u32x2){v.x, v.y}; dst[1] = (u32x2){v.z, v.w};
        }
        __syncthreads();
#pragma unroll 1
        for (int gi = 0; gi < 2; ++gi) {
            const int h = kh * 4 + 2 * ch + gi;
            f32x16 S[5];
#pragma unroll
            for (int t = 0; t < 5; ++t) {
#pragma unroll
                for (int i = 0; i < 16; ++i) S[t][i] = 0.f;
#pragma unroll
                for (int d0 = 0; d0 < 4; ++d0) { const bf16x8 kf = *(const LAS bf16x8*)(lds + KL_OFF + (32 * (rg + t) + r32) * KL_PITCH + (16 * d0 + 8 * hi) * 2);
                    S[t] = MFMA32(kf, qr[d0], S[t]); }
                if (t & 1) __builtin_amdgcn_sched_barrier(0);
            }
            if (gi == 0) {
#pragma unroll
                for (int d0 = 0; d0 < 4; ++d0) qr[d0] = *(const bf16x8*)(qp + 64 + 16 * d0);
            }
            const float sinkl = sinks[h] * LOG2E;
            float mx = sinkl;
#pragma unroll
            for (int t = 0; t < 5; ++t)
#pragma unroll
                for (int r = 0; r < 16; ++r) {
                    const bool tv = (n > 0) || (rg + t >= 4);
                    const bool valid = (t == 0) ? (tv && (crow(r, hi) > r32)) : (t == 4) ? (crow(r, hi) <= r32) : tv;
                    const float sv = valid ? S[t][r] : -1e30f; S[t][r] = sv; mx = fmaxf(mx, sv); }
            mx = fmaxf(mx, __shfl_xor(mx, 32));
            float sum = 0.f;
#pragma unroll
            for (int t = 0; t < 5; ++t)
#pragma unroll
                for (int r = 0; r < 16; ++r) { const float p = __builtin_amdgcn_exp2f(S[t][r] - mx); S[t][r] = p; sum += p; }
            sum += __shfl_xor(sum, 32);
            sum += __builtin_amdgcn_exp2f(sinkl - mx);
            const float linv = 1.0f / sum;
            f32x16 o0, o1;
#pragma unroll
            for (int i = 0; i < 16; ++i) { o0[i] = 0.f; o1[i] = 0.f; }
#pragma unroll
            for (int t = 0; t < 5; ++t)
#pragma unroll
                for (int s = 0; s < 2; ++s) {
                    u32x4 pw; pw.x = cvtpk(S[t][8 * s + 0], S[t][8 * s + 1]); pw.y = cvtpk(S[t][8 * s + 2], S[t][8 * s + 3]); pw.z = cvtpk(S[t][8 * s + 4], S[t][8 * s + 5]); pw.w = cvtpk(S[t][8 * s + 6], S[t][8 * s + 7]);
                    const bf16x8 pa = __builtin_bit_cast(bf16x8, pw);
                    const int keyb = 32 * (rg + t) + 16 * s + 4 * hi;
                    const LAS unsigned char* vb = lds + VL_OFF + r32 * VL_PITCH + keyb * 2;
                    const u32x2 l0 = *(const LAS u32x2*)(vb), h0 = *(const LAS u32x2*)(vb + 16);
                    const u32x2 l1 = *(const LAS u32x2*)(vb + 32 * VL_PITCH), h1 = *(const LAS u32x2*)(vb + 32 * VL_PITCH + 16);
                    const bf16x8 v0 = __builtin_bit_cast(bf16x8, ((u32x4){l0.x, l0.y, h0.x, h0.y})), v1 = __builtin_bit_cast(bf16x8, ((u32x4){l1.x, l1.y, h1.x, h1.y}));
                    o0 = MFMA32(pa, v0, o0); o1 = MFMA32(pa, v1, o1);
                    if (s == 1) __builtin_amdgcn_sched_barrier(0);
                }
            bf16* ybase = Y + (rowbase + 32 * rg + 4 * hi) * D + 512 + h * 64 + r32; asm volatile("" : "+v"(ybase));
            LAS float* ssb = SS + (8 + h) * 128 + 32 * rg + 4 * hi;
#pragma unroll
            for (int r = 0; r < 16; ++r) { const int ro = (r & 3) + 8 * (r >> 2); const float li = __shfl(linv, ro + 4 * hi);
                const float v0 = o0[r] * li, v1 = o1[r] * li;
                const float q = half_sum32(v0 * v0 + v1 * v1);
                if (r32 == 0) ssb[ro] = q;
                bf16* yp = ybase + ro * D; yp[0] = (bf16)(cvtpk(v0, 0.f) & 0xffffu); yp[32] = (bf16)(cvtpk(v1, 0.f) & 0xffffu); }
        }
        __syncthreads();
    }
#pragma unroll 4
    for (int i = tid; i < 128 * 128; i += NTHREADS) {
        const int row = i >> 7, c = i & 127, col = c * 8, half = col >> 9;
        float ss = 0.f;
#pragma unroll
        for (int k = 0; k < 8; ++k) ss += SS[(half * 8 + k) * 128 + row];
        const float rs = 1.0f / sqrtf(ss * (1.0f / 512.0f) + EPS);
        const float* gp = (half ? g_attn : g_pool) + (col & 511);
        const f32x4 g0 = *(const f32x4*)gp, g1 = *(const f32x4*)(gp + 4);
        bf16* yp = Y + (rowbase + row) * D + col; float f[8]; load8(yp, f);
        u32x4 o; o.x = cvtpk(f[0] * rs * g0.x, f[1] * rs * g0.y); o.y = cvtpk(f[2] * rs * g0.z, f[3] * rs * g0.w); o.z = cvtpk(f[4] * rs * g1.x, f[5] * rs * g1.y); o.w = cvtpk(f[6] * rs * g1.z, f[7] * rs * g1.w);
        *(u32x4*)yp = o;
    }
    __syncthreads();
}
__global__ void __launch_bounds__(NTHREADS, 2) hybrid_fwd(Args args) {
    extern __shared__ __attribute__((aligned(16))) unsigned char lds_raw[];
    LAS unsigned char* lds = (LAS unsigned char*)lds_raw;
    cg::grid_group grid = cg::this_grid();
    const int tid = threadIdx.x, lane = tid & 63, wid = __builtin_amdgcn_readfirstlane(tid >> 6);
    const int G = gridDim.x, bx = blockIdx.x;
    const int vcu = (G % 8 == 0) ? (bx % 8) * (G / 8) + bx / 8 : bx;
    const int gw = vcu * NWAVES + wid, NGW = G * NWAVES;
    unsigned char* ws = args.ws;
    bf16 *Wgu1 = (bf16*)(ws + WS_WGU1), *Wgu2 = (bf16*)(ws + WS_WGU2), *Wd1 = (bf16*)(ws + WS_WD1), *Wd2 = (bf16*)(ws + WS_WD2), *Win = (bf16*)(ws + WS_WIN), *Wout = (bf16*)(ws + WS_WOUT), *WpT = (bf16*)(ws + WS_WPOOL);
    float* CS = (float*)(ws + WS_CS);
    bf16 *A = (bf16*)(ws + WS_A), *HD = (bf16*)(ws + WS_HD), *H = (bf16*)(ws + WS_H), *Z = (bf16*)(ws + WS_Z), *Vt = (bf16*)(ws + WS_VT), *Y = (bf16*)(ws + WS_Y), *XR = (bf16*)(ws + WS_XR);
    const int lo = args.ph_lo, hi = args.ph_hi;
#define IN(k) (lo <= (k) && (k) < hi)
#define SEAM(k) do { if (IN(k) && IN((k) + 1)) { if ((k) == 0) grid.sync(); else xcd_barrier(bar); } } while (0)
    if (tid < 32) ((LAS unsigned*)(lds + MISC_OFF))[tid] = 0u;
    __syncthreads();
    XcdBarrier bar; bar.bar = (unsigned*)(ws + WS_CTL); bar.x = 0; bar.st = nullptr;
    if (hi - lo > 1) bar = xcd_barrier_post((unsigned*)(ws + WS_CTL), (volatile LAS unsigned*)(lds + MISC_OFF) + 8);

    if (IN(0)) {
        LAS float* scr = (LAS float*)(lds + wid * 16384);
        constexpr int I_GU = (D / 64) * (NGU / 32), I_DN = (FF / 64) * (D / 32), I_IN = (D / 64) * (NIN / 32), I_OUT = (D / 64) * (D / 32), I_PL = 4 * 2 * 4;
        constexpr int NITEMS = 2 * I_GU + 2 * I_DN + I_IN + I_OUT + I_PL;
        for (int it = gw; it < NITEMS; it += NGW) {
            int r = it;
            if (r < I_GU) { transpose_item(args.ffn1_wgu, D, NGU, Wgu1, 1, scr, r, lane); continue; } r -= I_GU;
            if (r < I_GU) { transpose_item(args.ffn2_wgu, D, NGU, Wgu2, 1, scr, r, lane); continue; } r -= I_GU;
            if (r < I_DN) { transpose_item(args.ffn1_wd, FF, D, Wd1, 0, scr, r, lane); continue; } r -= I_DN;
            if (r < I_DN) { transpose_item(args.ffn2_wd, FF, D, Wd2, 0, scr, r, lane); continue; } r -= I_DN;
            if (r < I_IN) { transpose_item(args.w_in, D, NIN, Win, 2, scr, r, lane); continue; } r -= I_IN;
            if (r < I_OUT) { transpose_item(args.w_out, D, D, Wout, 0, scr, r, lane); continue; } r -= I_OUT;
            { const int g = r >> 3; transpose_item(args.w_pool + (size_t)g * 16384, 128, 128, WpT + (size_t)g * 16384, 0, scr, r & 7, lane); }
        }
        for (int idx = vcu * NTHREADS + tid; idx < M * 8; idx += G * NTHREADS) {
            const int row = idx >> 3, i = idx & 7; const float ang = (float)args.pos[row] * inv_freq(i);
            float sn, cn; sincos_f(ang, sn, cn); CS[(size_t)row * 16 + i] = cn; CS[(size_t)row * 16 + 8 + i] = sn;
        }
        prenorm_rows(args.x, args.ffn1_pre, A, gw, NGW, lane);
    }
    SEAM(0);
    if (IN(1)) {
        pg8::Gemm g{A, Wgu1, M, NGU, D}; pg8::StaticOrder S; S.init(M, NGU, G, bx); pg8::EpiSwiGLU E{H, FF};
        pg8::gemm_phase<pg8::EpiSwiGLU, pg8::StaticOrder, true, true>(lds, g, S, E);
    }
    SEAM(1);
    if (IN(2)) {
        pg8::Gemm g{H, Wd1, M, D, FF}; pg8::StaticOrder S; S.init(M, D, G, bx); pg8::EpiBf16<0> E{HD, D, nullptr, 0, 0, 1.f};
        pg8::gemm_phase<pg8::EpiBf16<0>, pg8::StaticOrder, true, true>(lds, g, S, E);
    }
    SEAM(2);
    if (IN(3)) thin_rows<true, false, true>(args.x, XR, HD, args.ffn1_post, args.mix_pre, A, 0.5f, gw, NGW, lane);
    SEAM(3);
    if (IN(4)) {
        pg8::Gemm g{A, Win, M, NIN, D}; pg8::StaticOrder S; S.init(M, NIN, G, bx); pg8::EpiZ E{Z, Vt, CS, QSCALE, SEQ};
        pg8::gemm_phase<pg8::EpiZ, pg8::StaticOrder, true, true>(lds, g, S, E);
    }
    SEAM(4);
    if (IN(5)) { for (int blk = vcu; blk < NBLK; blk += G) mixer_block(lds, blk, Z, Vt, WpT, args.pool_scale, args.sinks, args.g_pool, args.g_attn, Y, tid, wid, lane); }
    SEAM(5);
    if (IN(6)) {
        pg8::Gemm g{Y, Wout, M, D, D}; pg8::StaticOrder S; S.init(M, D, G, bx); pg8::EpiBf16<0> E{HD, D, nullptr, 0, 0, 1.f};
        pg8::gemm_phase<pg8::EpiBf16<0>, pg8::StaticOrder, true, true>(lds, g, S, E);
    }
    SEAM(6);
    if (IN(7)) thin_rows<true, true, true>(XR, XR, HD, args.mix_post, args.ffn2_pre, A, 1.0f, gw, NGW, lane);
    SEAM(7);
    if (IN(8)) {
        pg8::Gemm g{A, Wgu2, M, NGU, D}; pg8::StaticOrder S; S.init(M, NGU, G, bx); pg8::EpiSwiGLU E{H, FF};
        pg8::gemm_phase<pg8::EpiSwiGLU, pg8::StaticOrder, true, true>(lds, g, S, E);
    }
    SEAM(8);
    if (IN(9)) {
        pg8::Gemm g{H, Wd2, M, D, FF}; pg8::StaticOrder S; S.init(M, D, G, bx); pg8::EpiBf16<0> E{HD, D, nullptr, 0, 0, 1.f};
        pg8::gemm_phase<pg8::EpiBf16<0>, pg8::StaticOrder, true, true>(lds, g, S, E);
    }
    SEAM(9);
    if (IN(10)) thin_rows<false, true, false>(XR, args.out, HD, args.ffn2_post, nullptr, nullptr, 0.5f, gw, NGW, lane);
#undef IN
#undef SEAM
}

#ifndef MK_N_LAUNCHES
#define MK_N_LAUNCHES 1
#endif
extern "C" void kernel_launch(void* const* d_in, const int* in_sizes, int n_in, void* d_out, int out_size, void* d_ws, size_t ws_size, hipStream_t stream) {
    static int grid = 0;
    if (grid == 0) {
        if (n_in != 19 || in_sizes[0] != M * D || out_size != M * D || ws_size < WS_END) { fprintf(stderr, "kernel_launch: unexpected shapes (n_in %d, in0 %d, out %d, ws %zu)\n", n_in, n_in > 0 ? in_sizes[0] : -1, out_size, ws_size); grid = -1; return; }
        int dev = 0, cus = 0, per_cu = 0;
        if (hipGetDevice(&dev) != hipSuccess || hipDeviceGetAttribute(&cus, hipDeviceAttributeMultiprocessorCount, dev) != hipSuccess) { grid = -1; return; }
        if (hipFuncSetAttribute((const void*)hybrid_fwd, hipFuncAttributeMaxDynamicSharedMemorySize, LDS_BYTES) != hipSuccess) { fprintf(stderr, "kernel_launch: hipFuncSetAttribute failed\n"); grid = -1; return; }
        if (hipOccupancyMaxActiveBlocksPerMultiprocessor(&per_cu, (const void*)hybrid_fwd, NTHREADS, LDS_BYTES) != hipSuccess || per_cu < 1) { fprintf(stderr, "kernel_launch: occupancy query says %d\n", per_cu); per_cu = 1; }
        (void)hipGetLastError();
        grid = cus * 1;
    }
    if (grid < 0) return;
    if (hipMemsetAsync((char*)d_ws + WS_CTL, 0, CTL_BYTES, stream) != hipSuccess) { fprintf(stderr, "kernel_launch: memset failed\n"); return; }
    Args a{};
    a.x = (const float*)d_in[0]; a.pos = (const int*)d_in[1];
    a.ffn1_pre = (const float*)d_in[2]; a.ffn1_wgu = (const float*)d_in[3]; a.ffn1_wd = (const float*)d_in[4]; a.ffn1_post = (const float*)d_in[5];
    a.mix_pre = (const float*)d_in[6]; a.w_in = (const float*)d_in[7]; a.w_pool = (const float*)d_in[8]; a.pool_scale = (const float*)d_in[9]; a.sinks = (const float*)d_in[10];
    a.g_pool = (const float*)d_in[11]; a.g_attn = (const float*)d_in[12]; a.w_out = (const float*)d_in[13]; a.mix_post = (const float*)d_in[14];
    a.ffn2_pre = (const float*)d_in[15]; a.ffn2_wgu = (const float*)d_in[16]; a.ffn2_wd = (const float*)d_in[17]; a.ffn2_post = (const float*)d_in[18];
    a.out = (float*)d_out; a.ws = (unsigned char*)d_ws;
    constexpr int NPH = 11;
#if MK_N_LAUNCHES == 1
    a.ph_lo = 0; a.ph_hi = NPH;
    { void* kargs[] = {&a}; hipError_t e = hipLaunchCooperativeKernel((const void*)hybrid_fwd, dim3(grid), dim3(NTHREADS), kargs, LDS_BYTES, stream);
      if (e != hipSuccess) fprintf(stderr, "kernel_launch: cooperative launch failed: %s (grid %d)\n", hipGetErrorString(e), grid); }
#else
    for (int p = 0; p < NPH; ++p) { a.ph_lo = p; a.ph_hi = p + 1; void* kargs[] = {&a};
        hipError_t e = hipLaunchCooperativeKernel((const void*)hybrid_fwd, dim3(grid), dim3(NTHREADS), kargs, LDS_BYTES, stream);
        if (e != hipSuccess) { fprintf(stderr, "kernel_launch: launch %d failed: %s\n", p, hipGetErrorString(e)); break; } }
#endif
}
```

```cpp
#include <hip/hip_runtime.h>
#include <hip/hip_cooperative_groups.h>
#include <cstdio>
#include <cstdint>
namespace cg = cooperative_groups;
namespace pg8 {
#define PG8_LAS __attribute__((address_space(3)))
typedef unsigned short bf16_t;
typedef short bf16x8 __attribute__((ext_vector_type(8)));
typedef float f32x4 __attribute__((ext_vector_type(4)));
typedef unsigned u32x4 __attribute__((ext_vector_type(4)));
constexpr int BM = 256, BK = 64, HALF = 128, HTB = HALF * BK * 2  , STAGE_BYTES = 8 * HTB, NXCD = 8, WGM = 8;

__host__ __device__ __forceinline__ int lds_byte(int r, int c) { const int st = (r >> 4) * 2 + (c >> 5), rr = r & 15, cc = c & 31, ob = rr * 64 + cc * 2; return st * 1024 + (ob ^ (((ob >> 9) & 1) << 5)); }
__host__ __device__ __forceinline__ void stage_rc(int b, int& R, int& C) { const int st = b / 1024, sb = b % 1024, swz = sb ^ (((sb >> 9) & 1) << 5); R = (st >> 1) * 16 + swz / 64; C = (st & 1) * 32 + (swz % 64) / 2; }
__host__ __device__ __forceinline__ int perm32(int rho) { const int n = rho >> 4, i = rho & 15; return 8 * (i >> 2) + 4 * n + (i & 3); }

struct Unit { int pm, pn; };
struct Gemm { const bf16_t* A; const bf16_t* Bt; int M, N, K; };

struct StaticOrder {
    int nM, nN, nwg, G, c;
    __host__ __device__ void init(int M, int N, int G_, int c_) { nM = M / BM; nN = N / BM; nwg = nM * nN; G = G_; c = c_; }
    __host__ __device__ bool next(int i, Unit& u) const {
        const long L = (long)i * G + c; if (L >= nwg) return false;
        int wgid = (int)L; { const int q = nwg / NXCD, r = nwg % NXCD, xcd = wgid % NXCD, off = wgid / NXCD; wgid = (xcd < r ? xcd * (q + 1) : r * (q + 1) + (xcd - r) * q) + off; }
        const int nig = WGM * nN, gid = wgid / nig, fm = gid * WGM, gsz = (nM - fm) < WGM ? (nM - fm) : WGM;
        u.pm = fm + ((wgid % nig) % gsz); u.pn = (wgid % nig) / gsz; return true;
    }
    __device__ __forceinline__ void a_ready(const Unit&) const {}
    __device__ __forceinline__ void done(const Unit&) const {}
};

__device__ __forceinline__ unsigned cvt_pk_bf16(float lo, float hi) { unsigned r; asm volatile("v_cvt_pk_bf16_f32 %0, %1, %2" : "=v"(r) : "v"(lo), "v"(hi)); return r; }
typedef float f32x2 __attribute__((ext_vector_type(2)));
__device__ __forceinline__ f32x2 gelu_pk(f32x2 v) {
    const f32x2 av = __builtin_elementwise_abs(v), d = av * 0.2316418882f + 1.0f;
    f32x2 t; t.x = __builtin_amdgcn_rcpf(d.x); t.y = __builtin_amdgcn_rcpf(d.y);
    f32x2 q = t * 0.5307027145f + (-0.7265760135f); q = q * t + 0.7107068705f; q = q * t + (-0.142248368f); q = q * t + 0.127414796f; q = q * t;
    const f32x2 s = (v * v) * (-0.72134752044f);
    f32x2 e; e.x = __builtin_amdgcn_exp2f(s.x); e.y = __builtin_amdgcn_exp2f(s.y);
    const f32x2 m = v * (q * e), r = v - m;
    f32x2 o; o.x = v.x < 0.f ? m.x : r.x; o.y = v.y < 0.f ? m.y : r.y; return o;
}

template <int ACT  > struct EpiBf16 {
    static constexpr bool PERM = true, AFTER_DRAIN = false; static_assert(ACT == 0 || ACT == 1, "EpiBf16: ACT is 0 (none) or 1 (gelu_pk)");
    bf16_t* O; int ldc; const float* bias; int split_cols; size_t split_stride; float scale0;
    __device__ __forceinline__ void operator()(const f32x4 (&acc)[2][2][4][2], const Unit& u, int wr, int wc, int fr, int fq) const {
        const int row0 = u.pm * BM + wr * 64 + fr; int colt = u.pn * BM; bf16_t* base = O;
        float sc = 1.f; if (split_cols) { const int t = colt / split_cols; base += (size_t)t * split_stride; colt -= t * split_cols; if (t == 0) sc = scale0; }
        const int col0 = colt + wc * 32 + 8 * fq, bcol0 = u.pn * BM + wc * 32 + 8 * fq;
        f32x4 bv[2][2];
#pragma unroll
        for (int bj = 0; bj < 2; ++bj)
#pragma unroll
            for (int n = 0; n < 2; ++n) bv[bj][n] = bias ? *(const f32x4*)(bias + bcol0 + bj * HALF + 4 * n) : (f32x4){0.f, 0.f, 0.f, 0.f};
#pragma unroll
        for (int ai = 0; ai < 2; ++ai)
#pragma unroll
            for (int m = 0; m < 4; ++m) { bf16_t* rowp = base + (size_t)(row0 + ai * HALF + m * 16) * ldc + col0;
#pragma unroll
                for (int bj = 0; bj < 2; ++bj) { f32x4 v0 = acc[ai][bj][m][0] + bv[bj][0], v1 = acc[ai][bj][m][1] + bv[bj][1];
                    if (ACT == 1) { f32x2 a = gelu_pk((f32x2){v0[0], v0[1]}), b = gelu_pk((f32x2){v0[2], v0[3]}), c = gelu_pk((f32x2){v1[0], v1[1]}), d = gelu_pk((f32x2){v1[2], v1[3]});
                        v0 = (f32x4){a.x, a.y, b.x, b.y}; v1 = (f32x4){c.x, c.y, d.x, d.y}; }
                    v0 = v0 * sc; v1 = v1 * sc; u32x4 w; w.x = cvt_pk_bf16(v0[0], v0[1]); w.y = cvt_pk_bf16(v0[2], v0[3]); w.z = cvt_pk_bf16(v1[0], v1[1]); w.w = cvt_pk_bf16(v1[2], v1[3]);
                    *(u32x4*)(rowp + bj * HALF) = w; } }
    }
};
typedef __bf16 bf16x2_t __attribute__((ext_vector_type(2)));
__device__ __forceinline__ unsigned cvtpk(float lo, float hi) { f32x2 v = {lo, hi}; bf16x2_t b = __builtin_convertvector(v, bf16x2_t); return __builtin_bit_cast(unsigned, b); }
__device__ __forceinline__ float silu_mul(float g, float u) { const float e = __builtin_amdgcn_exp2f(-1.4426950408889634f * g); return g * __builtin_amdgcn_rcpf(1.0f + e) * u; }

struct EpiSwiGLU {
    static constexpr bool PERM = true, AFTER_DRAIN = false;
    bf16_t* O; int ldc;
    __device__ __forceinline__ void operator()(const f32x4 (&acc)[2][2][4][2], const Unit& u, int wr, int wc, int fr, int fq) const {
        const int row0 = u.pm * BM + wr * 64 + fr, col0 = u.pn * HALF + wc * 32 + 8 * fq;
#pragma unroll
        for (int ai = 0; ai < 2; ++ai)
#pragma unroll
            for (int m = 0; m < 4; ++m) { bf16_t* rowp = O + (size_t)(row0 + ai * HALF + m * 16) * ldc + col0;
                const f32x4 g0 = acc[ai][0][m][0], g1 = acc[ai][0][m][1], u0 = acc[ai][1][m][0], u1 = acc[ai][1][m][1];
                u32x4 w; w.x = cvtpk(silu_mul(g0[0], u0[0]), silu_mul(g0[1], u0[1])); w.y = cvtpk(silu_mul(g0[2], u0[2]), silu_mul(g0[3], u0[3]));
                w.z = cvtpk(silu_mul(g1[0], u1[0]), silu_mul(g1[1], u1[1])); w.w = cvtpk(silu_mul(g1[2], u1[2]), silu_mul(g1[3], u1[3]));
                *(u32x4*)rowp = w; }
    }
};
struct EpiZ {
    static constexpr bool PERM = true, AFTER_DRAIN = false;
    bf16_t* Z; bf16_t* Vt; const float* cs; float qscale; int seq;
    __device__ __forceinline__ void operator()(const f32x4 (&acc)[2][2][4][2], const Unit& u, int wr, int wc, int fr, int fq) const {
        const int row0 = u.pm * BM + wr * 64 + fr, cl = wc * 32 + 8 * fq;
#pragma unroll
        for (int bj = 0; bj < 2; ++bj) {
            const int colh = u.pn * BM + bj * HALF;
            const bool isV = (colh == 1152);
            const bool rope = (colh >= 512) && (colh < 1152) && ((wc & 1) == 0) && (fq < 2);
            const float sc = (colh >= 512 && colh < 1024) ? qscale : 1.0f;
#pragma unroll
            for (int ai = 0; ai < 2; ++ai)
#pragma unroll
                for (int m = 0; m < 4; ++m) { const int row = row0 + ai * HALF + m * 16;
                    f32x4 v0 = acc[ai][bj][m][0], v1 = acc[ai][bj][m][1];
                    if (isV) {
                        const int b = row / seq, s = row - b * seq;
#pragma unroll
                        for (int i = 0; i < 4; ++i) { const int c0 = cl + i, c1 = cl + 4 + i;
                            Vt[((size_t)((b * 2 + (c0 >> 6)) * 64 + (c0 & 63))) * seq + s] = (bf16_t)(cvtpk(v0[i], 0.f) & 0xffffu);
                            Vt[((size_t)((b * 2 + (c1 >> 6)) * 64 + (c1 & 63))) * seq + s] = (bf16_t)(cvtpk(v1[i], 0.f) & 0xffffu); }
                    } else {
                        if (rope) { const f32x4 c = *(const f32x4*)(cs + (size_t)row * 16 + 4 * fq), sn = *(const f32x4*)(cs + (size_t)row * 16 + 8 + 4 * fq);
                            const f32x4 n0 = v0 * c - v1 * sn, n1 = v1 * c + v0 * sn; v0 = n0; v1 = n1; }
                        v0 = v0 * sc; v1 = v1 * sc;
                        u32x4 w; w.x = cvtpk(v0[0], v0[1]); w.y = cvtpk(v0[2], v0[3]); w.z = cvtpk(v1[0], v1[1]); w.w = cvtpk(v1[2], v1[3]);
                        *(u32x4*)(Z + (size_t)row * 1280 + colh + cl) = w; }
                }
        }
    }
};
template <class Epi, class Sched, bool ALIGN_EPI = false, bool SP2 = false>
__device__ __forceinline__ void gemm_phase(PG8_LAS unsigned char* lds, const Gemm g, const Sched& S, const Epi& E) {
    const int tid = threadIdx.x, wid = __builtin_amdgcn_readfirstlane(tid >> 6), lane = tid & 63, wr = wid >> 2, wc = wid & 3, fr = lane & 15, fq = lane >> 4;
    const int K = g.K, nt = K / BK;
    unsigned voffA[2], voffB[2];
#pragma unroll
    for (int i = 0; i < 2; ++i) { int R, C; stage_rc(tid * 16 + i * 8192, R, C); const int Rb = Epi::PERM ? ((R & ~31) + perm32(R & 31)) : R;
        voffA[i] = (unsigned)(R * K + C) * 2u; voffB[i] = (unsigned)(Rb * K + C) * 2u; }
    const size_t kstep = (size_t)(BK * 2);
    const size_t hstep = (size_t)HALF * K * 2;
    const size_t tstep = 2 * hstep;
    const unsigned ldsw = (unsigned)wid * 1024u;
    const int aoff = lds_byte(wr * 64 + fr, fq * 8), boff = lds_byte(wc * 32 + fr, fq * 8);
#define PG8_SA(b, h) (((b) * 2 + (h)) * HTB)
#define PG8_SB(b, h) ((4 + (b) * 2 + (h)) * HTB)
#define PG8_STAGE(bufoff, gbase, voff) do { _Pragma("unroll") for (int _i = 0; _i < 2; ++_i) \
        __builtin_amdgcn_global_load_lds((const unsigned*)((const char*)(gbase) + (voff)[_i]), (PG8_LAS unsigned*)(lds + (bufoff) + ldsw + _i * 8192), 16, 0, 0); } while (0)
#define PG8_LDA(dst, b, h) do { _Pragma("unroll") for (int m = 0; m < 4; ++m) _Pragma("unroll") for (int k = 0; k < 2; ++k) dst[m][k] = *(const PG8_LAS bf16x8*)(lds + PG8_SA(b, h) + aoff + m * 2048 + k * 1024); } while (0)
#define PG8_LDB(dst, b, h) do { _Pragma("unroll") for (int n = 0; n < 2; ++n) _Pragma("unroll") for (int k = 0; k < 2; ++k) dst[n][k] = *(const PG8_LAS bf16x8*)(lds + PG8_SB(b, h) + boff + n * 2048 + k * 1024); } while (0)
#define PG8_MMA(ai, bj, At, Bt) do { __builtin_amdgcn_s_setprio(1); _Pragma("unroll") for (int m = 0; m < 4; ++m) _Pragma("unroll") for (int n = 0; n < 2; ++n) _Pragma("unroll") for (int k = 0; k < 2; ++k) \
        acc[ai][bj][m][n] = __builtin_amdgcn_mfma_f32_16x16x32_bf16(Bt[n][k], At[m][k], acc[ai][bj][m][n], 0, 0, 0); __builtin_amdgcn_s_setprio(0); } while (0)
#define PG8_WAIT_V(n) asm volatile("s_waitcnt vmcnt(" #n ")" ::: "memory")
#define PG8_WAIT_L(n) asm volatile("s_waitcnt lgkmcnt(" #n ")" ::: "memory")
#define PG8_BAR __builtin_amdgcn_s_barrier()
#define PG8_SCHED __builtin_amdgcn_sched_barrier(0)
    Unit cur, nxt; int ui = 0;
    if (!S.next(0, cur)) return;
    f32x4 acc[2][2][4][2];
#pragma unroll
    for (int a = 0; a < 2; ++a)
#pragma unroll
        for (int b = 0; b < 2; ++b)
#pragma unroll
            for (int m = 0; m < 4; ++m)
#pragma unroll
                for (int n = 0; n < 2; ++n) acc[a][b][m][n] = (f32x4){0.f, 0.f, 0.f, 0.f};
    bf16x8 At[4][2], B0[2][2], B1[2][2];
    const char* cA = (const char*)g.A + (size_t)cur.pm * tstep; const char* cB = (const char*)g.Bt + (size_t)cur.pn * tstep;
    S.a_ready(cur);
    if constexpr (SP2) {
        PG8_STAGE(PG8_SB(0, 0), cB, voffB); PG8_STAGE(PG8_SB(0, 1), cB + hstep, voffB); PG8_STAGE(PG8_SA(0, 0), cA, voffA); PG8_STAGE(PG8_SA(0, 1), cA + hstep, voffA);
        if (wr == 1) PG8_BAR;
        PG8_WAIT_V(2); PG8_BAR;
        PG8_STAGE(PG8_SB(1, 0), cB + kstep, voffB); PG8_STAGE(PG8_SA(1, 0), cA + kstep, voffA); PG8_STAGE(PG8_SB(1, 1), cB + hstep + kstep, voffB);
        PG8_WAIT_V(6); PG8_BAR;
    } else {
        PG8_STAGE(PG8_SB(0, 0), cB, voffB); PG8_STAGE(PG8_SA(0, 0), cA, voffA); PG8_STAGE(PG8_SB(0, 1), cB + hstep, voffB); PG8_STAGE(PG8_SA(0, 1), cA + hstep, voffA);
        if (wr == 1) PG8_BAR;
        PG8_WAIT_V(4); PG8_BAR;
        PG8_STAGE(PG8_SB(1, 0), cB + kstep, voffB); PG8_STAGE(PG8_SA(1, 0), cA + kstep, voffA); PG8_STAGE(PG8_SB(1, 1), cB + hstep + kstep, voffB);
        PG8_WAIT_V(6); PG8_BAR;
    }
    for (;;) {
        const bool has_next = S.next(ui + 1, nxt);
        const char* nA = has_next ? (const char*)g.A + (size_t)nxt.pm * tstep : cA; const char* nB = has_next ? (const char*)g.Bt + (size_t)nxt.pn * tstep : cB;
        for (int t = 0; t < nt; t += 2) {
            const bool last = (t == nt - 2);
            const char* a1 = cA + (size_t)(t + 1) * kstep;
            const char* a2 = last ? nA : cA + (size_t)(t + 2) * kstep; const char* b2 = last ? nB : cB + (size_t)(t + 2) * kstep;
            const char* a3 = a2 + kstep; const char* b3 = b2 + kstep;
            if (last && has_next) S.a_ready(nxt);
            if constexpr (SP2) {
            PG8_LDB(B0, 0, 0); PG8_LDB(B1, 0, 1); PG8_SCHED; PG8_LDA(At, 0, 0); PG8_STAGE(PG8_SA(1, 1), a1 + hstep, voffA);
            PG8_WAIT_V(8); PG8_WAIT_L(0); PG8_BAR; PG8_MMA(0, 0, At, B0); PG8_MMA(0, 1, At, B1); PG8_BAR; PG8_SCHED;
            PG8_LDA(At, 0, 1); PG8_STAGE(PG8_SB(0, 0), b2, voffB); PG8_STAGE(PG8_SB(0, 1), b2 + hstep, voffB); PG8_STAGE(PG8_SA(0, 0), a2, voffA);
            PG8_WAIT_V(8); PG8_WAIT_L(0); PG8_BAR; PG8_MMA(1, 0, At, B0); PG8_MMA(1, 1, At, B1); PG8_BAR; PG8_SCHED;
            PG8_LDB(B0, 1, 0); PG8_LDB(B1, 1, 1); PG8_SCHED; PG8_LDA(At, 1, 0); PG8_STAGE(PG8_SA(0, 1), a2 + hstep, voffA);
            PG8_WAIT_V(8); PG8_WAIT_L(0); PG8_BAR; PG8_MMA(0, 0, At, B0); PG8_MMA(0, 1, At, B1); PG8_BAR; PG8_SCHED;
            PG8_LDA(At, 1, 1); PG8_STAGE(PG8_SB(1, 0), b3, voffB); PG8_STAGE(PG8_SB(1, 1), b3 + hstep, voffB); PG8_STAGE(PG8_SA(1, 0), a3, voffA);
            PG8_WAIT_V(8); PG8_WAIT_L(0); PG8_BAR; PG8_MMA(1, 0, At, B0); PG8_MMA(1, 1, At, B1); PG8_BAR; PG8_SCHED;
            } else {
            PG8_LDB(B0, 0, 0); PG8_SCHED; PG8_LDA(At, 0, 0); PG8_STAGE(PG8_SA(1, 1), a1 + hstep, voffA);
            PG8_WAIT_L(8); PG8_BAR; PG8_WAIT_L(0); PG8_MMA(0, 0, At, B0); PG8_BAR; PG8_SCHED;
            PG8_LDB(B1, 0, 1); PG8_STAGE(PG8_SB(0, 0), b2, voffB);
            PG8_BAR; PG8_WAIT_L(0); PG8_MMA(0, 1, At, B1); PG8_BAR;
            PG8_LDA(At, 0, 1); PG8_STAGE(PG8_SA(0, 0), a2, voffA);
            PG8_BAR; PG8_WAIT_L(0); PG8_MMA(1, 0, At, B0); PG8_BAR; PG8_SCHED;
            PG8_STAGE(PG8_SB(0, 1), b2 + hstep, voffB);
            PG8_WAIT_V(6); PG8_BAR; PG8_MMA(1, 1, At, B1); PG8_BAR;
            PG8_LDB(B0, 1, 0); PG8_SCHED; PG8_LDA(At, 1, 0); PG8_STAGE(PG8_SA(0, 1), a2 + hstep, voffA);
            PG8_WAIT_L(8); PG8_BAR; PG8_WAIT_L(0); PG8_MMA(0, 0, At, B0); PG8_BAR; PG8_SCHED;
            PG8_LDB(B1, 1, 1); PG8_STAGE(PG8_SB(1, 0), b3, voffB);
            PG8_BAR; PG8_WAIT_L(0); PG8_MMA(0, 1, At, B1); PG8_BAR;
            PG8_LDA(At, 1, 1); PG8_STAGE(PG8_SA(1, 0), a3, voffA);
            PG8_BAR; PG8_WAIT_L(0); PG8_MMA(1, 0, At, B0); PG8_BAR; PG8_SCHED;
            PG8_STAGE(PG8_SB(1, 1), b3 + hstep, voffB);
            PG8_WAIT_V(6); PG8_BAR; PG8_MMA(1, 1, At, B1); PG8_BAR;
            }
        }
        if constexpr (ALIGN_EPI) { if (wr == 0) PG8_BAR; }
        if constexpr (!Epi::AFTER_DRAIN) { E(acc, cur, wr, wc, fr, fq); S.done(cur); }
        if (!has_next) break;
#pragma unroll
        for (int a = 0; a < 2; ++a)
#pragma unroll
            for (int b = 0; b < 2; ++b)
#pragma unroll
                for (int m = 0; m < 4; ++m)
#pragma unroll
                    for (int n = 0; n < 2; ++n) acc[a][b][m][n] = (f32x4){0.f, 0.f, 0.f, 0.f};
        cur = nxt; cA = nA; cB = nB; ++ui;
        if constexpr (ALIGN_EPI) { if (wr == 1) PG8_BAR; }
    }
    PG8_WAIT_V(0);
    if constexpr (!ALIGN_EPI) { if (wr == 0) PG8_BAR; }
    PG8_BAR;
    if constexpr (Epi::AFTER_DRAIN) { E.fused(acc, cur, wr, wc, fr, fq, lds, wid, lane); S.done(cur); }
#undef PG8_SA
#undef PG8_SB
#undef PG8_STAGE
#undef PG8_LDA
#undef PG8_LDB
#undef PG8_MMA
#undef PG8_WAIT_V
#undef PG8_WAIT_L
#undef PG8_BAR
#undef PG8_SCHED
}
}
constexpr int BATCH = 4, SEQ = 8192, D = 1024, M = BATCH * SEQ, FF = 2816, NGU = 2 * FF, NIN = 1280, NBLK = M / 128, NB_SEQ = SEQ / 128;
constexpr float EPS = 1e-6f;
constexpr float QSCALE = 0.125f * 1.4426950408889634f;
constexpr float LOG2E = 1.4426950408889634f;
constexpr int NWAVES = 8, NTHREADS = 512;
constexpr size_t MiB = 1u << 20;
constexpr size_t WS_WGU1 = 0, WS_WGU2 = 11 * MiB, WS_WD1 = 22 * MiB, WS_WD2 = 28 * MiB, WS_WIN = 34 * MiB, WS_WOUT = 37 * MiB, WS_WPOOL = 39 * MiB, WS_CS = 40 * MiB;
constexpr size_t WS_CTL = 46 * MiB, CTL_BYTES = 16384;
constexpr size_t WS_A = 48 * MiB, WS_HD = 112 * MiB, WS_H = 176 * MiB, WS_Z = 176 * MiB, WS_VT = 256 * MiB, WS_Y = 264 * MiB, WS_XR = 352 * MiB, WS_END = 416 * MiB;
static_assert((size_t)NGU * D * 2 <= 11 * MiB && (size_t)D * FF * 2 <= 6 * MiB && (size_t)NIN * D * 2 <= 3 * MiB && (size_t)M * 16 * 4 <= 8 * MiB, "ws map");
static_assert(WS_Z + (size_t)M * NIN * 2 <= WS_VT && WS_VT + (size_t)M * 128 * 2 <= WS_Y && WS_Y + (size_t)M * D * 2 <= WS_END && WS_H + (size_t)M * FF * 2 <= WS_XR && WS_XR + (size_t)M * D * 2 <= WS_END, "ws map 2");
constexpr int LDS_BYTES = 147456;
constexpr int KL_OFF = 0, KL_PITCH = 144, VL_OFF = 36864, VL_PITCH = 520, DL_OFF = 36864 + 33280, DL_PITCH = 272, SS_OFF = DL_OFF + 34816;
constexpr int UL_OFF = 0, UL_PITCH = 272, UL_ROWS = 143;
static_assert(UL_OFF + UL_ROWS * UL_PITCH <= DL_OFF, "U tile overlays K|V only");
static_assert(SS_OFF + 16 * 128 * 4 <= 131072, "mixer LDS");
constexpr int RS_OFF = SS_OFF + 16 * 128 * 4, STG_OFF = RS_OFF + 1024;
constexpr int MISC_OFF = STG_OFF + 32768;
static_assert(MISC_OFF >= 131072 && MISC_OFF + 128 <= LDS_BYTES && STG_OFF % 16 == 0, "LDS map");

#define LAS __attribute__((address_space(3)))
typedef unsigned short bf16;
typedef unsigned u32x4 __attribute__((ext_vector_type(4)));
typedef unsigned u32x2 __attribute__((ext_vector_type(2)));
typedef float f32x4 __attribute__((ext_vector_type(4)));
typedef float f32x16 __attribute__((ext_vector_type(16)));
typedef short bf16x8 __attribute__((ext_vector_type(8)));
using pg8::cvtpk;
__device__ __forceinline__ float bflo(unsigned w) { return __uint_as_float(w << 16); }
__device__ __forceinline__ float bfhi(unsigned w) { return __uint_as_float(w & 0xffff0000u); }
__device__ __forceinline__ float wave_sum(float v) {
#pragma unroll
    for (int o = 1; o < 64; o <<= 1) v += __shfl_xor(v, o);
    return v;
}
__device__ __forceinline__ float half_sum32(float v) {
#pragma unroll
    for (int o = 1; o < 32; o <<= 1) v += __shfl_xor(v, o);
    return v;
}
__device__ __forceinline__ int crow(int r, int hi) { return (r & 3) + 8 * (r >> 2) + 4 * hi; }

struct Args {
    const float* x; const int* pos;
    const float *ffn1_pre, *ffn1_wgu, *ffn1_wd, *ffn1_post, *mix_pre, *w_in, *w_pool, *pool_scale, *sinks, *g_pool, *g_attn, *w_out, *mix_post, *ffn2_pre, *ffn2_wgu, *ffn2_wd, *ffn2_post;
    float* out; unsigned char* ws; int ph_lo, ph_hi;
};

__device__ __forceinline__ int dest_row(int mode, int n) {
    if (mode == 1) { return n < FF ? ((n >> 7) * 256 + (n & 127)) : ((((n - FF) >> 7) * 256) + 128 + ((n - FF) & 127)); }
    if (mode == 2) { if (n >= 512 && n < 1152) { const int d = n & 63; const int p = (d >= 4 && d < 8) ? d + 4 : ((d >= 8 && d < 12) ? d - 4 : d); return (n - d) + p; } return n; }
    return n;
}
__device__ __forceinline__ void transpose_item(const float* W, int K, int N, bf16* WT, int mode, LAS float* scr, int item, int lane) {
    const int nblk = N / 32, kb = item / nblk, nb = item % nblk, k0 = 64 * kb, n0 = 32 * nb;
#pragma unroll 8
    for (int i = 0; i < 32; ++i) { const int kk = 2 * i + (lane >> 5); scr[kk * 33 + (lane & 31)] = W[(size_t)(k0 + kk) * N + n0 + (lane & 31)]; }
    asm volatile("s_waitcnt lgkmcnt(0)" ::: "memory");
    const int c = lane & 7;
#pragma unroll
    for (int j = 0; j < 4; ++j) { const int n = (lane >> 3) + 8 * j; const LAS float* s = scr + (8 * c) * 33 + n;
        u32x4 o; o.x = cvtpk(s[0 * 33], s[1 * 33]); o.y = cvtpk(s[2 * 33], s[3 * 33]); o.z = cvtpk(s[4 * 33], s[5 * 33]); o.w = cvtpk(s[6 * 33], s[7 * 33]);
        *(u32x4*)(WT + (size_t)dest_row(mode, n0 + n) * K + k0 + 8 * c) = o; }
    asm volatile("s_waitcnt lgkmcnt(0)" ::: "memory");
}
__device__ __forceinline__ void sincos_f(float a, float& sn, float& cn) {
    const double ad = (double)a; const double q = __builtin_rint(ad * 0.63661977236758134308);
    const float r = (float)__builtin_fma(-q, 1.57079632679489661923, ad); const int qi = ((int)q) & 3;
    const float z = r * r;
    const float s = r + r * z * (-1.6666654611e-1f + z * (8.3321608736e-3f + z * (-1.9515295891e-4f)));
    const float c = 1.0f - 0.5f * z + z * z * (4.166664568298827e-2f + z * (-1.388731625493765e-3f + z * 2.443315711809948e-5f));
    sn = (qi == 0) ? s : (qi == 1) ? c : (qi == 2) ? -s : -c;
    cn = (qi == 0) ? c : (qi == 1) ? -s : (qi == 2) ? -c : s;
}
__device__ __forceinline__ float inv_freq(int i) {
    return i == 0 ? 1.0f : i == 1 ? 0.19392274474868576f : i == 2 ? 0.03760603093086393f : i == 3 ? 0.007292664737217109f : i == 4 ? 0.001414213562373095f : i == 5 ? 0.0002742481756762073f : i == 6 ? 5.318295896944988e-05f : 1.031338537721246e-05f;
}
__device__ __forceinline__ void prenorm_rows(const float* x, const float* g, bf16* a, int gw, int NGW, int lane) {
    f32x4 gv[4];
#pragma unroll
    for (int j = 0; j < 4; ++j) gv[j] = *((const f32x4*)g + lane + 64 * j);
    for (int m = gw; m < M; m += NGW) {
        const f32x4* xr = (const f32x4*)(x + (size_t)m * D) + lane; f32x4 v[4]; float s = 0.f;
#pragma unroll
        for (int j = 0; j < 4; ++j) { v[j] = xr[64 * j]; s += (v[j].x * v[j].x + v[j].y * v[j].y) + (v[j].z * v[j].z + v[j].w * v[j].w); }
        const float r = 1.0f / sqrtf(wave_sum(s) * (1.0f / D) + EPS);
        u32x2* o = (u32x2*)(a + (size_t)m * D) + lane;
#pragma unroll
        for (int j = 0; j < 4; ++j) { const f32x4 y = v[j] * r * gv[j]; u32x2 w; w.x = cvtpk(y.x, y.y); w.y = cvtpk(y.z, y.w); o[64 * j] = w; }
    }
}
template <bool HAS_A, bool XI_BF, bool XO_BF>
__device__ __forceinline__ void thin_rows(const void* xi, void* xo, const bf16* h, const float* gpost, const float* gpre, bf16* a, float coef, int gw, int NGW, int lane) {
    for (int m = gw; m < M; m += NGW) {
        const u32x2* hr = (const u32x2*)(h + (size_t)m * D) + lane;
        f32x4 v[4], hv[4]; float s = 0.f;
#pragma unroll
        for (int j = 0; j < 4; ++j) {
            if (XI_BF) { const u32x2 w = ((const u32x2*)((const bf16*)xi + (size_t)m * D) + lane)[64 * j]; v[j] = (f32x4){bflo(w.x), bfhi(w.x), bflo(w.y), bfhi(w.y)}; }
            else v[j] = ((const f32x4*)((const float*)xi + (size_t)m * D) + lane)[64 * j];
            const u32x2 w = hr[64 * j]; hv[j] = (f32x4){bflo(w.x), bfhi(w.x), bflo(w.y), bfhi(w.y)};
            s += (hv[j].x * hv[j].x + hv[j].y * hv[j].y) + (hv[j].z * hv[j].z + hv[j].w * hv[j].w); }
        const float r1 = coef / sqrtf(wave_sum(s) * (1.0f / D) + EPS);
        float s2 = 0.f;
#pragma unroll
        for (int j = 0; j < 4; ++j) { const f32x4 gp = *((const f32x4*)gpost + lane + 64 * j); v[j] = v[j] + hv[j] * r1 * gp;
            s2 += (v[j].x * v[j].x + v[j].y * v[j].y) + (v[j].z * v[j].z + v[j].w * v[j].w); }
#pragma unroll
        for (int j = 0; j < 4; ++j) {
            if (XO_BF) { u32x2 w; w.x = cvtpk(v[j].x, v[j].y); w.y = cvtpk(v[j].z, v[j].w); ((u32x2*)((bf16*)xo + (size_t)m * D) + lane)[64 * j] = w; }
            else ((f32x4*)((float*)xo + (size_t)m * D) + lane)[64 * j] = v[j]; }
        if (HAS_A) {
            const float r2 = 1.0f / sqrtf(wave_sum(s2) * (1.0f / D) + EPS);
            u32x2* o = (u32x2*)(a + (size_t)m * D) + lane;
#pragma unroll
            for (int j = 0; j < 4; ++j) { const f32x4 gq = *((const f32x4*)gpre + lane + 64 * j); const f32x4 y = v[j] * r2 * gq; u32x2 w; w.x = cvtpk(y.x, y.y); w.y = cvtpk(y.z, y.w); o[64 * j] = w; }
        }
    }
}
#define XB_TMO      128
#define XB_XCNT(j)  (256  + 64 * (j))
#define XB_XSUB(j)  (1280 + 64 * (j))
#define XB_XGEN(j)  (2304 + 64 * (j))
#define XB_TOP      3328
#define XB_TOPGEN   3392
#define XCD_BAR_WORDS 3456
#define XB_SPIN_CAP (1u << 18)

__device__ __forceinline__ unsigned xb_ld(unsigned* p)              { return __hip_atomic_load(p, __ATOMIC_RELAXED, __HIP_MEMORY_SCOPE_AGENT); }
__device__ __forceinline__ unsigned xb_add(unsigned* p, unsigned v) { return __hip_atomic_fetch_add(p, v, __ATOMIC_RELAXED, __HIP_MEMORY_SCOPE_AGENT); }
__device__ __forceinline__ unsigned xb_xcc_id() { return (unsigned)__builtin_amdgcn_s_getreg((3 << 11) | 20) & 0xFu; }
#define XB_SPIN(cond, bar) do { unsigned _sp = 0; while (cond) { __builtin_amdgcn_s_sleep(1); \
    if ((++_sp & 255u) == 0u) { if (xb_ld(&(bar)[XB_TMO])) break; if (_sp > XB_SPIN_CAP) { atomicAdd(&(bar)[XB_TMO], 1u); break; } } } } while (0)

struct XcdBarrier {
    unsigned* bar; unsigned x;
    volatile LAS unsigned* st;
};

__device__ __forceinline__ XcdBarrier xcd_barrier_post(unsigned* bar, volatile LAS unsigned* st) {
    XcdBarrier b; b.bar = bar; b.x = xb_xcc_id(); b.st = st;
    if (threadIdx.x == 0) (void)xb_add(&bar[XB_XCNT(b.x)], 1u);
    return b;
}
__device__ __forceinline__ void xcd_barrier_complete(unsigned* bar, unsigned x, unsigned& nloc, unsigned& nx) {
    const unsigned G = gridDim.x * gridDim.y * gridDim.z;
    unsigned sum, cnt, mine, sp = 0u;
    for (;;) {
        sum = 0u; cnt = 0u; mine = 0u;
#pragma unroll
        for (unsigned j = 0; j < 16; ++j) { const unsigned c = xb_ld(&bar[XB_XCNT(j)]); sum += c; cnt += (c > 0u) ? 1u : 0u; mine = (j == x) ? c : mine; }
        if (sum == G) break;
        __builtin_amdgcn_s_sleep(1);
        if ((++sp & 255u) == 0u) { if (xb_ld(&bar[XB_TMO])) break; if (sp > XB_SPIN_CAP) { atomicAdd(&bar[XB_TMO], 1u); break; } }
    }
    nloc = mine > 0u ? mine : 1u; nx = cnt > 0u ? cnt : 1u;
}

__device__ __forceinline__ void xcd_barrier(const XcdBarrier& b) {
    asm volatile("s_waitcnt vmcnt(0)" ::: "memory");
    __syncthreads();
    if (threadIdx.x == 0) {
        unsigned* bar = b.bar;
        __builtin_amdgcn_s_waitcnt(0);
        unsigned nloc = b.st[0], nx = b.st[1];
        if (nloc == 0u) { xcd_barrier_complete(bar, b.x, nloc, nx); b.st[0] = nloc; b.st[1] = nx; }
        const unsigned old = xb_add(&bar[XB_XSUB(b.x)], 1u);
        const unsigned gen = old / nloc;
        if (old + 1u == (gen + 1u) * nloc) {
            __builtin_amdgcn_fence(__ATOMIC_RELEASE, "agent");
            asm volatile("s_waitcnt vmcnt(0)" ::: "memory");
            const unsigned og = xb_add(&bar[XB_TOP], 1u);
            const unsigned tg = og / nx;
            if (og + 1u == (tg + 1u) * nx) xb_add(&bar[XB_TOPGEN], 1u);
            else XB_SPIN(xb_ld(&bar[XB_TOPGEN]) == tg, bar);
            __builtin_amdgcn_fence(__ATOMIC_ACQUIRE, "agent");
            xb_add(&bar[XB_XGEN(b.x)], 1u);
            asm volatile("s_waitcnt vmcnt(0)" ::: "memory");
        } else {
            XB_SPIN(xb_ld(&bar[XB_XGEN(b.x)]) == gen, bar);
            __builtin_amdgcn_fence(__ATOMIC_ACQUIRE, "agent");
            asm volatile("s_waitcnt vmcnt(0)" ::: "memory");
        }
    }
    __syncthreads();
}
#define MFMA32(a, b, c) __builtin_amdgcn_mfma_f32_32x32x16_bf16((a), (b), (c), 0, 0, 0)
__device__ __forceinline__ void load8(const bf16* p, float (&f)[8]) { const u32x4 w = *(const u32x4*)p;
    f[0] = bflo(w.x); f[1] = bfhi(w.x); f[2] = bflo(w.y); f[3] = bfhi(w.y); f[4] = bflo(w.z); f[5] = bfhi(w.z); f[6] = bflo(w.w); f[7] = bfhi(w.w); }

#define OPAQUE_V(x) asm volatile("" : "+v"(x))
#define OPAQUE_S(x) asm volatile("" : "+s"(x))
struct MixCtx { LAS unsigned char* lds; const bf16* Z; const bf16* Vt; const bf16* WpT; const float* pool_scale; const float* sinks; bf16* Y; size_t rowbase; int b, n, tid, lane, r32, hi, rg, ch; };

__device__ __forceinline__ void pool_load(const MixCtx& c, int g, u32x4 (&pre)[5]) {
#pragma unroll
    for (int k = 0; k < 5; ++k) { const int i = c.tid + NTHREADS * k, jr = i >> 4, cc = i & 15; pre[k] = (u32x4){0u, 0u, 0u, 0u};
        if (jr < UL_ROWS && c.n * 128 + jr - 15 >= 0) pre[k] = *(const u32x4*)(c.Z + (ptrdiff_t)((ptrdiff_t)c.rowbase + jr - 15) * NIN + g * 128 + cc * 8); }
}
template <int G> __device__ __forceinline__ void pool_group(const MixCtx& c, u32x4 (&pre)[5], unsigned (&kp)[16]) {
    constexpr int w = 2 << G;
    LAS unsigned char* lds = c.lds; int tid = c.tid, lane_ = c.lane, wid_ = c.rg + 4 * c.ch; OPAQUE_V(tid); OPAQUE_V(lane_); OPAQUE_S(wid_);
    const int r32 = lane_ & 31, hi = lane_ >> 5, rg = wid_ & 3, ch = wid_ >> 2;
#pragma unroll
    for (int k = 0; k < 5; ++k) { const int i = tid + NTHREADS * k, jr = i >> 4, cc = i & 15; if (jr < UL_ROWS) *(LAS u32x4*)(lds + UL_OFF + jr * UL_PITCH + cc * 16) = pre[k]; }
    __syncthreads();
    if (G < 3) pool_load(c, G + 1, pre);
    {
        const int c8 = tid & 15, t0 = (tid >> 4) * 4;
        const LAS unsigned char* ub = lds + UL_OFF + (15 + t0) * UL_PITCH + c8 * 16;
        float s[8], uv[8];
#pragma unroll
        for (int i = 0; i < 8; ++i) s[i] = 0.f;
#define LDU(row) do { const u32x4 w_ = *(const LAS u32x4*)(ub + (row) * UL_PITCH); uv[0] = bflo(w_.x); uv[1] = bfhi(w_.x); uv[2] = bflo(w_.y); uv[3] = bfhi(w_.y); uv[4] = bflo(w_.z); uv[5] = bfhi(w_.z); uv[6] = bflo(w_.w); uv[7] = bfhi(w_.w); } while (0)
#pragma unroll
        for (int j = 1 - w; j < 0; ++j) { LDU(j);
#pragma unroll
            for (int i = 0; i < 8; ++i) s[i] += uv[i]; }
#pragma unroll
        for (int tt = 0; tt < 4; ++tt) { const int t = t0 + tt;
            LDU(tt);
#pragma unroll
            for (int i = 0; i < 8; ++i) s[i] += uv[i];
            const int sp = c.n * 128 + t; const int cnt = (sp + 1 < w) ? sp + 1 : w; const float inv = 1.0f / (float)cnt;
            u32x4 o; o.x = cvtpk(s[0] * inv - uv[0], s[1] * inv - uv[1]); o.y = cvtpk(s[2] * inv - uv[2], s[3] * inv - uv[3]);
            o.z = cvtpk(s[4] * inv - uv[4], s[5] * inv - uv[5]); o.w = cvtpk(s[6] * inv - uv[6], s[7] * inv - uv[7]);
            *(LAS u32x4*)(lds + DL_OFF + t * DL_PITCH + c8 * 16) = o;
            LDU(tt - w + 1);
#pragma unroll
            for (int i = 0; i < 8; ++i) s[i] -= uv[i]; }
#undef LDU
    }
    __syncthreads();
    {
        f32x16 a0, a1;
#pragma unroll
        for (int i = 0; i < 16; ++i) { a0[i] = 0.f; a1[i] = 0.f; }
        const bf16* wp = c.WpT + (size_t)G * 16384 + (size_t)(64 * ch + r32) * 128 + 8 * hi;
#pragma unroll
        for (int ks = 0; ks < 8; ++ks) {
            const bf16x8 A = *(const LAS bf16x8*)(lds + DL_OFF + (32 * rg + r32) * DL_PITCH + (16 * ks + 8 * hi) * 2);
            const bf16x8 B0 = *(const bf16x8*)(wp + 16 * ks), B1 = *(const bf16x8*)(wp + 32 * 128 + 16 * ks);
            a0 = MFMA32(A, B0, a0); a1 = MFMA32(A, B1, a1);
        }
        const int c0 = G * 128 + 64 * ch + r32;
        const float ps0 = c.pool_scale[c0], ps1 = c.pool_scale[c0 + 32];
        LAS float* ssb = (LAS float*)(lds + SS_OFF) + (G * 2 + ch) * 128 + 32 * rg + 4 * hi;
#pragma unroll
        for (int r = 0; r < 16; ++r) { const int ro = (r & 3) + 8 * (r >> 2); const float v0 = a0[r] * ps0, v1 = a1[r] * ps1;
            const float q = half_sum32(v0 * v0 + v1 * v1);
            if (r32 == 0) ssb[ro] = q;
            kp[r] = cvtpk(v0, v1); }
    }
}
template <int KH, int GI> __device__ __forceinline__ void att_item(const MixCtx& c, bf16x8 (&qr)[4], const bf16* qp, unsigned (&kp)[16]) {
    LAS unsigned char* lds = c.lds; int lane_ = c.lane, wid_ = c.rg + 4 * c.ch; OPAQUE_V(lane_); OPAQUE_S(wid_);
    const int r32 = lane_ & 31, hi = lane_ >> 5, rg = wid_ & 3, ch = wid_ >> 2, n = c.n;
    const int h = KH * 4 + 2 * ch + GI;
    f32x16 S[5];
#pragma unroll
    for (int t = 0; t < 5; ++t) {
#pragma unroll
        for (int i = 0; i < 16; ++i) S[t][i] = 0.f;
#pragma unroll
        for (int d0 = 0; d0 < 4; ++d0) { const bf16x8 kf = *(const LAS bf16x8*)(lds + KL_OFF + (32 * (rg + t) + r32) * KL_PITCH + (16 * d0 + 8 * hi) * 2);
            S[t] = MFMA32(kf, qr[d0], S[t]); }
        if (t & 1) __builtin_amdgcn_sched_barrier(0);
    }
    if (GI == 0) {
#pragma unroll
        for (int d0 = 0; d0 < 4; ++d0) qr[d0] = *(const bf16x8*)(qp + 64 + 16 * d0);
    }
    const float sinkl = c.sinks[h] * LOG2E;
    float mx = sinkl;
#pragma unroll
    for (int t = 0; t < 5; ++t)
#pragma unroll
        for (int r = 0; r < 16; ++r) {
            const bool tv = (n > 0) || (rg + t >= 4);
            const bool valid = (t == 0) ? (tv && (crow(r, hi) > r32)) : (t == 4) ? (crow(r, hi) <= r32) : tv;
            const float sv = valid ? S[t][r] : -1e30f; S[t][r] = sv; mx = fmaxf(mx, sv); }
    mx = fmaxf(mx, __shfl_xor(mx, 32));
    float sum = 0.f;
#pragma unroll
    for (int t = 0; t < 5; ++t)
#pragma unroll
        for (int r = 0; r < 16; ++r) { const float p = __builtin_amdgcn_exp2f(S[t][r] - mx); S[t][r] = p; sum += p; }
    sum += __shfl_xor(sum, 32);
    sum += __builtin_amdgcn_exp2f(sinkl - mx);
    const float linv = 1.0f / sum;
    f32x16 o0, o1;
#pragma unroll
    for (int i = 0; i < 16; ++i) { o0[i] = 0.f; o1[i] = 0.f; }
#pragma unroll
    for (int t = 0; t < 5; ++t)
#pragma unroll
        for (int s = 0; s < 2; ++s) {
            u32x4 pw; pw.x = cvtpk(S[t][8 * s + 0], S[t][8 * s + 1]); pw.y = cvtpk(S[t][8 * s + 2], S[t][8 * s + 3]); pw.z = cvtpk(S[t][8 * s + 4], S[t][8 * s + 5]); pw.w = cvtpk(S[t][8 * s + 6], S[t][8 * s + 7]);
            const bf16x8 pa = __builtin_bit_cast(bf16x8, pw);
            const int keyb = 32 * (rg + t) + 16 * s + 4 * hi;
            const LAS unsigned char* vb = lds + VL_OFF + r32 * VL_PITCH + keyb * 2;
            const u32x2 l0 = *(const LAS u32x2*)(vb), h0 = *(const LAS u32x2*)(vb + 16);
            const u32x2 l1 = *(const LAS u32x2*)(vb + 32 * VL_PITCH), h1 = *(const LAS u32x2*)(vb + 32 * VL_PITCH + 16);
            const bf16x8 v0 = __builtin_bit_cast(bf16x8, ((u32x4){l0.x, l0.y, h0.x, h0.y})), v1 = __builtin_bit_cast(bf16x8, ((u32x4){l1.x, l1.y, h1.x, h1.y}));
            o0 = MFMA32(pa, v0, o0); o1 = MFMA32(pa, v1, o1);
            if (s == 1) __builtin_amdgcn_sched_barrier(0);
        }
    LAS float* ssb = (LAS float*)(lds + SS_OFF) + (8 + h) * 128 + 32 * rg + 4 * hi;
#pragma unroll
    for (int r = 0; r < 16; ++r) { const int ro = (r & 3) + 8 * (r >> 2); const float li = __shfl(linv, ro + 4 * hi);
        const float v0 = o0[r] * li, v1 = o1[r] * li;
        const float q = half_sum32(v0 * v0 + v1 * v1);
        if (r32 == 0) ssb[ro] = q;
        kp[r] = cvtpk(v0, v1); }
}
template <int KH> __device__ __forceinline__ void att_kvhead(const MixCtx& c, unsigned (&kpA)[16], unsigned (&kpB)[16]) {
    LAS unsigned char* lds = c.lds; int tid = c.tid; OPAQUE_V(tid); const int n = c.n;
    const bf16* qp = c.Z + (c.rowbase + 32 * c.rg + c.r32) * NIN + 512 + (KH * 4 + 2 * c.ch) * 64 + 8 * c.hi;
    bf16x8 qr[4];
#pragma unroll
    for (int d0 = 0; d0 < 4; ++d0) qr[d0] = *(const bf16x8*)(qp + 16 * d0);
#pragma unroll
    for (int k = 0; k < 4; ++k) {
        const int i = tid + NTHREADS * k, key = i >> 3, cc = i & 7; const bool valid = (n > 0) || (key >= 128);
        u32x4 v = (u32x4){0u, 0u, 0u, 0u};
        if (valid) v = *(const u32x4*)(c.Z + (c.rowbase + key - 128) * NIN + 1024 + KH * 64 + cc * 8);
        *(LAS u32x4*)(lds + KL_OFF + key * KL_PITCH + cc * 16) = v;
    }
#pragma unroll
    for (int k = 0; k < 4; ++k) {
        const int i = tid + NTHREADS * k, d = i >> 5, cc = i & 31; const bool valid = (n > 0) || (cc >= 16);
        u32x4 v = (u32x4){0u, 0u, 0u, 0u};
        if (valid) v = *(const u32x4*)(c.Vt + ((size_t)((c.b * 2 + KH) * 64 + d)) * SEQ + n * 128 - 128 + cc * 8);
        LAS u32x2* dst = (LAS u32x2*)(lds + VL_OFF + d * VL_PITCH + cc * 16);
        dst[0] = (u32x2){v.x, v.y}; dst[1] = (u32x2){v.z, v.w};
    }
    __syncthreads();
    att_item<KH, 0>(c, qr, qp, kpA);
    att_item<KH, 1>(c, qr, qp, kpB);
    __syncthreads();
}
__device__ __forceinline__ void finalize_item(const MixCtx& c, const unsigned (&kp)[16], const float* gptr, int colbase, int wid) {
    LAS bf16* stg = (LAS bf16*)(c.lds + STG_OFF) + wid * 2048; const LAS float* RS = (const LAS float*)(c.lds + RS_OFF);
    int lane = c.lane; OPAQUE_V(lane); const int r32 = lane & 31, hi = lane >> 5, rg = c.rg;
    const float g0 = gptr[r32], g1 = gptr[32 + r32];
#pragma unroll
    for (int r = 0; r < 16; ++r) { const int ro = (r & 3) + 8 * (r >> 2) + 4 * hi; const float rs = RS[32 * rg + ro];
        stg[ro * 64 + r32] = (bf16)(cvtpk(bflo(kp[r]) * rs * g0, 0.f) & 0xffffu); stg[ro * 64 + 32 + r32] = (bf16)(cvtpk(bfhi(kp[r]) * rs * g1, 0.f) & 0xffffu); }
    asm volatile("s_waitcnt lgkmcnt(0)" ::: "memory");
    bf16* yb = c.Y + (c.rowbase + 32 * rg + (lane >> 3)) * D + colbase + (lane & 7) * 8; asm volatile("" : "+v"(yb));
#pragma unroll
    for (int i = 0; i < 4; ++i) { const u32x4 v = *(const LAS u32x4*)(stg + (i * 8 + (lane >> 3)) * 64 + (lane & 7) * 8); *(u32x4*)(yb + (size_t)i * 8 * D) = v; }
    asm volatile("s_waitcnt lgkmcnt(0)" ::: "memory");
}
__device__ __forceinline__ void row_scale_table(LAS unsigned char* lds, int tid, int slot0) {
    if (tid < 128) { const LAS float* SS = (const LAS float*)(lds + SS_OFF); float ss = 0.f;
#pragma unroll
        for (int k = 0; k < 8; ++k) ss += SS[(slot0 + k) * 128 + tid];
        ((LAS float*)(lds + RS_OFF))[tid] = 1.0f / sqrtf(ss * (1.0f / 512.0f) + EPS); }
}
__device__ __forceinline__ void mixer_block(LAS unsigned char* lds, int blk, const bf16* Z, const bf16* Vt, const bf16* WpT, const float* pool_scale, const float* sinks,
                                            const float* g_pool, const float* g_attn, bf16* Y, int tid, int wid, int lane) {
    OPAQUE_V(tid); OPAQUE_V(lane); OPAQUE_S(wid);
    MixCtx c; c.lds = lds; c.Z = Z; c.Vt = Vt; c.WpT = WpT; c.pool_scale = pool_scale; c.sinks = sinks; c.Y = Y; c.rowbase = (size_t)blk * 128;
    c.b = blk / NB_SEQ; c.n = blk % NB_SEQ; c.tid = tid; c.lane = lane; c.r32 = lane & 31; c.hi = lane >> 5; c.rg = wid & 3; c.ch = wid >> 2;
    unsigned k0[16], k1[16], k2[16], k3[16];
    {
        u32x4 pre[5];
        pool_load(c, 0, pre);
        pool_group<0>(c, pre, k0); pool_group<1>(c, pre, k1); pool_group<2>(c, pre, k2); pool_group<3>(c, pre, k3);
    }
    __syncthreads();
    row_scale_table(lds, tid, 0);
    __syncthreads();
    { const int cb = 64 * c.ch;
      finalize_item(c, k0, g_pool + cb, cb, wid); finalize_item(c, k1, g_pool + 128 + cb, 128 + cb, wid); finalize_item(c, k2, g_pool + 256 + cb, 256 + cb, wid); finalize_item(c, k3, g_pool + 384 + cb, 384 + cb, wid); }
    att_kvhead<0>(c, k0, k1);
    att_kvhead<1>(c, k2, k3);
    row_scale_table(lds, tid, 8);
    __syncthreads();
    { const int h0 = 2 * c.ch;
      finalize_item(c, k0, g_attn + h0 * 64, 512 + h0 * 64, wid); finalize_item(c, k1, g_attn + (h0 + 1) * 64, 512 + (h0 + 1) * 64, wid);
      finalize_item(c, k2, g_attn + (h0 + 4) * 64, 512 + (h0 + 4) * 64, wid); finalize_item(c, k3, g_attn + (h0 + 5) * 64, 512 + (h0 + 5) * 64, wid); }
    __syncthreads();
}
__global__ void __launch_bounds__(NTHREADS, 2) hybrid_fwd(Args args) {
    extern __shared__ __attribute__((aligned(16))) unsigned char lds_raw[];
    LAS unsigned char* lds = (LAS unsigned char*)lds_raw;
    cg::grid_group grid = cg::this_grid();
    const int tid = threadIdx.x, lane = tid & 63, wid = __builtin_amdgcn_readfirstlane(tid >> 6);
    const int G = gridDim.x, bx = blockIdx.x;
    const int vcu = (G % 8 == 0) ? (bx % 8) * (G / 8) + bx / 8 : bx;
    const int gw = vcu * NWAVES + wid, NGW = G * NWAVES;
    unsigned char* ws = args.ws;
    bf16 *Wgu1 = (bf16*)(ws + WS_WGU1), *Wgu2 = (bf16*)(ws + WS_WGU2), *Wd1 = (bf16*)(ws + WS_WD1), *Wd2 = (bf16*)(ws + WS_WD2), *Win = (bf16*)(ws + WS_WIN), *Wout = (bf16*)(ws + WS_WOUT), *WpT = (bf16*)(ws + WS_WPOOL);
    float* CS = (float*)(ws + WS_CS);
    bf16 *A = (bf16*)(ws + WS_A), *HD = (bf16*)(ws + WS_HD), *H = (bf16*)(ws + WS_H), *Z = (bf16*)(ws + WS_Z), *Vt = (bf16*)(ws + WS_VT), *Y = (bf16*)(ws + WS_Y), *XR = (bf16*)(ws + WS_XR);
    const int lo = args.ph_lo, hi = args.ph_hi;
#define IN(k) (lo <= (k) && (k) < hi)
#define SEAM(k) do { if (IN(k) && IN((k) + 1)) { if ((k) == 0) grid.sync(); else xcd_barrier(bar); } } while (0)
    if (tid < 32) ((LAS unsigned*)(lds + MISC_OFF))[tid] = 0u;
    __syncthreads();
    XcdBarrier bar; bar.bar = (unsigned*)(ws + WS_CTL); bar.x = 0; bar.st = nullptr;
    if (hi - lo > 1) bar = xcd_barrier_post((unsigned*)(ws + WS_CTL), (volatile LAS unsigned*)(lds + MISC_OFF) + 8);

    if (IN(0)) {
        LAS float* scr = (LAS float*)(lds + wid * 16384);
        constexpr int I_GU = (D / 64) * (NGU / 32), I_DN = (FF / 64) * (D / 32), I_IN = (D / 64) * (NIN / 32), I_OUT = (D / 64) * (D / 32), I_PL = 4 * 2 * 4;
        constexpr int NITEMS = 2 * I_GU + 2 * I_DN + I_IN + I_OUT + I_PL;
        for (int it = gw; it < NITEMS; it += NGW) {
            int r = it;
            if (r < I_GU) { transpose_item(args.ffn1_wgu, D, NGU, Wgu1, 1, scr, r, lane); continue; } r -= I_GU;
            if (r < I_GU) { transpose_item(args.ffn2_wgu, D, NGU, Wgu2, 1, scr, r, lane); continue; } r -= I_GU;
            if (r < I_DN) { transpose_item(args.ffn1_wd, FF, D, Wd1, 0, scr, r, lane); continue; } r -= I_DN;
            if (r < I_DN) { transpose_item(args.ffn2_wd, FF, D, Wd2, 0, scr, r, lane); continue; } r -= I_DN;
            if (r < I_IN) { transpose_item(args.w_in, D, NIN, Win, 2, scr, r, lane); continue; } r -= I_IN;
            if (r < I_OUT) { transpose_item(args.w_out, D, D, Wout, 0, scr, r, lane); continue; } r -= I_OUT;
            { const int g = r >> 3; transpose_item(args.w_pool + (size_t)g * 16384, 128, 128, WpT + (size_t)g * 16384, 0, scr, r & 7, lane); }
        }
        for (int idx = vcu * NTHREADS + tid; idx < M * 8; idx += G * NTHREADS) {
            const int row = idx >> 3, i = idx & 7; const float ang = (float)args.pos[row] * inv_freq(i);
            float sn, cn; sincos_f(ang, sn, cn); CS[(size_t)row * 16 + i] = cn; CS[(size_t)row * 16 + 8 + i] = sn;
        }
        prenorm_rows(args.x, args.ffn1_pre, A, gw, NGW, lane);
    }
    SEAM(0);
    if (IN(1)) {
        pg8::Gemm g{A, Wgu1, M, NGU, D}; pg8::StaticOrder S; S.init(M, NGU, G, bx); pg8::EpiSwiGLU E{H, FF};
        pg8::gemm_phase<pg8::EpiSwiGLU, pg8::StaticOrder, true, true>(lds, g, S, E);
    }
    SEAM(1);
    if (IN(2)) {
        pg8::Gemm g{H, Wd1, M, D, FF}; pg8::StaticOrder S; S.init(M, D, G, bx); pg8::EpiBf16<0> E{HD, D, nullptr, 0, 0, 1.f};
        pg8::gemm_phase<pg8::EpiBf16<0>, pg8::StaticOrder, true, true>(lds, g, S, E);
    }
    SEAM(2);
    if (IN(3)) thin_rows<true, false, true>(args.x, XR, HD, args.ffn1_post, args.mix_pre, A, 0.5f, gw, NGW, lane);
    SEAM(3);
    if (IN(4)) {
        pg8::Gemm g{A, Win, M, NIN, D}; pg8::StaticOrder S; S.init(M, NIN, G, bx); pg8::EpiZ E{Z, Vt, CS, QSCALE, SEQ};
        pg8::gemm_phase<pg8::EpiZ, pg8::StaticOrder, true, true>(lds, g, S, E);
    }
    SEAM(4);
    if (IN(5)) { for (int blk = vcu; blk < NBLK; blk += G) mixer_block(lds, blk, Z, Vt, WpT, args.pool_scale, args.sinks, args.g_pool, args.g_attn, Y, tid, wid, lane); }
    SEAM(5);
    if (IN(6)) {
        pg8::Gemm g{Y, Wout, M, D, D}; pg8::StaticOrder S; S.init(M, D, G, bx); pg8::EpiBf16<0> E{HD, D, nullptr, 0, 0, 1.f};
        pg8::gemm_phase<pg8::EpiBf16<0>, pg8::StaticOrder, true, true>(lds, g, S, E);
    }
    SEAM(6);
    if (IN(7)) thin_rows<true, true, true>(XR, XR, HD, args.mix_post, args.ffn2_pre, A, 1.0f, gw, NGW, lane);
    SEAM(7);
    if (IN(8)) {
        pg8::Gemm g{A, Wgu2, M, NGU, D}; pg8::StaticOrder S; S.init(M, NGU, G, bx); pg8::EpiSwiGLU E{H, FF};
        pg8::gemm_phase<pg8::EpiSwiGLU, pg8::StaticOrder, true, true>(lds, g, S, E);
    }
    SEAM(8);
    if (IN(9)) {
        pg8::Gemm g{H, Wd2, M, D, FF}; pg8::StaticOrder S; S.init(M, D, G, bx); pg8::EpiBf16<0> E{HD, D, nullptr, 0, 0, 1.f};
        pg8::gemm_phase<pg8::EpiBf16<0>, pg8::StaticOrder, true, true>(lds, g, S, E);
    }
    SEAM(9);
    if (IN(10)) thin_rows<false, true, false>(XR, args.out, HD, args.ffn2_post, nullptr, nullptr, 0.5f, gw, NGW, lane);
#undef IN
#undef SEAM
}

#ifndef MK_N_LAUNCHES
#define MK_N_LAUNCHES 1
#endif
extern "C" void kernel_launch(void* const* d_in, const int* in_sizes, int n_in, void* d_out, int out_size, void* d_ws, size_t ws_size, hipStream_t stream) {
    static int grid = 0;
    if (grid == 0) {
        if (n_in != 19 || in_sizes[0] != M * D || out_size != M * D || ws_size < WS_END) { fprintf(stderr, "kernel_launch: unexpected shapes (n_in %d, in0 %d, out %d, ws %zu)\n", n_in, n_in > 0 ? in_sizes[0] : -1, out_size, ws_size); grid = -1; return; }
        int dev = 0, cus = 0, per_cu = 0;
        if (hipGetDevice(&dev) != hipSuccess || hipDeviceGetAttribute(&cus, hipDeviceAttributeMultiprocessorCount, dev) != hipSuccess) { grid = -1; return; }
        if (hipFuncSetAttribute((const void*)hybrid_fwd, hipFuncAttributeMaxDynamicSharedMemorySize, LDS_BYTES) != hipSuccess) { fprintf(stderr, "kernel_launch: hipFuncSetAttribute failed\n"); grid = -1; return; }
        if (hipOccupancyMaxActiveBlocksPerMultiprocessor(&per_cu, (const void*)hybrid_fwd, NTHREADS, LDS_BYTES) != hipSuccess || per_cu < 1) { fprintf(stderr, "kernel_launch: occupancy query says %d\n", per_cu); per_cu = 1; }
        (void)hipGetLastError();
        grid = cus * 1;
    }
    if (grid < 0) return;
    if (hipMemsetAsync((char*)d_ws + WS_CTL, 0, CTL_BYTES, stream) != hipSuccess) { fprintf(stderr, "kernel_launch: memset failed\n"); return; }
    Args a{};
    a.x = (const float*)d_in[0]; a.pos = (const int*)d_in[1];
    a.ffn1_pre = (const float*)d_in[2]; a.ffn1_wgu = (const float*)d_in[3]; a.ffn1_wd = (const float*)d_in[4]; a.ffn1_post = (const float*)d_in[5];
    a.mix_pre = (const float*)d_in[6]; a.w_in = (const float*)d_in[7]; a.w_pool = (const float*)d_in[8]; a.pool_scale = (const float*)d_in[9]; a.sinks = (const float*)d_in[10];
    a.g_pool = (const float*)d_in[11]; a.g_attn = (const float*)d_in[12]; a.w_out = (const float*)d_in[13]; a.mix_post = (const float*)d_in[14];
    a.ffn2_pre = (const float*)d_in[15]; a.ffn2_wgu = (const float*)d_in[16]; a.ffn2_wd = (const float*)d_in[17]; a.ffn2_post = (const float*)d_in[18];
    a.out = (float*)d_out; a.ws = (unsigned char*)d_ws;
    constexpr int NPH = 11;
#if MK_N_LAUNCHES == 1
    a.ph_lo = 0; a.ph_hi = NPH;
    { void* kargs[] = {&a}; hipError_t e = hipLaunchCooperativeKernel((const void*)hybrid_fwd, dim3(grid), dim3(NTHREADS), kargs, LDS_BYTES, stream);
      if (e != hipSuccess) fprintf(stderr, "kernel_launch: cooperative launch failed: %s (grid %d)\n", hipGetErrorString(e), grid); }
#else
    for (int p = 0; p < NPH; ++p) { a.ph_lo = p; a.ph_hi = p + 1; void* kargs[] = {&a};
        hipError_t e = hipLaunchCooperativeKernel((const void*)hybrid_fwd, dim3(grid), dim3(NTHREADS), kargs, LDS_BYTES, stream);
        if (e != hipSuccess) { fprintf(stderr, "kernel_launch: launch %d failed: %s\n", p, hipGetErrorString(e)); break; } }
#endif
}
```

```cpp
#include <hip/hip_runtime.h>
#include <hip/hip_cooperative_groups.h>
#include <cstdio>
#include <cstdint>
namespace cg = cooperative_groups;
namespace pg8 {
#define PG8_LAS __attribute__((address_space(3)))
typedef unsigned short bf16_t;
typedef short bf16x8 __attribute__((ext_vector_type(8)));
typedef float f32x4 __attribute__((ext_vector_type(4)));
typedef unsigned u32x4 __attribute__((ext_vector_type(4)));
constexpr int BM = 256, BK = 64, HALF = 128, HTB = HALF * BK * 2  , STAGE_BYTES = 8 * HTB, NXCD = 8, WGM = 8;

__host__ __device__ __forceinline__ int lds_byte(int r, int c) { const int st = (r >> 4) * 2 + (c >> 5), rr = r & 15, cc = c & 31, ob = rr * 64 + cc * 2; return st * 1024 + (ob ^ (((ob >> 9) & 1) << 5)); }
__host__ __device__ __forceinline__ void stage_rc(int b, int& R, int& C) { const int st = b / 1024, sb = b % 1024, swz = sb ^ (((sb >> 9) & 1) << 5); R = (st >> 1) * 16 + swz / 64; C = (st & 1) * 32 + (swz % 64) / 2; }
__host__ __device__ __forceinline__ int perm32(int rho) { const int n = rho >> 4, i = rho & 15; return 8 * (i >> 2) + 4 * n + (i & 3); }

struct Unit { int pm, pn; };
struct Gemm { const bf16_t* A; const bf16_t* Bt; int M, N, K; };

struct StaticOrder {
    int nM, nN, nwg, G, c;
    __host__ __device__ void init(int M, int N, int G_, int c_) { nM = M / BM; nN = N / BM; nwg = nM * nN; G = G_; c = c_; }
    __host__ __device__ bool next(int i, Unit& u) const {
        const long L = (long)i * G + c; if (L >= nwg) return false;
        int wgid = (int)L; { const int q = nwg / NXCD, r = nwg % NXCD, xcd = wgid % NXCD, off = wgid / NXCD; wgid = (xcd < r ? xcd * (q + 1) : r * (q + 1) + (xcd - r) * q) + off; }
        const int nig = WGM * nN, gid = wgid / nig, fm = gid * WGM, gsz = (nM - fm) < WGM ? (nM - fm) : WGM;
        u.pm = fm + ((wgid % nig) % gsz); u.pn = (wgid % nig) / gsz; return true;
    }
    __device__ __forceinline__ void a_ready(const Unit&) const {}
    __device__ __forceinline__ void done(const Unit&) const {}
};

__device__ __forceinline__ unsigned cvt_pk_bf16(float lo, float hi) { unsigned r; asm volatile("v_cvt_pk_bf16_f32 %0, %1, %2" : "=v"(r) : "v"(lo), "v"(hi)); return r; }
typedef float f32x2 __attribute__((ext_vector_type(2)));
__device__ __forceinline__ f32x2 gelu_pk(f32x2 v) {
    const f32x2 av = __builtin_elementwise_abs(v), d = av * 0.2316418882f + 1.0f;
    f32x2 t; t.x = __builtin_amdgcn_rcpf(d.x); t.y = __builtin_amdgcn_rcpf(d.y);
    f32x2 q = t * 0.5307027145f + (-0.7265760135f); q = q * t + 0.7107068705f; q = q * t + (-0.142248368f); q = q * t + 0.127414796f; q = q * t;
    const f32x2 s = (v * v) * (-0.72134752044f);
    f32x2 e; e.x = __builtin_amdgcn_exp2f(s.x); e.y = __builtin_amdgcn_exp2f(s.y);
    const f32x2 m = v * (q * e), r = v - m;
    f32x2 o; o.x = v.x < 0.f ? m.x : r.x; o.y = v.y < 0.f ? m.y : r.y; return o;
}

template <int ACT  > struct EpiBf16 {
    static constexpr bool PERM = true, AFTER_DRAIN = false; static_assert(ACT == 0 || ACT == 1, "EpiBf16: ACT is 0 (none) or 1 (gelu_pk)");
    bf16_t* O; int ldc; const float* bias; int split_cols; size_t split_stride; float scale0;
    __device__ __forceinline__ void operator()(const f32x4 (&acc)[2][2][4][2], const Unit& u, int wr, int wc, int fr, int fq) const {
        const int row0 = u.pm * BM + wr * 64 + fr; int colt = u.pn * BM; bf16_t* base = O;
        float sc = 1.f; if (split_cols) { const int t = colt / split_cols; base += (size_t)t * split_stride; colt -= t * split_cols; if (t == 0) sc = scale0; }
        const int col0 = colt + wc * 32 + 8 * fq, bcol0 = u.pn * BM + wc * 32 + 8 * fq;
        f32x4 bv[2][2];
#pragma unroll
        for (int bj = 0; bj < 2; ++bj)
#pragma unroll
            for (int n = 0; n < 2; ++n) bv[bj][n] = bias ? *(const f32x4*)(bias + bcol0 + bj * HALF + 4 * n) : (f32x4){0.f, 0.f, 0.f, 0.f};
#pragma unroll
        for (int ai = 0; ai < 2; ++ai)
#pragma unroll
            for (int m = 0; m < 4; ++m) { bf16_t* rowp = base + (size_t)(row0 + ai * HALF + m * 16) * ldc + col0;
#pragma unroll
                for (int bj = 0; bj < 2; ++bj) { f32x4 v0 = acc[ai][bj][m][0] + bv[bj][0], v1 = acc[ai][bj][m][1] + bv[bj][1];
                    if (ACT == 1) { f32x2 a = gelu_pk((f32x2){v0[0], v0[1]}), b = gelu_pk((f32x2){v0[2], v0[3]}), c = gelu_pk((f32x2){v1[0], v1[1]}), d = gelu_pk((f32x2){v1[2], v1[3]});
                        v0 = (f32x4){a.x, a.y, b.x, b.y}; v1 = (f32x4){c.x, c.y, d.x, d.y}; }
                    v0 = v0 * sc; v1 = v1 * sc; u32x4 w; w.x = cvt_pk_bf16(v0[0], v0[1]); w.y = cvt_pk_bf16(v0[2], v0[3]); w.z = cvt_pk_bf16(v1[0], v1[1]); w.w = cvt_pk_bf16(v1[2], v1[3]);
                    *(u32x4*)(rowp + bj * HALF) = w; } }
    }
};
typedef __bf16 bf16x2_t __attribute__((ext_vector_type(2)));
__device__ __forceinline__ unsigned cvtpk(float lo, float hi) { f32x2 v = {lo, hi}; bf16x2_t b = __builtin_convertvector(v, bf16x2_t); return __builtin_bit_cast(unsigned, b); }
__device__ __forceinline__ float silu_mul(float g, float u) { const float e = __builtin_amdgcn_exp2f(-1.4426950408889634f * g); return g * __builtin_amdgcn_rcpf(1.0f + e) * u; }

struct EpiSwiGLU {
    static constexpr bool PERM = true, AFTER_DRAIN = false;
    bf16_t* O; int ldc;
    __device__ __forceinline__ void operator()(const f32x4 (&acc)[2][2][4][2], const Unit& u, int wr, int wc, int fr, int fq) const {
        const int row0 = u.pm * BM + wr * 64 + fr, col0 = u.pn * HALF + wc * 32 + 8 * fq;
#pragma unroll
        for (int ai = 0; ai < 2; ++ai)
#pragma unroll
            for (int m = 0; m < 4; ++m) { bf16_t* rowp = O + (size_t)(row0 + ai * HALF + m * 16) * ldc + col0;
                const f32x4 g0 = acc[ai][0][m][0], g1 = acc[ai][0][m][1], u0 = acc[ai][1][m][0], u1 = acc[ai][1][m][1];
                u32x4 w; w.x = cvtpk(silu_mul(g0[0], u0[0]), silu_mul(g0[1], u0[1])); w.y = cvtpk(silu_mul(g0[2], u0[2]), silu_mul(g0[3], u0[3]));
                w.z = cvtpk(silu_mul(g1[0], u1[0]), silu_mul(g1[1], u1[1])); w.w = cvtpk(silu_mul(g1[2], u1[2]), silu_mul(g1[3], u1[3]));
                *(u32x4*)rowp = w; }
    }
};
struct EpiRowScale {
    static constexpr bool PERM = true, AFTER_DRAIN = false;
    bf16_t* O; int ldc; const float* rs;
    __device__ __forceinline__ void operator()(const f32x4 (&acc)[2][2][4][2], const Unit& u, int wr, int wc, int fr, int fq) const {
        const int row0 = u.pm * BM + wr * 64 + fr, col0 = u.pn * BM + wc * 32 + 8 * fq;
#pragma unroll
        for (int ai = 0; ai < 2; ++ai)
#pragma unroll
            for (int m = 0; m < 4; ++m) { const int row = row0 + ai * HALF + m * 16; const float sc = rs[row]; bf16_t* rowp = O + (size_t)row * ldc + col0;
#pragma unroll
                for (int bj = 0; bj < 2; ++bj) { const f32x4 v0 = acc[ai][bj][m][0] * sc, v1 = acc[ai][bj][m][1] * sc;
                    u32x4 w; w.x = cvtpk(v0[0], v0[1]); w.y = cvtpk(v0[2], v0[3]); w.z = cvtpk(v1[0], v1[1]); w.w = cvtpk(v1[2], v1[3]);
                    *(u32x4*)(rowp + bj * HALF) = w; } }
    }
};
struct EpiZ {
    static constexpr bool PERM = true, AFTER_DRAIN = false;
    bf16_t* Z; bf16_t* Vt; const float* cs; float qscale; int seq;
    __device__ __forceinline__ void operator()(const f32x4 (&acc)[2][2][4][2], const Unit& u, int wr, int wc, int fr, int fq) const {
        const int row0 = u.pm * BM + wr * 64 + fr, cl = wc * 32 + 8 * fq;
#pragma unroll
        for (int bj = 0; bj < 2; ++bj) {
            const int colh = u.pn * BM + bj * HALF;
            const bool isV = (colh == 1152);
            const bool rope = (colh >= 512) && (colh < 1152) && ((wc & 1) == 0) && (fq < 2);
            const float sc = (colh >= 512 && colh < 1024) ? qscale : 1.0f;
#pragma unroll
            for (int ai = 0; ai < 2; ++ai)
#pragma unroll
                for (int m = 0; m < 4; ++m) { const int row = row0 + ai * HALF + m * 16;
                    f32x4 v0 = acc[ai][bj][m][0], v1 = acc[ai][bj][m][1];
                    if (isV) {
                        const int b = row / seq, s = row - b * seq;
#pragma unroll
                        for (int i = 0; i < 4; ++i) { const int c0 = cl + i, c1 = cl + 4 + i;
                            Vt[((size_t)((b * 2 + (c0 >> 6)) * 64 + (c0 & 63))) * seq + s] = (bf16_t)(cvtpk(v0[i], 0.f) & 0xffffu);
                            Vt[((size_t)((b * 2 + (c1 >> 6)) * 64 + (c1 & 63))) * seq + s] = (bf16_t)(cvtpk(v1[i], 0.f) & 0xffffu); }
                    } else {
                        if (rope) { const f32x4 c = *(const f32x4*)(cs + (size_t)row * 16 + 4 * fq), sn = *(const f32x4*)(cs + (size_t)row * 16 + 8 + 4 * fq);
                            const f32x4 n0 = v0 * c - v1 * sn, n1 = v1 * c + v0 * sn; v0 = n0; v1 = n1; }
                        v0 = v0 * sc; v1 = v1 * sc;
                        u32x4 w; w.x = cvtpk(v0[0], v0[1]); w.y = cvtpk(v0[2], v0[3]); w.z = cvtpk(v1[0], v1[1]); w.w = cvtpk(v1[2], v1[3]);
                        *(u32x4*)(Z + (size_t)row * 1280 + colh + cl) = w; }
                }
        }
    }
};
template <class Epi, class Sched, bool ALIGN_EPI = false, bool SP2 = false>
__device__ __forceinline__ void gemm_phase(PG8_LAS unsigned char* lds, const Gemm g, const Sched& S, const Epi& E) {
    const int tid = threadIdx.x, wid = __builtin_amdgcn_readfirstlane(tid >> 6), lane = tid & 63, wr = wid >> 2, wc = wid & 3, fr = lane & 15, fq = lane >> 4;
    const int K = g.K, nt = K / BK;
    unsigned voffA[2], voffB[2];
#pragma unroll
    for (int i = 0; i < 2; ++i) { int R, C; stage_rc(tid * 16 + i * 8192, R, C); const int Rb = Epi::PERM ? ((R & ~31) + perm32(R & 31)) : R;
        voffA[i] = (unsigned)(R * K + C) * 2u; voffB[i] = (unsigned)(Rb * K + C) * 2u; }
    const size_t kstep = (size_t)(BK * 2);
    const size_t hstep = (size_t)HALF * K * 2;
    const size_t tstep = 2 * hstep;
    const unsigned ldsw = (unsigned)wid * 1024u;
    const int aoff = lds_byte(wr * 64 + fr, fq * 8), boff = lds_byte(wc * 32 + fr, fq * 8);
#define PG8_SA(b, h) (((b) * 2 + (h)) * HTB)
#define PG8_SB(b, h) ((4 + (b) * 2 + (h)) * HTB)
#define PG8_STAGE(bufoff, gbase, voff) do { _Pragma("unroll") for (int _i = 0; _i < 2; ++_i) \
        __builtin_amdgcn_global_load_lds((const unsigned*)((const char*)(gbase) + (voff)[_i]), (PG8_LAS unsigned*)(lds + (bufoff) + ldsw + _i * 8192), 16, 0, 0); } while (0)
#define PG8_LDA(dst, b, h) do { _Pragma("unroll") for (int m = 0; m < 4; ++m) _Pragma("unroll") for (int k = 0; k < 2; ++k) dst[m][k] = *(const PG8_LAS bf16x8*)(lds + PG8_SA(b, h) + aoff + m * 2048 + k * 1024); } while (0)
#define PG8_LDB(dst, b, h) do { _Pragma("unroll") for (int n = 0; n < 2; ++n) _Pragma("unroll") for (int k = 0; k < 2; ++k) dst[n][k] = *(const PG8_LAS bf16x8*)(lds + PG8_SB(b, h) + boff + n * 2048 + k * 1024); } while (0)
#define PG8_MMA(ai, bj, At, Bt) do { __builtin_amdgcn_s_setprio(1); _Pragma("unroll") for (int m = 0; m < 4; ++m) _Pragma("unroll") for (int n = 0; n < 2; ++n) _Pragma("unroll") for (int k = 0; k < 2; ++k) \
        acc[ai][bj][m][n] = __builtin_amdgcn_mfma_f32_16x16x32_bf16(Bt[n][k], At[m][k], acc[ai][bj][m][n], 0, 0, 0); __builtin_amdgcn_s_setprio(0); } while (0)
#define PG8_WAIT_V(n) asm volatile("s_waitcnt vmcnt(" #n ")" ::: "memory")
#define PG8_WAIT_L(n) asm volatile("s_waitcnt lgkmcnt(" #n ")" ::: "memory")
#define PG8_BAR __builtin_amdgcn_s_barrier()
#define PG8_SCHED __builtin_amdgcn_sched_barrier(0)
    Unit cur, nxt; int ui = 0;
    if (!S.next(0, cur)) return;
    f32x4 acc[2][2][4][2];
#pragma unroll
    for (int a = 0; a < 2; ++a)
#pragma unroll
        for (int b = 0; b < 2; ++b)
#pragma unroll
            for (int m = 0; m < 4; ++m)
#pragma unroll
                for (int n = 0; n < 2; ++n) acc[a][b][m][n] = (f32x4){0.f, 0.f, 0.f, 0.f};
    bf16x8 At[4][2], B0[2][2], B1[2][2];
    const char* cA = (const char*)g.A + (size_t)cur.pm * tstep; const char* cB = (const char*)g.Bt + (size_t)cur.pn * tstep;
    S.a_ready(cur);
    if constexpr (SP2) {
        PG8_STAGE(PG8_SB(0, 0), cB, voffB); PG8_STAGE(PG8_SB(0, 1), cB + hstep, voffB); PG8_STAGE(PG8_SA(0, 0), cA, voffA); PG8_STAGE(PG8_SA(0, 1), cA + hstep, voffA);
        if (wr == 1) PG8_BAR;
        PG8_WAIT_V(2); PG8_BAR;
        PG8_STAGE(PG8_SB(1, 0), cB + kstep, voffB); PG8_STAGE(PG8_SA(1, 0), cA + kstep, voffA); PG8_STAGE(PG8_SB(1, 1), cB + hstep + kstep, voffB);
        PG8_WAIT_V(6); PG8_BAR;
    } else {
        PG8_STAGE(PG8_SB(0, 0), cB, voffB); PG8_STAGE(PG8_SA(0, 0), cA, voffA); PG8_STAGE(PG8_SB(0, 1), cB + hstep, voffB); PG8_STAGE(PG8_SA(0, 1), cA + hstep, voffA);
        if (wr == 1) PG8_BAR;
        PG8_WAIT_V(4); PG8_BAR;
        PG8_STAGE(PG8_SB(1, 0), cB + kstep, voffB); PG8_STAGE(PG8_SA(1, 0), cA + kstep, voffA); PG8_STAGE(PG8_SB(1, 1), cB + hstep + kstep, voffB);
        PG8_WAIT_V(6); PG8_BAR;
    }
    for (;;) {
        const bool has_next = S.next(ui + 1, nxt);
        const char* nA = has_next ? (const char*)g.A + (size_t)nxt.pm * tstep : cA; const char* nB = has_next ? (const char*)g.Bt + (size_t)nxt.pn * tstep : cB;
        for (int t = 0; t < nt; t += 2) {
            const bool last = (t == nt - 2);
            const char* a1 = cA + (size_t)(t + 1) * kstep;
            const char* a2 = last ? nA : cA + (size_t)(t + 2) * kstep; const char* b2 = last ? nB : cB + (size_t)(t + 2) * kstep;
            const char* a3 = a2 + kstep; const char* b3 = b2 + kstep;
            if (last && has_next) S.a_ready(nxt);
            if constexpr (SP2) {
            PG8_LDB(B0, 0, 0); PG8_LDB(B1, 0, 1); PG8_SCHED; PG8_LDA(At, 0, 0); PG8_STAGE(PG8_SA(1, 1), a1 + hstep, voffA);
            PG8_WAIT_V(8); PG8_WAIT_L(0); PG8_BAR; PG8_MMA(0, 0, At, B0); PG8_MMA(0, 1, At, B1); PG8_BAR; PG8_SCHED;
            PG8_LDA(At, 0, 1); PG8_STAGE(PG8_SB(0, 0), b2, voffB); PG8_STAGE(PG8_SB(0, 1), b2 + hstep, voffB); PG8_STAGE(PG8_SA(0, 0), a2, voffA);
            PG8_WAIT_V(8); PG8_WAIT_L(0); PG8_BAR; PG8_MMA(1, 0, At, B0); PG8_MMA(1, 1, At, B1); PG8_BAR; PG8_SCHED;
            PG8_LDB(B0, 1, 0); PG8_LDB(B1, 1, 1); PG8_SCHED; PG8_LDA(At, 1, 0); PG8_STAGE(PG8_SA(0, 1), a2 + hstep, voffA);
            PG8_WAIT_V(8); PG8_WAIT_L(0); PG8_BAR; PG8_MMA(0, 0, At, B0); PG8_MMA(0, 1, At, B1); PG8_BAR; PG8_SCHED;
            PG8_LDA(At, 1, 1); PG8_STAGE(PG8_SB(1, 0), b3, voffB); PG8_STAGE(PG8_SB(1, 1), b3 + hstep, voffB); PG8_STAGE(PG8_SA(1, 0), a3, voffA);
            PG8_WAIT_V(8); PG8_WAIT_L(0); PG8_BAR; PG8_MMA(1, 0, At, B0); PG8_MMA(1, 1, At, B1); PG8_BAR; PG8_SCHED;
            } else {
            PG8_LDB(B0, 0, 0); PG8_SCHED; PG8_LDA(At, 0, 0); PG8_STAGE(PG8_SA(1, 1), a1 + hstep, voffA);
            PG8_WAIT_L(8); PG8_BAR; PG8_WAIT_L(0); PG8_MMA(0, 0, At, B0); PG8_BAR; PG8_SCHED;
            PG8_LDB(B1, 0, 1); PG8_STAGE(PG8_SB(0, 0), b2, voffB);
            PG8_BAR; PG8_WAIT_L(0); PG8_MMA(0, 1, At, B1); PG8_BAR;
            PG8_LDA(At, 0, 1); PG8_STAGE(PG8_SA(0, 0), a2, voffA);
            PG8_BAR; PG8_WAIT_L(0); PG8_MMA(1, 0, At, B0); PG8_BAR; PG8_SCHED;
            PG8_STAGE(PG8_SB(0, 1), b2 + hstep, voffB);
            PG8_WAIT_V(6); PG8_BAR; PG8_MMA(1, 1, At, B1); PG8_BAR;
            PG8_LDB(B0, 1, 0); PG8_SCHED; PG8_LDA(At, 1, 0); PG8_STAGE(PG8_SA(0, 1), a2 + hstep, voffA);
            PG8_WAIT_L(8); PG8_BAR; PG8_WAIT_L(0); PG8_MMA(0, 0, At, B0); PG8_BAR; PG8_SCHED;
            PG8_LDB(B1, 1, 1); PG8_STAGE(PG8_SB(1, 0), b3, voffB);
            PG8_BAR; PG8_WAIT_L(0); PG8_MMA(0, 1, At, B1); PG8_BAR;
            PG8_LDA(At, 1, 1); PG8_STAGE(PG8_SA(1, 0), a3, voffA);
            PG8_BAR; PG8_WAIT_L(0); PG8_MMA(1, 0, At, B0); PG8_BAR; PG8_SCHED;
            PG8_STAGE(PG8_SB(1, 1), b3 + hstep, voffB);
            PG8_WAIT_V(6); PG8_BAR; PG8_MMA(1, 1, At, B1); PG8_BAR;
            }
        }
        if constexpr (ALIGN_EPI) { if (wr == 0) PG8_BAR; }
        if constexpr (!Epi::AFTER_DRAIN) { E(acc, cur, wr, wc, fr, fq); S.done(cur); }
        if (!has_next) break;
#pragma unroll
        for (int a = 0; a < 2; ++a)
#pragma unroll
            for (int b = 0; b < 2; ++b)
#pragma unroll
                for (int m = 0; m < 4; ++m)
#pragma unroll
                    for (int n = 0; n < 2; ++n) acc[a][b][m][n] = (f32x4){0.f, 0.f, 0.f, 0.f};
        cur = nxt; cA = nA; cB = nB; ++ui;
        if constexpr (ALIGN_EPI) { if (wr == 1) PG8_BAR; }
    }
    PG8_WAIT_V(0);
    if constexpr (!ALIGN_EPI) { if (wr == 0) PG8_BAR; }
    PG8_BAR;
    if constexpr (Epi::AFTER_DRAIN) { E.fused(acc, cur, wr, wc, fr, fq, lds, wid, lane); S.done(cur); }
#undef PG8_SA
#undef PG8_SB
#undef PG8_STAGE
#undef PG8_LDA
#undef PG8_LDB
#undef PG8_MMA
#undef PG8_WAIT_V
#undef PG8_WAIT_L
#undef PG8_BAR
#undef PG8_SCHED
}
}
constexpr int BATCH = 4, SEQ = 8192, D = 1024, M = BATCH * SEQ, FF = 2816, NGU = 2 * FF, NIN = 1280, NBLK = M / 128, NB_SEQ = SEQ / 128;
constexpr float EPS = 1e-6f;
constexpr float QSCALE = 0.125f * 1.4426950408889634f;
constexpr float LOG2E = 1.4426950408889634f;
constexpr int NWAVES = 8, NTHREADS = 512;
constexpr size_t MiB = 1u << 20;
constexpr size_t WS_WGU1 = 0, WS_WGU2 = 11 * MiB, WS_WD1 = 22 * MiB, WS_WD2 = 28 * MiB, WS_WIN = 34 * MiB, WS_WOUT = 37 * MiB, WS_WPOOL = 39 * MiB, WS_CS = 40 * MiB;
constexpr size_t WS_CTL = 46 * MiB, CTL_BYTES = 16384, WS_RA = 47 * MiB;
constexpr size_t WS_A = 48 * MiB, WS_HD = 112 * MiB, WS_H = 176 * MiB, WS_Z = 176 * MiB, WS_VT = 256 * MiB, WS_Y = 264 * MiB, WS_XR = 352 * MiB, WS_END = 416 * MiB;
static_assert((size_t)NGU * D * 2 <= 11 * MiB && (size_t)D * FF * 2 <= 6 * MiB && (size_t)NIN * D * 2 <= 3 * MiB && (size_t)M * 16 * 4 <= 8 * MiB, "ws map");
static_assert(WS_Z + (size_t)M * NIN * 2 <= WS_VT && WS_VT + (size_t)M * 128 * 2 <= WS_Y && WS_Y + (size_t)M * D * 2 <= WS_END && WS_H + (size_t)M * FF * 2 <= WS_XR && WS_XR + (size_t)M * D * 2 <= WS_END, "ws map 2");
constexpr int LDS_BYTES = 163840;
constexpr int KL_OFF = 0, KL_PITCH = 144, VL_OFF = 36864, VL_PITCH = 520, UL_OFF = 70144, UL_PITCH = 272, UL_ROWS = 143, DL_OFF = UL_OFF + 38912, DL_PITCH = 272;
constexpr int RAL_OFF = DL_OFF + 34816, ASTG_OFF = RAL_OFF + 512, MISC_OFF = ASTG_OFF + 16384;
static_assert(UL_ROWS * UL_PITCH <= 38912 && MISC_OFF >= 131072 && MISC_OFF + 128 <= LDS_BYTES && ASTG_OFF % 16 == 0 && DL_OFF % 16 == 0, "LDS map");

#define LAS __attribute__((address_space(3)))
typedef unsigned short bf16;
typedef unsigned u32x4 __attribute__((ext_vector_type(4)));
typedef unsigned u32x2 __attribute__((ext_vector_type(2)));
typedef float f32x4 __attribute__((ext_vector_type(4)));
typedef float f32x16 __attribute__((ext_vector_type(16)));
typedef short bf16x8 __attribute__((ext_vector_type(8)));
using pg8::cvtpk;
__device__ __forceinline__ float bflo(unsigned w) { return __uint_as_float(w << 16); }
__device__ __forceinline__ float bfhi(unsigned w) { return __uint_as_float(w & 0xffff0000u); }
__device__ __forceinline__ float wave_sum(float v) {
#pragma unroll
    for (int o = 1; o < 64; o <<= 1) v += __shfl_xor(v, o);
    return v;
}
__device__ __forceinline__ float half_sum32(float v) {
#pragma unroll
    for (int o = 1; o < 32; o <<= 1) v += __shfl_xor(v, o);
    return v;
}
__device__ __forceinline__ int crow(int r, int hi) { return (r & 3) + 8 * (r >> 2) + 4 * hi; }

struct Args {
    const float* x; const int* pos;
    const float *ffn1_pre, *ffn1_wgu, *ffn1_wd, *ffn1_post, *mix_pre, *w_in, *w_pool, *pool_scale, *sinks, *g_pool, *g_attn, *w_out, *mix_post, *ffn2_pre, *ffn2_wgu, *ffn2_wd, *ffn2_post;
    float* out; unsigned char* ws; int ph_lo, ph_hi;
};

__device__ __forceinline__ int dest_row(int mode, int n) {
    if (mode == 1) { return n < FF ? ((n >> 7) * 256 + (n & 127)) : ((((n - FF) >> 7) * 256) + 128 + ((n - FF) & 127)); }
    if (mode == 2) { if (n >= 512 && n < 1152) { const int d = n & 63; const int p = (d >= 4 && d < 8) ? d + 4 : ((d >= 8 && d < 12) ? d - 4 : d); return (n - d) + p; } return n; }
    return n;
}
__device__ __forceinline__ void transpose_item(const float* W, int K, int N, bf16* WT, int mode, LAS float* scr, int item, int lane) {
    const int nblk = N / 32, kb = item / nblk, nb = item % nblk, k0 = 64 * kb, n0 = 32 * nb;
#pragma unroll 8
    for (int i = 0; i < 32; ++i) { const int kk = 2 * i + (lane >> 5); scr[kk * 33 + (lane & 31)] = W[(size_t)(k0 + kk) * N + n0 + (lane & 31)]; }
    asm volatile("s_waitcnt lgkmcnt(0)" ::: "memory");
    const int c = lane & 7;
#pragma unroll
    for (int j = 0; j < 4; ++j) { const int n = (lane >> 3) + 8 * j; const LAS float* s = scr + (8 * c) * 33 + n;
        u32x4 o; o.x = cvtpk(s[0 * 33], s[1 * 33]); o.y = cvtpk(s[2 * 33], s[3 * 33]); o.z = cvtpk(s[4 * 33], s[5 * 33]); o.w = cvtpk(s[6 * 33], s[7 * 33]);
        *(u32x4*)(WT + (size_t)dest_row(mode, n0 + n) * K + k0 + 8 * c) = o; }
    asm volatile("s_waitcnt lgkmcnt(0)" ::: "memory");
}
__device__ __forceinline__ void sincos_f(float a, float& sn, float& cn) {
    const double ad = (double)a; const double q = __builtin_rint(ad * 0.63661977236758134308);
    const float r = (float)__builtin_fma(-q, 1.57079632679489661923, ad); const int qi = ((int)q) & 3;
    const float z = r * r;
    const float s = r + r * z * (-1.6666654611e-1f + z * (8.3321608736e-3f + z * (-1.9515295891e-4f)));
    const float c = 1.0f - 0.5f * z + z * z * (4.166664568298827e-2f + z * (-1.388731625493765e-3f + z * 2.443315711809948e-5f));
    sn = (qi == 0) ? s : (qi == 1) ? c : (qi == 2) ? -s : -c;
    cn = (qi == 0) ? c : (qi == 1) ? -s : (qi == 2) ? -c : s;
}
__device__ __forceinline__ float inv_freq(int i) {
    return i == 0 ? 1.0f : i == 1 ? 0.19392274474868576f : i == 2 ? 0.03760603093086393f : i == 3 ? 0.007292664737217109f : i == 4 ? 0.001414213562373095f : i == 5 ? 0.0002742481756762073f : i == 6 ? 5.318295896944988e-05f : 1.031338537721246e-05f;
}
__device__ __forceinline__ void prenorm_rows(const float* x, const float* g, bf16* a, int gw, int NGW, int lane) {
    f32x4 gv[4];
#pragma unroll
    for (int j = 0; j < 4; ++j) gv[j] = *((const f32x4*)g + lane + 64 * j);
    for (int m = gw; m < M; m += NGW) {
        const f32x4* xr = (const f32x4*)(x + (size_t)m * D) + lane; f32x4 v[4]; float s = 0.f;
#pragma unroll
        for (int j = 0; j < 4; ++j) { v[j] = xr[64 * j]; s += (v[j].x * v[j].x + v[j].y * v[j].y) + (v[j].z * v[j].z + v[j].w * v[j].w); }
        const float r = 1.0f / sqrtf(wave_sum(s) * (1.0f / D) + EPS);
        u32x2* o = (u32x2*)(a + (size_t)m * D) + lane;
#pragma unroll
        for (int j = 0; j < 4; ++j) { const f32x4 y = v[j] * r * gv[j]; u32x2 w; w.x = cvtpk(y.x, y.y); w.y = cvtpk(y.z, y.w); o[64 * j] = w; }
    }
}
template <bool HAS_A, bool XI_BF, bool XO_BF>
__device__ __forceinline__ void thin_rows(const void* xi, void* xo, const bf16* h, const float* gpost, const float* gpre, bf16* a, float coef, int gw, int NGW, int lane) {
    for (int m = gw; m < M; m += NGW) {
        const u32x2* hr = (const u32x2*)(h + (size_t)m * D) + lane;
        f32x4 v[4], hv[4]; float s = 0.f;
#pragma unroll
        for (int j = 0; j < 4; ++j) {
            if (XI_BF) { const u32x2 w = ((const u32x2*)((const bf16*)xi + (size_t)m * D) + lane)[64 * j]; v[j] = (f32x4){bflo(w.x), bfhi(w.x), bflo(w.y), bfhi(w.y)}; }
            else v[j] = ((const f32x4*)((const float*)xi + (size_t)m * D) + lane)[64 * j];
            const u32x2 w = hr[64 * j]; hv[j] = (f32x4){bflo(w.x), bfhi(w.x), bflo(w.y), bfhi(w.y)};
            s += (hv[j].x * hv[j].x + hv[j].y * hv[j].y) + (hv[j].z * hv[j].z + hv[j].w * hv[j].w); }
        const float r1 = coef / sqrtf(wave_sum(s) * (1.0f / D) + EPS);
        float s2 = 0.f;
#pragma unroll
        for (int j = 0; j < 4; ++j) { const f32x4 gp = *((const f32x4*)gpost + lane + 64 * j); v[j] = v[j] + hv[j] * r1 * gp;
            s2 += (v[j].x * v[j].x + v[j].y * v[j].y) + (v[j].z * v[j].z + v[j].w * v[j].w); }
#pragma unroll
        for (int j = 0; j < 4; ++j) {
            if (XO_BF) { u32x2 w; w.x = cvtpk(v[j].x, v[j].y); w.y = cvtpk(v[j].z, v[j].w); ((u32x2*)((bf16*)xo + (size_t)m * D) + lane)[64 * j] = w; }
            else ((f32x4*)((float*)xo + (size_t)m * D) + lane)[64 * j] = v[j]; }
        if (HAS_A) {
            const float r2 = 1.0f / sqrtf(wave_sum(s2) * (1.0f / D) + EPS);
            u32x2* o = (u32x2*)(a + (size_t)m * D) + lane;
#pragma unroll
            for (int j = 0; j < 4; ++j) { const f32x4 gq = *((const f32x4*)gpre + lane + 64 * j); const f32x4 y = v[j] * r2 * gq; u32x2 w; w.x = cvtpk(y.x, y.y); w.y = cvtpk(y.z, y.w); o[64 * j] = w; }
        }
    }
}
#define XB_TMO      128
#define XB_XCNT(j)  (256  + 64 * (j))
#define XB_XSUB(j)  (1280 + 64 * (j))
#define XB_XGEN(j)  (2304 + 64 * (j))
#define XB_TOP      3328
#define XB_TOPGEN   3392
#define XCD_BAR_WORDS 3456
#define XB_SPIN_CAP (1u << 18)

__device__ __forceinline__ unsigned xb_ld(unsigned* p)              { return __hip_atomic_load(p, __ATOMIC_RELAXED, __HIP_MEMORY_SCOPE_AGENT); }
__device__ __forceinline__ unsigned xb_add(unsigned* p, unsigned v) { return __hip_atomic_fetch_add(p, v, __ATOMIC_RELAXED, __HIP_MEMORY_SCOPE_AGENT); }
__device__ __forceinline__ unsigned xb_xcc_id() { return (unsigned)__builtin_amdgcn_s_getreg((3 << 11) | 20) & 0xFu; }
#define XB_SPIN(cond, bar) do { unsigned _sp = 0; while (cond) { __builtin_amdgcn_s_sleep(1); \
    if ((++_sp & 255u) == 0u) { if (xb_ld(&(bar)[XB_TMO])) break; if (_sp > XB_SPIN_CAP) { atomicAdd(&(bar)[XB_TMO], 1u); break; } } } } while (0)

struct XcdBarrier {
    unsigned* bar; unsigned x;
    volatile LAS unsigned* st;
};

__device__ __forceinline__ XcdBarrier xcd_barrier_post(unsigned* bar, volatile LAS unsigned* st) {
    XcdBarrier b; b.bar = bar; b.x = xb_xcc_id(); b.st = st;
    if (threadIdx.x == 0) (void)xb_add(&bar[XB_XCNT(b.x)], 1u);
    return b;
}
__device__ __forceinline__ void xcd_barrier_complete(unsigned* bar, unsigned x, unsigned& nloc, unsigned& nx) {
    const unsigned G = gridDim.x * gridDim.y * gridDim.z;
    unsigned sum, cnt, mine, sp = 0u;
    for (;;) {
        sum = 0u; cnt = 0u; mine = 0u;
#pragma unroll
        for (unsigned j = 0; j < 16; ++j) { const unsigned c = xb_ld(&bar[XB_XCNT(j)]); sum += c; cnt += (c > 0u) ? 1u : 0u; mine = (j == x) ? c : mine; }
        if (sum == G) break;
        __builtin_amdgcn_s_sleep(1);
        if ((++sp & 255u) == 0u) { if (xb_ld(&bar[XB_TMO])) break; if (sp > XB_SPIN_CAP) { atomicAdd(&bar[XB_TMO], 1u); break; } }
    }
    nloc = mine > 0u ? mine : 1u; nx = cnt > 0u ? cnt : 1u;
}

__device__ __forceinline__ void xcd_barrier(const XcdBarrier& b) {
    asm volatile("s_waitcnt vmcnt(0)" ::: "memory");
    __syncthreads();
    if (threadIdx.x == 0) {
        unsigned* bar = b.bar;
        __builtin_amdgcn_s_waitcnt(0);
        unsigned nloc = b.st[0], nx = b.st[1];
        if (nloc == 0u) { xcd_barrier_complete(bar, b.x, nloc, nx); b.st[0] = nloc; b.st[1] = nx; }
        const unsigned old = xb_add(&bar[XB_XSUB(b.x)], 1u);
        const unsigned gen = old / nloc;
        if (old + 1u == (gen + 1u) * nloc) {
            __builtin_amdgcn_fence(__ATOMIC_RELEASE, "agent");
            asm volatile("s_waitcnt vmcnt(0)" ::: "memory");
            const unsigned og = xb_add(&bar[XB_TOP], 1u);
            const unsigned tg = og / nx;
            if (og + 1u == (tg + 1u) * nx) xb_add(&bar[XB_TOPGEN], 1u);
            else XB_SPIN(xb_ld(&bar[XB_TOPGEN]) == tg, bar);
            __builtin_amdgcn_fence(__ATOMIC_ACQUIRE, "agent");
            xb_add(&bar[XB_XGEN(b.x)], 1u);
            asm volatile("s_waitcnt vmcnt(0)" ::: "memory");
        } else {
            XB_SPIN(xb_ld(&bar[XB_XGEN(b.x)]) == gen, bar);
            __builtin_amdgcn_fence(__ATOMIC_ACQUIRE, "agent");
            asm volatile("s_waitcnt vmcnt(0)" ::: "memory");
        }
    }
    __syncthreads();
}
#define MFMA32(a, b, c) __builtin_amdgcn_mfma_f32_32x32x16_bf16((a), (b), (c), 0, 0, 0)
__device__ __forceinline__ void load8(const bf16* p, float (&f)[8]) { const u32x4 w = *(const u32x4*)p;
    f[0] = bflo(w.x); f[1] = bfhi(w.x); f[2] = bflo(w.y); f[3] = bfhi(w.y); f[4] = bflo(w.z); f[5] = bfhi(w.z); f[6] = bflo(w.w); f[7] = bfhi(w.w); }

#define OPAQUE_V(x) asm volatile("" : "+v"(x))
#define OPAQUE_S(x) asm volatile("" : "+s"(x))
struct MixCtx { LAS unsigned char* lds; const bf16* Z; const bf16* Vt; const bf16* WpT; const float* pool_scale; const float* sinks; const float* g_pool; const float* g_attn; bf16* Y; float* RA; size_t rowbase; int b, n, htid, lane, hw; };

template <int G> __device__ __forceinline__ void pool_group(const MixCtx& c, f32x16& ssacc, unsigned (&kA)[16], unsigned (&kB)[16]) {
    constexpr int w = 2 << G;
    LAS unsigned char* lds = c.lds; int htid = c.htid, lane_ = c.lane, hw = c.hw; OPAQUE_V(htid); OPAQUE_V(lane_); OPAQUE_S(hw);
    const int r32 = lane_ & 31, hi = lane_ >> 5;
#pragma unroll
    for (int k = 0; k < 9; ++k) { const int i = htid + 256 * k, jr = i >> 4, cc = i & 15;
        if (jr < UL_ROWS) { u32x4 v = (u32x4){0u, 0u, 0u, 0u};
            if (c.n * 128 + jr - 15 >= 0) v = *(const u32x4*)(c.Z + (ptrdiff_t)((ptrdiff_t)c.rowbase + jr - 15) * NIN + G * 128 + cc * 8);
            *(LAS u32x4*)(lds + UL_OFF + jr * UL_PITCH + cc * 16) = v; } }
    __syncthreads();
    {
        const int c8 = htid & 15, t0 = (htid >> 4) * 8;
        const LAS unsigned char* ub = lds + UL_OFF + (15 + t0) * UL_PITCH + c8 * 16;
        float s[8], uv[8];
#pragma unroll
        for (int i = 0; i < 8; ++i) s[i] = 0.f;
#define LDU(row) do { const u32x4 w_ = *(const LAS u32x4*)(ub + (row) * UL_PITCH); uv[0] = bflo(w_.x); uv[1] = bfhi(w_.x); uv[2] = bflo(w_.y); uv[3] = bfhi(w_.y); uv[4] = bflo(w_.z); uv[5] = bfhi(w_.z); uv[6] = bflo(w_.w); uv[7] = bfhi(w_.w); } while (0)
#pragma unroll
        for (int j = 1 - w; j < 0; ++j) { LDU(j);
#pragma unroll
            for (int i = 0; i < 8; ++i) s[i] += uv[i]; }
#pragma unroll
        for (int tt = 0; tt < 8; ++tt) { const int t = t0 + tt;
            LDU(tt);
#pragma unroll
            for (int i = 0; i < 8; ++i) s[i] += uv[i];
            const int sp = c.n * 128 + t; const int cnt = (sp + 1 < w) ? sp + 1 : w; const float inv = 1.0f / (float)cnt;
            u32x4 o; o.x = cvtpk(s[0] * inv - uv[0], s[1] * inv - uv[1]); o.y = cvtpk(s[2] * inv - uv[2], s[3] * inv - uv[3]);
            o.z = cvtpk(s[4] * inv - uv[4], s[5] * inv - uv[5]); o.w = cvtpk(s[6] * inv - uv[6], s[7] * inv - uv[7]);
            *(LAS u32x4*)(lds + DL_OFF + t * DL_PITCH + c8 * 16) = o;
            LDU(tt - w + 1);
#pragma unroll
            for (int i = 0; i < 8; ++i) s[i] -= uv[i]; }
#undef LDU
    }
    __syncthreads();
#pragma unroll
    for (int j2 = 0; j2 < 2; ++j2) {
        f32x16 a0, a1;
#pragma unroll
        for (int i = 0; i < 16; ++i) { a0[i] = 0.f; a1[i] = 0.f; }
        const bf16* wp = c.WpT + (size_t)G * 16384 + (size_t)(64 * j2 + r32) * 128 + 8 * hi;
#pragma unroll
        for (int ks = 0; ks < 8; ++ks) {
            const bf16x8 A = *(const LAS bf16x8*)(lds + DL_OFF + (32 * hw + r32) * DL_PITCH + (16 * ks + 8 * hi) * 2);
            const bf16x8 B0 = *(const bf16x8*)(wp + 16 * ks), B1 = *(const bf16x8*)(wp + 32 * 128 + 16 * ks);
            a0 = MFMA32(A, B0, a0); a1 = MFMA32(A, B1, a1);
        }
        const float* psp = c.pool_scale + G * 128 + 64 * j2 + r32;
        const float ps0 = psp[0], ps1 = psp[32];
#pragma unroll
        for (int r = 0; r < 16; ++r) { const float v0 = a0[r] * ps0, v1 = a1[r] * ps1;
            { float q_ = ssacc[r] + (v0 * v0 + v1 * v1); asm volatile("" : "+v"(q_)); ssacc[r] = q_; }
            unsigned pk_ = cvtpk(v0, v1); asm volatile("" : "+v"(pk_));
            if (j2 == 0) kA[r] = pk_; else kB[r] = pk_; }
        __builtin_amdgcn_sched_barrier(0);
    }
    __syncthreads();
}
__device__ __forceinline__ void store_item(const MixCtx& c, LAS bf16* stg, const unsigned (&kp)[16], const float (&f)[16], const float* gptr, int colbase) {
    int lane = c.lane; OPAQUE_V(lane); const int r32 = lane & 31, hi = lane >> 5;
    const float g0 = gptr[r32], g1 = gptr[32 + r32];
#pragma unroll
    for (int r = 0; r < 16; ++r) { const int ro = (r & 3) + 8 * (r >> 2) + 4 * hi;
        stg[ro * 64 + r32] = (bf16)(cvtpk(bflo(kp[r]) * f[r] * g0, 0.f) & 0xffffu); stg[ro * 64 + 32 + r32] = (bf16)(cvtpk(bfhi(kp[r]) * f[r] * g1, 0.f) & 0xffffu); }
    asm volatile("s_waitcnt lgkmcnt(0)" ::: "memory");
    size_t yo = (c.rowbase + 32 * c.hw + (lane >> 3)) * D + colbase + (lane & 7) * 8; OPAQUE_V(yo); bf16* yb = c.Y + yo;
#pragma unroll
    for (int i = 0; i < 4; ++i) { const u32x4 v = *(const LAS u32x4*)(stg + (i * 8 + (lane >> 3)) * 64 + (lane & 7) * 8); *(u32x4*)(yb + (size_t)i * 8 * D) = v; }
    asm volatile("s_waitcnt lgkmcnt(0)" ::: "memory");
}
__device__ __forceinline__ void pool_half(const MixCtx& c) {
    f32x16 ssacc;
#pragma unroll
    for (int r = 0; r < 16; ++r) ssacc[r] = 0.f;
    unsigned a0[16], b0[16], a1[16], b1[16], a2[16], b2[16], a3[16], b3[16];
    pool_group<0>(c, ssacc, a0, b0); pool_group<1>(c, ssacc, a1, b1); pool_group<2>(c, ssacc, a2, b2); pool_group<3>(c, ssacc, a3, b3);
    int lane = c.lane; OPAQUE_V(lane); const int hi = lane >> 5;
    const LAS float* RAL = (const LAS float*)(c.lds + RAL_OFF);
    float f[16];
#pragma unroll
    for (int r = 0; r < 16; ++r) { const int ro = (r & 3) + 8 * (r >> 2) + 4 * hi; const float ss = half_sum32(ssacc[r]);
        f[r] = __builtin_amdgcn_rsqf(ss * (1.0f / 512.0f) + EPS) * __builtin_amdgcn_rcpf(RAL[32 * c.hw + ro]); }
    if (c.htid < 128) c.RA[c.rowbase + c.htid] = RAL[c.htid];
    LAS bf16* stg = (LAS bf16*)(c.lds + UL_OFF) + c.hw * 2048;
    store_item(c, stg, a0, f, c.g_pool, 0); store_item(c, stg, b0, f, c.g_pool + 64, 64);
    store_item(c, stg, a1, f, c.g_pool + 128, 128); store_item(c, stg, b1, f, c.g_pool + 192, 192);
    store_item(c, stg, a2, f, c.g_pool + 256, 256); store_item(c, stg, b2, f, c.g_pool + 320, 320);
    store_item(c, stg, a3, f, c.g_pool + 384, 384); store_item(c, stg, b3, f, c.g_pool + 448, 448);
    __syncthreads();
}
template <int KH, int GI> __device__ __forceinline__ void att_item(const MixCtx& c, bf16x8 (&qr)[4], const bf16* qp, f32x16& ssacc) {
    LAS unsigned char* lds = c.lds; int lane_ = c.lane, rg = c.hw; OPAQUE_V(lane_); OPAQUE_S(rg);
    const int r32 = lane_ & 31, hi = lane_ >> 5, n = c.n;
    constexpr int h = KH * 4 + GI;
    f32x16 S[5];
#pragma unroll
    for (int t = 0; t < 5; ++t) {
#pragma unroll
        for (int i = 0; i < 16; ++i) S[t][i] = 0.f;
#pragma unroll
        for (int d0 = 0; d0 < 4; ++d0) { const bf16x8 kf = *(const LAS bf16x8*)(lds + KL_OFF + (32 * (rg + t) + r32) * KL_PITCH + (16 * d0 + 8 * hi) * 2);
            S[t] = MFMA32(kf, qr[d0], S[t]); }
        if (t & 1) __builtin_amdgcn_sched_barrier(0);
    }
    if (GI < 3) {
#pragma unroll
        for (int d0 = 0; d0 < 4; ++d0) qr[d0] = *(const bf16x8*)(qp + 64 * (GI + 1) + 16 * d0);
    }
    const float sinkl = c.sinks[h] * LOG2E;
    const float g0 = c.g_attn[h * 64 + r32], g1 = c.g_attn[h * 64 + 32 + r32];
    float mx = sinkl;
#pragma unroll
    for (int t = 0; t < 5; ++t)
#pragma unroll
        for (int r = 0; r < 16; ++r) {
            const bool tv = (n > 0) || (rg + t >= 4);
            const bool valid = (t == 0) ? (tv && (crow(r, hi) > r32)) : (t == 4) ? (crow(r, hi) <= r32) : tv;
            const float sv = valid ? S[t][r] : -1e30f; S[t][r] = sv; mx = fmaxf(mx, sv); }
    mx = fmaxf(mx, __shfl_xor(mx, 32));
    float sum = 0.f;
#pragma unroll
    for (int t = 0; t < 5; ++t)
#pragma unroll
        for (int r = 0; r < 16; ++r) { const float p = __builtin_amdgcn_exp2f(S[t][r] - mx); S[t][r] = p; sum += p; }
    sum += __shfl_xor(sum, 32);
    sum += __builtin_amdgcn_exp2f(sinkl - mx);
    const float linv = 1.0f / sum;
    f32x16 o0, o1;
#pragma unroll
    for (int i = 0; i < 16; ++i) { o0[i] = 0.f; o1[i] = 0.f; }
#pragma unroll
    for (int t = 0; t < 5; ++t)
#pragma unroll
        for (int s = 0; s < 2; ++s) {
            u32x4 pw; pw.x = cvtpk(S[t][8 * s + 0], S[t][8 * s + 1]); pw.y = cvtpk(S[t][8 * s + 2], S[t][8 * s + 3]); pw.z = cvtpk(S[t][8 * s + 4], S[t][8 * s + 5]); pw.w = cvtpk(S[t][8 * s + 6], S[t][8 * s + 7]);
            const bf16x8 pa = __builtin_bit_cast(bf16x8, pw);
            const int keyb = 32 * (rg + t) + 16 * s + 4 * hi;
            const LAS unsigned char* vb = lds + VL_OFF + r32 * VL_PITCH + keyb * 2;
            const u32x2 l0 = *(const LAS u32x2*)(vb), h0 = *(const LAS u32x2*)(vb + 16);
            const u32x2 l1 = *(const LAS u32x2*)(vb + 32 * VL_PITCH), h1 = *(const LAS u32x2*)(vb + 32 * VL_PITCH + 16);
            const bf16x8 v0 = __builtin_bit_cast(bf16x8, ((u32x4){l0.x, l0.y, h0.x, h0.y})), v1 = __builtin_bit_cast(bf16x8, ((u32x4){l1.x, l1.y, h1.x, h1.y}));
            o0 = MFMA32(pa, v0, o0); o1 = MFMA32(pa, v1, o1);
            if (s == 1) __builtin_amdgcn_sched_barrier(0);
        }
    LAS bf16* stg = (LAS bf16*)(lds + ASTG_OFF) + rg * 2048;
#pragma unroll
    for (int r = 0; r < 16; ++r) { const int ro = (r & 3) + 8 * (r >> 2) + 4 * hi; const float li = __shfl(linv, ro);
        const float v0 = o0[r] * li, v1 = o1[r] * li;
        { float q_ = ssacc[r] + (v0 * v0 + v1 * v1); asm volatile("" : "+v"(q_)); ssacc[r] = q_; }
        stg[ro * 64 + r32] = (bf16)(cvtpk(v0 * g0, 0.f) & 0xffffu); stg[ro * 64 + 32 + r32] = (bf16)(cvtpk(v1 * g1, 0.f) & 0xffffu); }
    asm volatile("s_waitcnt lgkmcnt(0)" ::: "memory");
    size_t yo = (c.rowbase + 32 * rg + (lane_ >> 3)) * D + 512 + h * 64 + (lane_ & 7) * 8; OPAQUE_V(yo); bf16* yb = c.Y + yo;
#pragma unroll
    for (int i = 0; i < 4; ++i) { const u32x4 v = *(const LAS u32x4*)(stg + (i * 8 + (lane_ >> 3)) * 64 + (lane_ & 7) * 8); *(u32x4*)(yb + (size_t)i * 8 * D) = v; }
    asm volatile("s_waitcnt lgkmcnt(0)" ::: "memory");
}
template <int KH> __device__ __forceinline__ void att_kvhead(const MixCtx& c, f32x16& ssacc) {
    LAS unsigned char* lds = c.lds; int htid = c.htid; OPAQUE_V(htid); const int n = c.n;
    const bf16* qp = c.Z + (c.rowbase + 32 * c.hw + (c.lane & 31)) * NIN + 512 + (KH * 4) * 64 + 8 * (c.lane >> 5);
    bf16x8 qr[4];
#pragma unroll
    for (int d0 = 0; d0 < 4; ++d0) qr[d0] = *(const bf16x8*)(qp + 16 * d0);
#pragma unroll
    for (int k = 0; k < 8; ++k) {
        const int i = htid + 256 * k, key = i >> 3, cc = i & 7; const bool valid = (n > 0) || (key >= 128);
        u32x4 v = (u32x4){0u, 0u, 0u, 0u};
        if (valid) v = *(const u32x4*)(c.Z + (c.rowbase + key - 128) * NIN + 1024 + KH * 64 + cc * 8);
        *(LAS u32x4*)(lds + KL_OFF + key * KL_PITCH + cc * 16) = v;
    }
#pragma unroll
    for (int k = 0; k < 8; ++k) {
        const int i = htid + 256 * k, d = i >> 5, cc = i & 31; const bool valid = (n > 0) || (cc >= 16);
        u32x4 v = (u32x4){0u, 0u, 0u, 0u};
        if (valid) v = *(const u32x4*)(c.Vt + ((size_t)((c.b * 2 + KH) * 64 + d)) * SEQ + n * 128 - 128 + cc * 8);
        LAS u32x2* dst = (LAS u32x2*)(lds + VL_OFF + d * VL_PITCH + cc * 16);
        dst[0] = (u32x2){v.x, v.y}; dst[1] = (u32x2){v.z, v.w};
    }
    __syncthreads();
    att_item<KH, 0>(c, qr, qp, ssacc); __syncthreads();
    att_item<KH, 1>(c, qr, qp, ssacc); __syncthreads();
    att_item<KH, 2>(c, qr, qp, ssacc); __syncthreads();
    att_item<KH, 3>(c, qr, qp, ssacc);
}
__device__ __forceinline__ void att_half(const MixCtx& c) {
    f32x16 ssacc;
#pragma unroll
    for (int r = 0; r < 16; ++r) ssacc[r] = 0.f;
    att_kvhead<0>(c, ssacc); __syncthreads();
    att_kvhead<1>(c, ssacc);
    { int lane = c.lane; OPAQUE_V(lane); const int r32 = lane & 31, hi = lane >> 5; LAS float* RAL = (LAS float*)(c.lds + RAL_OFF);
#pragma unroll
      for (int r = 0; r < 16; ++r) { const int ro = (r & 3) + 8 * (r >> 2) + 4 * hi; const float ss = half_sum32(ssacc[r]);
          if (r32 == 0) RAL[32 * c.hw + ro] = __builtin_amdgcn_rsqf(ss * (1.0f / 512.0f) + EPS); } }
    __syncthreads(); __syncthreads(); __syncthreads(); __syncthreads();
}
__device__ __forceinline__ void mixer_block(LAS unsigned char* lds, int blk, const bf16* Z, const bf16* Vt, const bf16* WpT, const float* pool_scale, const float* sinks,
                                            const float* g_pool, const float* g_attn, bf16* Y, float* RA, int tid, int wid, int lane) {
    OPAQUE_V(tid); OPAQUE_V(lane); OPAQUE_S(wid);
    MixCtx c; c.lds = lds; c.Z = Z; c.Vt = Vt; c.WpT = WpT; c.pool_scale = pool_scale; c.sinks = sinks; c.g_pool = g_pool; c.g_attn = g_attn; c.Y = Y; c.RA = RA; c.rowbase = (size_t)blk * 128;
    c.b = blk / NB_SEQ; c.n = blk % NB_SEQ; c.htid = tid & 255; c.lane = lane; c.hw = wid & 3;
    if (wid < 4) pool_half(c); else att_half(c);
}
__global__ void __launch_bounds__(NTHREADS, 2) hybrid_fwd(Args args) {
    extern __shared__ __attribute__((aligned(16))) unsigned char lds_raw[];
    LAS unsigned char* lds = (LAS unsigned char*)lds_raw;
    cg::grid_group grid = cg::this_grid();
    const int tid = threadIdx.x, lane = tid & 63, wid = __builtin_amdgcn_readfirstlane(tid >> 6);
    const int G = gridDim.x, bx = blockIdx.x;
    const int vcu = (G % 8 == 0) ? (bx % 8) * (G / 8) + bx / 8 : bx;
    const int gw = vcu * NWAVES + wid, NGW = G * NWAVES;
    unsigned char* ws = args.ws;
    bf16 *Wgu1 = (bf16*)(ws + WS_WGU1), *Wgu2 = (bf16*)(ws + WS_WGU2), *Wd1 = (bf16*)(ws + WS_WD1), *Wd2 = (bf16*)(ws + WS_WD2), *Win = (bf16*)(ws + WS_WIN), *Wout = (bf16*)(ws + WS_WOUT), *WpT = (bf16*)(ws + WS_WPOOL);
    float* CS = (float*)(ws + WS_CS);
    bf16 *A = (bf16*)(ws + WS_A), *HD = (bf16*)(ws + WS_HD), *H = (bf16*)(ws + WS_H), *Z = (bf16*)(ws + WS_Z), *Vt = (bf16*)(ws + WS_VT), *Y = (bf16*)(ws + WS_Y), *XR = (bf16*)(ws + WS_XR); float* RAg = (float*)(ws + WS_RA);
    const int lo = args.ph_lo, hi = args.ph_hi;
#define IN(k) (lo <= (k) && (k) < hi)
#define SEAM(k) do { if (IN(k) && IN((k) + 1)) { if ((k) == 0) grid.sync(); else xcd_barrier(bar); } } while (0)
    if (tid < 32) ((LAS unsigned*)(lds + MISC_OFF))[tid] = 0u;
    __syncthreads();
    XcdBarrier bar; bar.bar = (unsigned*)(ws + WS_CTL); bar.x = 0; bar.st = nullptr;
    if (hi - lo > 1) bar = xcd_barrier_post((unsigned*)(ws + WS_CTL), (volatile LAS unsigned*)(lds + MISC_OFF) + 8);

    if (IN(0)) {
        LAS float* scr = (LAS float*)(lds + wid * 16384);
        constexpr int I_GU = (D / 64) * (NGU / 32), I_DN = (FF / 64) * (D / 32), I_IN = (D / 64) * (NIN / 32), I_OUT = (D / 64) * (D / 32), I_PL = 4 * 2 * 4;
        constexpr int NITEMS = 2 * I_GU + 2 * I_DN + I_IN + I_OUT + I_PL;
        for (int it = gw; it < NITEMS; it += NGW) {
            int r = it;
            if (r < I_GU) { transpose_item(args.ffn1_wgu, D, NGU, Wgu1, 1, scr, r, lane); continue; } r -= I_GU;
            if (r < I_GU) { transpose_item(args.ffn2_wgu, D, NGU, Wgu2, 1, scr, r, lane); continue; } r -= I_GU;
            if (r < I_DN) { transpose_item(args.ffn1_wd, FF, D, Wd1, 0, scr, r, lane); continue; } r -= I_DN;
            if (r < I_DN) { transpose_item(args.ffn2_wd, FF, D, Wd2, 0, scr, r, lane); continue; } r -= I_DN;
            if (r < I_IN) { transpose_item(args.w_in, D, NIN, Win, 2, scr, r, lane); continue; } r -= I_IN;
            if (r < I_OUT) { transpose_item(args.w_out, D, D, Wout, 0, scr, r, lane); continue; } r -= I_OUT;
            { const int g = r >> 3; transpose_item(args.w_pool + (size_t)g * 16384, 128, 128, WpT + (size_t)g * 16384, 0, scr, r & 7, lane); }
        }
        for (int idx = vcu * NTHREADS + tid; idx < M * 8; idx += G * NTHREADS) {
            const int row = idx >> 3, i = idx & 7; const float ang = (float)args.pos[row] * inv_freq(i);
            float sn, cn; sincos_f(ang, sn, cn); CS[(size_t)row * 16 + i] = cn; CS[(size_t)row * 16 + 8 + i] = sn;
        }
        prenorm_rows(args.x, args.ffn1_pre, A, gw, NGW, lane);
    }
    SEAM(0);
    if (IN(1)) {
        pg8::Gemm g{A, Wgu1, M, NGU, D}; pg8::StaticOrder S; S.init(M, NGU, G, bx); pg8::EpiSwiGLU E{H, FF};
        pg8::gemm_phase<pg8::EpiSwiGLU, pg8::StaticOrder, true, true>(lds, g, S, E);
    }
    SEAM(1);
    if (IN(2)) {
        pg8::Gemm g{H, Wd1, M, D, FF}; pg8::StaticOrder S; S.init(M, D, G, bx); pg8::EpiBf16<0> E{HD, D, nullptr, 0, 0, 1.f};
        pg8::gemm_phase<pg8::EpiBf16<0>, pg8::StaticOrder, true, true>(lds, g, S, E);
    }
    SEAM(2);
    if (IN(3)) thin_rows<true, false, true>(args.x, XR, HD, args.ffn1_post, args.mix_pre, A, 0.5f, gw, NGW, lane);
    SEAM(3);
    if (IN(4)) {
        pg8::Gemm g{A, Win, M, NIN, D}; pg8::StaticOrder S; S.init(M, NIN, G, bx); pg8::EpiZ E{Z, Vt, CS, QSCALE, SEQ};
        pg8::gemm_phase<pg8::EpiZ, pg8::StaticOrder, true, true>(lds, g, S, E);
    }
    SEAM(4);
    if (IN(5)) { for (int blk = vcu; blk < NBLK; blk += G) mixer_block(lds, blk, Z, Vt, WpT, args.pool_scale, args.sinks, args.g_pool, args.g_attn, Y, RAg, tid, wid, lane); }
    SEAM(5);
    if (IN(6)) {
        pg8::Gemm g{Y, Wout, M, D, D}; pg8::StaticOrder S; S.init(M, D, G, bx); pg8::EpiRowScale E{HD, D, RAg};
        pg8::gemm_phase<pg8::EpiRowScale, pg8::StaticOrder, true, true>(lds, g, S, E);
    }
    SEAM(6);
    if (IN(7)) thin_rows<true, true, true>(XR, XR, HD, args.mix_post, args.ffn2_pre, A, 1.0f, gw, NGW, lane);
    SEAM(7);
    if (IN(8)) {
        pg8::Gemm g{A, Wgu2, M, NGU, D}; pg8::StaticOrder S; S.init(M, NGU, G, bx); pg8::EpiSwiGLU E{H, FF};
        pg8::gemm_phase<pg8::EpiSwiGLU, pg8::StaticOrder, true, true>(lds, g, S, E);
    }
    SEAM(8);
    if (IN(9)) {
        pg8::Gemm g{H, Wd2, M, D, FF}; pg8::StaticOrder S; S.init(M, D, G, bx); pg8::EpiBf16<0> E{HD, D, nullptr, 0, 0, 1.f};
        pg8::gemm_phase<pg8::EpiBf16<0>, pg8::StaticOrder, true, true>(lds, g, S, E);
    }
    SEAM(9);
    if (IN(10)) thin_rows<false, true, false>(XR, args.out, HD, args.ffn2_post, nullptr, nullptr, 0.5f, gw, NGW, lane);
#undef IN
#undef SEAM
}

#ifndef MK_N_LAUNCHES
#define MK_N_LAUNCHES 1
#endif
extern "C" void kernel_launch(void* const* d_in, const int* in_sizes, int n_in, void* d_out, int out_size, void* d_ws, size_t ws_size, hipStream_t stream) {
    static int grid = 0;
    if (grid == 0) {
        if (n_in != 19 || in_sizes[0] != M * D || out_size != M * D || ws_size < WS_END) { fprintf(stderr, "kernel_launch: unexpected shapes (n_in %d, in0 %d, out %d, ws %zu)\n", n_in, n_in > 0 ? in_sizes[0] : -1, out_size, ws_size); grid = -1; return; }
        int dev = 0, cus = 0, per_cu = 0;
        if (hipGetDevice(&dev) != hipSuccess || hipDeviceGetAttribute(&cus, hipDeviceAttributeMultiprocessorCount, dev) != hipSuccess) { grid = -1; return; }
        if (hipFuncSetAttribute((const void*)hybrid_fwd, hipFuncAttributeMaxDynamicSharedMemorySize, LDS_BYTES) != hipSuccess) { fprintf(stderr, "kernel_launch: hipFuncSetAttribute failed\n"); grid = -1; return; }
        if (hipOccupancyMaxActiveBlocksPerMultiprocessor(&per_cu, (const void*)hybrid_fwd, NTHREADS, LDS_BYTES) != hipSuccess || per_cu < 1) { fprintf(stderr, "kernel_launch: occupancy query says %d\n", per_cu); per_cu = 1; }
        (void)hipGetLastError();
        grid = cus * 1;
    }
    if (grid < 0) return;
    if (hipMemsetAsync((char*)d_ws + WS_CTL, 0, CTL_BYTES, stream) != hipSuccess) { fprintf(stderr, "kernel_launch: memset failed\n"); return; }
    Args a{};
    a.x = (const float*)d_in[0]; a.pos = (const int*)d_in[1];
    a.ffn1_pre = (const float*)d_in[2]; a.ffn1_wgu = (const float*)d_in[3]; a.ffn1_wd = (const float*)d_in[4]; a.ffn1_post = (const float*)d_in[5];
    a.mix_pre = (const float*)d_in[6]; a.w_in = (const float*)d_in[7]; a.w_pool = (const float*)d_in[8]; a.pool_scale = (const float*)d_in[9]; a.sinks = (const float*)d_in[10];
    a.g_pool = (const float*)d_in[11]; a.g_attn = (const float*)d_in[12]; a.w_out = (const float*)d_in[13]; a.mix_post = (const float*)d_in[14];
    a.ffn2_pre = (const float*)d_in[15]; a.ffn2_wgu = (const float*)d_in[16]; a.ffn2_wd = (const float*)d_in[17]; a.ffn2_post = (const float*)d_in[18];
    a.out = (float*)d_out; a.ws = (unsigned char*)d_ws;
    constexpr int NPH = 11;
#if MK_N_LAUNCHES == 1
    a.ph_lo = 0; a.ph_hi = NPH;
    { void* kargs[] = {&a}; hipError_t e = hipLaunchCooperativeKernel((const void*)hybrid_fwd, dim3(grid), dim3(NTHREADS), kargs, LDS_BYTES, stream);
      if (e != hipSuccess) fprintf(stderr, "kernel_launch: cooperative launch failed: %s (grid %d)\n", hipGetErrorString(e), grid); }
#else
    for (int p = 0; p < NPH; ++p) { a.ph_lo = p; a.ph_hi = p + 1; void* kargs[] = {&a};
        hipError_t e = hipLaunchCooperativeKernel((const void*)hybrid_fwd, dim3(grid), dim3(NTHREADS), kargs, LDS_BYTES, stream);
        if (e != hipSuccess) { fprintf(stderr, "kernel_launch: launch %d failed: %s\n", p, hipGetErrorString(e)); break; } }
#endif
}
```

```cpp
#include <hip/hip_runtime.h>
#include <hip/hip_cooperative_groups.h>
#include <cstdio>
#include <cstdint>
namespace cg = cooperative_groups;
namespace pg8 {
#define PG8_LAS __attribute__((address_space(3)))
typedef unsigned short bf16_t;
typedef short bf16x8 __attribute__((ext_vector_type(8)));
typedef float f32x4 __attribute__((ext_vector_type(4)));
typedef unsigned u32x4 __attribute__((ext_vector_type(4)));
constexpr int BM = 256, BK = 64, HALF = 128, HTB = HALF * BK * 2  , STAGE_BYTES = 8 * HTB, NXCD = 8, WGM = 8;

__host__ __device__ __forceinline__ int lds_byte(int r, int c) { const int st = (r >> 4) * 2 + (c >> 5), rr = r & 15, cc = c & 31, ob = rr * 64 + cc * 2; return st * 1024 + (ob ^ (((ob >> 9) & 1) << 5)); }
__host__ __device__ __forceinline__ void stage_rc(int b, int& R, int& C) { const int st = b / 1024, sb = b % 1024, swz = sb ^ (((sb >> 9) & 1) << 5); R = (st >> 1) * 16 + swz / 64; C = (st & 1) * 32 + (swz % 64) / 2; }
__host__ __device__ __forceinline__ int perm32(int rho) { const int n = rho >> 4, i = rho & 15; return 8 * (i >> 2) + 4 * n + (i & 3); }

struct Unit { int pm, pn; };
struct Gemm { const bf16_t* A; const bf16_t* Bt; int M, N, K; };

struct StaticOrder {
    int nM, nN, nwg, G, c;
    __host__ __device__ void init(int M, int N, int G_, int c_) { nM = M / BM; nN = N / BM; nwg = nM * nN; G = G_; c = c_; }
    __host__ __device__ bool next(int i, Unit& u) const {
        const long L = (long)i * G + c; if (L >= nwg) return false;
        int wgid = (int)L; { const int q = nwg / NXCD, r = nwg % NXCD, xcd = wgid % NXCD, off = wgid / NXCD; wgid = (xcd < r ? xcd * (q + 1) : r * (q + 1) + (xcd - r) * q) + off; }
        const int nig = WGM * nN, gid = wgid / nig, fm = gid * WGM, gsz = (nM - fm) < WGM ? (nM - fm) : WGM;
        u.pm = fm + ((wgid % nig) % gsz); u.pn = (wgid % nig) / gsz; return true;
    }
    __device__ __forceinline__ void a_ready(const Unit&) const {}
    __device__ __forceinline__ void done(const Unit&) const {}
};

__device__ __forceinline__ unsigned cvt_pk_bf16(float lo, float hi) { unsigned r; asm volatile("v_cvt_pk_bf16_f32 %0, %1, %2" : "=v"(r) : "v"(lo), "v"(hi)); return r; }
typedef float f32x2 __attribute__((ext_vector_type(2)));
__device__ __forceinline__ f32x2 gelu_pk(f32x2 v) {
    const f32x2 av = __builtin_elementwise_abs(v), d = av * 0.2316418882f + 1.0f;
    f32x2 t; t.x = __builtin_amdgcn_rcpf(d.x); t.y = __builtin_amdgcn_rcpf(d.y);
    f32x2 q = t * 0.5307027145f + (-0.7265760135f); q = q * t + 0.7107068705f; q = q * t + (-0.142248368f); q = q * t + 0.127414796f; q = q * t;
    const f32x2 s = (v * v) * (-0.72134752044f);
    f32x2 e; e.x = __builtin_amdgcn_exp2f(s.x); e.y = __builtin_amdgcn_exp2f(s.y);
    const f32x2 m = v * (q * e), r = v - m;
    f32x2 o; o.x = v.x < 0.f ? m.x : r.x; o.y = v.y < 0.f ? m.y : r.y; return o;
}

template <int ACT  > struct EpiBf16 {
    static constexpr bool PERM = true, AFTER_DRAIN = false; static_assert(ACT == 0 || ACT == 1, "EpiBf16: ACT is 0 (none) or 1 (gelu_pk)");
    bf16_t* O; int ldc; const float* bias; int split_cols; size_t split_stride; float scale0;
    __device__ __forceinline__ void operator()(const f32x4 (&acc)[2][2][4][2], const Unit& u, int wr, int wc, int fr, int fq) const {
        const int row0 = u.pm * BM + wr * 64 + fr; int colt = u.pn * BM; bf16_t* base = O;
        float sc = 1.f; if (split_cols) { const int t = colt / split_cols; base += (size_t)t * split_stride; colt -= t * split_cols; if (t == 0) sc = scale0; }
        const int col0 = colt + wc * 32 + 8 * fq, bcol0 = u.pn * BM + wc * 32 + 8 * fq;
        f32x4 bv[2][2];
#pragma unroll
        for (int bj = 0; bj < 2; ++bj)
#pragma unroll
            for (int n = 0; n < 2; ++n) bv[bj][n] = bias ? *(const f32x4*)(bias + bcol0 + bj * HALF + 4 * n) : (f32x4){0.f, 0.f, 0.f, 0.f};
#pragma unroll
        for (int ai = 0; ai < 2; ++ai)
#pragma unroll
            for (int m = 0; m < 4; ++m) { bf16_t* rowp = base + (size_t)(row0 + ai * HALF + m * 16) * ldc + col0;
#pragma unroll
                for (int bj = 0; bj < 2; ++bj) { f32x4 v0 = acc[ai][bj][m][0] + bv[bj][0], v1 = acc[ai][bj][m][1] + bv[bj][1];
                    if (ACT == 1) { f32x2 a = gelu_pk((f32x2){v0[0], v0[1]}), b = gelu_pk((f32x2){v0[2], v0[3]}), c = gelu_pk((f32x2){v1[0], v1[1]}), d = gelu_pk((f32x2){v1[2], v1[3]});
                        v0 = (f32x4){a.x, a.y, b.x, b.y}; v1 = (f32x4){c.x, c.y, d.x, d.y}; }
                    v0 = v0 * sc; v1 = v1 * sc; u32x4 w; w.x = cvt_pk_bf16(v0[0], v0[1]); w.y = cvt_pk_bf16(v0[2], v0[3]); w.z = cvt_pk_bf16(v1[0], v1[1]); w.w = cvt_pk_bf16(v1[2], v1[3]);
                    *(u32x4*)(rowp + bj * HALF) = w; } }
    }
};
typedef __bf16 bf16x2_t __attribute__((ext_vector_type(2)));
__device__ __forceinline__ unsigned cvtpk(float lo, float hi) { f32x2 v = {lo, hi}; bf16x2_t b = __builtin_convertvector(v, bf16x2_t); return __builtin_bit_cast(unsigned, b); }
__device__ __forceinline__ float silu_mul(float g, float u) { const float e = __builtin_amdgcn_exp2f(-1.4426950408889634f * g); return g * __builtin_amdgcn_rcpf(1.0f + e) * u; }

struct EpiSwiGLU {
    static constexpr bool PERM = true, AFTER_DRAIN = false;
    bf16_t* O; int ldc; const float* rs;
    __device__ __forceinline__ void operator()(const f32x4 (&acc)[2][2][4][2], const Unit& u, int wr, int wc, int fr, int fq) const {
        const int row0 = u.pm * BM + wr * 64 + fr, col0 = u.pn * HALF + wc * 32 + 8 * fq;
#pragma unroll
        for (int ai = 0; ai < 2; ++ai)
#pragma unroll
            for (int m = 0; m < 4; ++m) { const int row = row0 + ai * HALF + m * 16; bf16_t* rowp = O + (size_t)row * ldc + col0; const float r = rs[row];
                const f32x4 g0 = acc[ai][0][m][0] * r, g1 = acc[ai][0][m][1] * r, u0 = acc[ai][1][m][0] * r, u1 = acc[ai][1][m][1] * r;
                u32x4 w; w.x = cvtpk(silu_mul(g0[0], u0[0]), silu_mul(g0[1], u0[1])); w.y = cvtpk(silu_mul(g0[2], u0[2]), silu_mul(g0[3], u0[3]));
                w.z = cvtpk(silu_mul(g1[0], u1[0]), silu_mul(g1[1], u1[1])); w.w = cvtpk(silu_mul(g1[2], u1[2]), silu_mul(g1[3], u1[3]));
                *(u32x4*)rowp = w; }
    }
};
struct EpiRowScale {
    static constexpr bool PERM = true, AFTER_DRAIN = false;
    bf16_t* O; int ldc; const float* rs;
    __device__ __forceinline__ void operator()(const f32x4 (&acc)[2][2][4][2], const Unit& u, int wr, int wc, int fr, int fq) const {
        const int row0 = u.pm * BM + wr * 64 + fr, col0 = u.pn * BM + wc * 32 + 8 * fq;
#pragma unroll
        for (int ai = 0; ai < 2; ++ai)
#pragma unroll
            for (int m = 0; m < 4; ++m) { const int row = row0 + ai * HALF + m * 16; const float sc = rs[row]; bf16_t* rowp = O + (size_t)row * ldc + col0;
#pragma unroll
                for (int bj = 0; bj < 2; ++bj) { const f32x4 v0 = acc[ai][bj][m][0] * sc, v1 = acc[ai][bj][m][1] * sc;
                    u32x4 w; w.x = cvtpk(v0[0], v0[1]); w.y = cvtpk(v0[2], v0[3]); w.z = cvtpk(v1[0], v1[1]); w.w = cvtpk(v1[2], v1[3]);
                    *(u32x4*)(rowp + bj * HALF) = w; } }
    }
};
struct EpiZ {
    static constexpr bool PERM = true, AFTER_DRAIN = false;
    bf16_t* Z; bf16_t* Vt; const float* cs; float qscale; int seq; const float* rs;
    __device__ __forceinline__ void operator()(const f32x4 (&acc)[2][2][4][2], const Unit& u, int wr, int wc, int fr, int fq) const {
        const int row0 = u.pm * BM + wr * 64 + fr, cl = wc * 32 + 8 * fq;
#pragma unroll
        for (int bj = 0; bj < 2; ++bj) {
            const int colh = u.pn * BM + bj * HALF;
            const bool isV = (colh == 1152);
            const bool rope = (colh >= 512) && (colh < 1152) && ((wc & 1) == 0) && (fq < 2);
            const float sc = (colh >= 512 && colh < 1024) ? qscale : 1.0f;
#pragma unroll
            for (int ai = 0; ai < 2; ++ai)
#pragma unroll
                for (int m = 0; m < 4; ++m) { const int row = row0 + ai * HALF + m * 16;
                    const float r = rs[row];
                    f32x4 v0 = acc[ai][bj][m][0] * r, v1 = acc[ai][bj][m][1] * r;
                    if (isV) {
                        const int b = row / seq, s = row - b * seq;
#pragma unroll
                        for (int i = 0; i < 4; ++i) { const int c0 = cl + i, c1 = cl + 4 + i;
                            Vt[((size_t)((b * 2 + (c0 >> 6)) * 64 + (c0 & 63))) * seq + s] = (bf16_t)(cvtpk(v0[i], 0.f) & 0xffffu);
                            Vt[((size_t)((b * 2 + (c1 >> 6)) * 64 + (c1 & 63))) * seq + s] = (bf16_t)(cvtpk(v1[i], 0.f) & 0xffffu); }
                    } else {
                        if (rope) { const f32x4 c = *(const f32x4*)(cs + (size_t)row * 16 + 4 * fq), sn = *(const f32x4*)(cs + (size_t)row * 16 + 8 + 4 * fq);
                            const f32x4 n0 = v0 * c - v1 * sn, n1 = v1 * c + v0 * sn; v0 = n0; v1 = n1; }
                        v0 = v0 * sc; v1 = v1 * sc;
                        u32x4 w; w.x = cvtpk(v0[0], v0[1]); w.y = cvtpk(v0[2], v0[3]); w.z = cvtpk(v1[0], v1[1]); w.w = cvtpk(v1[2], v1[3]);
                        *(u32x4*)(Z + (size_t)row * 1280 + colh + cl) = w; }
                }
        }
    }
};
template <class Epi, class Sched, bool ALIGN_EPI = false, bool SP2 = false>
__device__ __forceinline__ void gemm_phase(PG8_LAS unsigned char* lds, const Gemm g, const Sched& S, const Epi& E) {
    const int tid = threadIdx.x, wid = __builtin_amdgcn_readfirstlane(tid >> 6), lane = tid & 63, wr = wid >> 2, wc = wid & 3, fr = lane & 15, fq = lane >> 4;
    const int K = g.K, nt = K / BK;
    unsigned voffA[2], voffB[2];
#pragma unroll
    for (int i = 0; i < 2; ++i) { int R, C; stage_rc(tid * 16 + i * 8192, R, C); const int Rb = Epi::PERM ? ((R & ~31) + perm32(R & 31)) : R;
        voffA[i] = (unsigned)(R * K + C) * 2u; voffB[i] = (unsigned)(Rb * K + C) * 2u; }
    const size_t kstep = (size_t)(BK * 2);
    const size_t hstep = (size_t)HALF * K * 2;
    const size_t tstep = 2 * hstep;
    const unsigned ldsw = (unsigned)wid * 1024u;
    const int aoff = lds_byte(wr * 64 + fr, fq * 8), boff = lds_byte(wc * 32 + fr, fq * 8);
#define PG8_SA(b, h) (((b) * 2 + (h)) * HTB)
#define PG8_SB(b, h) ((4 + (b) * 2 + (h)) * HTB)
#define PG8_STAGE(bufoff, gbase, voff) do { _Pragma("unroll") for (int _i = 0; _i < 2; ++_i) \
        __builtin_amdgcn_global_load_lds((const unsigned*)((const char*)(gbase) + (voff)[_i]), (PG8_LAS unsigned*)(lds + (bufoff) + ldsw + _i * 8192), 16, 0, 0); } while (0)
#define PG8_LDA(dst, b, h) do { _Pragma("unroll") for (int m = 0; m < 4; ++m) _Pragma("unroll") for (int k = 0; k < 2; ++k) dst[m][k] = *(const PG8_LAS bf16x8*)(lds + PG8_SA(b, h) + aoff + m * 2048 + k * 1024); } while (0)
#define PG8_LDB(dst, b, h) do { _Pragma("unroll") for (int n = 0; n < 2; ++n) _Pragma("unroll") for (int k = 0; k < 2; ++k) dst[n][k] = *(const PG8_LAS bf16x8*)(lds + PG8_SB(b, h) + boff + n * 2048 + k * 1024); } while (0)
#define PG8_MMA(ai, bj, At, Bt) do { __builtin_amdgcn_s_setprio(1); _Pragma("unroll") for (int m = 0; m < 4; ++m) _Pragma("unroll") for (int n = 0; n < 2; ++n) _Pragma("unroll") for (int k = 0; k < 2; ++k) \
        acc[ai][bj][m][n] = __builtin_amdgcn_mfma_f32_16x16x32_bf16(Bt[n][k], At[m][k], acc[ai][bj][m][n], 0, 0, 0); __builtin_amdgcn_s_setprio(0); } while (0)
#define PG8_WAIT_V(n) asm volatile("s_waitcnt vmcnt(" #n ")" ::: "memory")
#define PG8_WAIT_L(n) asm volatile("s_waitcnt lgkmcnt(" #n ")" ::: "memory")
#define PG8_BAR __builtin_amdgcn_s_barrier()
#define PG8_SCHED __builtin_amdgcn_sched_barrier(0)
    Unit cur, nxt; int ui = 0;
    if (!S.next(0, cur)) return;
    f32x4 acc[2][2][4][2];
#pragma unroll
    for (int a = 0; a < 2; ++a)
#pragma unroll
        for (int b = 0; b < 2; ++b)
#pragma unroll
            for (int m = 0; m < 4; ++m)
#pragma unroll
                for (int n = 0; n < 2; ++n) acc[a][b][m][n] = (f32x4){0.f, 0.f, 0.f, 0.f};
    bf16x8 At[4][2], B0[2][2], B1[2][2];
    const char* cA = (const char*)g.A + (size_t)cur.pm * tstep; const char* cB = (const char*)g.Bt + (size_t)cur.pn * tstep;
    S.a_ready(cur);
    if constexpr (SP2) {
        PG8_STAGE(PG8_SB(0, 0), cB, voffB); PG8_STAGE(PG8_SB(0, 1), cB + hstep, voffB); PG8_STAGE(PG8_SA(0, 0), cA, voffA); PG8_STAGE(PG8_SA(0, 1), cA + hstep, voffA);
        if (wr == 1) PG8_BAR;
        PG8_WAIT_V(2); PG8_BAR;
        PG8_STAGE(PG8_SB(1, 0), cB + kstep, voffB); PG8_STAGE(PG8_SA(1, 0), cA + kstep, voffA); PG8_STAGE(PG8_SB(1, 1), cB + hstep + kstep, voffB);
        PG8_WAIT_V(6); PG8_BAR;
    } else {
        PG8_STAGE(PG8_SB(0, 0), cB, voffB); PG8_STAGE(PG8_SA(0, 0), cA, voffA); PG8_STAGE(PG8_SB(0, 1), cB + hstep, voffB); PG8_STAGE(PG8_SA(0, 1), cA + hstep, voffA);
        if (wr == 1) PG8_BAR;
        PG8_WAIT_V(4); PG8_BAR;
        PG8_STAGE(PG8_SB(1, 0), cB + kstep, voffB); PG8_STAGE(PG8_SA(1, 0), cA + kstep, voffA); PG8_STAGE(PG8_SB(1, 1), cB + hstep + kstep, voffB);
        PG8_WAIT_V(6); PG8_BAR;
    }
    for (;;) {
        const bool has_next = S.next(ui + 1, nxt);
        const char* nA = has_next ? (const char*)g.A + (size_t)nxt.pm * tstep : cA; const char* nB = has_next ? (const char*)g.Bt + (size_t)nxt.pn * tstep : cB;
        for (int t = 0; t < nt; t += 2) {
            const bool last = (t == nt - 2);
            const char* a1 = cA + (size_t)(t + 1) * kstep;
            const char* a2 = last ? nA : cA + (size_t)(t + 2) * kstep; const char* b2 = last ? nB : cB + (size_t)(t + 2) * kstep;
            const char* a3 = a2 + kstep; const char* b3 = b2 + kstep;
            if (last && has_next) S.a_ready(nxt);
            if constexpr (SP2) {
            PG8_LDB(B0, 0, 0); PG8_LDB(B1, 0, 1); PG8_SCHED; PG8_LDA(At, 0, 0); PG8_STAGE(PG8_SA(1, 1), a1 + hstep, voffA);
            PG8_WAIT_V(8); PG8_WAIT_L(0); PG8_BAR; PG8_MMA(0, 0, At, B0); PG8_MMA(0, 1, At, B1); PG8_BAR; PG8_SCHED;
            PG8_LDA(At, 0, 1); PG8_STAGE(PG8_SB(0, 0), b2, voffB); PG8_STAGE(PG8_SB(0, 1), b2 + hstep, voffB); PG8_STAGE(PG8_SA(0, 0), a2, voffA);
            PG8_WAIT_V(8); PG8_WAIT_L(0); PG8_BAR; PG8_MMA(1, 0, At, B0); PG8_MMA(1, 1, At, B1); PG8_BAR; PG8_SCHED;
            PG8_LDB(B0, 1, 0); PG8_LDB(B1, 1, 1); PG8_SCHED; PG8_LDA(At, 1, 0); PG8_STAGE(PG8_SA(0, 1), a2 + hstep, voffA);
            PG8_WAIT_V(8); PG8_WAIT_L(0); PG8_BAR; PG8_MMA(0, 0, At, B0); PG8_MMA(0, 1, At, B1); PG8_BAR; PG8_SCHED;
            PG8_LDA(At, 1, 1); PG8_STAGE(PG8_SB(1, 0), b3, voffB); PG8_STAGE(PG8_SB(1, 1), b3 + hstep, voffB); PG8_STAGE(PG8_SA(1, 0), a3, voffA);
            PG8_WAIT_V(8); PG8_WAIT_L(0); PG8_BAR; PG8_MMA(1, 0, At, B0); PG8_MMA(1, 1, At, B1); PG8_BAR; PG8_SCHED;
            } else {
            PG8_LDB(B0, 0, 0); PG8_SCHED; PG8_LDA(At, 0, 0); PG8_STAGE(PG8_SA(1, 1), a1 + hstep, voffA);
            PG8_WAIT_L(8); PG8_BAR; PG8_WAIT_L(0); PG8_MMA(0, 0, At, B0); PG8_BAR; PG8_SCHED;
            PG8_LDB(B1, 0, 1); PG8_STAGE(PG8_SB(0, 0), b2, voffB);
            PG8_BAR; PG8_WAIT_L(0); PG8_MMA(0, 1, At, B1); PG8_BAR;
            PG8_LDA(At, 0, 1); PG8_STAGE(PG8_SA(0, 0), a2, voffA);
            PG8_BAR; PG8_WAIT_L(0); PG8_MMA(1, 0, At, B0); PG8_BAR; PG8_SCHED;
            PG8_STAGE(PG8_SB(0, 1), b2 + hstep, voffB);
            PG8_WAIT_V(6); PG8_BAR; PG8_MMA(1, 1, At, B1); PG8_BAR;
            PG8_LDB(B0, 1, 0); PG8_SCHED; PG8_LDA(At, 1, 0); PG8_STAGE(PG8_SA(0, 1), a2 + hstep, voffA);
            PG8_WAIT_L(8); PG8_BAR; PG8_WAIT_L(0); PG8_MMA(0, 0, At, B0); PG8_BAR; PG8_SCHED;
            PG8_LDB(B1, 1, 1); PG8_STAGE(PG8_SB(1, 0), b3, voffB);
            PG8_BAR; PG8_WAIT_L(0); PG8_MMA(0, 1, At, B1); PG8_BAR;
            PG8_LDA(At, 1, 1); PG8_STAGE(PG8_SA(1, 0), a3, voffA);
            PG8_BAR; PG8_WAIT_L(0); PG8_MMA(1, 0, At, B0); PG8_BAR; PG8_SCHED;
            PG8_STAGE(PG8_SB(1, 1), b3 + hstep, voffB);
            PG8_WAIT_V(6); PG8_BAR; PG8_MMA(1, 1, At, B1); PG8_BAR;
            }
        }
        if constexpr (ALIGN_EPI) { if (wr == 0) PG8_BAR; }
        if constexpr (!Epi::AFTER_DRAIN) { E(acc, cur, wr, wc, fr, fq); S.done(cur); }
        if (!has_next) break;
#pragma unroll
        for (int a = 0; a < 2; ++a)
#pragma unroll
            for (int b = 0; b < 2; ++b)
#pragma unroll
                for (int m = 0; m < 4; ++m)
#pragma unroll
                    for (int n = 0; n < 2; ++n) acc[a][b][m][n] = (f32x4){0.f, 0.f, 0.f, 0.f};
        cur = nxt; cA = nA; cB = nB; ++ui;
        if constexpr (ALIGN_EPI) { if (wr == 1) PG8_BAR; }
    }
    PG8_WAIT_V(0);
    if constexpr (!ALIGN_EPI) { if (wr == 0) PG8_BAR; }
    PG8_BAR;
    if constexpr (Epi::AFTER_DRAIN) { E.fused(acc, cur, wr, wc, fr, fq, lds, wid, lane); S.done(cur); }
#undef PG8_SA
#undef PG8_SB
#undef PG8_STAGE
#undef PG8_LDA
#undef PG8_LDB
#undef PG8_MMA
#undef PG8_WAIT_V
#undef PG8_WAIT_L
#undef PG8_BAR
#undef PG8_SCHED
}
}
constexpr int BATCH = 4, SEQ = 8192, D = 1024, M = BATCH * SEQ, FF = 2816, NGU = 2 * FF, NIN = 1280, NBLK = M / 128, NB_SEQ = SEQ / 128;
constexpr float EPS = 1e-6f;
constexpr float QSCALE = 0.125f * 1.4426950408889634f;
constexpr float LOG2E = 1.4426950408889634f;
constexpr int NWAVES = 8, NTHREADS = 512;
constexpr size_t MiB = 1u << 20;
constexpr size_t WS_WGU1 = 0, WS_WGU2 = 11 * MiB, WS_WD1 = 22 * MiB, WS_WD2 = 28 * MiB, WS_WIN = 34 * MiB, WS_WOUT = 37 * MiB, WS_WPOOL = 39 * MiB, WS_CS = 40 * MiB;
constexpr size_t WS_CTL = 46 * MiB, CTL_BYTES = 16384, WS_RA = 47 * MiB;
constexpr size_t WS_A = 48 * MiB, WS_HD = 112 * MiB, WS_H = 176 * MiB, WS_Z = 176 * MiB, WS_VT = 256 * MiB, WS_Y = 264 * MiB, WS_XR = 352 * MiB, WS_END = 416 * MiB;
static_assert((size_t)NGU * D * 2 <= 11 * MiB && (size_t)D * FF * 2 <= 6 * MiB && (size_t)NIN * D * 2 <= 3 * MiB && (size_t)M * 16 * 4 <= 8 * MiB, "ws map");
static_assert(WS_Z + (size_t)M * NIN * 2 <= WS_VT && WS_VT + (size_t)M * 128 * 2 <= WS_Y && WS_Y + (size_t)M * D * 2 <= WS_END && WS_H + (size_t)M * FF * 2 <= WS_XR && WS_XR + (size_t)M * D * 2 <= WS_END, "ws map 2");
constexpr int LDS_BYTES = 163840;
constexpr int KL_OFF = 0, KL_PITCH = 144, VL_OFF = 36864, VL_PITCH = 520, UL_OFF = 70144, UL_PITCH = 272, UL_ROWS = 143, DL_OFF = UL_OFF + 38912, DL_PITCH = 272;
constexpr int RAL_OFF = DL_OFF + 34816, ASTG_OFF = RAL_OFF + 512, MISC_OFF = ASTG_OFF + 16384;
static_assert(UL_ROWS * UL_PITCH <= 38912 && MISC_OFF >= 131072 && MISC_OFF + 128 <= LDS_BYTES && ASTG_OFF % 16 == 0 && DL_OFF % 16 == 0, "LDS map");

#define LAS __attribute__((address_space(3)))
typedef unsigned short bf16;
typedef unsigned u32x4 __attribute__((ext_vector_type(4)));
typedef unsigned u32x2 __attribute__((ext_vector_type(2)));
typedef float f32x4 __attribute__((ext_vector_type(4)));
typedef float f32x16 __attribute__((ext_vector_type(16)));
typedef short bf16x8 __attribute__((ext_vector_type(8)));
using pg8::cvtpk;
__device__ __forceinline__ float bflo(unsigned w) { return __uint_as_float(w << 16); }
__device__ __forceinline__ float bfhi(unsigned w) { return __uint_as_float(w & 0xffff0000u); }
__device__ __forceinline__ float wave_sum(float v) {
#pragma unroll
    for (int o = 1; o < 64; o <<= 1) v += __shfl_xor(v, o);
    return v;
}
__device__ __forceinline__ float half_sum32(float v) {
#pragma unroll
    for (int o = 1; o < 32; o <<= 1) v += __shfl_xor(v, o);
    return v;
}
__device__ __forceinline__ int crow(int r, int hi) { return (r & 3) + 8 * (r >> 2) + 4 * hi; }

struct Args {
    const float* x; const int* pos;
    const float *ffn1_pre, *ffn1_wgu, *ffn1_wd, *ffn1_post, *mix_pre, *w_in, *w_pool, *pool_scale, *sinks, *g_pool, *g_attn, *w_out, *mix_post, *ffn2_pre, *ffn2_wgu, *ffn2_wd, *ffn2_post;
    float* out; unsigned char* ws; int ph_lo, ph_hi;
};

__device__ __forceinline__ int dest_row(int mode, int n) {
    if (mode == 1) { return n < FF ? ((n >> 7) * 256 + (n & 127)) : ((((n - FF) >> 7) * 256) + 128 + ((n - FF) & 127)); }
    if (mode == 2) { if (n >= 512 && n < 1152) { const int d = n & 63; const int p = (d >= 4 && d < 8) ? d + 4 : ((d >= 8 && d < 12) ? d - 4 : d); return (n - d) + p; } return n; }
    return n;
}
__device__ __forceinline__ void transpose_item(const float* W, int K, int N, bf16* WT, int mode, LAS float* scr, int item, int lane, const float* gk = nullptr) {
    const int nblk = N / 32, kb = item / nblk, nb = item % nblk, k0 = 64 * kb, n0 = 32 * nb;
#pragma unroll 8
    for (int i = 0; i < 32; ++i) { const int kk = 2 * i + (lane >> 5); const float gg = gk ? gk[k0 + kk] : 1.0f; scr[kk * 33 + (lane & 31)] = W[(size_t)(k0 + kk) * N + n0 + (lane & 31)] * gg; }
    asm volatile("s_waitcnt lgkmcnt(0)" ::: "memory");
    const int c = lane & 7;
#pragma unroll
    for (int j = 0; j < 4; ++j) { const int n = (lane >> 3) + 8 * j; const LAS float* s = scr + (8 * c) * 33 + n;
        u32x4 o; o.x = cvtpk(s[0 * 33], s[1 * 33]); o.y = cvtpk(s[2 * 33], s[3 * 33]); o.z = cvtpk(s[4 * 33], s[5 * 33]); o.w = cvtpk(s[6 * 33], s[7 * 33]);
        *(u32x4*)(WT + (size_t)dest_row(mode, n0 + n) * K + k0 + 8 * c) = o; }
    asm volatile("s_waitcnt lgkmcnt(0)" ::: "memory");
}
__device__ __forceinline__ void sincos_f(float a, float& sn, float& cn) {
    const double ad = (double)a; const double q = __builtin_rint(ad * 0.63661977236758134308);
    const float r = (float)__builtin_fma(-q, 1.57079632679489661923, ad); const int qi = ((int)q) & 3;
    const float z = r * r;
    const float s = r + r * z * (-1.6666654611e-1f + z * (8.3321608736e-3f + z * (-1.9515295891e-4f)));
    const float c = 1.0f - 0.5f * z + z * z * (4.166664568298827e-2f + z * (-1.388731625493765e-3f + z * 2.443315711809948e-5f));
    sn = (qi == 0) ? s : (qi == 1) ? c : (qi == 2) ? -s : -c;
    cn = (qi == 0) ? c : (qi == 1) ? -s : (qi == 2) ? -c : s;
}
__device__ __forceinline__ float inv_freq(int i) {
    return i == 0 ? 1.0f : i == 1 ? 0.19392274474868576f : i == 2 ? 0.03760603093086393f : i == 3 ? 0.007292664737217109f : i == 4 ? 0.001414213562373095f : i == 5 ? 0.0002742481756762073f : i == 6 ? 5.318295896944988e-05f : 1.031338537721246e-05f;
}
__device__ __forceinline__ void prenorm_rows(const float* x, bf16* xb, float* rs, int gw, int NGW, int lane) {
    for (int m = gw; m < M; m += NGW) {
        const f32x4* xr = (const f32x4*)(x + (size_t)m * D) + lane; f32x4 v[4]; float s = 0.f;
#pragma unroll
        for (int j = 0; j < 4; ++j) { v[j] = xr[64 * j]; s += (v[j].x * v[j].x + v[j].y * v[j].y) + (v[j].z * v[j].z + v[j].w * v[j].w); }
        u32x2* o = (u32x2*)(xb + (size_t)m * D) + lane;
#pragma unroll
        for (int j = 0; j < 4; ++j) { u32x2 w; w.x = cvtpk(v[j].x, v[j].y); w.y = cvtpk(v[j].z, v[j].w); o[64 * j] = w; }
        const float r = 1.0f / sqrtf(wave_sum(s) * (1.0f / D) + EPS);
        if (lane == 0) rs[m] = r;
    }
}
template <bool HAS_A, bool XI_BF, bool XO_BF>
__device__ __forceinline__ void thin_rows(const void* xi, void* xo, const bf16* h, const float* gpost, float* rsout, float coef, int gw, int NGW, int lane) {
    for (int m = gw; m < M; m += NGW) {
        const u32x2* hr = (const u32x2*)(h + (size_t)m * D) + lane;
        f32x4 v[4], hv[4]; float s = 0.f;
#pragma unroll
        for (int j = 0; j < 4; ++j) {
            if (XI_BF) { const u32x2 w = ((const u32x2*)((const bf16*)xi + (size_t)m * D) + lane)[64 * j]; v[j] = (f32x4){bflo(w.x), bfhi(w.x), bflo(w.y), bfhi(w.y)}; }
            else v[j] = ((const f32x4*)((const float*)xi + (size_t)m * D) + lane)[64 * j];
            const u32x2 w = hr[64 * j]; hv[j] = (f32x4){bflo(w.x), bfhi(w.x), bflo(w.y), bfhi(w.y)};
            s += (hv[j].x * hv[j].x + hv[j].y * hv[j].y) + (hv[j].z * hv[j].z + hv[j].w * hv[j].w); }
        const float r1 = coef / sqrtf(wave_sum(s) * (1.0f / D) + EPS);
        float s2 = 0.f;
#pragma unroll
        for (int j = 0; j < 4; ++j) { const f32x4 gp = *((const f32x4*)gpost + lane + 64 * j); v[j] = v[j] + hv[j] * r1 * gp;
            s2 += (v[j].x * v[j].x + v[j].y * v[j].y) + (v[j].z * v[j].z + v[j].w * v[j].w); }
#pragma unroll
        for (int j = 0; j < 4; ++j) {
            if (XO_BF) { u32x2 w; w.x = cvtpk(v[j].x, v[j].y); w.y = cvtpk(v[j].z, v[j].w); ((u32x2*)((bf16*)xo + (size_t)m * D) + lane)[64 * j] = w; }
            else ((f32x4*)((float*)xo + (size_t)m * D) + lane)[64 * j] = v[j]; }
        if (HAS_A) { const float r2 = 1.0f / sqrtf(wave_sum(s2) * (1.0f / D) + EPS); if (lane == 0) rsout[m] = r2; }
    }
}
#define XB_TMO      128
#define XB_XCNT(j)  (256  + 64 * (j))
#define XB_XSUB(j)  (1280 + 64 * (j))
#define XB_XGEN(j)  (2304 + 64 * (j))
#define XB_TOP      3328
#define XB_TOPGEN   3392
#define XCD_BAR_WORDS 3456
#define XB_SPIN_CAP (1u << 18)

__device__ __forceinline__ unsigned xb_ld(unsigned* p)              { return __hip_atomic_load(p, __ATOMIC_RELAXED, __HIP_MEMORY_SCOPE_AGENT); }
__device__ __forceinline__ unsigned xb_add(unsigned* p, unsigned v) { return __hip_atomic_fetch_add(p, v, __ATOMIC_RELAXED, __HIP_MEMORY_SCOPE_AGENT); }
__device__ __forceinline__ unsigned xb_xcc_id() { return (unsigned)__builtin_amdgcn_s_getreg((3 << 11) | 20) & 0xFu; }
#define XB_SPIN(cond, bar) do { unsigned _sp = 0; while (cond) { __builtin_amdgcn_s_sleep(1); \
    if ((++_sp & 255u) == 0u) { if (xb_ld(&(bar)[XB_TMO])) break; if (_sp > XB_SPIN_CAP) { atomicAdd(&(bar)[XB_TMO], 1u); break; } } } } while (0)

struct XcdBarrier {
    unsigned* bar; unsigned x;
    volatile LAS unsigned* st;
};

__device__ __forceinline__ XcdBarrier xcd_barrier_post(unsigned* bar, volatile LAS unsigned* st) {
    XcdBarrier b; b.bar = bar; b.x = xb_xcc_id(); b.st = st;
    if (threadIdx.x == 0) (void)xb_add(&bar[XB_XCNT(b.x)], 1u);
    return b;
}
__device__ __forceinline__ void xcd_barrier_complete(unsigned* bar, unsigned x, unsigned& nloc, unsigned& nx) {
    const unsigned G = gridDim.x * gridDim.y * gridDim.z;
    unsigned sum, cnt, mine, sp = 0u;
    for (;;) {
        sum = 0u; cnt = 0u; mine = 0u;
#pragma unroll
        for (unsigned j = 0; j < 16; ++j) { const unsigned c = xb_ld(&bar[XB_XCNT(j)]); sum += c; cnt += (c > 0u) ? 1u : 0u; mine = (j == x) ? c : mine; }
        if (sum == G) break;
        __builtin_amdgcn_s_sleep(1);
        if ((++sp & 255u) == 0u) { if (xb_ld(&bar[XB_TMO])) break; if (sp > XB_SPIN_CAP) { atomicAdd(&bar[XB_TMO], 1u); break; } }
    }
    nloc = mine > 0u ? mine : 1u; nx = cnt > 0u ? cnt : 1u;
}

__device__ __forceinline__ void xcd_barrier(const XcdBarrier& b) {
    asm volatile("s_waitcnt vmcnt(0)" ::: "memory");
    __syncthreads();
    if (threadIdx.x == 0) {
        unsigned* bar = b.bar;
        __builtin_amdgcn_s_waitcnt(0);
        unsigned nloc = b.st[0], nx = b.st[1];
        if (nloc == 0u) { xcd_barrier_complete(bar, b.x, nloc, nx); b.st[0] = nloc; b.st[1] = nx; }
        const unsigned old = xb_add(&bar[XB_XSUB(b.x)], 1u);
        const unsigned gen = old / nloc;
        if (old + 1u == (gen + 1u) * nloc) {
            __builtin_amdgcn_fence(__ATOMIC_RELEASE, "agent");
            asm volatile("s_waitcnt vmcnt(0)" ::: "memory");
            const unsigned og = xb_add(&bar[XB_TOP], 1u);
            const unsigned tg = og / nx;
            if (og + 1u == (tg + 1u) * nx) xb_add(&bar[XB_TOPGEN], 1u);
            else XB_SPIN(xb_ld(&bar[XB_TOPGEN]) == tg, bar);
            __builtin_amdgcn_fence(__ATOMIC_ACQUIRE, "agent");
            xb_add(&bar[XB_XGEN(b.x)], 1u);
            asm volatile("s_waitcnt vmcnt(0)" ::: "memory");
        } else {
            XB_SPIN(xb_ld(&bar[XB_XGEN(b.x)]) == gen, bar);
            __builtin_amdgcn_fence(__ATOMIC_ACQUIRE, "agent");
            asm volatile("s_waitcnt vmcnt(0)" ::: "memory");
        }
    }
    __syncthreads();
}
#define MFMA32(a, b, c) __builtin_amdgcn_mfma_f32_32x32x16_bf16((a), (b), (c), 0, 0, 0)
__device__ __forceinline__ void load8(const bf16* p, float (&f)[8]) { const u32x4 w = *(const u32x4*)p;
    f[0] = bflo(w.x); f[1] = bfhi(w.x); f[2] = bflo(w.y); f[3] = bfhi(w.y); f[4] = bflo(w.z); f[5] = bfhi(w.z); f[6] = bflo(w.w); f[7] = bfhi(w.w); }

#define OPAQUE_V(x) asm volatile("" : "+v"(x))
#define OPAQUE_S(x) asm volatile("" : "+s"(x))
struct MixCtx { LAS unsigned char* lds; const bf16* Z; const bf16* Vt; const bf16* WpT; const float* pool_scale; const float* sinks; const float* g_pool; const float* g_attn; bf16* Y; float* RA; size_t rowbase; int b, n, htid, lane, hw; };

template <int G> __device__ __forceinline__ void pool_group(const MixCtx& c, f32x16& ssacc, unsigned (&kA)[16], unsigned (&kB)[16]) {
    constexpr int w = 2 << G;
    LAS unsigned char* lds = c.lds; int htid = c.htid, lane_ = c.lane, hw = c.hw; OPAQUE_V(htid); OPAQUE_V(lane_); OPAQUE_S(hw);
    const int r32 = lane_ & 31, hi = lane_ >> 5;
#pragma unroll
    for (int k = 0; k < 9; ++k) { const int i = htid + 256 * k, jr = i >> 4, cc = i & 15;
        if (jr < UL_ROWS) { u32x4 v = (u32x4){0u, 0u, 0u, 0u};
            if (c.n * 128 + jr - 15 >= 0) v = *(const u32x4*)(c.Z + (ptrdiff_t)((ptrdiff_t)c.rowbase + jr - 15) * NIN + G * 128 + cc * 8);
            *(LAS u32x4*)(lds + UL_OFF + jr * UL_PITCH + cc * 16) = v; } }
    __syncthreads();
    {
        const int c8 = htid & 15, t0 = (htid >> 4) * 8;
        const LAS unsigned char* ub = lds + UL_OFF + (15 + t0) * UL_PITCH + c8 * 16;
        float s[8], uv[8];
#pragma unroll
        for (int i = 0; i < 8; ++i) s[i] = 0.f;
#define LDU(row) do { const u32x4 w_ = *(const LAS u32x4*)(ub + (row) * UL_PITCH); uv[0] = bflo(w_.x); uv[1] = bfhi(w_.x); uv[2] = bflo(w_.y); uv[3] = bfhi(w_.y); uv[4] = bflo(w_.z); uv[5] = bfhi(w_.z); uv[6] = bflo(w_.w); uv[7] = bfhi(w_.w); } while (0)
#pragma unroll
        for (int j = 1 - w; j < 0; ++j) { LDU(j);
#pragma unroll
            for (int i = 0; i < 8; ++i) s[i] += uv[i]; }
#pragma unroll
        for (int tt = 0; tt < 8; ++tt) { const int t = t0 + tt;
            LDU(tt);
#pragma unroll
            for (int i = 0; i < 8; ++i) s[i] += uv[i];
            const int sp = c.n * 128 + t; const int cnt = (sp + 1 < w) ? sp + 1 : w; const float inv = 1.0f / (float)cnt;
            u32x4 o; o.x = cvtpk(s[0] * inv - uv[0], s[1] * inv - uv[1]); o.y = cvtpk(s[2] * inv - uv[2], s[3] * inv - uv[3]);
            o.z = cvtpk(s[4] * inv - uv[4], s[5] * inv - uv[5]); o.w = cvtpk(s[6] * inv - uv[6], s[7] * inv - uv[7]);
            *(LAS u32x4*)(lds + DL_OFF + t * DL_PITCH + c8 * 16) = o;
            LDU(tt - w + 1);
#pragma unroll
            for (int i = 0; i < 8; ++i) s[i] -= uv[i]; }
#undef LDU
    }
    __syncthreads();
#pragma unroll
    for (int j2 = 0; j2 < 2; ++j2) {
        f32x16 a0, a1;
#pragma unroll
        for (int i = 0; i < 16; ++i) { a0[i] = 0.f; a1[i] = 0.f; }
        const bf16* wp = c.WpT + (size_t)G * 16384 + (size_t)(64 * j2 + r32) * 128 + 8 * hi;
#pragma unroll
        for (int ks = 0; ks < 8; ++ks) {
            const bf16x8 A = *(const LAS bf16x8*)(lds + DL_OFF + (32 * hw + r32) * DL_PITCH + (16 * ks + 8 * hi) * 2);
            const bf16x8 B0 = *(const bf16x8*)(wp + 16 * ks), B1 = *(const bf16x8*)(wp + 32 * 128 + 16 * ks);
            a0 = MFMA32(A, B0, a0); a1 = MFMA32(A, B1, a1);
        }
        const float* psp = c.pool_scale + G * 128 + 64 * j2 + r32;
        const float ps0 = psp[0], ps1 = psp[32];
#pragma unroll
        for (int r = 0; r < 16; ++r) { const float v0 = a0[r] * ps0, v1 = a1[r] * ps1;
            { float q_ = ssacc[r] + (v0 * v0 + v1 * v1); asm volatile("" : "+v"(q_)); ssacc[r] = q_; }
            unsigned pk_ = cvtpk(v0, v1); asm volatile("" : "+v"(pk_));
            if (j2 == 0) kA[r] = pk_; else kB[r] = pk_; }
        __builtin_amdgcn_sched_barrier(0);
    }
    __syncthreads();
}
__device__ __forceinline__ void store_item(const MixCtx& c, LAS bf16* stg, const unsigned (&kp)[16], const float (&f)[16], const float* gptr, int colbase) {
    int lane = c.lane; OPAQUE_V(lane); const int r32 = lane & 31, hi = lane >> 5;
    const float g0 = gptr[r32], g1 = gptr[32 + r32];
#pragma unroll
    for (int r = 0; r < 16; ++r) { const int ro = (r & 3) + 8 * (r >> 2) + 4 * hi;
        stg[ro * 64 + r32] = (bf16)(cvtpk(bflo(kp[r]) * f[r] * g0, 0.f) & 0xffffu); stg[ro * 64 + 32 + r32] = (bf16)(cvtpk(bfhi(kp[r]) * f[r] * g1, 0.f) & 0xffffu); }
    asm volatile("s_waitcnt lgkmcnt(0)" ::: "memory");
    size_t yo = (c.rowbase + 32 * c.hw + (lane >> 3)) * D + colbase + (lane & 7) * 8; OPAQUE_V(yo); bf16* yb = c.Y + yo;
#pragma unroll
    for (int i = 0; i < 4; ++i) { const u32x4 v = *(const LAS u32x4*)(stg + (i * 8 + (lane >> 3)) * 64 + (lane & 7) * 8); *(u32x4*)(yb + (size_t)i * 8 * D) = v; }
    asm volatile("s_waitcnt lgkmcnt(0)" ::: "memory");
}
__device__ __forceinline__ void pool_half(const MixCtx& c) {
    f32x16 ssacc;
#pragma unroll
    for (int r = 0; r < 16; ++r) ssacc[r] = 0.f;
    unsigned a0[16], b0[16], a1[16], b1[16], a2[16], b2[16], a3[16], b3[16];
    pool_group<0>(c, ssacc, a0, b0); pool_group<1>(c, ssacc, a1, b1); pool_group<2>(c, ssacc, a2, b2); pool_group<3>(c, ssacc, a3, b3);
    int lane = c.lane; OPAQUE_V(lane); const int hi = lane >> 5;
    const LAS float* RAL = (const LAS float*)(c.lds + RAL_OFF);
    float f[16];
#pragma unroll
    for (int r = 0; r < 16; ++r) { const int ro = (r & 3) + 8 * (r >> 2) + 4 * hi; const float ss = half_sum32(ssacc[r]);
        f[r] = __builtin_amdgcn_rsqf(ss * (1.0f / 512.0f) + EPS) * __builtin_amdgcn_rcpf(RAL[32 * c.hw + ro]); }
    if (c.htid < 128) c.RA[c.rowbase + c.htid] = RAL[c.htid];
    LAS bf16* stg = (LAS bf16*)(c.lds + UL_OFF) + c.hw * 2048;
    store_item(c, stg, a0, f, c.g_pool, 0); store_item(c, stg, b0, f, c.g_pool + 64, 64);
    store_item(c, stg, a1, f, c.g_pool + 128, 128); store_item(c, stg, b1, f, c.g_pool + 192, 192);
    store_item(c, stg, a2, f, c.g_pool + 256, 256); store_item(c, stg, b2, f, c.g_pool + 320, 320);
    store_item(c, stg, a3, f, c.g_pool + 384, 384); store_item(c, stg, b3, f, c.g_pool + 448, 448);
    __syncthreads();
}
template <int KH, int GI> __device__ __forceinline__ void att_item(const MixCtx& c, bf16x8 (&qr)[4], const bf16* qp, f32x16& ssacc) {
    LAS unsigned char* lds = c.lds; int lane_ = c.lane, rg = c.hw; OPAQUE_V(lane_); OPAQUE_S(rg);
    const int r32 = lane_ & 31, hi = lane_ >> 5, n = c.n;
    constexpr int h = KH * 4 + GI;
    f32x16 S[5];
#pragma unroll
    for (int t = 0; t < 5; ++t) {
#pragma unroll
        for (int i = 0; i < 16; ++i) S[t][i] = 0.f;
#pragma unroll
        for (int d0 = 0; d0 < 4; ++d0) { const bf16x8 kf = *(const LAS bf16x8*)(lds + KL_OFF + (32 * (rg + t) + r32) * KL_PITCH + (16 * d0 + 8 * hi) * 2);
            S[t] = MFMA32(kf, qr[d0], S[t]); }
        if (t & 1) __builtin_amdgcn_sched_barrier(0);
    }
    if (GI < 3) {
#pragma unroll
        for (int d0 = 0; d0 < 4; ++d0) qr[d0] = *(const bf16x8*)(qp + 64 * (GI + 1) + 16 * d0);
    }
    const float sinkl = c.sinks[h] * LOG2E;
    const float g0 = c.g_attn[h * 64 + r32], g1 = c.g_attn[h * 64 + 32 + r32];
    float mx = sinkl;
#pragma unroll
    for (int t = 0; t < 5; ++t)
#pragma unroll
        for (int r = 0; r < 16; ++r) {
            const bool tv = (n > 0) || (rg + t >= 4);
            const bool valid = (t == 0) ? (tv && (crow(r, hi) > r32)) : (t == 4) ? (crow(r, hi) <= r32) : tv;
            const float sv = valid ? S[t][r] : -1e30f; S[t][r] = sv; mx = fmaxf(mx, sv); }
    mx = fmaxf(mx, __shfl_xor(mx, 32));
    float sum = 0.f;
#pragma unroll
    for (int t = 0; t < 5; ++t)
#pragma unroll
        for (int r = 0; r < 16; ++r) { const float p = __builtin_amdgcn_exp2f(S[t][r] - mx); S[t][r] = p; sum += p; }
    sum += __shfl_xor(sum, 32);
    sum += __builtin_amdgcn_exp2f(sinkl - mx);
    const float linv = 1.0f / sum;
    f32x16 o0, o1;
#pragma unroll
    for (int i = 0; i < 16; ++i) { o0[i] = 0.f; o1[i] = 0.f; }
#pragma unroll
    for (int t = 0; t < 5; ++t)
#pragma unroll
        for (int s = 0; s < 2; ++s) {
            u32x4 pw; pw.x = cvtpk(S[t][8 * s + 0], S[t][8 * s + 1]); pw.y = cvtpk(S[t][8 * s + 2], S[t][8 * s + 3]); pw.z = cvtpk(S[t][8 * s + 4], S[t][8 * s + 5]); pw.w = cvtpk(S[t][8 * s + 6], S[t][8 * s + 7]);
            const bf16x8 pa = __builtin_bit_cast(bf16x8, pw);
            const int keyb = 32 * (rg + t) + 16 * s + 4 * hi;
            const LAS unsigned char* vb = lds + VL_OFF + r32 * VL_PITCH + keyb * 2;
            const u32x2 l0 = *(const LAS u32x2*)(vb), h0 = *(const LAS u32x2*)(vb + 16);
            const u32x2 l1 = *(const LAS u32x2*)(vb + 32 * VL_PITCH), h1 = *(const LAS u32x2*)(vb + 32 * VL_PITCH + 16);
            const bf16x8 v0 = __builtin_bit_cast(bf16x8, ((u32x4){l0.x, l0.y, h0.x, h0.y})), v1 = __builtin_bit_cast(bf16x8, ((u32x4){l1.x, l1.y, h1.x, h1.y}));
            o0 = MFMA32(pa, v0, o0); o1 = MFMA32(pa, v1, o1);
            if (s == 1) __builtin_amdgcn_sched_barrier(0);
        }
    LAS bf16* stg = (LAS bf16*)(lds + ASTG_OFF) + rg * 2048;
#pragma unroll
    for (int r = 0; r < 16; ++r) { const int ro = (r & 3) + 8 * (r >> 2) + 4 * hi; const float li = __shfl(linv, ro);
        const float v0 = o0[r] * li, v1 = o1[r] * li;
        { float q_ = ssacc[r] + (v0 * v0 + v1 * v1); asm volatile("" : "+v"(q_)); ssacc[r] = q_; }
        stg[ro * 64 + r32] = (bf16)(cvtpk(v0 * g0, 0.f) & 0xffffu); stg[ro * 64 + 32 + r32] = (bf16)(cvtpk(v1 * g1, 0.f) & 0xffffu); }
    asm volatile("s_waitcnt lgkmcnt(0)" ::: "memory");
    size_t yo = (c.rowbase + 32 * rg + (lane_ >> 3)) * D + 512 + h * 64 + (lane_ & 7) * 8; OPAQUE_V(yo); bf16* yb = c.Y + yo;
#pragma unroll
    for (int i = 0; i < 4; ++i) { const u32x4 v = *(const LAS u32x4*)(stg + (i * 8 + (lane_ >> 3)) * 64 + (lane_ & 7) * 8); *(u32x4*)(yb + (size_t)i * 8 * D) = v; }
    asm volatile("s_waitcnt lgkmcnt(0)" ::: "memory");
}
template <int KH> __device__ __forceinline__ void att_kvhead(const MixCtx& c, f32x16& ssacc) {
    LAS unsigned char* lds = c.lds; int htid = c.htid; OPAQUE_V(htid); const int n = c.n;
    const bf16* qp = c.Z + (c.rowbase + 32 * c.hw + (c.lane & 31)) * NIN + 512 + (KH * 4) * 64 + 8 * (c.lane >> 5);
    bf16x8 qr[4];
#pragma unroll
    for (int d0 = 0; d0 < 4; ++d0) qr[d0] = *(const bf16x8*)(qp + 16 * d0);
#pragma unroll
    for (int k = 0; k < 8; ++k) {
        const int i = htid + 256 * k, key = i >> 3, cc = i & 7; const bool valid = (n > 0) || (key >= 128);
        u32x4 v = (u32x4){0u, 0u, 0u, 0u};
        if (valid) v = *(const u32x4*)(c.Z + (c.rowbase + key - 128) * NIN + 1024 + KH * 64 + cc * 8);
        *(LAS u32x4*)(lds + KL_OFF + key * KL_PITCH + cc * 16) = v;
    }
#pragma unroll
    for (int k = 0; k < 8; ++k) {
        const int i = htid + 256 * k, d = i >> 5, cc = i & 31; const bool valid = (n > 0) || (cc >= 16);
        u32x4 v = (u32x4){0u, 0u, 0u, 0u};
        if (valid) v = *(const u32x4*)(c.Vt + ((size_t)((c.b * 2 + KH) * 64 + d)) * SEQ + n * 128 - 128 + cc * 8);
        LAS u32x2* dst = (LAS u32x2*)(lds + VL_OFF + d * VL_PITCH + cc * 16);
        dst[0] = (u32x2){v.x, v.y}; dst[1] = (u32x2){v.z, v.w};
    }
    __syncthreads();
    att_item<KH, 0>(c, qr, qp, ssacc); __syncthreads();
    att_item<KH, 1>(c, qr, qp, ssacc); __syncthreads();
    att_item<KH, 2>(c, qr, qp, ssacc); __syncthreads();
    att_item<KH, 3>(c, qr, qp, ssacc);
}
__device__ __forceinline__ void att_half(const MixCtx& c) {
    f32x16 ssacc;
#pragma unroll
    for (int r = 0; r < 16; ++r) ssacc[r] = 0.f;
    att_kvhead<0>(c, ssacc); __syncthreads();
    att_kvhead<1>(c, ssacc);
    { int lane = c.lane; OPAQUE_V(lane); const int r32 = lane & 31, hi = lane >> 5; LAS float* RAL = (LAS float*)(c.lds + RAL_OFF);
#pragma unroll
      for (int r = 0; r < 16; ++r) { const int ro = (r & 3) + 8 * (r >> 2) + 4 * hi; const float ss = half_sum32(ssacc[r]);
          if (r32 == 0) RAL[32 * c.hw + ro] = __builtin_amdgcn_rsqf(ss * (1.0f / 512.0f) + EPS); } }
    __syncthreads(); __syncthreads(); __syncthreads(); __syncthreads();
}
__device__ __forceinline__ void mixer_block(LAS unsigned char* lds, int blk, const bf16* Z, const bf16* Vt, const bf16* WpT, const float* pool_scale, const float* sinks,
                                            const float* g_pool, const float* g_attn, bf16* Y, float* RA, int tid, int wid, int lane) {
    OPAQUE_V(tid); OPAQUE_V(lane); OPAQUE_S(wid);
    MixCtx c; c.lds = lds; c.Z = Z; c.Vt = Vt; c.WpT = WpT; c.pool_scale = pool_scale; c.sinks = sinks; c.g_pool = g_pool; c.g_attn = g_attn; c.Y = Y; c.RA = RA; c.rowbase = (size_t)blk * 128;
    c.b = blk / NB_SEQ; c.n = blk % NB_SEQ; c.htid = tid & 255; c.lane = lane; c.hw = wid & 3;
    if (wid < 4) pool_half(c); else att_half(c);
}
__global__ void __launch_bounds__(NTHREADS, 2) hybrid_fwd(Args args) {
    extern __shared__ __attribute__((aligned(16))) unsigned char lds_raw[];
    LAS unsigned char* lds = (LAS unsigned char*)lds_raw;
    cg::grid_group grid = cg::this_grid();
    const int tid = threadIdx.x, lane = tid & 63, wid = __builtin_amdgcn_readfirstlane(tid >> 6);
    const int G = gridDim.x, bx = blockIdx.x;
    const int vcu = (G % 8 == 0) ? (bx % 8) * (G / 8) + bx / 8 : bx;
    const int gw = vcu * NWAVES + wid, NGW = G * NWAVES;
    unsigned char* ws = args.ws;
    bf16 *Wgu1 = (bf16*)(ws + WS_WGU1), *Wgu2 = (bf16*)(ws + WS_WGU2), *Wd1 = (bf16*)(ws + WS_WD1), *Wd2 = (bf16*)(ws + WS_WD2), *Win = (bf16*)(ws + WS_WIN), *Wout = (bf16*)(ws + WS_WOUT), *WpT = (bf16*)(ws + WS_WPOOL);
    float* CS = (float*)(ws + WS_CS);
    bf16 *HD = (bf16*)(ws + WS_HD), *H = (bf16*)(ws + WS_H), *Z = (bf16*)(ws + WS_Z), *Vt = (bf16*)(ws + WS_VT), *Y = (bf16*)(ws + WS_Y), *XR = (bf16*)(ws + WS_XR); float* RAg = (float*)(ws + WS_RA); float* RS = (float*)(ws + WS_RA + 512 * 1024);
    const int lo = args.ph_lo, hi = args.ph_hi;
#define IN(k) (lo <= (k) && (k) < hi)
#define SEAM(k) do { if (IN(k) && IN((k) + 1)) { if ((k) == 0) grid.sync(); else xcd_barrier(bar); } } while (0)
    if (tid < 32) ((LAS unsigned*)(lds + MISC_OFF))[tid] = 0u;
    __syncthreads();
    XcdBarrier bar; bar.bar = (unsigned*)(ws + WS_CTL); bar.x = 0; bar.st = nullptr;
    if (hi - lo > 1) bar = xcd_barrier_post((unsigned*)(ws + WS_CTL), (volatile LAS unsigned*)(lds + MISC_OFF) + 8);

    if (IN(0)) {
        LAS float* scr = (LAS float*)(lds + wid * 16384);
        constexpr int I_GU = (D / 64) * (NGU / 32), I_DN = (FF / 64) * (D / 32), I_IN = (D / 64) * (NIN / 32), I_OUT = (D / 64) * (D / 32), I_PL = 4 * 2 * 4;
        constexpr int NITEMS = 2 * I_GU + 2 * I_DN + I_IN + I_OUT + I_PL;
        for (int it = gw; it < NITEMS; it += NGW) {
            int r = it;
            if (r < I_GU) { transpose_item(args.ffn1_wgu, D, NGU, Wgu1, 1, scr, r, lane, args.ffn1_pre); continue; } r -= I_GU;
            if (r < I_GU) { transpose_item(args.ffn2_wgu, D, NGU, Wgu2, 1, scr, r, lane, args.ffn2_pre); continue; } r -= I_GU;
            if (r < I_DN) { transpose_item(args.ffn1_wd, FF, D, Wd1, 0, scr, r, lane); continue; } r -= I_DN;
            if (r < I_DN) { transpose_item(args.ffn2_wd, FF, D, Wd2, 0, scr, r, lane); continue; } r -= I_DN;
            if (r < I_IN) { transpose_item(args.w_in, D, NIN, Win, 2, scr, r, lane, args.mix_pre); continue; } r -= I_IN;
            if (r < I_OUT) { transpose_item(args.w_out, D, D, Wout, 0, scr, r, lane); continue; } r -= I_OUT;
            { const int g = r >> 3; transpose_item(args.w_pool + (size_t)g * 16384, 128, 128, WpT + (size_t)g * 16384, 0, scr, r & 7, lane); }
        }
        for (int idx = vcu * NTHREADS + tid; idx < M * 8; idx += G * NTHREADS) {
            const int row = idx >> 3, i = idx & 7; const float ang = (float)args.pos[row] * inv_freq(i);
            float sn, cn; sincos_f(ang, sn, cn); CS[(size_t)row * 16 + i] = cn; CS[(size_t)row * 16 + 8 + i] = sn;
        }
        prenorm_rows(args.x, XR, RS, gw, NGW, lane);
    }
    SEAM(0);
    if (IN(1)) {
        pg8::Gemm g{XR, Wgu1, M, NGU, D}; pg8::StaticOrder S; S.init(M, NGU, G, bx); pg8::EpiSwiGLU E{H, FF, RS};
        pg8::gemm_phase<pg8::EpiSwiGLU, pg8::StaticOrder, true, true>(lds, g, S, E);
    }
    SEAM(1);
    if (IN(2)) {
        pg8::Gemm g{H, Wd1, M, D, FF}; pg8::StaticOrder S; S.init(M, D, G, bx); pg8::EpiBf16<0> E{HD, D, nullptr, 0, 0, 1.f};
        pg8::gemm_phase<pg8::EpiBf16<0>, pg8::StaticOrder, true, true>(lds, g, S, E);
    }
    SEAM(2);
    if (IN(3)) thin_rows<true, false, true>(args.x, XR, HD, args.ffn1_post, RS, 0.5f, gw, NGW, lane);
    SEAM(3);
    if (IN(4)) {
        pg8::Gemm g{XR, Win, M, NIN, D}; pg8::StaticOrder S; S.init(M, NIN, G, bx); pg8::EpiZ E{Z, Vt, CS, QSCALE, SEQ, RS};
        pg8::gemm_phase<pg8::EpiZ, pg8::StaticOrder, true, true>(lds, g, S, E);
    }
    SEAM(4);
    if (IN(5)) { for (int blk = vcu; blk < NBLK; blk += G) mixer_block(lds, blk, Z, Vt, WpT, args.pool_scale, args.sinks, args.g_pool, args.g_attn, Y, RAg, tid, wid, lane); }
    SEAM(5);
    if (IN(6)) {
        pg8::Gemm g{Y, Wout, M, D, D}; pg8::StaticOrder S; S.init(M, D, G, bx); pg8::EpiRowScale E{HD, D, RAg};
        pg8::gemm_phase<pg8::EpiRowScale, pg8::StaticOrder, true, true>(lds, g, S, E);
    }
    SEAM(6);
    if (IN(7)) thin_rows<true, true, true>(XR, XR, HD, args.mix_post, RS, 1.0f, gw, NGW, lane);
    SEAM(7);
    if (IN(8)) {
        pg8::Gemm g{XR, Wgu2, M, NGU, D}; pg8::StaticOrder S; S.init(M, NGU, G, bx); pg8::EpiSwiGLU E{H, FF, RS};
        pg8::gemm_phase<pg8::EpiSwiGLU, pg8::StaticOrder, true, true>(lds, g, S, E);
    }
    SEAM(8);
    if (IN(9)) {
        pg8::Gemm g{H, Wd2, M, D, FF}; pg8::StaticOrder S; S.init(M, D, G, bx); pg8::EpiBf16<0> E{HD, D, nullptr, 0, 0, 1.f};
        pg8::gemm_phase<pg8::EpiBf16<0>, pg8::StaticOrder, true, true>(lds, g, S, E);
    }
    SEAM(9);
    if (IN(10)) thin_rows<false, true, false>(XR, args.out, HD, args.ffn2_post, nullptr, 0.5f, gw, NGW, lane);
#undef IN
#undef SEAM
}

#ifndef MK_N_LAUNCHES
#define MK_N_LAUNCHES 1
#endif
extern "C" void kernel_launch(void* const* d_in, const int* in_sizes, int n_in, void* d_out, int out_size, void* d_ws, size_t ws_size, hipStream_t stream) {
    static int grid = 0;
    if (grid == 0) {
        if (n_in != 19 || in_sizes[0] != M * D || out_size != M * D || ws_size < WS_END) { fprintf(stderr, "kernel_launch: unexpected shapes (n_in %d, in0 %d, out %d, ws %zu)\n", n_in, n_in > 0 ? in_sizes[0] : -1, out_size, ws_size); grid = -1; return; }
        int dev = 0, cus = 0, per_cu = 0;
        if (hipGetDevice(&dev) != hipSuccess || hipDeviceGetAttribute(&cus, hipDeviceAttributeMultiprocessorCount, dev) != hipSuccess) { grid = -1; return; }
        if (hipFuncSetAttribute((const void*)hybrid_fwd, hipFuncAttributeMaxDynamicSharedMemorySize, LDS_BYTES) != hipSuccess) { fprintf(stderr, "kernel_launch: hipFuncSetAttribute failed\n"); grid = -1; return; }
        if (hipOccupancyMaxActiveBlocksPerMultiprocessor(&per_cu, (const void*)hybrid_fwd, NTHREADS, LDS_BYTES) != hipSuccess || per_cu < 1) { fprintf(stderr, "kernel_launch: occupancy query says %d\n", per_cu); per_cu = 1; }
        (void)hipGetLastError();
        grid = cus * 1;
    }
    if (grid < 0) return;
    if (hipMemsetAsync((char*)d_ws + WS_CTL, 0, CTL_BYTES, stream) != hipSuccess) { fprintf(stderr, "kernel_launch: memset failed\n"); return; }
    Args a{};
    a.x = (const float*)d_in[0]; a.pos = (const int*)d_in[1];
    a.ffn1_pre = (const float*)d_in[2]; a.ffn1_wgu = (const float*)d_in[3]; a.ffn1_wd = (const float*)d_in[4]; a.ffn1_post = (const float*)d_in[5];
    a.mix_pre = (const float*)d_in[6]; a.w_in = (const float*)d_in[7]; a.w_pool = (const float*)d_in[8]; a.pool_scale = (const float*)d_in[9]; a.sinks = (const float*)d_in[10];
    a.g_pool = (const float*)d_in[11]; a.g_attn = (const float*)d_in[12]; a.w_out = (const float*)d_in[13]; a.mix_post = (const float*)d_in[14];
    a.ffn2_pre = (const float*)d_in[15]; a.ffn2_wgu = (const float*)d_in[16]; a.ffn2_wd = (const float*)d_in[17]; a.ffn2_post = (const float*)d_in[18];
    a.out = (float*)d_out; a.ws = (unsigned char*)d_ws;
    constexpr int NPH = 11;
#if MK_N_LAUNCHES == 1
    a.ph_lo = 0; a.ph_hi = NPH;
    { void* kargs[] = {&a}; hipError_t e = hipLaunchCooperativeKernel((const void*)hybrid_fwd, dim3(grid), dim3(NTHREADS), kargs, LDS_BYTES, stream);
      if (e != hipSuccess) fprintf(stderr, "kernel_launch: cooperative launch failed: %s (grid %d)\n", hipGetErrorString(e), grid); }
#else
    for (int p = 0; p < NPH; ++p) { a.ph_lo = p; a.ph_hi = p + 1; void* kargs[] = {&a};
        hipError_t e = hipLaunchCooperativeKernel((const void*)hybrid_fwd, dim3(grid), dim3(NTHREADS), kargs, LDS_BYTES, stream);
        if (e != hipSuccess) { fprintf(stderr, "kernel_launch: launch %d failed: %s\n", p, hipGetErrorString(e)); break; } }
#endif
}
```

```cpp
#include <hip/hip_runtime.h>
#include <hip/hip_cooperative_groups.h>
#include <cstdio>
#include <cstdint>
namespace cg = cooperative_groups;
namespace pg8 {
#define PG8_LAS __attribute__((address_space(3)))
typedef unsigned short bf16_t;
typedef short bf16x8 __attribute__((ext_vector_type(8)));
typedef float f32x4 __attribute__((ext_vector_type(4)));
typedef unsigned u32x4 __attribute__((ext_vector_type(4)));
constexpr int BM = 256, BK = 64, HALF = 128, HTB = HALF * BK * 2  , STAGE_BYTES = 8 * HTB, NXCD = 8, WGM = 8;

__host__ __device__ __forceinline__ int lds_byte(int r, int c) { const int st = (r >> 4) * 2 + (c >> 5), rr = r & 15, cc = c & 31, ob = rr * 64 + cc * 2; return st * 1024 + (ob ^ (((ob >> 9) & 1) << 5)); }
__host__ __device__ __forceinline__ void stage_rc(int b, int& R, int& C) { const int st = b / 1024, sb = b % 1024, swz = sb ^ (((sb >> 9) & 1) << 5); R = (st >> 1) * 16 + swz / 64; C = (st & 1) * 32 + (swz % 64) / 2; }
__host__ __device__ __forceinline__ int perm32(int rho) { const int n = rho >> 4, i = rho & 15; return 8 * (i >> 2) + 4 * n + (i & 3); }

struct Unit { int pm, pn; };
struct Gemm { const bf16_t* A; const bf16_t* Bt; int M, N, K; };

struct StaticOrder {
    int nM, nN, nwg, G, c;
    __host__ __device__ void init(int M, int N, int G_, int c_) { nM = M / BM; nN = N / BM; nwg = nM * nN; G = G_; c = c_; }
    __host__ __device__ bool next(int i, Unit& u) const {
        const long L = (long)i * G + c; if (L >= nwg) return false;
        int wgid = (int)L; { const int q = nwg / NXCD, r = nwg % NXCD, xcd = wgid % NXCD, off = wgid / NXCD; wgid = (xcd < r ? xcd * (q + 1) : r * (q + 1) + (xcd - r) * q) + off; }
        const int nig = WGM * nN, gid = wgid / nig, fm = gid * WGM, gsz = (nM - fm) < WGM ? (nM - fm) : WGM;
        u.pm = fm + ((wgid % nig) % gsz); u.pn = (wgid % nig) / gsz; return true;
    }
    __device__ __forceinline__ void a_ready(const Unit&) const {}
    __device__ __forceinline__ void done(const Unit&) const {}
};

__device__ __forceinline__ unsigned cvt_pk_bf16(float lo, float hi) { unsigned r; asm volatile("v_cvt_pk_bf16_f32 %0, %1, %2" : "=v"(r) : "v"(lo), "v"(hi)); return r; }
typedef float f32x2 __attribute__((ext_vector_type(2)));
__device__ __forceinline__ f32x2 gelu_pk(f32x2 v) {
    const f32x2 av = __builtin_elementwise_abs(v), d = av * 0.2316418882f + 1.0f;
    f32x2 t; t.x = __builtin_amdgcn_rcpf(d.x); t.y = __builtin_amdgcn_rcpf(d.y);
    f32x2 q = t * 0.5307027145f + (-0.7265760135f); q = q * t + 0.7107068705f; q = q * t + (-0.142248368f); q = q * t + 0.127414796f; q = q * t;
    const f32x2 s = (v * v) * (-0.72134752044f);
    f32x2 e; e.x = __builtin_amdgcn_exp2f(s.x); e.y = __builtin_amdgcn_exp2f(s.y);
    const f32x2 m = v * (q * e), r = v - m;
    f32x2 o; o.x = v.x < 0.f ? m.x : r.x; o.y = v.y < 0.f ? m.y : r.y; return o;
}

template <int ACT  > struct EpiBf16 {
    static constexpr bool PERM = true, AFTER_DRAIN = false; static_assert(ACT == 0 || ACT == 1, "EpiBf16: ACT is 0 (none) or 1 (gelu_pk)");
    bf16_t* O; int ldc; const float* bias; int split_cols; size_t split_stride; float scale0;
    __device__ __forceinline__ void operator()(const f32x4 (&acc)[2][2][4][2], const Unit& u, int wr, int wc, int fr, int fq) const {
        const int row0 = u.pm * BM + wr * 64 + fr; int colt = u.pn * BM; bf16_t* base = O;
        float sc = 1.f; if (split_cols) { const int t = colt / split_cols; base += (size_t)t * split_stride; colt -= t * split_cols; if (t == 0) sc = scale0; }
        const int col0 = colt + wc * 32 + 8 * fq, bcol0 = u.pn * BM + wc * 32 + 8 * fq;
        f32x4 bv[2][2];
#pragma unroll
        for (int bj = 0; bj < 2; ++bj)
#pragma unroll
            for (int n = 0; n < 2; ++n) bv[bj][n] = bias ? *(const f32x4*)(bias + bcol0 + bj * HALF + 4 * n) : (f32x4){0.f, 0.f, 0.f, 0.f};
#pragma unroll
        for (int ai = 0; ai < 2; ++ai)
#pragma unroll
            for (int m = 0; m < 4; ++m) { bf16_t* rowp = base + (size_t)(row0 + ai * HALF + m * 16) * ldc + col0;
#pragma unroll
                for (int bj = 0; bj < 2; ++bj) { f32x4 v0 = acc[ai][bj][m][0] + bv[bj][0], v1 = acc[ai][bj][m][1] + bv[bj][1];
                    if (ACT == 1) { f32x2 a = gelu_pk((f32x2){v0[0], v0[1]}), b = gelu_pk((f32x2){v0[2], v0[3]}), c = gelu_pk((f32x2){v1[0], v1[1]}), d = gelu_pk((f32x2){v1[2], v1[3]});
                        v0 = (f32x4){a.x, a.y, b.x, b.y}; v1 = (f32x4){c.x, c.y, d.x, d.y}; }
                    v0 = v0 * sc; v1 = v1 * sc; u32x4 w; w.x = cvt_pk_bf16(v0[0], v0[1]); w.y = cvt_pk_bf16(v0[2], v0[3]); w.z = cvt_pk_bf16(v1[0], v1[1]); w.w = cvt_pk_bf16(v1[2], v1[3]);
                    *(u32x4*)(rowp + bj * HALF) = w; } }
    }
};
typedef __bf16 bf16x2_t __attribute__((ext_vector_type(2)));
__device__ __forceinline__ unsigned cvtpk(float lo, float hi) { f32x2 v = {lo, hi}; bf16x2_t b = __builtin_convertvector(v, bf16x2_t); return __builtin_bit_cast(unsigned, b); }
__device__ __forceinline__ float silu_mul(float g, float u) { const float e = __builtin_amdgcn_exp2f(-1.4426950408889634f * g); return g * __builtin_amdgcn_rcpf(1.0f + e) * u; }

struct EpiSwiGLU {
    static constexpr bool PERM = true, AFTER_DRAIN = false;
    bf16_t* O; int ldc; const float* rs;
    __device__ __forceinline__ void operator()(const f32x4 (&acc)[2][2][4][2], const Unit& u, int wr, int wc, int fr, int fq) const {
        const int row0 = u.pm * BM + wr * 64 + fr, col0 = u.pn * HALF + wc * 32 + 8 * fq;
#pragma unroll
        for (int ai = 0; ai < 2; ++ai)
#pragma unroll
            for (int m = 0; m < 4; ++m) { const int row = row0 + ai * HALF + m * 16; bf16_t* rowp = O + (size_t)row * ldc + col0; const float r = rs[row];
                const f32x4 g0 = acc[ai][0][m][0] * r, g1 = acc[ai][0][m][1] * r, u0 = acc[ai][1][m][0] * r, u1 = acc[ai][1][m][1] * r;
                u32x4 w; w.x = cvtpk(silu_mul(g0[0], u0[0]), silu_mul(g0[1], u0[1])); w.y = cvtpk(silu_mul(g0[2], u0[2]), silu_mul(g0[3], u0[3]));
                w.z = cvtpk(silu_mul(g1[0], u1[0]), silu_mul(g1[1], u1[1])); w.w = cvtpk(silu_mul(g1[2], u1[2]), silu_mul(g1[3], u1[3]));
                *(u32x4*)rowp = w; }
    }
};
struct EpiRowScale {
    static constexpr bool PERM = true, AFTER_DRAIN = false;
    bf16_t* O; int ldc; const float* rs;
    __device__ __forceinline__ void operator()(const f32x4 (&acc)[2][2][4][2], const Unit& u, int wr, int wc, int fr, int fq) const {
        const int row0 = u.pm * BM + wr * 64 + fr, col0 = u.pn * BM + wc * 32 + 8 * fq;
#pragma unroll
        for (int ai = 0; ai < 2; ++ai)
#pragma unroll
            for (int m = 0; m < 4; ++m) { const int row = row0 + ai * HALF + m * 16; const float sc = rs[row]; bf16_t* rowp = O + (size_t)row * ldc + col0;
#pragma unroll
                for (int bj = 0; bj < 2; ++bj) { const f32x4 v0 = acc[ai][bj][m][0] * sc, v1 = acc[ai][bj][m][1] * sc;
                    u32x4 w; w.x = cvtpk(v0[0], v0[1]); w.y = cvtpk(v0[2], v0[3]); w.z = cvtpk(v1[0], v1[1]); w.w = cvtpk(v1[2], v1[3]);
                    *(u32x4*)(rowp + bj * HALF) = w; } }
    }
};
struct EpiZ {
    static constexpr bool PERM = true, AFTER_DRAIN = false;
    bf16_t* Z; bf16_t* Vt; const float* cs; float qscale; int seq; const float* rs;
    __device__ __forceinline__ void operator()(const f32x4 (&acc)[2][2][4][2], const Unit& u, int wr, int wc, int fr, int fq) const {
        const int row0 = u.pm * BM + wr * 64 + fr, cl = wc * 32 + 8 * fq;
#pragma unroll
        for (int bj = 0; bj < 2; ++bj) {
            const int colh = u.pn * BM + bj * HALF;
            const bool isV = (colh == 1152);
            const bool rope = (colh >= 512) && (colh < 1152) && ((wc & 1) == 0) && (fq < 2);
            const float sc = (colh >= 512 && colh < 1024) ? qscale : 1.0f;
#pragma unroll
            for (int ai = 0; ai < 2; ++ai)
#pragma unroll
                for (int m = 0; m < 4; ++m) { const int row = row0 + ai * HALF + m * 16;
                    const float r = rs[row];
                    f32x4 v0 = acc[ai][bj][m][0] * r, v1 = acc[ai][bj][m][1] * r;
                    if (isV) {
                        const int b = row / seq, s = row - b * seq;
#pragma unroll
                        for (int i = 0; i < 4; ++i) { const int c0 = cl + i, c1 = cl + 4 + i;
                            Vt[((size_t)((b * 2 + (c0 >> 6)) * 64 + (c0 & 63))) * seq + s] = (bf16_t)(cvtpk(v0[i], 0.f) & 0xffffu);
                            Vt[((size_t)((b * 2 + (c1 >> 6)) * 64 + (c1 & 63))) * seq + s] = (bf16_t)(cvtpk(v1[i], 0.f) & 0xffffu); }
                    } else {
                        if (rope) { const f32x4 c = *(const f32x4*)(cs + (size_t)row * 16 + 4 * fq), sn = *(const f32x4*)(cs + (size_t)row * 16 + 8 + 4 * fq);
                            const f32x4 n0 = v0 * c - v1 * sn, n1 = v1 * c + v0 * sn; v0 = n0; v1 = n1; }
                        v0 = v0 * sc; v1 = v1 * sc;
                        u32x4 w; w.x = cvtpk(v0[0], v0[1]); w.y = cvtpk(v0[2], v0[3]); w.z = cvtpk(v1[0], v1[1]); w.w = cvtpk(v1[2], v1[3]);
                        *(u32x4*)(Z + (size_t)row * 1280 + colh + cl) = w; }
                }
        }
    }
};
template <class Epi, class Sched, bool ALIGN_EPI = false, bool SP2 = false>
__device__ __forceinline__ void gemm_phase(PG8_LAS unsigned char* lds, const Gemm g, const Sched& S, const Epi& E) {
    const int tid = threadIdx.x, wid = __builtin_amdgcn_readfirstlane(tid >> 6), lane = tid & 63, wr = wid >> 2, wc = wid & 3, fr = lane & 15, fq = lane >> 4;
    const int K = g.K, nt = K / BK;
    unsigned voffA[2], voffB[2];
#pragma unroll
    for (int i = 0; i < 2; ++i) { int R, C; stage_rc(tid * 16 + i * 8192, R, C); const int Rb = Epi::PERM ? ((R & ~31) + perm32(R & 31)) : R;
        voffA[i] = (unsigned)(R * K + C) * 2u; voffB[i] = (unsigned)(Rb * K + C) * 2u; }
    const size_t kstep = (size_t)(BK * 2);
    const size_t hstep = (size_t)HALF * K * 2;
    const size_t tstep = 2 * hstep;
    const unsigned ldsw = (unsigned)wid * 1024u;
    const int aoff = lds_byte(wr * 64 + fr, fq * 8), boff = lds_byte(wc * 32 + fr, fq * 8);
#define PG8_SA(b, h) (((b) * 2 + (h)) * HTB)
#define PG8_SB(b, h) ((4 + (b) * 2 + (h)) * HTB)
#define PG8_STAGE(bufoff, gbase, voff) do { _Pragma("unroll") for (int _i = 0; _i < 2; ++_i) \
        __builtin_amdgcn_global_load_lds((const unsigned*)((const char*)(gbase) + (voff)[_i]), (PG8_LAS unsigned*)(lds + (bufoff) + ldsw + _i * 8192), 16, 0, 0); } while (0)
#define PG8_LDA(dst, b, h) do { _Pragma("unroll") for (int m = 0; m < 4; ++m) _Pragma("unroll") for (int k = 0; k < 2; ++k) dst[m][k] = *(const PG8_LAS bf16x8*)(lds + PG8_SA(b, h) + aoff + m * 2048 + k * 1024); } while (0)
#define PG8_LDB(dst, b, h) do { _Pragma("unroll") for (int n = 0; n < 2; ++n) _Pragma("unroll") for (int k = 0; k < 2; ++k) dst[n][k] = *(const PG8_LAS bf16x8*)(lds + PG8_SB(b, h) + boff + n * 2048 + k * 1024); } while (0)
#define PG8_MMA(ai, bj, At, Bt) do { __builtin_amdgcn_s_setprio(1); _Pragma("unroll") for (int m = 0; m < 4; ++m) _Pragma("unroll") for (int n = 0; n < 2; ++n) _Pragma("unroll") for (int k = 0; k < 2; ++k) \
        acc[ai][bj][m][n] = __builtin_amdgcn_mfma_f32_16x16x32_bf16(Bt[n][k], At[m][k], acc[ai][bj][m][n], 0, 0, 0); __builtin_amdgcn_s_setprio(0); } while (0)
#define PG8_WAIT_V(n) asm volatile("s_waitcnt vmcnt(" #n ")" ::: "memory")
#define PG8_WAIT_L(n) asm volatile("s_waitcnt lgkmcnt(" #n ")" ::: "memory")
#define PG8_BAR __builtin_amdgcn_s_barrier()
#define PG8_SCHED __builtin_amdgcn_sched_barrier(0)
    Unit cur, nxt; int ui = 0;
    if (!S.next(0, cur)) return;
    f32x4 acc[2][2][4][2];
#pragma unroll
    for (int a = 0; a < 2; ++a)
#pragma unroll
        for (int b = 0; b < 2; ++b)
#pragma unroll
            for (int m = 0; m < 4; ++m)
#pragma unroll
                for (int n = 0; n < 2; ++n) acc[a][b][m][n] = (f32x4){0.f, 0.f, 0.f, 0.f};
    bf16x8 At[4][2], B0[2][2], B1[2][2];
    const char* cA = (const char*)g.A + (size_t)cur.pm * tstep; const char* cB = (const char*)g.Bt + (size_t)cur.pn * tstep;
    S.a_ready(cur);
    if constexpr (SP2) {
        PG8_STAGE(PG8_SB(0, 0), cB, voffB); PG8_STAGE(PG8_SB(0, 1), cB + hstep, voffB); PG8_STAGE(PG8_SA(0, 0), cA, voffA); PG8_STAGE(PG8_SA(0, 1), cA + hstep, voffA);
        if (wr == 1) PG8_BAR;
        PG8_WAIT_V(2); PG8_BAR;
        PG8_STAGE(PG8_SB(1, 0), cB + kstep, voffB); PG8_STAGE(PG8_SA(1, 0), cA + kstep, voffA); PG8_STAGE(PG8_SB(1, 1), cB + hstep + kstep, voffB);
        PG8_WAIT_V(6); PG8_BAR;
    } else {
        PG8_STAGE(PG8_SB(0, 0), cB, voffB); PG8_STAGE(PG8_SA(0, 0), cA, voffA); PG8_STAGE(PG8_SB(0, 1), cB + hstep, voffB); PG8_STAGE(PG8_SA(0, 1), cA + hstep, voffA);
        if (wr == 1) PG8_BAR;
        PG8_WAIT_V(4); PG8_BAR;
        PG8_STAGE(PG8_SB(1, 0), cB + kstep, voffB); PG8_STAGE(PG8_SA(1, 0), cA + kstep, voffA); PG8_STAGE(PG8_SB(1, 1), cB + hstep + kstep, voffB);
        PG8_WAIT_V(6); PG8_BAR;
    }
    for (;;) {
        const bool has_next = S.next(ui + 1, nxt);
        const char* nA = has_next ? (const char*)g.A + (size_t)nxt.pm * tstep : cA; const char* nB = has_next ? (const char*)g.Bt + (size_t)nxt.pn * tstep : cB;
        for (int t = 0; t < nt; t += 2) {
            const bool last = (t == nt - 2);
            const char* a1 = cA + (size_t)(t + 1) * kstep;
            const char* a2 = last ? nA : cA + (size_t)(t + 2) * kstep; const char* b2 = last ? nB : cB + (size_t)(t + 2) * kstep;
            const char* a3 = a2 + kstep; const char* b3 = b2 + kstep;
            if (last && has_next) S.a_ready(nxt);
            if constexpr (SP2) {
            PG8_LDB(B0, 0, 0); PG8_LDB(B1, 0, 1); PG8_SCHED; PG8_LDA(At, 0, 0); PG8_STAGE(PG8_SA(1, 1), a1 + hstep, voffA);
            PG8_WAIT_V(8); PG8_WAIT_L(0); PG8_BAR; PG8_MMA(0, 0, At, B0); PG8_MMA(0, 1, At, B1); PG8_BAR; PG8_SCHED;
            PG8_LDA(At, 0, 1); PG8_STAGE(PG8_SB(0, 0), b2, voffB); PG8_STAGE(PG8_SB(0, 1), b2 + hstep, voffB); PG8_STAGE(PG8_SA(0, 0), a2, voffA);
            PG8_WAIT_V(8); PG8_WAIT_L(0); PG8_BAR; PG8_MMA(1, 0, At, B0); PG8_MMA(1, 1, At, B1); PG8_BAR; PG8_SCHED;
            PG8_LDB(B0, 1, 0); PG8_LDB(B1, 1, 1); PG8_SCHED; PG8_LDA(At, 1, 0); PG8_STAGE(PG8_SA(0, 1), a2 + hstep, voffA);
            PG8_WAIT_V(8); PG8_WAIT_L(0); PG8_BAR; PG8_MMA(0, 0, At, B0); PG8_MMA(0, 1, At, B1); PG8_BAR; PG8_SCHED;
            PG8_LDA(At, 1, 1); PG8_STAGE(PG8_SB(1, 0), b3, voffB); PG8_STAGE(PG8_SB(1, 1), b3 + hstep, voffB); PG8_STAGE(PG8_SA(1, 0), a3, voffA);
            PG8_WAIT_V(8); PG8_WAIT_L(0); PG8_BAR; PG8_MMA(1, 0, At, B0); PG8_MMA(1, 1, At, B1); PG8_BAR; PG8_SCHED;
            } else {
            PG8_LDB(B0, 0, 0); PG8_SCHED; PG8_LDA(At, 0, 0); PG8_STAGE(PG8_SA(1, 1), a1 + hstep, voffA);
            PG8_WAIT_L(8); PG8_BAR; PG8_WAIT_L(0); PG8_MMA(0, 0, At, B0); PG8_BAR; PG8_SCHED;
            PG8_LDB(B1, 0, 1); PG8_STAGE(PG8_SB(0, 0), b2, voffB);
            PG8_BAR; PG8_WAIT_L(0); PG8_MMA(0, 1, At, B1); PG8_BAR;
            PG8_LDA(At, 0, 1); PG8_STAGE(PG8_SA(0, 0), a2, voffA);
            PG8_BAR; PG8_WAIT_L(0); PG8_MMA(1, 0, At, B0); PG8_BAR; PG8_SCHED;
            PG8_STAGE(PG8_SB(0, 1), b2 + hstep, voffB);
            PG8_WAIT_V(6); PG8_BAR; PG8_MMA(1, 1, At, B1); PG8_BAR;
            PG8_LDB(B0, 1, 0); PG8_SCHED; PG8_LDA(At, 1, 0); PG8_STAGE(PG8_SA(0, 1), a2 + hstep, voffA);
            PG8_WAIT_L(8); PG8_BAR; PG8_WAIT_L(0); PG8_MMA(0, 0, At, B0); PG8_BAR; PG8_SCHED;
            PG8_LDB(B1, 1, 1); PG8_STAGE(PG8_SB(1, 0), b3, voffB);
            PG8_BAR; PG8_WAIT_L(0); PG8_MMA(0, 1, At, B1); PG8_BAR;
            PG8_LDA(At, 1, 1); PG8_STAGE(PG8_SA(1, 0), a3, voffA);
            PG8_BAR; PG8_WAIT_L(0); PG8_MMA(1, 0, At, B0); PG8_BAR; PG8_SCHED;
            PG8_STAGE(PG8_SB(1, 1), b3 + hstep, voffB);
            PG8_WAIT_V(6); PG8_BAR; PG8_MMA(1, 1, At, B1); PG8_BAR;
            }
        }
        if constexpr (ALIGN_EPI) { if (wr == 0) PG8_BAR; }
        if constexpr (!Epi::AFTER_DRAIN) { E(acc, cur, wr, wc, fr, fq); S.done(cur); }
        if (!has_next) break;
#pragma unroll
        for (int a = 0; a < 2; ++a)
#pragma unroll
            for (int b = 0; b < 2; ++b)
#pragma unroll
                for (int m = 0; m < 4; ++m)
#pragma unroll
                    for (int n = 0; n < 2; ++n) acc[a][b][m][n] = (f32x4){0.f, 0.f, 0.f, 0.f};
        cur = nxt; cA = nA; cB = nB; ++ui;
        if constexpr (ALIGN_EPI) { if (wr == 1) PG8_BAR; }
    }
    PG8_WAIT_V(0);
    if constexpr (!ALIGN_EPI) { if (wr == 0) PG8_BAR; }
    PG8_BAR;
    if constexpr (Epi::AFTER_DRAIN) { E.fused(acc, cur, wr, wc, fr, fq, lds, wid, lane); S.done(cur); }
#undef PG8_SA
#undef PG8_SB
#undef PG8_STAGE
#undef PG8_LDA
#undef PG8_LDB
#undef PG8_MMA
#undef PG8_WAIT_V
#undef PG8_WAIT_L
#undef PG8_BAR
#undef PG8_SCHED
}
}
constexpr int BATCH = 4, SEQ = 8192, D = 1024, M = BATCH * SEQ, FF = 2816, NGU = 2 * FF, NIN = 1280, NBLK = M / 128, NB_SEQ = SEQ / 128;
constexpr float EPS = 1e-6f;
constexpr float QSCALE = 0.125f * 1.4426950408889634f;
constexpr float LOG2E = 1.4426950408889634f;
constexpr int NWAVES = 8, NTHREADS = 512;
constexpr size_t MiB = 1u << 20;
constexpr size_t WS_WGU1 = 0, WS_WGU2 = 11 * MiB, WS_WD1 = 22 * MiB, WS_WD2 = 28 * MiB, WS_WIN = 34 * MiB, WS_WOUT = 37 * MiB, WS_WPOOL = 39 * MiB, WS_CS = 40 * MiB;
constexpr size_t WS_CTL = 46 * MiB, CTL_BYTES = 16384, WS_RA = 47 * MiB;
constexpr size_t WS_A = 48 * MiB, WS_HD = 112 * MiB, WS_H = 176 * MiB, WS_Z = 176 * MiB, WS_VT = 256 * MiB, WS_Y = 264 * MiB, WS_XR = 352 * MiB, WS_END = 416 * MiB;
static_assert((size_t)NGU * D * 2 <= 11 * MiB && (size_t)D * FF * 2 <= 6 * MiB && (size_t)NIN * D * 2 <= 3 * MiB && (size_t)M * 16 * 4 <= 8 * MiB, "ws map");
static_assert(WS_Z + (size_t)M * NIN * 2 <= WS_VT && WS_VT + (size_t)M * 128 * 2 <= WS_Y && WS_Y + (size_t)M * D * 2 <= WS_END && WS_H + (size_t)M * FF * 2 <= WS_XR && WS_XR + (size_t)M * D * 2 <= WS_END, "ws map 2");
constexpr int LDS_BYTES = 163840;
constexpr int KL_OFF = 0, KL_PITCH = 144, VL_OFF = 36864, VL_PITCH = 520, UL_OFF = 70144, UL_PITCH = 272, UL_ROWS = 143, DL_OFF = UL_OFF + 38912, DL_PITCH = 272;
constexpr int RAL_OFF = DL_OFF + 34816, ASTG_OFF = RAL_OFF + 512, MISC_OFF = ASTG_OFF + 16384;
static_assert(UL_ROWS * UL_PITCH <= 38912 && MISC_OFF >= 131072 && MISC_OFF + 128 <= LDS_BYTES && ASTG_OFF % 16 == 0 && DL_OFF % 16 == 0, "LDS map");

#define LAS __attribute__((address_space(3)))
typedef unsigned short bf16;
typedef unsigned u32x4 __attribute__((ext_vector_type(4)));
typedef unsigned u32x2 __attribute__((ext_vector_type(2)));
typedef float f32x4 __attribute__((ext_vector_type(4)));
typedef float f32x16 __attribute__((ext_vector_type(16)));
typedef short bf16x8 __attribute__((ext_vector_type(8)));
using pg8::cvtpk;
__device__ __forceinline__ float bflo(unsigned w) { return __uint_as_float(w << 16); }
__device__ __forceinline__ float bfhi(unsigned w) { return __uint_as_float(w & 0xffff0000u); }
__device__ __forceinline__ float wave_sum(float v) {
#pragma unroll
    for (int o = 1; o < 64; o <<= 1) v += __shfl_xor(v, o);
    return v;
}
__device__ __forceinline__ float half_sum32(float v) {
#pragma unroll
    for (int o = 1; o < 32; o <<= 1) v += __shfl_xor(v, o);
    return v;
}
__device__ __forceinline__ int crow(int r, int hi) { return (r & 3) + 8 * (r >> 2) + 4 * hi; }

struct Args {
    const float* x; const int* pos;
    const float *ffn1_pre, *ffn1_wgu, *ffn1_wd, *ffn1_post, *mix_pre, *w_in, *w_pool, *pool_scale, *sinks, *g_pool, *g_attn, *w_out, *mix_post, *ffn2_pre, *ffn2_wgu, *ffn2_wd, *ffn2_post;
    float* out; unsigned char* ws; int ph_lo, ph_hi;
};

__device__ __forceinline__ int dest_row(int mode, int n) {
    if (mode == 1) { return n < FF ? ((n >> 7) * 256 + (n & 127)) : ((((n - FF) >> 7) * 256) + 128 + ((n - FF) & 127)); }
    if (mode == 2) { if (n >= 512 && n < 1152) { const int d = n & 63; const int p = (d >= 4 && d < 8) ? d + 4 : ((d >= 8 && d < 12) ? d - 4 : d); return (n - d) + p; } return n; }
    return n;
}
__device__ __forceinline__ void transpose_item(const float* W, int K, int N, bf16* WT, int mode, LAS float* scr, int item, int lane, const float* gk = nullptr, const float* gk2 = nullptr, const float* gn = nullptr) {
    const int nblk = N / 32, kb = item / nblk, nb = item % nblk, k0 = 64 * kb, n0 = 32 * nb;
#pragma unroll 8
    for (int i = 0; i < 32; ++i) { const int kk = 2 * i + (lane >> 5); const int kr = k0 + kk; float gg = gk ? ((gk2 && kr >= 512) ? gk2[kr - 512] : gk[kr]) : 1.0f; if (gn) gg *= gn[n0 + (lane & 31)]; scr[kk * 33 + (lane & 31)] = W[(size_t)kr * N + n0 + (lane & 31)] * gg; }
    asm volatile("s_waitcnt lgkmcnt(0)" ::: "memory");
    const int c = lane & 7;
#pragma unroll
    for (int j = 0; j < 4; ++j) { const int n = (lane >> 3) + 8 * j; const LAS float* s = scr + (8 * c) * 33 + n;
        u32x4 o; o.x = cvtpk(s[0 * 33], s[1 * 33]); o.y = cvtpk(s[2 * 33], s[3 * 33]); o.z = cvtpk(s[4 * 33], s[5 * 33]); o.w = cvtpk(s[6 * 33], s[7 * 33]);
        *(u32x4*)(WT + (size_t)dest_row(mode, n0 + n) * K + k0 + 8 * c) = o; }
    asm volatile("s_waitcnt lgkmcnt(0)" ::: "memory");
}
__device__ __forceinline__ void sincos_f(float a, float& sn, float& cn) {
    const double ad = (double)a; const double q = __builtin_rint(ad * 0.63661977236758134308);
    const float r = (float)__builtin_fma(-q, 1.57079632679489661923, ad); const int qi = ((int)q) & 3;
    const float z = r * r;
    const float s = r + r * z * (-1.6666654611e-1f + z * (8.3321608736e-3f + z * (-1.9515295891e-4f)));
    const float c = 1.0f - 0.5f * z + z * z * (4.166664568298827e-2f + z * (-1.388731625493765e-3f + z * 2.443315711809948e-5f));
    sn = (qi == 0) ? s : (qi == 1) ? c : (qi == 2) ? -s : -c;
    cn = (qi == 0) ? c : (qi == 1) ? -s : (qi == 2) ? -c : s;
}
__device__ __forceinline__ float inv_freq(int i) {
    return i == 0 ? 1.0f : i == 1 ? 0.19392274474868576f : i == 2 ? 0.03760603093086393f : i == 3 ? 0.007292664737217109f : i == 4 ? 0.001414213562373095f : i == 5 ? 0.0002742481756762073f : i == 6 ? 5.318295896944988e-05f : 1.031338537721246e-05f;
}
__device__ __forceinline__ void prenorm_rows(const float* x, bf16* xb, float* rs, int gw, int NGW, int lane) {
    for (int m = gw; m < M; m += NGW) {
        const f32x4* xr = (const f32x4*)(x + (size_t)m * D) + lane; f32x4 v[4]; float s = 0.f;
#pragma unroll
        for (int j = 0; j < 4; ++j) { v[j] = xr[64 * j]; s += (v[j].x * v[j].x + v[j].y * v[j].y) + (v[j].z * v[j].z + v[j].w * v[j].w); }
        u32x2* o = (u32x2*)(xb + (size_t)m * D) + lane;
#pragma unroll
        for (int j = 0; j < 4; ++j) { u32x2 w; w.x = cvtpk(v[j].x, v[j].y); w.y = cvtpk(v[j].z, v[j].w); o[64 * j] = w; }
        const float r = 1.0f / sqrtf(wave_sum(s) * (1.0f / D) + EPS);
        if (lane == 0) rs[m] = r;
    }
}
template <bool HAS_A, bool XI_BF, bool XO_BF>
__device__ __forceinline__ void thin_rows(const void* xi, void* xo, const bf16* h, const float* gpost, float* rsout, float coef, int gw, int NGW, int lane) {
    for (int m = gw; m < M; m += NGW) {
        const u32x2* hr = (const u32x2*)(h + (size_t)m * D) + lane;
        f32x4 v[4], hv[4]; float s = 0.f;
#pragma unroll
        for (int j = 0; j < 4; ++j) {
            if (XI_BF) { const u32x2 w = ((const u32x2*)((const bf16*)xi + (size_t)m * D) + lane)[64 * j]; v[j] = (f32x4){bflo(w.x), bfhi(w.x), bflo(w.y), bfhi(w.y)}; }
            else v[j] = ((const f32x4*)((const float*)xi + (size_t)m * D) + lane)[64 * j];
            const u32x2 w = hr[64 * j]; hv[j] = (f32x4){bflo(w.x), bfhi(w.x), bflo(w.y), bfhi(w.y)};
            s += (hv[j].x * hv[j].x + hv[j].y * hv[j].y) + (hv[j].z * hv[j].z + hv[j].w * hv[j].w); }
        const float r1 = coef / sqrtf(wave_sum(s) * (1.0f / D) + EPS);
        float s2 = 0.f;
#pragma unroll
        for (int j = 0; j < 4; ++j) { const f32x4 gp = *((const f32x4*)gpost + lane + 64 * j); v[j] = v[j] + hv[j] * r1 * gp;
            s2 += (v[j].x * v[j].x + v[j].y * v[j].y) + (v[j].z * v[j].z + v[j].w * v[j].w); }
#pragma unroll
        for (int j = 0; j < 4; ++j) {
            if (XO_BF) { u32x2 w; w.x = cvtpk(v[j].x, v[j].y); w.y = cvtpk(v[j].z, v[j].w); ((u32x2*)((bf16*)xo + (size_t)m * D) + lane)[64 * j] = w; }
            else ((f32x4*)((float*)xo + (size_t)m * D) + lane)[64 * j] = v[j]; }
        if (HAS_A) { const float r2 = 1.0f / sqrtf(wave_sum(s2) * (1.0f / D) + EPS); if (lane == 0) rsout[m] = r2; }
    }
}
#define XB_TMO      128
#define XB_XCNT(j)  (256  + 64 * (j))
#define XB_XSUB(j)  (1280 + 64 * (j))
#define XB_XGEN(j)  (2304 + 64 * (j))
#define XB_TOP      3328
#define XB_TOPGEN   3392
#define XCD_BAR_WORDS 3456
#define XB_SPIN_CAP (1u << 18)

__device__ __forceinline__ unsigned xb_ld(unsigned* p)              { return __hip_atomic_load(p, __ATOMIC_RELAXED, __HIP_MEMORY_SCOPE_AGENT); }
__device__ __forceinline__ unsigned xb_add(unsigned* p, unsigned v) { return __hip_atomic_fetch_add(p, v, __ATOMIC_RELAXED, __HIP_MEMORY_SCOPE_AGENT); }
__device__ __forceinline__ unsigned xb_xcc_id() { return (unsigned)__builtin_amdgcn_s_getreg((3 << 11) | 20) & 0xFu; }
#define XB_SPIN(cond, bar) do { unsigned _sp = 0; while (cond) { __builtin_amdgcn_s_sleep(1); \
    if ((++_sp & 255u) == 0u) { if (xb_ld(&(bar)[XB_TMO])) break; if (_sp > XB_SPIN_CAP) { atomicAdd(&(bar)[XB_TMO], 1u); break; } } } } while (0)

struct XcdBarrier {
    unsigned* bar; unsigned x;
    volatile LAS unsigned* st;
};

__device__ __forceinline__ XcdBarrier xcd_barrier_post(unsigned* bar, volatile LAS unsigned* st) {
    XcdBarrier b; b.bar = bar; b.x = xb_xcc_id(); b.st = st;
    if (threadIdx.x == 0) (void)xb_add(&bar[XB_XCNT(b.x)], 1u);
    return b;
}
__device__ __forceinline__ void xcd_barrier_complete(unsigned* bar, unsigned x, unsigned& nloc, unsigned& nx) {
    const unsigned G = gridDim.x * gridDim.y * gridDim.z;
    unsigned sum, cnt, mine, sp = 0u;
    for (;;) {
        sum = 0u; cnt = 0u; mine = 0u;
#pragma unroll
        for (unsigned j = 0; j < 16; ++j) { const unsigned c = xb_ld(&bar[XB_XCNT(j)]); sum += c; cnt += (c > 0u) ? 1u : 0u; mine = (j == x) ? c : mine; }
        if (sum == G) break;
        __builtin_amdgcn_s_sleep(1);
        if ((++sp & 255u) == 0u) { if (xb_ld(&bar[XB_TMO])) break; if (sp > XB_SPIN_CAP) { atomicAdd(&bar[XB_TMO], 1u); break; } }
    }
    nloc = mine > 0u ? mine : 1u; nx = cnt > 0u ? cnt : 1u;
}

__device__ __forceinline__ void xcd_barrier(const XcdBarrier& b) {
    asm volatile("s_waitcnt vmcnt(0)" ::: "memory");
    __syncthreads();
    if (threadIdx.x == 0) {
        unsigned* bar = b.bar;
        __builtin_amdgcn_s_waitcnt(0);
        unsigned nloc = b.st[0], nx = b.st[1];
        if (nloc == 0u) { xcd_barrier_complete(bar, b.x, nloc, nx); b.st[0] = nloc; b.st[1] = nx; }
        const unsigned old = xb_add(&bar[XB_XSUB(b.x)], 1u);
        const unsigned gen = old / nloc;
        if (old + 1u == (gen + 1u) * nloc) {
            __builtin_amdgcn_fence(__ATOMIC_RELEASE, "agent");
            asm volatile("s_waitcnt vmcnt(0)" ::: "memory");
            const unsigned og = xb_add(&bar[XB_TOP], 1u);
            const unsigned tg = og / nx;
            if (og + 1u == (tg + 1u) * nx) xb_add(&bar[XB_TOPGEN], 1u);
            else XB_SPIN(xb_ld(&bar[XB_TOPGEN]) == tg, bar);
            __builtin_amdgcn_fence(__ATOMIC_ACQUIRE, "agent");
            xb_add(&bar[XB_XGEN(b.x)], 1u);
            asm volatile("s_waitcnt vmcnt(0)" ::: "memory");
        } else {
            XB_SPIN(xb_ld(&bar[XB_XGEN(b.x)]) == gen, bar);
            __builtin_amdgcn_fence(__ATOMIC_ACQUIRE, "agent");
            asm volatile("s_waitcnt vmcnt(0)" ::: "memory");
        }
    }
    __syncthreads();
}
#define MFMA32(a, b, c) __builtin_amdgcn_mfma_f32_32x32x16_bf16((a), (b), (c), 0, 0, 0)
__device__ __forceinline__ void load8(const bf16* p, float (&f)[8]) { const u32x4 w = *(const u32x4*)p;
    f[0] = bflo(w.x); f[1] = bfhi(w.x); f[2] = bflo(w.y); f[3] = bfhi(w.y); f[4] = bflo(w.z); f[5] = bfhi(w.z); f[6] = bflo(w.w); f[7] = bfhi(w.w); }

#define OPAQUE_V(x) asm volatile("" : "+v"(x))
#define OPAQUE_S(x) asm volatile("" : "+s"(x))
struct MixCtx { LAS unsigned char* lds; const bf16* Z; const bf16* Vt; const bf16* WpT; const float* pool_scale; const float* sinks; const float* g_pool; const float* g_attn; bf16* Y; float* RA; size_t rowbase; int b, n, htid, lane, hw; };

__device__ __forceinline__ void u_load(const MixCtx& c, int g, u32x4 (&pre)[9]) {
    int htid = c.htid; OPAQUE_V(htid);
#pragma unroll
    for (int k = 0; k < 9; ++k) { const int i = htid + 256 * k, jr = i >> 4, cc = i & 15; pre[k] = (u32x4){0u, 0u, 0u, 0u};
        if (jr < UL_ROWS && c.n * 128 + jr - 15 >= 0) pre[k] = *(const u32x4*)(c.Z + (ptrdiff_t)((ptrdiff_t)c.rowbase + jr - 15) * NIN + g * 128 + cc * 8); }
}
__device__ __forceinline__ void u_store(const MixCtx& c, const u32x4 (&pre)[9]) {
    int htid = c.htid; OPAQUE_V(htid);
#pragma unroll
    for (int k = 0; k < 9; ++k) { const int i = htid + 256 * k, jr = i >> 4, cc = i & 15; if (jr < UL_ROWS) *(LAS u32x4*)(c.lds + UL_OFF + jr * UL_PITCH + cc * 16) = pre[k]; }
}
template <int G> __device__ __forceinline__ void pool_D(const MixCtx& c) {
    constexpr int w = 2 << G;
    LAS unsigned char* lds = c.lds; int htid = c.htid; OPAQUE_V(htid);
    const int c8 = htid & 15, t0 = (htid >> 4) * 8;
    const LAS unsigned char* ub = lds + UL_OFF + (15 + t0) * UL_PITCH + c8 * 16;
    float s[8], uv[8];
#pragma unroll
    for (int i = 0; i < 8; ++i) s[i] = 0.f;
#define LDU(row) do { const u32x4 w_ = *(const LAS u32x4*)(ub + (row) * UL_PITCH); uv[0] = bflo(w_.x); uv[1] = bfhi(w_.x); uv[2] = bflo(w_.y); uv[3] = bfhi(w_.y); uv[4] = bflo(w_.z); uv[5] = bfhi(w_.z); uv[6] = bflo(w_.w); uv[7] = bfhi(w_.w); } while (0)
#pragma unroll
    for (int j = 1 - w; j < 0; ++j) { LDU(j);
#pragma unroll
        for (int i = 0; i < 8; ++i) s[i] += uv[i]; }
#pragma unroll
    for (int tt = 0; tt < 8; ++tt) { const int t = t0 + tt;
        LDU(tt);
#pragma unroll
        for (int i = 0; i < 8; ++i) s[i] += uv[i];
        const int sp = c.n * 128 + t; const int cnt = (sp + 1 < w) ? sp + 1 : w; const float inv = 1.0f / (float)cnt;
        u32x4 o; o.x = cvtpk(s[0] * inv - uv[0], s[1] * inv - uv[1]); o.y = cvtpk(s[2] * inv - uv[2], s[3] * inv - uv[3]);
        o.z = cvtpk(s[4] * inv - uv[4], s[5] * inv - uv[5]); o.w = cvtpk(s[6] * inv - uv[6], s[7] * inv - uv[7]);
        *(LAS u32x4*)(lds + DL_OFF + t * DL_PITCH + c8 * 16) = o;
        LDU(tt - w + 1);
#pragma unroll
        for (int i = 0; i < 8; ++i) s[i] -= uv[i]; }
#undef LDU
}
template <int G> __device__ __forceinline__ void pool_M(const MixCtx& c, f32x16& ssacc, unsigned (&kA)[16], unsigned (&kB)[16]) {
    LAS unsigned char* lds = c.lds; int lane_ = c.lane, hw = c.hw; OPAQUE_V(lane_); OPAQUE_S(hw);
    const int r32 = lane_ & 31, hi = lane_ >> 5;
#pragma unroll
    for (int j2 = 0; j2 < 2; ++j2) {
        f32x16 a0, a1;
#pragma unroll
        for (int i = 0; i < 16; ++i) { a0[i] = 0.f; a1[i] = 0.f; }
        const bf16* wp = c.WpT + (size_t)G * 16384 + (size_t)(64 * j2 + r32) * 128 + 8 * hi;
#pragma unroll
        for (int ks = 0; ks < 8; ++ks) {
            const bf16x8 A = *(const LAS bf16x8*)(lds + DL_OFF + (32 * hw + r32) * DL_PITCH + (16 * ks + 8 * hi) * 2);
            const bf16x8 B0 = *(const bf16x8*)(wp + 16 * ks), B1 = *(const bf16x8*)(wp + 32 * 128 + 16 * ks);
            a0 = MFMA32(A, B0, a0); a1 = MFMA32(A, B1, a1);
        }
#pragma unroll
        for (int r = 0; r < 16; ++r) { const float v0 = a0[r], v1 = a1[r];
            { float q_ = ssacc[r] + (v0 * v0 + v1 * v1); asm volatile("" : "+v"(q_)); ssacc[r] = q_; }
            unsigned pk_ = cvtpk(v0, v1); asm volatile("" : "+v"(pk_));
            if (j2 == 0) kA[r] = pk_; else kB[r] = pk_; }
        __builtin_amdgcn_sched_barrier(0);
    }
}
__device__ __forceinline__ void store_item(const MixCtx& c, LAS bf16* stg, const unsigned (&kp)[16], const float (&f)[16], int colbase) {
    int lane = c.lane; OPAQUE_V(lane); const int r32 = lane & 31, hi = lane >> 5;
#pragma unroll
    for (int r = 0; r < 16; ++r) { const int ro = (r & 3) + 8 * (r >> 2) + 4 * hi;
        stg[ro * 64 + r32] = (bf16)(cvtpk(bflo(kp[r]) * f[r], 0.f) & 0xffffu); stg[ro * 64 + 32 + r32] = (bf16)(cvtpk(bfhi(kp[r]) * f[r], 0.f) & 0xffffu); }
    asm volatile("s_waitcnt lgkmcnt(0)" ::: "memory");
    size_t yo = (c.rowbase + 32 * c.hw + (lane >> 3)) * D + colbase + (lane & 7) * 8; OPAQUE_V(yo); bf16* yb = c.Y + yo;
#pragma unroll
    for (int i = 0; i < 4; ++i) { const u32x4 v = *(const LAS u32x4*)(stg + (i * 8 + (lane >> 3)) * 64 + (lane & 7) * 8); *(u32x4*)(yb + (size_t)i * 8 * D) = v; }
    asm volatile("s_waitcnt lgkmcnt(0)" ::: "memory");
}
__device__ __forceinline__ void pool_half(const MixCtx& c) {
    f32x16 ssacc;
#pragma unroll
    for (int r = 0; r < 16; ++r) ssacc[r] = 0.f;
    unsigned a0[16], b0[16], a1[16], b1[16], a2[16], b2[16], a3[16], b3[16];
    __syncthreads();
    pool_D<0>(c); __syncthreads(); pool_M<0>(c, ssacc, a0, b0); __syncthreads();
    pool_D<1>(c); __syncthreads(); pool_M<1>(c, ssacc, a1, b1); __syncthreads();
    pool_D<2>(c); __syncthreads(); pool_M<2>(c, ssacc, a2, b2); __syncthreads();
    pool_D<3>(c); __syncthreads(); pool_M<3>(c, ssacc, a3, b3); __syncthreads();
    __syncthreads();
    int lane = c.lane; OPAQUE_V(lane); const int hi = lane >> 5;
    const LAS float* RAL = (const LAS float*)(c.lds + RAL_OFF);
    float f[16];
#pragma unroll
    for (int r = 0; r < 16; ++r) { const int ro = (r & 3) + 8 * (r >> 2) + 4 * hi; const float ss = half_sum32(ssacc[r]);
        f[r] = __builtin_amdgcn_rsqf(ss * (1.0f / 512.0f) + EPS) * __builtin_amdgcn_rcpf(RAL[32 * c.hw + ro]); }
    if (c.htid < 128) c.RA[c.rowbase + c.htid] = RAL[c.htid];
    LAS bf16* stg = (LAS bf16*)(c.lds + UL_OFF) + c.hw * 2048;
    store_item(c, stg, a0, f, 0); store_item(c, stg, b0, f, 64); store_item(c, stg, a1, f, 128); store_item(c, stg, b1, f, 192);
    store_item(c, stg, a2, f, 256); store_item(c, stg, b2, f, 320); store_item(c, stg, a3, f, 384); store_item(c, stg, b3, f, 448);
    __syncthreads();
}
template <int KH, int GI> __device__ __forceinline__ void att_item(const MixCtx& c, bf16x8 (&qr)[4], const bf16* qp, f32x16& ssacc) {
    LAS unsigned char* lds = c.lds; int lane_ = c.lane, rg = c.hw; OPAQUE_V(lane_); OPAQUE_S(rg);
    const int r32 = lane_ & 31, hi = lane_ >> 5, n = c.n;
    constexpr int h = KH * 4 + GI;
    f32x16 S[5];
#pragma unroll
    for (int t = 0; t < 5; ++t) {
#pragma unroll
        for (int i = 0; i < 16; ++i) S[t][i] = 0.f;
#pragma unroll
        for (int d0 = 0; d0 < 4; ++d0) { const bf16x8 kf = *(const LAS bf16x8*)(lds + KL_OFF + (32 * (rg + t) + r32) * KL_PITCH + (16 * d0 + 8 * hi) * 2);
            S[t] = MFMA32(kf, qr[d0], S[t]); }
        if (t & 1) __builtin_amdgcn_sched_barrier(0);
    }
    if (GI < 3) {
#pragma unroll
        for (int d0 = 0; d0 < 4; ++d0) qr[d0] = *(const bf16x8*)(qp + 64 * (GI + 1) + 16 * d0);
    }
    const float sinkl = c.sinks[h] * LOG2E;
    float mx = sinkl;
#pragma unroll
    for (int t = 0; t < 5; ++t)
#pragma unroll
        for (int r = 0; r < 16; ++r) {
            const bool tv = (n > 0) || (rg + t >= 4);
            const bool valid = (t == 0) ? (tv && (crow(r, hi) > r32)) : (t == 4) ? (crow(r, hi) <= r32) : tv;
            const float sv = valid ? S[t][r] : -1e30f; S[t][r] = sv; mx = fmaxf(mx, sv); }
    mx = fmaxf(mx, __shfl_xor(mx, 32));
    float sum = 0.f;
#pragma unroll
    for (int t = 0; t < 5; ++t)
#pragma unroll
        for (int r = 0; r < 16; ++r) { const float p = __builtin_amdgcn_exp2f(S[t][r] - mx); S[t][r] = p; sum += p; }
    sum += __shfl_xor(sum, 32);
    sum += __builtin_amdgcn_exp2f(sinkl - mx);
    const float linv = 1.0f / sum;
    f32x16 o0, o1;
#pragma unroll
    for (int i = 0; i < 16; ++i) { o0[i] = 0.f; o1[i] = 0.f; }
#pragma unroll
    for (int t = 0; t < 5; ++t)
#pragma unroll
        for (int s = 0; s < 2; ++s) {
            u32x4 pw; pw.x = cvtpk(S[t][8 * s + 0], S[t][8 * s + 1]); pw.y = cvtpk(S[t][8 * s + 2], S[t][8 * s + 3]); pw.z = cvtpk(S[t][8 * s + 4], S[t][8 * s + 5]); pw.w = cvtpk(S[t][8 * s + 6], S[t][8 * s + 7]);
            const bf16x8 pa = __builtin_bit_cast(bf16x8, pw);
            const int keyb = 32 * (rg + t) + 16 * s + 4 * hi;
            const LAS unsigned char* vb = lds + VL_OFF + r32 * VL_PITCH + keyb * 2;
            const u32x2 l0 = *(const LAS u32x2*)(vb), h0 = *(const LAS u32x2*)(vb + 16);
            const u32x2 l1 = *(const LAS u32x2*)(vb + 32 * VL_PITCH), h1 = *(const LAS u32x2*)(vb + 32 * VL_PITCH + 16);
            const bf16x8 v0 = __builtin_bit_cast(bf16x8, ((u32x4){l0.x, l0.y, h0.x, h0.y})), v1 = __builtin_bit_cast(bf16x8, ((u32x4){l1.x, l1.y, h1.x, h1.y}));
            o0 = MFMA32(pa, v0, o0); o1 = MFMA32(pa, v1, o1);
            if (s == 1) __builtin_amdgcn_sched_barrier(0);
        }
    LAS bf16* stg = (LAS bf16*)(lds + ASTG_OFF) + rg * 2048;
#pragma unroll
    for (int r = 0; r < 16; ++r) { const int ro = (r & 3) + 8 * (r >> 2) + 4 * hi; const float li = __shfl(linv, ro);
        const float v0 = o0[r] * li, v1 = o1[r] * li;
        { float q_ = ssacc[r] + (v0 * v0 + v1 * v1); asm volatile("" : "+v"(q_)); ssacc[r] = q_; }
        stg[ro * 64 + r32] = (bf16)(cvtpk(v0, 0.f) & 0xffffu); stg[ro * 64 + 32 + r32] = (bf16)(cvtpk(v1, 0.f) & 0xffffu); }
    asm volatile("s_waitcnt lgkmcnt(0)" ::: "memory");
    size_t yo = (c.rowbase + 32 * rg + (lane_ >> 3)) * D + 512 + h * 64 + (lane_ & 7) * 8; OPAQUE_V(yo); bf16* yb = c.Y + yo;
#pragma unroll
    for (int i = 0; i < 4; ++i) { const u32x4 v = *(const LAS u32x4*)(stg + (i * 8 + (lane_ >> 3)) * 64 + (lane_ & 7) * 8); *(u32x4*)(yb + (size_t)i * 8 * D) = v; }
    asm volatile("s_waitcnt lgkmcnt(0)" ::: "memory");
}
template <int KH> __device__ __forceinline__ void att_fill(const MixCtx& c, bf16x8 (&qr)[4], const bf16* qp) {
    LAS unsigned char* lds = c.lds; int htid = c.htid; OPAQUE_V(htid); const int n = c.n;
#pragma unroll
    for (int d0 = 0; d0 < 4; ++d0) qr[d0] = *(const bf16x8*)(qp + 16 * d0);
#pragma unroll
    for (int k = 0; k < 8; ++k) {
        const int i = htid + 256 * k, key = i >> 3, cc = i & 7; const bool valid = (n > 0) || (key >= 128);
        u32x4 v = (u32x4){0u, 0u, 0u, 0u};
        if (valid) v = *(const u32x4*)(c.Z + (c.rowbase + key - 128) * NIN + 1024 + KH * 64 + cc * 8);
        *(LAS u32x4*)(lds + KL_OFF + key * KL_PITCH + cc * 16) = v;
    }
#pragma unroll
    for (int k = 0; k < 8; ++k) {
        const int i = htid + 256 * k, d = i >> 5, cc = i & 31; const bool valid = (n > 0) || (cc >= 16);
        u32x4 v = (u32x4){0u, 0u, 0u, 0u};
        if (valid) v = *(const u32x4*)(c.Vt + ((size_t)((c.b * 2 + KH) * 64 + d)) * SEQ + n * 128 - 128 + cc * 8);
        LAS u32x2* dst = (LAS u32x2*)(lds + VL_OFF + d * VL_PITCH + cc * 16);
        dst[0] = (u32x2){v.x, v.y}; dst[1] = (u32x2){v.z, v.w};
    }
}
__device__ __forceinline__ void att_half(const MixCtx& c) {
    f32x16 ssacc;
#pragma unroll
    for (int r = 0; r < 16; ++r) ssacc[r] = 0.f;
    const bf16* qp0 = c.Z + (c.rowbase + 32 * c.hw + (c.lane & 31)) * NIN + 512 + 8 * (c.lane >> 5);
    const bf16* qp1 = qp0 + 256;
    bf16x8 qr[4]; u32x4 pre[9];
    u_load(c, 0, pre); att_fill<0>(c, qr, qp0); u_store(c, pre);            __syncthreads();
    u_load(c, 1, pre); att_item<0, 0>(c, qr, qp0, ssacc);                  __syncthreads();
    u_store(c, pre);   att_item<0, 1>(c, qr, qp0, ssacc);                  __syncthreads();
    u_load(c, 2, pre); att_item<0, 2>(c, qr, qp0, ssacc);                  __syncthreads();
    u_store(c, pre);   att_item<0, 3>(c, qr, qp0, ssacc);                  __syncthreads();
    u_load(c, 3, pre); att_fill<1>(c, qr, qp1);                            __syncthreads();
    u_store(c, pre);   att_item<1, 0>(c, qr, qp1, ssacc);                  __syncthreads();
    att_item<1, 1>(c, qr, qp1, ssacc);                                     __syncthreads();
    att_item<1, 2>(c, qr, qp1, ssacc);                                     __syncthreads();
    att_item<1, 3>(c, qr, qp1, ssacc);
    { int lane = c.lane; OPAQUE_V(lane); const int r32 = lane & 31, hi = lane >> 5; LAS float* RAL = (LAS float*)(c.lds + RAL_OFF);
#pragma unroll
      for (int r = 0; r < 16; ++r) { const int ro = (r & 3) + 8 * (r >> 2) + 4 * hi; const float ss = half_sum32(ssacc[r]);
          if (r32 == 0) RAL[32 * c.hw + ro] = __builtin_amdgcn_rsqf(ss * (1.0f / 512.0f) + EPS); } }
    __syncthreads();
    __syncthreads();
}
__device__ __forceinline__ void mixer_block(LAS unsigned char* lds, int blk, const bf16* Z, const bf16* Vt, const bf16* WpT, const float* pool_scale, const float* sinks,
                                            const float* g_pool, const float* g_attn, bf16* Y, float* RA, int tid, int wid, int lane) {
    OPAQUE_V(tid); OPAQUE_V(lane); OPAQUE_S(wid);
    MixCtx c; c.lds = lds; c.Z = Z; c.Vt = Vt; c.WpT = WpT; c.pool_scale = pool_scale; c.sinks = sinks; c.g_pool = g_pool; c.g_attn = g_attn; c.Y = Y; c.RA = RA; c.rowbase = (size_t)blk * 128;
    c.b = blk / NB_SEQ; c.n = blk % NB_SEQ; c.htid = tid & 255; c.lane = lane; c.hw = wid & 3;
    if (wid < 4) pool_half(c); else att_half(c);
}
__global__ void __launch_bounds__(NTHREADS, 2) hybrid_fwd(Args args) {
    extern __shared__ __attribute__((aligned(16))) unsigned char lds_raw[];
    LAS unsigned char* lds = (LAS unsigned char*)lds_raw;
    cg::grid_group grid = cg::this_grid();
    const int tid = threadIdx.x, lane = tid & 63, wid = __builtin_amdgcn_readfirstlane(tid >> 6);
    const int G = gridDim.x, bx = blockIdx.x;
    const int vcu = (G % 8 == 0) ? (bx % 8) * (G / 8) + bx / 8 : bx;
    const int gw = vcu * NWAVES + wid, NGW = G * NWAVES;
    unsigned char* ws = args.ws;
    bf16 *Wgu1 = (bf16*)(ws + WS_WGU1), *Wgu2 = (bf16*)(ws + WS_WGU2), *Wd1 = (bf16*)(ws + WS_WD1), *Wd2 = (bf16*)(ws + WS_WD2), *Win = (bf16*)(ws + WS_WIN), *Wout = (bf16*)(ws + WS_WOUT), *WpT = (bf16*)(ws + WS_WPOOL);
    float* CS = (float*)(ws + WS_CS);
    bf16 *HD = (bf16*)(ws + WS_HD), *H = (bf16*)(ws + WS_H), *Z = (bf16*)(ws + WS_Z), *Vt = (bf16*)(ws + WS_VT), *Y = (bf16*)(ws + WS_Y), *XR = (bf16*)(ws + WS_XR); float* RAg = (float*)(ws + WS_RA); float* RS = (float*)(ws + WS_RA + 512 * 1024);
    const int lo = args.ph_lo, hi = args.ph_hi;
#define IN(k) (lo <= (k) && (k) < hi)
#define SEAM(k) do { if (IN(k) && IN((k) + 1)) { if ((k) == 0) grid.sync(); else xcd_barrier(bar); } } while (0)
    if (tid < 32) ((LAS unsigned*)(lds + MISC_OFF))[tid] = 0u;
    __syncthreads();
    XcdBarrier bar; bar.bar = (unsigned*)(ws + WS_CTL); bar.x = 0; bar.st = nullptr;
    if (hi - lo > 1) bar = xcd_barrier_post((unsigned*)(ws + WS_CTL), (volatile LAS unsigned*)(lds + MISC_OFF) + 8);

    if (IN(0)) {
        LAS float* scr = (LAS float*)(lds + wid * 16384);
        constexpr int I_GU = (D / 64) * (NGU / 32), I_DN = (FF / 64) * (D / 32), I_IN = (D / 64) * (NIN / 32), I_OUT = (D / 64) * (D / 32), I_PL = 4 * 2 * 4;
        constexpr int NITEMS = 2 * I_GU + 2 * I_DN + I_IN + I_OUT + I_PL;
        for (int it = gw; it < NITEMS; it += NGW) {
            int r = it;
            if (r < I_GU) { transpose_item(args.ffn1_wgu, D, NGU, Wgu1, 1, scr, r, lane, args.ffn1_pre); continue; } r -= I_GU;
            if (r < I_GU) { transpose_item(args.ffn2_wgu, D, NGU, Wgu2, 1, scr, r, lane, args.ffn2_pre); continue; } r -= I_GU;
            if (r < I_DN) { transpose_item(args.ffn1_wd, FF, D, Wd1, 0, scr, r, lane); continue; } r -= I_DN;
            if (r < I_DN) { transpose_item(args.ffn2_wd, FF, D, Wd2, 0, scr, r, lane); continue; } r -= I_DN;
            if (r < I_IN) { transpose_item(args.w_in, D, NIN, Win, 2, scr, r, lane, args.mix_pre); continue; } r -= I_IN;
            if (r < I_OUT) { transpose_item(args.w_out, D, D, Wout, 0, scr, r, lane, args.g_pool, args.g_attn); continue; } r -= I_OUT;
            { const int g = r >> 3; transpose_item(args.w_pool + (size_t)g * 16384, 128, 128, WpT + (size_t)g * 16384, 0, scr, r & 7, lane, nullptr, nullptr, args.pool_scale + g * 128); }
        }
        for (int idx = vcu * NTHREADS + tid; idx < M * 8; idx += G * NTHREADS) {
            const int row = idx >> 3, i = idx & 7; const float ang = (float)args.pos[row] * inv_freq(i);
            float sn, cn; sincos_f(ang, sn, cn); CS[(size_t)row * 16 + i] = cn; CS[(size_t)row * 16 + 8 + i] = sn;
        }
        prenorm_rows(args.x, XR, RS, gw, NGW, lane);
    }
    SEAM(0);
    if (IN(1)) {
        pg8::Gemm g{XR, Wgu1, M, NGU, D}; pg8::StaticOrder S; S.init(M, NGU, G, bx); pg8::EpiSwiGLU E{H, FF, RS};
        pg8::gemm_phase<pg8::EpiSwiGLU, pg8::StaticOrder, true, true>(lds, g, S, E);
    }
    SEAM(1);
    if (IN(2)) {
        pg8::Gemm g{H, Wd1, M, D, FF}; pg8::StaticOrder S; S.init(M, D, G, bx); pg8::EpiBf16<0> E{HD, D, nullptr, 0, 0, 1.f};
        pg8::gemm_phase<pg8::EpiBf16<0>, pg8::StaticOrder, true, true>(lds, g, S, E);
    }
    SEAM(2);
    if (IN(3)) thin_rows<true, false, true>(args.x, XR, HD, args.ffn1_post, RS, 0.5f, gw, NGW, lane);
    SEAM(3);
    if (IN(4)) {
        pg8::Gemm g{XR, Win, M, NIN, D}; pg8::StaticOrder S; S.init(M, NIN, G, bx); pg8::EpiZ E{Z, Vt, CS, QSCALE, SEQ, RS};
        pg8::gemm_phase<pg8::EpiZ, pg8::StaticOrder, true, true>(lds, g, S, E);
    }
    SEAM(4);
    if (IN(5)) { for (int blk = vcu; blk < NBLK; blk += G) mixer_block(lds, blk, Z, Vt, WpT, args.pool_scale, args.sinks, args.g_pool, args.g_attn, Y, RAg, tid, wid, lane); }
    SEAM(5);
    if (IN(6)) {
        pg8::Gemm g{Y, Wout, M, D, D}; pg8::StaticOrder S; S.init(M, D, G, bx); pg8::EpiRowScale E{HD, D, RAg};
        pg8::gemm_phase<pg8::EpiRowScale, pg8::StaticOrder, true, true>(lds, g, S, E);
    }
    SEAM(6);
    if (IN(7)) thin_rows<true, true, true>(XR, XR, HD, args.mix_post, RS, 1.0f, gw, NGW, lane);
    SEAM(7);
    if (IN(8)) {
        pg8::Gemm g{XR, Wgu2, M, NGU, D}; pg8::StaticOrder S; S.init(M, NGU, G, bx); pg8::EpiSwiGLU E{H, FF, RS};
        pg8::gemm_phase<pg8::EpiSwiGLU, pg8::StaticOrder, true, true>(lds, g, S, E);
    }
    SEAM(8);
    if (IN(9)) {
        pg8::Gemm g{H, Wd2, M, D, FF}; pg8::StaticOrder S; S.init(M, D, G, bx); pg8::EpiBf16<0> E{HD, D, nullptr, 0, 0, 1.f};
        pg8::gemm_phase<pg8::EpiBf16<0>, pg8::StaticOrder, true, true>(lds, g, S, E);
    }
    SEAM(9);
    if (IN(10)) thin_rows<false, true, false>(XR, args.out, HD, args.ffn2_post, nullptr, 0.5f, gw, NGW, lane);
#undef IN
#undef SEAM
}

#ifndef MK_N_LAUNCHES
#define MK_N_LAUNCHES 1
#endif
extern "C" void kernel_launch(void* const* d_in, const int* in_sizes, int n_in, void* d_out, int out_size, void* d_ws, size_t ws_size, hipStream_t stream) {
    static int grid = 0;
    if (grid == 0) {
        if (n_in != 19 || in_sizes[0] != M * D || out_size != M * D || ws_size < WS_END) { fprintf(stderr, "kernel_launch: unexpected shapes (n_in %d, in0 %d, out %d, ws %zu)\n", n_in, n_in > 0 ? in_sizes[0] : -1, out_size, ws_size); grid = -1; return; }
        int dev = 0, cus = 0, per_cu = 0;
        if (hipGetDevice(&dev) != hipSuccess || hipDeviceGetAttribute(&cus, hipDeviceAttributeMultiprocessorCount, dev) != hipSuccess) { grid = -1; return; }
        if (hipFuncSetAttribute((const void*)hybrid_fwd, hipFuncAttributeMaxDynamicSharedMemorySize, LDS_BYTES) != hipSuccess) { fprintf(stderr, "kernel_launch: hipFuncSetAttribute failed\n"); grid = -1; return; }
        if (hipOccupancyMaxActiveBlocksPerMultiprocessor(&per_cu, (const void*)hybrid_fwd, NTHREADS, LDS_BYTES) != hipSuccess || per_cu < 1) { fprintf(stderr, "kernel_launch: occupancy query says %d\n", per_cu); per_cu = 1; }
        (void)hipGetLastError();
        grid = cus * 1;
    }
    if (grid < 0) return;
    if (hipMemsetAsync((char*)d_ws + WS_CTL, 0, CTL_BYTES, stream) != hipSuccess) { fprintf(stderr, "kernel_launch: memset failed\n"); return; }
    Args a{};
    a.x = (const float*)d_in[0]; a.pos = (const int*)d_in[1];
    a.ffn1_pre = (const float*)d_in[2]; a.ffn1_wgu = (const float*)d_in[3]; a.ffn1_wd = (const float*)d_in[4]; a.ffn1_post = (const float*)d_in[5];
    a.mix_pre = (const float*)d_in[6]; a.w_in = (const float*)d_in[7]; a.w_pool = (const float*)d_in[8]; a.pool_scale = (const float*)d_in[9]; a.sinks = (const float*)d_in[10];
    a.g_pool = (const float*)d_in[11]; a.g_attn = (const float*)d_in[12]; a.w_out = (const float*)d_in[13]; a.mix_post = (const float*)d_in[14];
    a.ffn2_pre = (const float*)d_in[15]; a.ffn2_wgu = (const float*)d_in[16]; a.ffn2_wd = (const float*)d_in[17]; a.ffn2_post = (const float*)d_in[18];
    a.out = (float*)d_out; a.ws = (unsigned char*)d_ws;
    constexpr int NPH = 11;
#if MK_N_LAUNCHES == 1
    a.ph_lo = 0; a.ph_hi = NPH;
    { void* kargs[] = {&a}; hipError_t e = hipLaunchCooperativeKernel((const void*)hybrid_fwd, dim3(grid), dim3(NTHREADS), kargs, LDS_BYTES, stream);
      if (e != hipSuccess) fprintf(stderr, "kernel_launch: cooperative launch failed: %s (grid %d)\n", hipGetErrorString(e), grid); }
#else
    for (int p = 0; p < NPH; ++p) { a.ph_lo = p; a.ph_hi = p + 1; void* kargs[] = {&a};
        hipError_t e = hipLaunchCooperativeKernel((const void*)hybrid_fwd, dim3(grid), dim3(NTHREADS), kargs, LDS_BYTES, stream);
        if (e != hipSuccess) { fprintf(stderr, "kernel_launch: launch %d failed: %s\n", p, hipGetErrorString(e)); break; } }
#endif
}
```

```cpp
#include <hip/hip_runtime.h>
#include <hip/hip_cooperative_groups.h>
#include <cstdio>
#include <cstdint>
namespace cg = cooperative_groups;
namespace pg8 {
#define PG8_LAS __attribute__((address_space(3)))
typedef unsigned short bf16_t;
typedef short bf16x8 __attribute__((ext_vector_type(8)));
typedef float f32x4 __attribute__((ext_vector_type(4)));
typedef unsigned u32x4 __attribute__((ext_vector_type(4)));
constexpr int BM = 256, BK = 64, HALF = 128, HTB = HALF * BK * 2  , STAGE_BYTES = 8 * HTB, NXCD = 8, WGM = 8;

__host__ __device__ __forceinline__ int lds_byte(int r, int c) { const int st = (r >> 4) * 2 + (c >> 5), rr = r & 15, cc = c & 31, ob = rr * 64 + cc * 2; return st * 1024 + (ob ^ (((ob >> 9) & 1) << 5)); }
__host__ __device__ __forceinline__ void stage_rc(int b, int& R, int& C) { const int st = b / 1024, sb = b % 1024, swz = sb ^ (((sb >> 9) & 1) << 5); R = (st >> 1) * 16 + swz / 64; C = (st & 1) * 32 + (swz % 64) / 2; }
__host__ __device__ __forceinline__ int perm32(int rho) { const int n = rho >> 4, i = rho & 15; return 8 * (i >> 2) + 4 * n + (i & 3); }

struct Unit { int pm, pn; };
struct Gemm { const bf16_t* A; const bf16_t* Bt; int M, N, K; };

struct StaticOrder {
    int nM, nN, nwg, G, c;
    __host__ __device__ void init(int M, int N, int G_, int c_) { nM = M / BM; nN = N / BM; nwg = nM * nN; G = G_; c = c_; }
    __host__ __device__ bool next(int i, Unit& u) const {
        const long L = (long)i * G + c; if (L >= nwg) return false;
        int wgid = (int)L; { const int q = nwg / NXCD, r = nwg % NXCD, xcd = wgid % NXCD, off = wgid / NXCD; wgid = (xcd < r ? xcd * (q + 1) : r * (q + 1) + (xcd - r) * q) + off; }
        const int nig = WGM * nN, gid = wgid / nig, fm = gid * WGM, gsz = (nM - fm) < WGM ? (nM - fm) : WGM;
        u.pm = fm + ((wgid % nig) % gsz); u.pn = (wgid % nig) / gsz; return true;
    }
    __device__ __forceinline__ void a_ready(const Unit&) const {}
    __device__ __forceinline__ void done(const Unit&) const {}
};

__device__ __forceinline__ unsigned cvt_pk_bf16(float lo, float hi) { unsigned r; asm volatile("v_cvt_pk_bf16_f32 %0, %1, %2" : "=v"(r) : "v"(lo), "v"(hi)); return r; }
typedef float f32x2 __attribute__((ext_vector_type(2)));
__device__ __forceinline__ f32x2 gelu_pk(f32x2 v) {
    const f32x2 av = __builtin_elementwise_abs(v), d = av * 0.2316418882f + 1.0f;
    f32x2 t; t.x = __builtin_amdgcn_rcpf(d.x); t.y = __builtin_amdgcn_rcpf(d.y);
    f32x2 q = t * 0.5307027145f + (-0.7265760135f); q = q * t + 0.7107068705f; q = q * t + (-0.142248368f); q = q * t + 0.127414796f; q = q * t;
    const f32x2 s = (v * v) * (-0.72134752044f);
    f32x2 e; e.x = __builtin_amdgcn_exp2f(s.x); e.y = __builtin_amdgcn_exp2f(s.y);
    const f32x2 m = v * (q * e), r = v - m;
    f32x2 o; o.x = v.x < 0.f ? m.x : r.x; o.y = v.y < 0.f ? m.y : r.y; return o;
}

template <int ACT  > struct EpiBf16 {
    static constexpr bool PERM = true, AFTER_DRAIN = false; static_assert(ACT == 0 || ACT == 1, "EpiBf16: ACT is 0 (none) or 1 (gelu_pk)");
    bf16_t* O; int ldc; const float* bias; int split_cols; size_t split_stride; float scale0;
    __device__ __forceinline__ void operator()(const f32x4 (&acc)[2][2][4][2], const Unit& u, int wr, int wc, int fr, int fq) const {
        const int row0 = u.pm * BM + wr * 64 + fr; int colt = u.pn * BM; bf16_t* base = O;
        float sc = 1.f; if (split_cols) { const int t = colt / split_cols; base += (size_t)t * split_stride; colt -= t * split_cols; if (t == 0) sc = scale0; }
        const int col0 = colt + wc * 32 + 8 * fq, bcol0 = u.pn * BM + wc * 32 + 8 * fq;
        f32x4 bv[2][2];
#pragma unroll
        for (int bj = 0; bj < 2; ++bj)
#pragma unroll
            for (int n = 0; n < 2; ++n) bv[bj][n] = bias ? *(const f32x4*)(bias + bcol0 + bj * HALF + 4 * n) : (f32x4){0.f, 0.f, 0.f, 0.f};
#pragma unroll
        for (int ai = 0; ai < 2; ++ai)
#pragma unroll
            for (int m = 0; m < 4; ++m) { bf16_t* rowp = base + (size_t)(row0 + ai * HALF + m * 16) * ldc + col0;
#pragma unroll
                for (int bj = 0; bj < 2; ++bj) { f32x4 v0 = acc[ai][bj][m][0] + bv[bj][0], v1 = acc[ai][bj][m][1] + bv[bj][1];
                    if (ACT == 1) { f32x2 a = gelu_pk((f32x2){v0[0], v0[1]}), b = gelu_pk((f32x2){v0[2], v0[3]}), c = gelu_pk((f32x2){v1[0], v1[1]}), d = gelu_pk((f32x2){v1[2], v1[3]});
                        v0 = (f32x4){a.x, a.y, b.x, b.y}; v1 = (f32x4){c.x, c.y, d.x, d.y}; }
                    v0 = v0 * sc; v1 = v1 * sc; u32x4 w; w.x = cvt_pk_bf16(v0[0], v0[1]); w.y = cvt_pk_bf16(v0[2], v0[3]); w.z = cvt_pk_bf16(v1[0], v1[1]); w.w = cvt_pk_bf16(v1[2], v1[3]);
                    *(u32x4*)(rowp + bj * HALF) = w; } }
    }
};
typedef __bf16 bf16x2_t __attribute__((ext_vector_type(2)));
__device__ __forceinline__ unsigned cvtpk(float lo, float hi) { f32x2 v = {lo, hi}; bf16x2_t b = __builtin_convertvector(v, bf16x2_t); return __builtin_bit_cast(unsigned, b); }
__device__ __forceinline__ float silu_mul(float g, float u) { const float e = __builtin_amdgcn_exp2f(-1.4426950408889634f * g); return g * __builtin_amdgcn_rcpf(1.0f + e) * u; }

struct EpiSwiGLU {
    static constexpr bool PERM = true, AFTER_DRAIN = false;
    bf16_t* O; int ldc; const float* rs;
    __device__ __forceinline__ void operator()(const f32x4 (&acc)[2][2][4][2], const Unit& u, int wr, int wc, int fr, int fq) const {
        const int row0 = u.pm * BM + wr * 64 + fr, col0 = u.pn * HALF + wc * 32 + 8 * fq;
#pragma unroll
        for (int ai = 0; ai < 2; ++ai)
#pragma unroll
            for (int m = 0; m < 4; ++m) { const int row = row0 + ai * HALF + m * 16; bf16_t* rowp = O + (size_t)row * ldc + col0; const float r = rs[row];
                const f32x4 g0 = acc[ai][0][m][0] * r, g1 = acc[ai][0][m][1] * r, u0 = acc[ai][1][m][0] * r, u1 = acc[ai][1][m][1] * r;
                u32x4 w; w.x = cvtpk(silu_mul(g0[0], u0[0]), silu_mul(g0[1], u0[1])); w.y = cvtpk(silu_mul(g0[2], u0[2]), silu_mul(g0[3], u0[3]));
                w.z = cvtpk(silu_mul(g1[0], u1[0]), silu_mul(g1[1], u1[1])); w.w = cvtpk(silu_mul(g1[2], u1[2]), silu_mul(g1[3], u1[3]));
                *(u32x4*)rowp = w; }
    }
};
struct EpiRowScale {
    static constexpr bool PERM = true, AFTER_DRAIN = false;
    bf16_t* O; int ldc; const float* rs;
    __device__ __forceinline__ void operator()(const f32x4 (&acc)[2][2][4][2], const Unit& u, int wr, int wc, int fr, int fq) const {
        const int row0 = u.pm * BM + wr * 64 + fr, col0 = u.pn * BM + wc * 32 + 8 * fq;
#pragma unroll
        for (int ai = 0; ai < 2; ++ai)
#pragma unroll
            for (int m = 0; m < 4; ++m) { const int row = row0 + ai * HALF + m * 16; const float sc = rs[row]; bf16_t* rowp = O + (size_t)row * ldc + col0;
#pragma unroll
                for (int bj = 0; bj < 2; ++bj) { const f32x4 v0 = acc[ai][bj][m][0] * sc, v1 = acc[ai][bj][m][1] * sc;
                    u32x4 w; w.x = cvtpk(v0[0], v0[1]); w.y = cvtpk(v0[2], v0[3]); w.z = cvtpk(v1[0], v1[1]); w.w = cvtpk(v1[2], v1[3]);
                    *(u32x4*)(rowp + bj * HALF) = w; } }
    }
};
struct EpiZ {
    static constexpr bool PERM = true, AFTER_DRAIN = false;
    bf16_t* Z; bf16_t* Vt; const float* cs; float qscale; int seq; const float* rs;
    __device__ __forceinline__ void operator()(const f32x4 (&acc)[2][2][4][2], const Unit& u, int wr, int wc, int fr, int fq) const {
        const int row0 = u.pm * BM + wr * 64 + fr, cl = wc * 32 + 8 * fq;
#pragma unroll
        for (int bj = 0; bj < 2; ++bj) {
            const int colh = u.pn * BM + bj * HALF;
            const bool isV = (colh == 1152);
            const bool rope = (colh >= 512) && (colh < 1152) && ((wc & 1) == 0) && (fq < 2);
            const float sc = (colh >= 512 && colh < 1024) ? qscale : 1.0f;
#pragma unroll
            for (int ai = 0; ai < 2; ++ai)
#pragma unroll
                for (int m = 0; m < 4; ++m) { const int row = row0 + ai * HALF + m * 16;
                    const float r = rs[row];
                    f32x4 v0 = acc[ai][bj][m][0] * r, v1 = acc[ai][bj][m][1] * r;
                    if (isV) {
                        const int b = row / seq, s = row - b * seq;
#pragma unroll
                        for (int i = 0; i < 4; ++i) { const int c0 = cl + i, c1 = cl + 4 + i;
                            Vt[((size_t)((b * 2 + (c0 >> 6)) * 64 + (c0 & 63))) * seq + s] = (bf16_t)(cvtpk(v0[i], 0.f) & 0xffffu);
                            Vt[((size_t)((b * 2 + (c1 >> 6)) * 64 + (c1 & 63))) * seq + s] = (bf16_t)(cvtpk(v1[i], 0.f) & 0xffffu); }
                    } else {
                        if (rope) { const f32x4 c = *(const f32x4*)(cs + (size_t)row * 16 + 4 * fq), sn = *(const f32x4*)(cs + (size_t)row * 16 + 8 + 4 * fq);
                            const f32x4 n0 = v0 * c - v1 * sn, n1 = v1 * c + v0 * sn; v0 = n0; v1 = n1; }
                        v0 = v0 * sc; v1 = v1 * sc;
                        u32x4 w; w.x = cvtpk(v0[0], v0[1]); w.y = cvtpk(v0[2], v0[3]); w.z = cvtpk(v1[0], v1[1]); w.w = cvtpk(v1[2], v1[3]);
                        *(u32x4*)(Z + (size_t)row * 1280 + colh + cl) = w; }
                }
        }
    }
};
template <class Epi, class Sched, bool ALIGN_EPI = false, bool SP2 = false>
__device__ __forceinline__ void gemm_phase(PG8_LAS unsigned char* lds, const Gemm g, const Sched& S, const Epi& E) {
    const int tid = threadIdx.x, wid = __builtin_amdgcn_readfirstlane(tid >> 6), lane = tid & 63, wr = wid >> 2, wc = wid & 3, fr = lane & 15, fq = lane >> 4;
    const int K = g.K, nt = K / BK;
    unsigned voffA[2], voffB[2];
#pragma unroll
    for (int i = 0; i < 2; ++i) { int R, C; stage_rc(tid * 16 + i * 8192, R, C); const int Rb = Epi::PERM ? ((R & ~31) + perm32(R & 31)) : R;
        voffA[i] = (unsigned)(R * K + C) * 2u; voffB[i] = (unsigned)(Rb * K + C) * 2u; }
    const size_t kstep = (size_t)(BK * 2);
    const size_t hstep = (size_t)HALF * K * 2;
    const size_t tstep = 2 * hstep;
    const unsigned ldsw = (unsigned)wid * 1024u;
    const int aoff = lds_byte(wr * 64 + fr, fq * 8), boff = lds_byte(wc * 32 + fr, fq * 8);
#define PG8_SA(b, h) (((b) * 2 + (h)) * HTB)
#define PG8_SB(b, h) ((4 + (b) * 2 + (h)) * HTB)
#define PG8_STAGE(bufoff, gbase, voff) do { _Pragma("unroll") for (int _i = 0; _i < 2; ++_i) \
        __builtin_amdgcn_global_load_lds((const unsigned*)((const char*)(gbase) + (voff)[_i]), (PG8_LAS unsigned*)(lds + (bufoff) + ldsw + _i * 8192), 16, 0, 0); } while (0)
#define PG8_LDA(dst, b, h) do { _Pragma("unroll") for (int m = 0; m < 4; ++m) _Pragma("unroll") for (int k = 0; k < 2; ++k) dst[m][k] = *(const PG8_LAS bf16x8*)(lds + PG8_SA(b, h) + aoff + m * 2048 + k * 1024); } while (0)
#define PG8_LDB(dst, b, h) do { _Pragma("unroll") for (int n = 0; n < 2; ++n) _Pragma("unroll") for (int k = 0; k < 2; ++k) dst[n][k] = *(const PG8_LAS bf16x8*)(lds + PG8_SB(b, h) + boff + n * 2048 + k * 1024); } while (0)
#define PG8_MMA(ai, bj, At, Bt) do { __builtin_amdgcn_s_setprio(1); _Pragma("unroll") for (int m = 0; m < 4; ++m) _Pragma("unroll") for (int n = 0; n < 2; ++n) _Pragma("unroll") for (int k = 0; k < 2; ++k) \
        acc[ai][bj][m][n] = __builtin_amdgcn_mfma_f32_16x16x32_bf16(Bt[n][k], At[m][k], acc[ai][bj][m][n], 0, 0, 0); __builtin_amdgcn_s_setprio(0); } while (0)
#define PG8_WAIT_V(n) asm volatile("s_waitcnt vmcnt(" #n ")" ::: "memory")
#define PG8_WAIT_L(n) asm volatile("s_waitcnt lgkmcnt(" #n ")" ::: "memory")
#define PG8_BAR __builtin_amdgcn_s_barrier()
#define PG8_SCHED __builtin_amdgcn_sched_barrier(0)
    Unit cur, nxt; int ui = 0;
    if (!S.next(0, cur)) return;
    f32x4 acc[2][2][4][2];
#pragma unroll
    for (int a = 0; a < 2; ++a)
#pragma unroll
        for (int b = 0; b < 2; ++b)
#pragma unroll
            for (int m = 0; m < 4; ++m)
#pragma unroll
                for (int n = 0; n < 2; ++n) acc[a][b][m][n] = (f32x4){0.f, 0.f, 0.f, 0.f};
    bf16x8 At[4][2], B0[2][2], B1[2][2];
    const char* cA = (const char*)g.A + (size_t)cur.pm * tstep; const char* cB = (const char*)g.Bt + (size_t)cur.pn * tstep;
    S.a_ready(cur);
    if constexpr (SP2) {
        PG8_STAGE(PG8_SB(0, 0), cB, voffB); PG8_STAGE(PG8_SB(0, 1), cB + hstep, voffB); PG8_STAGE(PG8_SA(0, 0), cA, voffA); PG8_STAGE(PG8_SA(0, 1), cA + hstep, voffA);
        if (wr == 1) PG8_BAR;
        PG8_WAIT_V(2); PG8_BAR;
        PG8_STAGE(PG8_SB(1, 0), cB + kstep, voffB); PG8_STAGE(PG8_SA(1, 0), cA + kstep, voffA); PG8_STAGE(PG8_SB(1, 1), cB + hstep + kstep, voffB);
        PG8_WAIT_V(6); PG8_BAR;
    } else {
        PG8_STAGE(PG8_SB(0, 0), cB, voffB); PG8_STAGE(PG8_SA(0, 0), cA, voffA); PG8_STAGE(PG8_SB(0, 1), cB + hstep, voffB); PG8_STAGE(PG8_SA(0, 1), cA + hstep, voffA);
        if (wr == 1) PG8_BAR;
        PG8_WAIT_V(4); PG8_BAR;
        PG8_STAGE(PG8_SB(1, 0), cB + kstep, voffB); PG8_STAGE(PG8_SA(1, 0), cA + kstep, voffA); PG8_STAGE(PG8_SB(1, 1), cB + hstep + kstep, voffB);
        PG8_WAIT_V(6); PG8_BAR;
    }
    for (;;) {
        const bool has_next = S.next(ui + 1, nxt);
        const char* nA = has_next ? (const char*)g.A + (size_t)nxt.pm * tstep : cA; const char* nB = has_next ? (const char*)g.Bt + (size_t)nxt.pn * tstep : cB;
        for (int t = 0; t < nt; t += 2) {
            const bool last = (t == nt - 2);
            const char* a1 = cA + (size_t)(t + 1) * kstep;
            const char* a2 = last ? nA : cA + (size_t)(t + 2) * kstep; const char* b2 = last ? nB : cB + (size_t)(t + 2) * kstep;
            const char* a3 = a2 + kstep; const char* b3 = b2 + kstep;
            if (last && has_next) S.a_ready(nxt);
            if constexpr (SP2) {
            PG8_LDB(B0, 0, 0); PG8_LDB(B1, 0, 1); PG8_SCHED; PG8_LDA(At, 0, 0); PG8_STAGE(PG8_SA(1, 1), a1 + hstep, voffA);
            PG8_WAIT_V(8); PG8_WAIT_L(0); PG8_BAR; PG8_MMA(0, 0, At, B0); PG8_MMA(0, 1, At, B1); PG8_BAR; PG8_SCHED;
            PG8_LDA(At, 0, 1); PG8_STAGE(PG8_SB(0, 0), b2, voffB); PG8_STAGE(PG8_SB(0, 1), b2 + hstep, voffB); PG8_STAGE(PG8_SA(0, 0), a2, voffA);
            PG8_WAIT_V(8); PG8_WAIT_L(0); PG8_BAR; PG8_MMA(1, 0, At, B0); PG8_MMA(1, 1, At, B1); PG8_BAR; PG8_SCHED;
            PG8_LDB(B0, 1, 0); PG8_LDB(B1, 1, 1); PG8_SCHED; PG8_LDA(At, 1, 0); PG8_STAGE(PG8_SA(0, 1), a2 + hstep, voffA);
            PG8_WAIT_V(8); PG8_WAIT_L(0); PG8_BAR; PG8_MMA(0, 0, At, B0); PG8_MMA(0, 1, At, B1); PG8_BAR; PG8_SCHED;
            PG8_LDA(At, 1, 1); PG8_STAGE(PG8_SB(1, 0), b3, voffB); PG8_STAGE(PG8_SB(1, 1), b3 + hstep, voffB); PG8_STAGE(PG8_SA(1, 0), a3, voffA);
            PG8_WAIT_V(8); PG8_WAIT_L(0); PG8_BAR; PG8_MMA(1, 0, At, B0); PG8_MMA(1, 1, At, B1); PG8_BAR; PG8_SCHED;
            } else {
            PG8_LDB(B0, 0, 0); PG8_SCHED; PG8_LDA(At, 0, 0); PG8_STAGE(PG8_SA(1, 1), a1 + hstep, voffA);
            PG8_WAIT_L(8); PG8_BAR; PG8_WAIT_L(0); PG8_MMA(0, 0, At, B0); PG8_BAR; PG8_SCHED;
            PG8_LDB(B1, 0, 1); PG8_STAGE(PG8_SB(0, 0), b2, voffB);
            PG8_BAR; PG8_WAIT_L(0); PG8_MMA(0, 1, At, B1); PG8_BAR;
            PG8_LDA(At, 0, 1); PG8_STAGE(PG8_SA(0, 0), a2, voffA);
            PG8_BAR; PG8_WAIT_L(0); PG8_MMA(1, 0, At, B0); PG8_BAR; PG8_SCHED;
            PG8_STAGE(PG8_SB(0, 1), b2 + hstep, voffB);
            PG8_WAIT_V(6); PG8_BAR; PG8_MMA(1, 1, At, B1); PG8_BAR;
            PG8_LDB(B0, 1, 0); PG8_SCHED; PG8_LDA(At, 1, 0); PG8_STAGE(PG8_SA(0, 1), a2 + hstep, voffA);
            PG8_WAIT_L(8); PG8_BAR; PG8_WAIT_L(0); PG8_MMA(0, 0, At, B0); PG8_BAR; PG8_SCHED;
            PG8_LDB(B1, 1, 1); PG8_STAGE(PG8_SB(1, 0), b3, voffB);
            PG8_BAR; PG8_WAIT_L(0); PG8_MMA(0, 1, At, B1); PG8_BAR;
            PG8_LDA(At, 1, 1); PG8_STAGE(PG8_SA(1, 0), a3, voffA);
            PG8_BAR; PG8_WAIT_L(0); PG8_MMA(1, 0, At, B0); PG8_BAR; PG8_SCHED;
            PG8_STAGE(PG8_SB(1, 1), b3 + hstep, voffB);
            PG8_WAIT_V(6); PG8_BAR; PG8_MMA(1, 1, At, B1); PG8_BAR;
            }
        }
        if constexpr (ALIGN_EPI) { if (wr == 0) PG8_BAR; }
        if constexpr (!Epi::AFTER_DRAIN) { E(acc, cur, wr, wc, fr, fq); S.done(cur); }
        if (!has_next) break;
#pragma unroll
        for (int a = 0; a < 2; ++a)
#pragma unroll
            for (int b = 0; b < 2; ++b)
#pragma unroll
                for (int m = 0; m < 4; ++m)
#pragma unroll
                    for (int n = 0; n < 2; ++n) acc[a][b][m][n] = (f32x4){0.f, 0.f, 0.f, 0.f};
        cur = nxt; cA = nA; cB = nB; ++ui;
        if constexpr (ALIGN_EPI) { if (wr == 1) PG8_BAR; }
    }
    PG8_WAIT_V(0);
    if constexpr (!ALIGN_EPI) { if (wr == 0) PG8_BAR; }
    PG8_BAR;
    if constexpr (Epi::AFTER_DRAIN) { E.fused(acc, cur, wr, wc, fr, fq, lds, wid, lane); S.done(cur); }
#undef PG8_SA
#undef PG8_SB
#undef PG8_STAGE
#undef PG8_LDA
#undef PG8_LDB
#undef PG8_MMA
#undef PG8_WAIT_V
#undef PG8_WAIT_L
#undef PG8_BAR
#undef PG8_SCHED
}
}
constexpr int BATCH = 4, SEQ = 8192, D = 1024, M = BATCH * SEQ, FF = 2816, NGU = 2 * FF, NIN = 1280, NBLK = M / 128, NB_SEQ = SEQ / 128;
constexpr float EPS = 1e-6f;
constexpr float QSCALE = 0.125f * 1.4426950408889634f;
constexpr float LOG2E = 1.4426950408889634f;
constexpr int NWAVES = 8, NTHREADS = 512;
constexpr size_t MiB = 1u << 20;
constexpr size_t WS_WGU1 = 0, WS_WGU2 = 11 * MiB, WS_WD1 = 22 * MiB, WS_WD2 = 28 * MiB, WS_WIN = 34 * MiB, WS_WOUT = 37 * MiB, WS_WPOOL = 39 * MiB, WS_CS = 40 * MiB;
constexpr size_t WS_CTL = 46 * MiB, CTL_BYTES = 262144, WS_RA = 47 * MiB;
constexpr size_t WS_Y = 48 * MiB, WS_HD = 112 * MiB, WS_H = 176 * MiB, WS_XR = 352 * MiB, WS_Z = 416 * MiB, WS_VT = 496 * MiB, WS_END = 504 * MiB;
static_assert((size_t)NGU * D * 2 <= 11 * MiB && (size_t)D * FF * 2 <= 6 * MiB && (size_t)NIN * D * 2 <= 3 * MiB && (size_t)M * 16 * 4 <= 6 * MiB, "ws map");
static_assert(WS_Y + (size_t)M * D * 2 <= WS_HD && WS_HD + (size_t)M * D * 2 <= WS_H && WS_H + (size_t)M * FF * 2 <= WS_XR && WS_XR + (size_t)M * D * 2 <= WS_Z && WS_Z + (size_t)M * NIN * 2 <= WS_VT && WS_VT + (size_t)M * 128 * 2 <= WS_END, "ws map 2");
constexpr int LDS_BYTES = 163840;
constexpr int KL_OFF = 0, KL_PITCH = 144, VL_OFF = 36864, VL_PITCH = 520, UL_OFF = 70144, UL_PITCH = 272, UL_ROWS = 143, DL_OFF = UL_OFF + 38912, DL_PITCH = 272;
constexpr int RAL_OFF = DL_OFF + 34816, ASTG_OFF = RAL_OFF + 512, MISC_OFF = ASTG_OFF + 16384;
static_assert(UL_ROWS * UL_PITCH <= 38912 && MISC_OFF >= 131072 && MISC_OFF + 128 <= LDS_BYTES && ASTG_OFF % 16 == 0 && DL_OFF % 16 == 0, "LDS map");

#define LAS __attribute__((address_space(3)))
typedef unsigned short bf16;
typedef unsigned u32x4 __attribute__((ext_vector_type(4)));
typedef unsigned u32x2 __attribute__((ext_vector_type(2)));
typedef float f32x4 __attribute__((ext_vector_type(4)));
typedef float f32x16 __attribute__((ext_vector_type(16)));
typedef short bf16x8 __attribute__((ext_vector_type(8)));
using pg8::cvtpk;
__device__ __forceinline__ float bflo(unsigned w) { return __uint_as_float(w << 16); }
__device__ __forceinline__ float bfhi(unsigned w) { return __uint_as_float(w & 0xffff0000u); }
__device__ __forceinline__ float wave_sum(float v) {
#pragma unroll
    for (int o = 1; o < 64; o <<= 1) v += __shfl_xor(v, o);
    return v;
}
__device__ __forceinline__ float half_sum32(float v) {
#pragma unroll
    for (int o = 1; o < 32; o <<= 1) v += __shfl_xor(v, o);
    return v;
}
__device__ __forceinline__ int crow(int r, int hi) { return (r & 3) + 8 * (r >> 2) + 4 * hi; }

struct Args {
    const float* x; const int* pos;
    const float *ffn1_pre, *ffn1_wgu, *ffn1_wd, *ffn1_post, *mix_pre, *w_in, *w_pool, *pool_scale, *sinks, *g_pool, *g_attn, *w_out, *mix_post, *ffn2_pre, *ffn2_wgu, *ffn2_wd, *ffn2_post;
    float* out; unsigned char* ws; int ph_lo, ph_hi;
};

__device__ __forceinline__ int dest_row(int mode, int n) {
    if (mode == 1) { return n < FF ? ((n >> 7) * 256 + (n & 127)) : ((((n - FF) >> 7) * 256) + 128 + ((n - FF) & 127)); }
    if (mode == 2) { if (n >= 512 && n < 1152) { const int d = n & 63; const int p = (d >= 4 && d < 8) ? d + 4 : ((d >= 8 && d < 12) ? d - 4 : d); return (n - d) + p; } return n; }
    return n;
}
__device__ __forceinline__ void transpose_item(const float* W, int K, int N, bf16* WT, int mode, LAS float* scr, int item, int lane, const float* gk = nullptr, const float* gk2 = nullptr, const float* gn = nullptr) {
    const int nblk = N / 32, kb = item / nblk, nb = item % nblk, k0 = 64 * kb, n0 = 32 * nb;
#pragma unroll 8
    for (int i = 0; i < 32; ++i) { const int kk = 2 * i + (lane >> 5); const int kr = k0 + kk; float gg = gk ? ((gk2 && kr >= 512) ? gk2[kr - 512] : gk[kr]) : 1.0f; if (gn) gg *= gn[n0 + (lane & 31)]; scr[kk * 33 + (lane & 31)] = W[(size_t)kr * N + n0 + (lane & 31)] * gg; }
    asm volatile("s_waitcnt lgkmcnt(0)" ::: "memory");
    const int c = lane & 7;
#pragma unroll
    for (int j = 0; j < 4; ++j) { const int n = (lane >> 3) + 8 * j; const LAS float* s = scr + (8 * c) * 33 + n;
        u32x4 o; o.x = cvtpk(s[0 * 33], s[1 * 33]); o.y = cvtpk(s[2 * 33], s[3 * 33]); o.z = cvtpk(s[4 * 33], s[5 * 33]); o.w = cvtpk(s[6 * 33], s[7 * 33]);
        *(u32x4*)(WT + (size_t)dest_row(mode, n0 + n) * K + k0 + 8 * c) = o; }
    asm volatile("s_waitcnt lgkmcnt(0)" ::: "memory");
}
__device__ __forceinline__ void sincos_f(float a, float& sn, float& cn) {
    const double ad = (double)a; const double q = __builtin_rint(ad * 0.63661977236758134308);
    const float r = (float)__builtin_fma(-q, 1.57079632679489661923, ad); const int qi = ((int)q) & 3;
    const float z = r * r;
    const float s = r + r * z * (-1.6666654611e-1f + z * (8.3321608736e-3f + z * (-1.9515295891e-4f)));
    const float c = 1.0f - 0.5f * z + z * z * (4.166664568298827e-2f + z * (-1.388731625493765e-3f + z * 2.443315711809948e-5f));
    sn = (qi == 0) ? s : (qi == 1) ? c : (qi == 2) ? -s : -c;
    cn = (qi == 0) ? c : (qi == 1) ? -s : (qi == 2) ? -c : s;
}
__device__ __forceinline__ float inv_freq(int i) {
    return i == 0 ? 1.0f : i == 1 ? 0.19392274474868576f : i == 2 ? 0.03760603093086393f : i == 3 ? 0.007292664737217109f : i == 4 ? 0.001414213562373095f : i == 5 ? 0.0002742481756762073f : i == 6 ? 5.318295896944988e-05f : 1.031338537721246e-05f;
}
__device__ __forceinline__ void prenorm_rows(const float* x, bf16* xb, float* rs, int gw, int NGW, int lane) {
    for (int m = gw; m < M; m += NGW) {
        const f32x4* xr = (const f32x4*)(x + (size_t)m * D) + lane; f32x4 v[4]; float s = 0.f;
#pragma unroll
        for (int j = 0; j < 4; ++j) { v[j] = xr[64 * j]; s += (v[j].x * v[j].x + v[j].y * v[j].y) + (v[j].z * v[j].z + v[j].w * v[j].w); }
        u32x2* o = (u32x2*)(xb + (size_t)m * D) + lane;
#pragma unroll
        for (int j = 0; j < 4; ++j) { u32x2 w; w.x = cvtpk(v[j].x, v[j].y); w.y = cvtpk(v[j].z, v[j].w); o[64 * j] = w; }
        const float r = 1.0f / sqrtf(wave_sum(s) * (1.0f / D) + EPS);
        if (lane == 0) rs[m] = r;
    }
}
template <bool HAS_A, bool XI_BF, bool XO_BF>
__device__ __forceinline__ void thin_rows(const void* xi, void* xo, const bf16* h, const float* gpost, float* rsout, float coef, int m0, int m1, int NGW, int lane) {
    for (int m = m0; m < m1; m += NGW) {
        const u32x2* hr = (const u32x2*)(h + (size_t)m * D) + lane;
        f32x4 v[4], hv[4]; float s = 0.f;
#pragma unroll
        for (int j = 0; j < 4; ++j) {
            if (XI_BF) { const u32x2 w = ((const u32x2*)((const bf16*)xi + (size_t)m * D) + lane)[64 * j]; v[j] = (f32x4){bflo(w.x), bfhi(w.x), bflo(w.y), bfhi(w.y)}; }
            else v[j] = ((const f32x4*)((const float*)xi + (size_t)m * D) + lane)[64 * j];
            const u32x2 w = hr[64 * j]; hv[j] = (f32x4){bflo(w.x), bfhi(w.x), bflo(w.y), bfhi(w.y)};
            s += (hv[j].x * hv[j].x + hv[j].y * hv[j].y) + (hv[j].z * hv[j].z + hv[j].w * hv[j].w); }
        const float r1 = coef / sqrtf(wave_sum(s) * (1.0f / D) + EPS);
        float s2 = 0.f;
#pragma unroll
        for (int j = 0; j < 4; ++j) { const f32x4 gp = *((const f32x4*)gpost + lane + 64 * j); v[j] = v[j] + hv[j] * r1 * gp;
            s2 += (v[j].x * v[j].x + v[j].y * v[j].y) + (v[j].z * v[j].z + v[j].w * v[j].w); }
#pragma unroll
        for (int j = 0; j < 4; ++j) {
            if (XO_BF) { u32x2 w; w.x = cvtpk(v[j].x, v[j].y); w.y = cvtpk(v[j].z, v[j].w); ((u32x2*)((bf16*)xo + (size_t)m * D) + lane)[64 * j] = w; }
            else ((f32x4*)((float*)xo + (size_t)m * D) + lane)[64 * j] = v[j]; }
        if (HAS_A) { const float r2 = 1.0f / sqrtf(wave_sum(s2) * (1.0f / D) + EPS); if (lane == 0) rsout[m] = r2; }
    }
}
#define XB_TMO      128
#define XB_XCNT(j)  (256  + 64 * (j))
#define XB_XSUB(j)  (1280 + 64 * (j))
#define XB_XGEN(j)  (2304 + 64 * (j))
#define XB_TOP      3328
#define XB_TOPGEN   3392
#define XCD_BAR_WORDS 3456
#define XB_SPIN_CAP (1u << 18)

__device__ __forceinline__ unsigned xb_ld(unsigned* p)              { return __hip_atomic_load(p, __ATOMIC_RELAXED, __HIP_MEMORY_SCOPE_AGENT); }
__device__ __forceinline__ unsigned xb_add(unsigned* p, unsigned v) { return __hip_atomic_fetch_add(p, v, __ATOMIC_RELAXED, __HIP_MEMORY_SCOPE_AGENT); }
__device__ __forceinline__ unsigned xb_xcc_id() { return (unsigned)__builtin_amdgcn_s_getreg((3 << 11) | 20) & 0xFu; }
#define XB_SPIN(cond, bar) do { unsigned _sp = 0; while (cond) { __builtin_amdgcn_s_sleep(1); \
    if ((++_sp & 255u) == 0u) { if (xb_ld(&(bar)[XB_TMO])) break; if (_sp > XB_SPIN_CAP) { atomicAdd(&(bar)[XB_TMO], 1u); break; } } } } while (0)

struct XcdBarrier {
    unsigned* bar; unsigned x; unsigned total;
    volatile LAS unsigned* st;
};

__device__ __forceinline__ XcdBarrier xcd_barrier_post(unsigned* bar, volatile LAS unsigned* st, unsigned total) {
    XcdBarrier b; b.bar = bar; b.x = xb_xcc_id(); b.st = st; b.total = total;
    if (threadIdx.x == 0) (void)xb_add(&bar[XB_XCNT(b.x)], 1u);
    return b;
}
__device__ __forceinline__ void xcd_barrier_complete(unsigned* bar, unsigned x, unsigned G, unsigned& nloc, unsigned& nx) {
    unsigned sum, cnt, mine, sp = 0u;
    for (;;) {
        sum = 0u; cnt = 0u; mine = 0u;
#pragma unroll
        for (unsigned j = 0; j < 16; ++j) { const unsigned c = xb_ld(&bar[XB_XCNT(j)]); sum += c; cnt += (c > 0u) ? 1u : 0u; mine = (j == x) ? c : mine; }
        if (sum == G) break;
        __builtin_amdgcn_s_sleep(1);
        if ((++sp & 255u) == 0u) { if (xb_ld(&bar[XB_TMO])) break; if (sp > XB_SPIN_CAP) { atomicAdd(&bar[XB_TMO], 1u); break; } }
    }
    nloc = mine > 0u ? mine : 1u; nx = cnt > 0u ? cnt : 1u;
}

__device__ __forceinline__ void xcd_barrier(const XcdBarrier& b) {
    asm volatile("s_waitcnt vmcnt(0)" ::: "memory");
    __syncthreads();
    if (threadIdx.x == 0) {
        unsigned* bar = b.bar;
        __builtin_amdgcn_s_waitcnt(0);
        unsigned nloc = b.st[0], nx = b.st[1];
        if (nloc == 0u) { xcd_barrier_complete(bar, b.x, b.total, nloc, nx); b.st[0] = nloc; b.st[1] = nx; }
        const unsigned old = xb_add(&bar[XB_XSUB(b.x)], 1u);
        const unsigned gen = old / nloc;
        if (old + 1u == (gen + 1u) * nloc) {
            if (nx > 1u) __builtin_amdgcn_fence(__ATOMIC_RELEASE, "agent");
            asm volatile("s_waitcnt vmcnt(0)" ::: "memory");
            const unsigned og = xb_add(&bar[XB_TOP], 1u);
            const unsigned tg = og / nx;
            if (og + 1u == (tg + 1u) * nx) xb_add(&bar[XB_TOPGEN], 1u);
            else XB_SPIN(xb_ld(&bar[XB_TOPGEN]) == tg, bar);
            __builtin_amdgcn_fence(__ATOMIC_ACQUIRE, "agent");
            xb_add(&bar[XB_XGEN(b.x)], 1u);
            asm volatile("s_waitcnt vmcnt(0)" ::: "memory");
        } else {
            XB_SPIN(xb_ld(&bar[XB_XGEN(b.x)]) == gen, bar);
            __builtin_amdgcn_fence(__ATOMIC_ACQUIRE, "agent");
            asm volatile("s_waitcnt vmcnt(0)" ::: "memory");
        }
    }
    __syncthreads();
}
#define MFMA32(a, b, c) __builtin_amdgcn_mfma_f32_32x32x16_bf16((a), (b), (c), 0, 0, 0)
__device__ __forceinline__ void load8(const bf16* p, float (&f)[8]) { const u32x4 w = *(const u32x4*)p;
    f[0] = bflo(w.x); f[1] = bfhi(w.x); f[2] = bflo(w.y); f[3] = bfhi(w.y); f[4] = bflo(w.z); f[5] = bfhi(w.z); f[6] = bflo(w.w); f[7] = bfhi(w.w); }

#define OPAQUE_V(x) asm volatile("" : "+v"(x))
#define OPAQUE_S(x) asm volatile("" : "+s"(x))
struct MixCtx { LAS unsigned char* lds; const bf16* Z; const bf16* Vt; const bf16* WpT; const float* pool_scale; const float* sinks; const float* g_pool; const float* g_attn; bf16* Y; float* RA; size_t rowbase; int b, n, htid, lane, hw; };

__device__ __forceinline__ void u_load(const MixCtx& c, int g, u32x4 (&pre)[9]) {
    int htid = c.htid; OPAQUE_V(htid);
#pragma unroll
    for (int k = 0; k < 9; ++k) { const int i = htid + 256 * k, jr = i >> 4, cc = i & 15; pre[k] = (u32x4){0u, 0u, 0u, 0u};
        if (jr < UL_ROWS && c.n * 128 + jr - 15 >= 0) pre[k] = *(const u32x4*)(c.Z + (ptrdiff_t)((ptrdiff_t)c.rowbase + jr - 15) * NIN + g * 128 + cc * 8); }
}
__device__ __forceinline__ void u_store(const MixCtx& c, const u32x4 (&pre)[9]) {
    int htid = c.htid; OPAQUE_V(htid);
#pragma unroll
    for (int k = 0; k < 9; ++k) { const int i = htid + 256 * k, jr = i >> 4, cc = i & 15; if (jr < UL_ROWS) *(LAS u32x4*)(c.lds + UL_OFF + jr * UL_PITCH + cc * 16) = pre[k]; }
}
template <int G> __device__ __forceinline__ void pool_D(const MixCtx& c) {
    constexpr int w = 2 << G;
    LAS unsigned char* lds = c.lds; int htid = c.htid; OPAQUE_V(htid);
    const int c8 = htid & 15, t0 = (htid >> 4) * 8;
    const LAS unsigned char* ub = lds + UL_OFF + (15 + t0) * UL_PITCH + c8 * 16;
    float s[8], uv[8];
#pragma unroll
    for (int i = 0; i < 8; ++i) s[i] = 0.f;
#define LDU(row) do { const u32x4 w_ = *(const LAS u32x4*)(ub + (row) * UL_PITCH); uv[0] = bflo(w_.x); uv[1] = bfhi(w_.x); uv[2] = bflo(w_.y); uv[3] = bfhi(w_.y); uv[4] = bflo(w_.z); uv[5] = bfhi(w_.z); uv[6] = bflo(w_.w); uv[7] = bfhi(w_.w); } while (0)
#pragma unroll
    for (int j = 1 - w; j < 0; ++j) { LDU(j);
#pragma unroll
        for (int i = 0; i < 8; ++i) s[i] += uv[i]; }
#pragma unroll
    for (int tt = 0; tt < 8; ++tt) { const int t = t0 + tt;
        LDU(tt);
#pragma unroll
        for (int i = 0; i < 8; ++i) s[i] += uv[i];
        const int sp = c.n * 128 + t; const int cnt = (sp + 1 < w) ? sp + 1 : w; const float inv = 1.0f / (float)cnt;
        u32x4 o; o.x = cvtpk(s[0] * inv - uv[0], s[1] * inv - uv[1]); o.y = cvtpk(s[2] * inv - uv[2], s[3] * inv - uv[3]);
        o.z = cvtpk(s[4] * inv - uv[4], s[5] * inv - uv[5]); o.w = cvtpk(s[6] * inv - uv[6], s[7] * inv - uv[7]);
        *(LAS u32x4*)(lds + DL_OFF + t * DL_PITCH + c8 * 16) = o;
        LDU(tt - w + 1);
#pragma unroll
        for (int i = 0; i < 8; ++i) s[i] -= uv[i]; }
#undef LDU
}
template <int G> __device__ __forceinline__ void pool_M(const MixCtx& c, f32x16& ssacc, unsigned (&kA)[16], unsigned (&kB)[16]) {
    LAS unsigned char* lds = c.lds; int lane_ = c.lane, hw = c.hw; OPAQUE_V(lane_); OPAQUE_S(hw);
    const int r32 = lane_ & 31, hi = lane_ >> 5;
#pragma unroll
    for (int j2 = 0; j2 < 2; ++j2) {
        f32x16 a0, a1;
#pragma unroll
        for (int i = 0; i < 16; ++i) { a0[i] = 0.f; a1[i] = 0.f; }
        const bf16* wp = c.WpT + (size_t)G * 16384 + (size_t)(64 * j2 + r32) * 128 + 8 * hi;
#pragma unroll
        for (int ks = 0; ks < 8; ++ks) {
            const bf16x8 A = *(const LAS bf16x8*)(lds + DL_OFF + (32 * hw + r32) * DL_PITCH + (16 * ks + 8 * hi) * 2);
            const bf16x8 B0 = *(const bf16x8*)(wp + 16 * ks), B1 = *(const bf16x8*)(wp + 32 * 128 + 16 * ks);
            a0 = MFMA32(A, B0, a0); a1 = MFMA32(A, B1, a1);
        }
#pragma unroll
        for (int r = 0; r < 16; ++r) { const float v0 = a0[r], v1 = a1[r];
            { float q_ = ssacc[r] + (v0 * v0 + v1 * v1); asm volatile("" : "+v"(q_)); ssacc[r] = q_; }
            unsigned pk_ = cvtpk(v0, v1); asm volatile("" : "+v"(pk_));
            if (j2 == 0) kA[r] = pk_; else kB[r] = pk_; }
        __builtin_amdgcn_sched_barrier(0);
    }
}
__device__ __forceinline__ void store_item(const MixCtx& c, LAS bf16* stg, const unsigned (&kp)[16], const float (&f)[16], int colbase) {
    int lane = c.lane; OPAQUE_V(lane); const int r32 = lane & 31, hi = lane >> 5;
#pragma unroll
    for (int r = 0; r < 16; ++r) { const int ro = (r & 3) + 8 * (r >> 2) + 4 * hi;
        stg[ro * 64 + r32] = (bf16)(cvtpk(bflo(kp[r]) * f[r], 0.f) & 0xffffu); stg[ro * 64 + 32 + r32] = (bf16)(cvtpk(bfhi(kp[r]) * f[r], 0.f) & 0xffffu); }
    asm volatile("s_waitcnt lgkmcnt(0)" ::: "memory");
    size_t yo = (c.rowbase + 32 * c.hw + (lane >> 3)) * D + colbase + (lane & 7) * 8; OPAQUE_V(yo); bf16* yb = c.Y + yo;
#pragma unroll
    for (int i = 0; i < 4; ++i) { const u32x4 v = *(const LAS u32x4*)(stg + (i * 8 + (lane >> 3)) * 64 + (lane & 7) * 8); *(u32x4*)(yb + (size_t)i * 8 * D) = v; }
    asm volatile("s_waitcnt lgkmcnt(0)" ::: "memory");
}
__device__ __forceinline__ void pool_half(const MixCtx& c) {
    f32x16 ssacc;
#pragma unroll
    for (int r = 0; r < 16; ++r) ssacc[r] = 0.f;
    unsigned a0[16], b0[16], a1[16], b1[16], a2[16], b2[16], a3[16], b3[16];
    __syncthreads();
    pool_D<0>(c); __syncthreads(); pool_M<0>(c, ssacc, a0, b0); __syncthreads();
    pool_D<1>(c); __syncthreads(); pool_M<1>(c, ssacc, a1, b1); __syncthreads();
    pool_D<2>(c); __syncthreads(); pool_M<2>(c, ssacc, a2, b2); __syncthreads();
    pool_D<3>(c); __syncthreads(); pool_M<3>(c, ssacc, a3, b3); __syncthreads();
    __syncthreads();
    int lane = c.lane; OPAQUE_V(lane); const int hi = lane >> 5;
    const LAS float* RAL = (const LAS float*)(c.lds + RAL_OFF);
    float f[16];
#pragma unroll
    for (int r = 0; r < 16; ++r) { const int ro = (r & 3) + 8 * (r >> 2) + 4 * hi; const float ss = half_sum32(ssacc[r]);
        f[r] = __builtin_amdgcn_rsqf(ss * (1.0f / 512.0f) + EPS) * __builtin_amdgcn_rcpf(RAL[32 * c.hw + ro]); }
    if (c.htid < 128) c.RA[c.rowbase + c.htid] = RAL[c.htid];
    LAS bf16* stg = (LAS bf16*)(c.lds + UL_OFF) + c.hw * 2048;
    store_item(c, stg, a0, f, 0); store_item(c, stg, b0, f, 64); store_item(c, stg, a1, f, 128); store_item(c, stg, b1, f, 192);
    store_item(c, stg, a2, f, 256); store_item(c, stg, b2, f, 320); store_item(c, stg, a3, f, 384); store_item(c, stg, b3, f, 448);
    __syncthreads();
}
template <int KH, int GI> __device__ __forceinline__ void att_item(const MixCtx& c, bf16x8 (&qr)[4], const bf16* qp, f32x16& ssacc) {
    LAS unsigned char* lds = c.lds; int lane_ = c.lane, rg = c.hw; OPAQUE_V(lane_); OPAQUE_S(rg);
    const int r32 = lane_ & 31, hi = lane_ >> 5, n = c.n;
    constexpr int h = KH * 4 + GI;
    f32x16 S[5];
#pragma unroll
    for (int t = 0; t < 5; ++t) {
#pragma unroll
        for (int i = 0; i < 16; ++i) S[t][i] = 0.f;
#pragma unroll
        for (int d0 = 0; d0 < 4; ++d0) { const bf16x8 kf = *(const LAS bf16x8*)(lds + KL_OFF + (32 * (rg + t) + r32) * KL_PITCH + (16 * d0 + 8 * hi) * 2);
            S[t] = MFMA32(kf, qr[d0], S[t]); }
        if (t & 1) __builtin_amdgcn_sched_barrier(0);
    }
    if (GI < 3) {
#pragma unroll
        for (int d0 = 0; d0 < 4; ++d0) qr[d0] = *(const bf16x8*)(qp + 64 * (GI + 1) + 16 * d0);
    }
    const float sinkl = c.sinks[h] * LOG2E;
    float mx = sinkl;
#pragma unroll
    for (int t = 0; t < 5; ++t)
#pragma unroll
        for (int r = 0; r < 16; ++r) {
            const bool tv = (n > 0) || (rg + t >= 4);
            const bool valid = (t == 0) ? (tv && (crow(r, hi) > r32)) : (t == 4) ? (crow(r, hi) <= r32) : tv;
            const float sv = valid ? S[t][r] : -1e30f; S[t][r] = sv; mx = fmaxf(mx, sv); }
    mx = fmaxf(mx, __shfl_xor(mx, 32));
    float sum = 0.f;
#pragma unroll
    for (int t = 0; t < 5; ++t)
#pragma unroll
        for (int r = 0; r < 16; ++r) { const float p = __builtin_amdgcn_exp2f(S[t][r] - mx); S[t][r] = p; sum += p; }
    sum += __shfl_xor(sum, 32);
    sum += __builtin_amdgcn_exp2f(sinkl - mx);
    const float linv = 1.0f / sum;
    f32x16 o0, o1;
#pragma unroll
    for (int i = 0; i < 16; ++i) { o0[i] = 0.f; o1[i] = 0.f; }
#pragma unroll
    for (int t = 0; t < 5; ++t)
#pragma unroll
        for (int s = 0; s < 2; ++s) {
            u32x4 pw; pw.x = cvtpk(S[t][8 * s + 0], S[t][8 * s + 1]); pw.y = cvtpk(S[t][8 * s + 2], S[t][8 * s + 3]); pw.z = cvtpk(S[t][8 * s + 4], S[t][8 * s + 5]); pw.w = cvtpk(S[t][8 * s + 6], S[t][8 * s + 7]);
            const bf16x8 pa = __builtin_bit_cast(bf16x8, pw);
            const int keyb = 32 * (rg + t) + 16 * s + 4 * hi;
            const LAS unsigned char* vb = lds + VL_OFF + r32 * VL_PITCH + keyb * 2;
            const u32x2 l0 = *(const LAS u32x2*)(vb), h0 = *(const LAS u32x2*)(vb + 16);
            const u32x2 l1 = *(const LAS u32x2*)(vb + 32 * VL_PITCH), h1 = *(const LAS u32x2*)(vb + 32 * VL_PITCH + 16);
            const bf16x8 v0 = __builtin_bit_cast(bf16x8, ((u32x4){l0.x, l0.y, h0.x, h0.y})), v1 = __builtin_bit_cast(bf16x8, ((u32x4){l1.x, l1.y, h1.x, h1.y}));
            o0 = MFMA32(pa, v0, o0); o1 = MFMA32(pa, v1, o1);
            if (s == 1) __builtin_amdgcn_sched_barrier(0);
        }
    LAS bf16* stg = (LAS bf16*)(lds + ASTG_OFF) + rg * 2048;
#pragma unroll
    for (int r = 0; r < 16; ++r) { const int ro = (r & 3) + 8 * (r >> 2) + 4 * hi; const float li = __shfl(linv, ro);
        const float v0 = o0[r] * li, v1 = o1[r] * li;
        { float q_ = ssacc[r] + (v0 * v0 + v1 * v1); asm volatile("" : "+v"(q_)); ssacc[r] = q_; }
        stg[ro * 64 + r32] = (bf16)(cvtpk(v0, 0.f) & 0xffffu); stg[ro * 64 + 32 + r32] = (bf16)(cvtpk(v1, 0.f) & 0xffffu); }
    asm volatile("s_waitcnt lgkmcnt(0)" ::: "memory");
    size_t yo = (c.rowbase + 32 * rg + (lane_ >> 3)) * D + 512 + h * 64 + (lane_ & 7) * 8; OPAQUE_V(yo); bf16* yb = c.Y + yo;
#pragma unroll
    for (int i = 0; i < 4; ++i) { const u32x4 v = *(const LAS u32x4*)(stg + (i * 8 + (lane_ >> 3)) * 64 + (lane_ & 7) * 8); *(u32x4*)(yb + (size_t)i * 8 * D) = v; }
    asm volatile("s_waitcnt lgkmcnt(0)" ::: "memory");
}
template <int KH> __device__ __forceinline__ void att_fill(const MixCtx& c, bf16x8 (&qr)[4], const bf16* qp) {
    LAS unsigned char* lds = c.lds; int htid = c.htid; OPAQUE_V(htid); const int n = c.n;
#pragma unroll
    for (int d0 = 0; d0 < 4; ++d0) qr[d0] = *(const bf16x8*)(qp + 16 * d0);
#pragma unroll
    for (int k = 0; k < 8; ++k) {
        const int i = htid + 256 * k, key = i >> 3, cc = i & 7; const bool valid = (n > 0) || (key >= 128);
        u32x4 v = (u32x4){0u, 0u, 0u, 0u};
        if (valid) v = *(const u32x4*)(c.Z + (c.rowbase + key - 128) * NIN + 1024 + KH * 64 + cc * 8);
        *(LAS u32x4*)(lds + KL_OFF + key * KL_PITCH + cc * 16) = v;
    }
#pragma unroll
    for (int k = 0; k < 8; ++k) {
        const int i = htid + 256 * k, d = i >> 5, cc = i & 31; const bool valid = (n > 0) || (cc >= 16);
        u32x4 v = (u32x4){0u, 0u, 0u, 0u};
        if (valid) v = *(const u32x4*)(c.Vt + ((size_t)((c.b * 2 + KH) * 64 + d)) * SEQ + n * 128 - 128 + cc * 8);
        LAS u32x2* dst = (LAS u32x2*)(lds + VL_OFF + d * VL_PITCH + cc * 16);
        dst[0] = (u32x2){v.x, v.y}; dst[1] = (u32x2){v.z, v.w};
    }
}
__device__ __forceinline__ void att_half(const MixCtx& c) {
    f32x16 ssacc;
#pragma unroll
    for (int r = 0; r < 16; ++r) ssacc[r] = 0.f;
    const bf16* qp0 = c.Z + (c.rowbase + 32 * c.hw + (c.lane & 31)) * NIN + 512 + 8 * (c.lane >> 5);
    const bf16* qp1 = qp0 + 256;
    bf16x8 qr[4]; u32x4 pre[9];
    u_load(c, 0, pre); att_fill<0>(c, qr, qp0); u_store(c, pre);            __syncthreads();
    u_load(c, 1, pre); att_item<0, 0>(c, qr, qp0, ssacc);                  __syncthreads();
    u_store(c, pre);   att_item<0, 1>(c, qr, qp0, ssacc);                  __syncthreads();
    u_load(c, 2, pre); att_item<0, 2>(c, qr, qp0, ssacc);                  __syncthreads();
    u_store(c, pre);   att_item<0, 3>(c, qr, qp0, ssacc);                  __syncthreads();
    u_load(c, 3, pre); att_fill<1>(c, qr, qp1);                            __syncthreads();
    u_store(c, pre);   att_item<1, 0>(c, qr, qp1, ssacc);                  __syncthreads();
    att_item<1, 1>(c, qr, qp1, ssacc);                                     __syncthreads();
    att_item<1, 2>(c, qr, qp1, ssacc);                                     __syncthreads();
    att_item<1, 3>(c, qr, qp1, ssacc);
    { int lane = c.lane; OPAQUE_V(lane); const int r32 = lane & 31, hi = lane >> 5; LAS float* RAL = (LAS float*)(c.lds + RAL_OFF);
#pragma unroll
      for (int r = 0; r < 16; ++r) { const int ro = (r & 3) + 8 * (r >> 2) + 4 * hi; const float ss = half_sum32(ssacc[r]);
          if (r32 == 0) RAL[32 * c.hw + ro] = __builtin_amdgcn_rsqf(ss * (1.0f / 512.0f) + EPS); } }
    __syncthreads();
    __syncthreads();
}
__device__ __forceinline__ void mixer_block(LAS unsigned char* lds, int blk, const bf16* Z, const bf16* Vt, const bf16* WpT, const float* pool_scale, const float* sinks,
                                            const float* g_pool, const float* g_attn, bf16* Y, float* RA, int tid, int wid, int lane) {
    OPAQUE_V(tid); OPAQUE_V(lane); OPAQUE_S(wid);
    MixCtx c; c.lds = lds; c.Z = Z; c.Vt = Vt; c.WpT = WpT; c.pool_scale = pool_scale; c.sinks = sinks; c.g_pool = g_pool; c.g_attn = g_attn; c.Y = Y; c.RA = RA; c.rowbase = (size_t)blk * 128;
    c.b = blk / NB_SEQ; c.n = blk % NB_SEQ; c.htid = tid & 255; c.lane = lane; c.hw = wid & 3;
    if (wid < 4) pool_half(c); else att_half(c);
}
__global__ void __launch_bounds__(NTHREADS, 2) hybrid_fwd(Args args) {
    extern __shared__ __attribute__((aligned(16))) unsigned char lds_raw[];
    LAS unsigned char* lds = (LAS unsigned char*)lds_raw;
    cg::grid_group grid = cg::this_grid();
    const int tid = threadIdx.x, lane = tid & 63, wid = __builtin_amdgcn_readfirstlane(tid >> 6);
    const int G = gridDim.x, bx = blockIdx.x;
    const int vcu = (G % 8 == 0) ? (bx % 8) * (G / 8) + bx / 8 : bx;
    const int gw = vcu * NWAVES + wid, NGW = G * NWAVES;
    unsigned char* ws = args.ws;
    bf16 *Wgu1 = (bf16*)(ws + WS_WGU1), *Wgu2 = (bf16*)(ws + WS_WGU2), *Wd1 = (bf16*)(ws + WS_WD1), *Wd2 = (bf16*)(ws + WS_WD2), *Win = (bf16*)(ws + WS_WIN), *Wout = (bf16*)(ws + WS_WOUT), *WpT = (bf16*)(ws + WS_WPOOL);
    float* CS = (float*)(ws + WS_CS);
    bf16 *HD = (bf16*)(ws + WS_HD), *H = (bf16*)(ws + WS_H), *Z = (bf16*)(ws + WS_Z), *Vt = (bf16*)(ws + WS_VT), *Y = (bf16*)(ws + WS_Y), *XR = (bf16*)(ws + WS_XR); float* RAg = (float*)(ws + WS_RA); float* RS = (float*)(ws + WS_RA + 512 * 1024);
    const int lo = args.ph_lo, hi = args.ph_hi;
#define IN(k) (lo <= (k) && (k) < hi)
#define SEAM(k) do { if (IN(k) && IN((k) + 1)) { if ((k) == 0) grid.sync(); else xcd_barrier(bar); } } while (0)
    if (tid < 32) ((LAS unsigned*)(lds + MISC_OFF))[tid] = 0u;
    __syncthreads();
    const int grp = bx & 7, gslot = bx >> 3, GW = G >> 3;
    unsigned* ctl = (unsigned*)(ws + WS_CTL);
    XcdBarrier bar; bar.bar = ctl + (1 + grp) * XCD_BAR_WORDS; bar.x = 0; bar.st = nullptr; bar.total = (unsigned)GW;
    const bool one_launch = (hi - lo > 1);
    const int grow0 = grp * (M / 8) + gslot * NWAVES + wid, grow1 = (grp + 1) * (M / 8);
    unsigned* halo_flag = ctl + 9 * XCD_BAR_WORDS;

    if (IN(0)) {
        for (int i = vcu * NTHREADS + tid; i < (int)(CTL_BYTES / 4); i += G * NTHREADS) __hip_atomic_store(ctl + i, 0u, __ATOMIC_RELAXED, __HIP_MEMORY_SCOPE_AGENT);
        LAS float* scr = (LAS float*)(lds + wid * 16384);
        constexpr int I_GU = (D / 64) * (NGU / 32), I_DN = (FF / 64) * (D / 32), I_IN = (D / 64) * (NIN / 32), I_OUT = (D / 64) * (D / 32), I_PL = 4 * 2 * 4;
        constexpr int NITEMS = 2 * I_GU + 2 * I_DN + I_IN + I_OUT + I_PL;
        for (int it = gw; it < NITEMS; it += NGW) {
            int r = it;
            if (r < I_GU) { transpose_item(args.ffn1_wgu, D, NGU, Wgu1, 1, scr, r, lane, args.ffn1_pre); continue; } r -= I_GU;
            if (r < I_GU) { transpose_item(args.ffn2_wgu, D, NGU, Wgu2, 1, scr, r, lane, args.ffn2_pre); continue; } r -= I_GU;
            if (r < I_DN) { transpose_item(args.ffn1_wd, FF, D, Wd1, 0, scr, r, lane); continue; } r -= I_DN;
            if (r < I_DN) { transpose_item(args.ffn2_wd, FF, D, Wd2, 0, scr, r, lane); continue; } r -= I_DN;
            if (r < I_IN) { transpose_item(args.w_in, D, NIN, Win, 2, scr, r, lane, args.mix_pre); continue; } r -= I_IN;
            if (r < I_OUT) { transpose_item(args.w_out, D, D, Wout, 0, scr, r, lane, args.g_pool, args.g_attn); continue; } r -= I_OUT;
            { const int g = r >> 3; transpose_item(args.w_pool + (size_t)g * 16384, 128, 128, WpT + (size_t)g * 16384, 0, scr, r & 7, lane, nullptr, nullptr, args.pool_scale + g * 128); }
        }
        for (int idx = vcu * NTHREADS + tid; idx < M * 8; idx += G * NTHREADS) {
            const int row = idx >> 3, i = idx & 7; const float ang = (float)args.pos[row] * inv_freq(i);
            float sn, cn; sincos_f(ang, sn, cn); CS[(size_t)row * 16 + i] = cn; CS[(size_t)row * 16 + 8 + i] = sn;
        }
        prenorm_rows(args.x, XR, RS, gw, NGW, lane);
    }
    SEAM(0);
    if (one_launch) bar = xcd_barrier_post(ctl + (1 + grp) * XCD_BAR_WORDS, (volatile LAS unsigned*)(lds + MISC_OFF) + 8, (unsigned)GW);
    if (IN(1)) {
        pg8::Gemm g{XR, Wgu1, M, NGU, D}; pg8::StaticOrder S; S.init(M, NGU, G, bx); pg8::EpiSwiGLU E{H, FF, RS};
        pg8::gemm_phase<pg8::EpiSwiGLU, pg8::StaticOrder, true, true>(lds, g, S, E);
    }
    SEAM(1);
    if (IN(2)) {
        pg8::Gemm g{H, Wd1, M, D, FF}; pg8::StaticOrder S; S.init(M, D, G, bx); pg8::EpiBf16<0> E{HD, D, nullptr, 0, 0, 1.f};
        pg8::gemm_phase<pg8::EpiBf16<0>, pg8::StaticOrder, true, true>(lds, g, S, E);
    }
    SEAM(2);
    if (IN(3)) thin_rows<true, false, true>(args.x, XR, HD, args.ffn1_post, RS, 0.5f, grow0, grow1, GW * NWAVES, lane);
    SEAM(3);
    if (IN(4)) {
        pg8::Gemm g{XR, Win, M, NIN, D}; pg8::StaticOrder S; S.init(M, NIN, G, bx); pg8::EpiZ E{Z, Vt, CS, QSCALE, SEQ, RS};
        pg8::gemm_phase<pg8::EpiZ, pg8::StaticOrder, true, true>(lds, g, S, E);
    }
    SEAM(4);
    if (IN(4) && IN(5)) { if (gslot == 0 && tid == 0) { __builtin_amdgcn_fence(__ATOMIC_RELEASE, "agent"); asm volatile("s_waitcnt vmcnt(0)" ::: "memory"); } __syncthreads(); if (gslot == 0 && tid == 0) __hip_atomic_store(halo_flag + 64 * grp, 1u, __ATOMIC_RELAXED, __HIP_MEMORY_SCOPE_AGENT); }
    if (IN(5)) { for (int blk = grp * (NBLK / 8) + gslot; blk < (grp + 1) * (NBLK / 8); blk += GW) {
        if (IN(4) && (blk % NB_SEQ) != 0 && (blk % (NBLK / 8)) == 0) {
            if (tid == 0) { unsigned sp = 0; while (__hip_atomic_load(halo_flag + 64 * (grp - 1), __ATOMIC_RELAXED, __HIP_MEMORY_SCOPE_AGENT) == 0u) { __builtin_amdgcn_s_sleep(2); if (++sp > (1u << 22)) break; }
                            __builtin_amdgcn_fence(__ATOMIC_ACQUIRE, "agent"); asm volatile("s_waitcnt vmcnt(0)" ::: "memory"); }
            __syncthreads(); }
        mixer_block(lds, blk, Z, Vt, WpT, args.pool_scale, args.sinks, args.g_pool, args.g_attn, Y, RAg, tid, wid, lane); } }
    SEAM(5);
    if (IN(6)) {
        pg8::Gemm g{Y, Wout, M, D, D}; pg8::StaticOrder S; S.init(M, D, G, bx); pg8::EpiRowScale E{HD, D, RAg};
        pg8::gemm_phase<pg8::EpiRowScale, pg8::StaticOrder, true, true>(lds, g, S, E);
    }
    SEAM(6);
    if (IN(7)) thin_rows<true, true, true>(XR, XR, HD, args.mix_post, RS, 1.0f, grow0, grow1, GW * NWAVES, lane);
    SEAM(7);
    if (IN(8)) {
        pg8::Gemm g{XR, Wgu2, M, NGU, D}; pg8::StaticOrder S; S.init(M, NGU, G, bx); pg8::EpiSwiGLU E{H, FF, RS};
        pg8::gemm_phase<pg8::EpiSwiGLU, pg8::StaticOrder, true, true>(lds, g, S, E);
    }
    SEAM(8);
    if (IN(9)) {
        pg8::Gemm g{H, Wd2, M, D, FF}; pg8::StaticOrder S; S.init(M, D, G, bx); pg8::EpiBf16<0> E{HD, D, nullptr, 0, 0, 1.f};
        pg8::gemm_phase<pg8::EpiBf16<0>, pg8::StaticOrder, true, true>(lds, g, S, E);
    }
    SEAM(9);
    if (IN(10)) thin_rows<false, true, false>(XR, args.out, HD, args.ffn2_post, nullptr, 0.5f, grow0, grow1, GW * NWAVES, lane);
#undef IN
#undef SEAM
}

#ifndef MK_N_LAUNCHES
#define MK_N_LAUNCHES 1
#endif
extern "C" void kernel_launch(void* const* d_in, const int* in_sizes, int n_in, void* d_out, int out_size, void* d_ws, size_t ws_size, hipStream_t stream) {
    static int grid = 0;
    if (grid == 0) {
        if (n_in != 19 || in_sizes[0] != M * D || out_size != M * D || ws_size < WS_END) { fprintf(stderr, "kernel_launch: unexpected shapes (n_in %d, in0 %d, out %d, ws %zu)\n", n_in, n_in > 0 ? in_sizes[0] : -1, out_size, ws_size); grid = -1; return; }
        int dev = 0, cus = 0, per_cu = 0;
        if (hipGetDevice(&dev) != hipSuccess || hipDeviceGetAttribute(&cus, hipDeviceAttributeMultiprocessorCount, dev) != hipSuccess) { grid = -1; return; }
        if (hipFuncSetAttribute((const void*)hybrid_fwd, hipFuncAttributeMaxDynamicSharedMemorySize, LDS_BYTES) != hipSuccess) { fprintf(stderr, "kernel_launch: hipFuncSetAttribute failed\n"); grid = -1; return; }
        if (hipOccupancyMaxActiveBlocksPerMultiprocessor(&per_cu, (const void*)hybrid_fwd, NTHREADS, LDS_BYTES) != hipSuccess || per_cu < 1) { fprintf(stderr, "kernel_launch: occupancy query says %d\n", per_cu); per_cu = 1; }
        (void)hipGetLastError();
        grid = (cus / 8) * 8;
    }
    if (grid < 0) return;
    Args a{};
    a.x = (const float*)d_in[0]; a.pos = (const int*)d_in[1];
    a.ffn1_pre = (const float*)d_in[2]; a.ffn1_wgu = (const float*)d_in[3]; a.ffn1_wd = (const float*)d_in[4]; a.ffn1_post = (const float*)d_in[5];
    a.mix_pre = (const float*)d_in[6]; a.w_in = (const float*)d_in[7]; a.w_pool = (const float*)d_in[8]; a.pool_scale = (const float*)d_in[9]; a.sinks = (const float*)d_in[10];
    a.g_pool = (const float*)d_in[11]; a.g_attn = (const float*)d_in[12]; a.w_out = (const float*)d_in[13]; a.mix_post = (const float*)d_in[14];
    a.ffn2_pre = (const float*)d_in[15]; a.ffn2_wgu = (const float*)d_in[16]; a.ffn2_wd = (const float*)d_in[17]; a.ffn2_post = (const float*)d_in[18];
    a.out = (float*)d_out; a.ws = (unsigned char*)d_ws;
    constexpr int NPH = 11;
#if MK_N_LAUNCHES == 1
    a.ph_lo = 0; a.ph_hi = NPH;
    { void* kargs[] = {&a}; hipError_t e = hipLaunchCooperativeKernel((const void*)hybrid_fwd, dim3(grid), dim3(NTHREADS), kargs, LDS_BYTES, stream);
      if (e != hipSuccess) fprintf(stderr, "kernel_launch: cooperative launch failed: %s (grid %d)\n", hipGetErrorString(e), grid); }
#else
    for (int p = 0; p < NPH; ++p) { a.ph_lo = p; a.ph_hi = p + 1; void* kargs[] = {&a};
        hipError_t e = hipLaunchCooperativeKernel((const void*)hybrid_fwd, dim3(grid), dim3(NTHREADS), kargs, LDS_BYTES, stream);
        if (e != hipSuccess) { fprintf(stderr, "kernel_launch: launch %d failed: %s\n", p, hipGetErrorString(e)); break; } }
#endif
}
```

```cpp
#include <hip/hip_runtime.h>
#include <hip/hip_cooperative_groups.h>
#include <cstdio>
#include <cstdint>
namespace cg = cooperative_groups;
namespace pg8 {
#define PG8_LAS __attribute__((address_space(3)))
typedef unsigned short bf16_t;
typedef short bf16x8 __attribute__((ext_vector_type(8)));
typedef float f32x4 __attribute__((ext_vector_type(4)));
typedef unsigned u32x4 __attribute__((ext_vector_type(4)));
constexpr int BM = 256, BK = 64, HALF = 128, HTB = HALF * BK * 2  , STAGE_BYTES = 8 * HTB, NXCD = 8, WGM = 8;

__host__ __device__ __forceinline__ int lds_byte(int r, int c) { const int st = (r >> 4) * 2 + (c >> 5), rr = r & 15, cc = c & 31, ob = rr * 64 + cc * 2; return st * 1024 + (ob ^ (((ob >> 9) & 1) << 5)); }
__host__ __device__ __forceinline__ void stage_rc(int b, int& R, int& C) { const int st = b / 1024, sb = b % 1024, swz = sb ^ (((sb >> 9) & 1) << 5); R = (st >> 1) * 16 + swz / 64; C = (st & 1) * 32 + (swz % 64) / 2; }
__host__ __device__ __forceinline__ int perm32(int rho) { const int n = rho >> 4, i = rho & 15; return 8 * (i >> 2) + 4 * n + (i & 3); }

struct Unit { int pm, pn; };
struct Gemm { const bf16_t* A; const bf16_t* Bt; int M, N, K; };

struct StaticOrder {
    int nM, nN, nwg, G, c;
    __host__ __device__ void init(int M, int N, int G_, int c_) { nM = M / BM; nN = N / BM; nwg = nM * nN; G = G_; c = c_; }
    __host__ __device__ bool next(int i, Unit& u) const {
        const long L = (long)i * G + c; if (L >= nwg) return false;
        int wgid = (int)L; { const int q = nwg / NXCD, r = nwg % NXCD, xcd = wgid % NXCD, off = wgid / NXCD; wgid = (xcd < r ? xcd * (q + 1) : r * (q + 1) + (xcd - r) * q) + off; }
        const int nig = WGM * nN, gid = wgid / nig, fm = gid * WGM, gsz = (nM - fm) < WGM ? (nM - fm) : WGM;
        u.pm = fm + ((wgid % nig) % gsz); u.pn = (wgid % nig) / gsz; return true;
    }
    __device__ __forceinline__ void a_ready(const Unit&) const {}
    __device__ __forceinline__ void done(const Unit&) const {}
};

__device__ __forceinline__ unsigned cvt_pk_bf16(float lo, float hi) { unsigned r; asm volatile("v_cvt_pk_bf16_f32 %0, %1, %2" : "=v"(r) : "v"(lo), "v"(hi)); return r; }
typedef float f32x2 __attribute__((ext_vector_type(2)));
__device__ __forceinline__ f32x2 gelu_pk(f32x2 v) {
    const f32x2 av = __builtin_elementwise_abs(v), d = av * 0.2316418882f + 1.0f;
    f32x2 t; t.x = __builtin_amdgcn_rcpf(d.x); t.y = __builtin_amdgcn_rcpf(d.y);
    f32x2 q = t * 0.5307027145f + (-0.7265760135f); q = q * t + 0.7107068705f; q = q * t + (-0.142248368f); q = q * t + 0.127414796f; q = q * t;
    const f32x2 s = (v * v) * (-0.72134752044f);
    f32x2 e; e.x = __builtin_amdgcn_exp2f(s.x); e.y = __builtin_amdgcn_exp2f(s.y);
    const f32x2 m = v * (q * e), r = v - m;
    f32x2 o; o.x = v.x < 0.f ? m.x : r.x; o.y = v.y < 0.f ? m.y : r.y; return o;
}

template <int ACT  > struct EpiBf16 {
    static constexpr bool PERM = true, AFTER_DRAIN = false; static_assert(ACT == 0 || ACT == 1, "EpiBf16: ACT is 0 (none) or 1 (gelu_pk)");
    bf16_t* O; int ldc; const float* bias; int split_cols; size_t split_stride; float scale0;
    __device__ __forceinline__ void operator()(const f32x4 (&acc)[2][2][4][2], const Unit& u, int wr, int wc, int fr, int fq) const {
        const int row0 = u.pm * BM + wr * 64 + fr; int colt = u.pn * BM; bf16_t* base = O;
        float sc = 1.f; if (split_cols) { const int t = colt / split_cols; base += (size_t)t * split_stride; colt -= t * split_cols; if (t == 0) sc = scale0; }
        const int col0 = colt + wc * 32 + 8 * fq, bcol0 = u.pn * BM + wc * 32 + 8 * fq;
        f32x4 bv[2][2];
#pragma unroll
        for (int bj = 0; bj < 2; ++bj)
#pragma unroll
            for (int n = 0; n < 2; ++n) bv[bj][n] = bias ? *(const f32x4*)(bias + bcol0 + bj * HALF + 4 * n) : (f32x4){0.f, 0.f, 0.f, 0.f};
#pragma unroll
        for (int ai = 0; ai < 2; ++ai)
#pragma unroll
            for (int m = 0; m < 4; ++m) { bf16_t* rowp = base + (size_t)(row0 + ai * HALF + m * 16) * ldc + col0;
#pragma unroll
                for (int bj = 0; bj < 2; ++bj) { f32x4 v0 = acc[ai][bj][m][0] + bv[bj][0], v1 = acc[ai][bj][m][1] + bv[bj][1];
                    if (ACT == 1) { f32x2 a = gelu_pk((f32x2){v0[0], v0[1]}), b = gelu_pk((f32x2){v0[2], v0[3]}), c = gelu_pk((f32x2){v1[0], v1[1]}), d = gelu_pk((f32x2){v1[2], v1[3]});
                        v0 = (f32x4){a.x, a.y, b.x, b.y}; v1 = (f32x4){c.x, c.y, d.x, d.y}; }
                    v0 = v0 * sc; v1 = v1 * sc; u32x4 w; w.x = cvt_pk_bf16(v0[0], v0[1]); w.y = cvt_pk_bf16(v0[2], v0[3]); w.z = cvt_pk_bf16(v1[0], v1[1]); w.w = cvt_pk_bf16(v1[2], v1[3]);
                    *(u32x4*)(rowp + bj * HALF) = w; } }
    }
};
typedef __bf16 bf16x2_t __attribute__((ext_vector_type(2)));
__device__ __forceinline__ unsigned cvtpk(float lo, float hi) { f32x2 v = {lo, hi}; bf16x2_t b = __builtin_convertvector(v, bf16x2_t); return __builtin_bit_cast(unsigned, b); }
__device__ __forceinline__ float silu_mul(float g, float u) { const float e = __builtin_amdgcn_exp2f(-1.4426950408889634f * g); return g * __builtin_amdgcn_rcpf(1.0f + e) * u; }

struct EpiSwiGLU {
    static constexpr bool PERM = true, AFTER_DRAIN = false;
    bf16_t* O; int ldc; const float* rs;
    __device__ __forceinline__ void operator()(const f32x4 (&acc)[2][2][4][2], const Unit& u, int wr, int wc, int fr, int fq) const {
        const int row0 = u.pm * BM + wr * 64 + fr, col0 = u.pn * HALF + wc * 32 + 8 * fq;
#pragma unroll
        for (int ai = 0; ai < 2; ++ai)
#pragma unroll
            for (int m = 0; m < 4; ++m) { const int row = row0 + ai * HALF + m * 16; bf16_t* rowp = O + (size_t)row * ldc + col0; const float r = rs[row];
                const f32x4 g0 = acc[ai][0][m][0] * r, g1 = acc[ai][0][m][1] * r, u0 = acc[ai][1][m][0] * r, u1 = acc[ai][1][m][1] * r;
                u32x4 w; w.x = cvtpk(silu_mul(g0[0], u0[0]), silu_mul(g0[1], u0[1])); w.y = cvtpk(silu_mul(g0[2], u0[2]), silu_mul(g0[3], u0[3]));
                w.z = cvtpk(silu_mul(g1[0], u1[0]), silu_mul(g1[1], u1[1])); w.w = cvtpk(silu_mul(g1[2], u1[2]), silu_mul(g1[3], u1[3]));
                *(u32x4*)rowp = w; }
    }
};
struct EpiRowScale {
    static constexpr bool PERM = true, AFTER_DRAIN = false;
    bf16_t* O; int ldc; const float* rs;
    __device__ __forceinline__ void operator()(const f32x4 (&acc)[2][2][4][2], const Unit& u, int wr, int wc, int fr, int fq) const {
        const int row0 = u.pm * BM + wr * 64 + fr, col0 = u.pn * BM + wc * 32 + 8 * fq;
#pragma unroll
        for (int ai = 0; ai < 2; ++ai)
#pragma unroll
            for (int m = 0; m < 4; ++m) { const int row = row0 + ai * HALF + m * 16; const float sc = rs[row]; bf16_t* rowp = O + (size_t)row * ldc + col0;
#pragma unroll
                for (int bj = 0; bj < 2; ++bj) { const f32x4 v0 = acc[ai][bj][m][0] * sc, v1 = acc[ai][bj][m][1] * sc;
                    u32x4 w; w.x = cvtpk(v0[0], v0[1]); w.y = cvtpk(v0[2], v0[3]); w.z = cvtpk(v1[0], v1[1]); w.w = cvtpk(v1[2], v1[3]);
                    *(u32x4*)(rowp + bj * HALF) = w; } }
    }
};
struct EpiZ {
    static constexpr bool PERM = true, AFTER_DRAIN = false;
    bf16_t* Z; bf16_t* Vt; const float* cs; float qscale; int seq; const float* rs;
    __device__ __forceinline__ void operator()(const f32x4 (&acc)[2][2][4][2], const Unit& u, int wr, int wc, int fr, int fq) const {
        const int row0 = u.pm * BM + wr * 64 + fr, cl = wc * 32 + 8 * fq;
#pragma unroll
        for (int bj = 0; bj < 2; ++bj) {
            const int colh = u.pn * BM + bj * HALF;
            const bool isV = (colh == 1152);
            const bool rope = (colh >= 512) && (colh < 1152) && ((wc & 1) == 0) && (fq < 2);
            const float sc = (colh >= 512 && colh < 1024) ? qscale : 1.0f;
#pragma unroll
            for (int ai = 0; ai < 2; ++ai)
#pragma unroll
                for (int m = 0; m < 4; ++m) { const int row = row0 + ai * HALF + m * 16;
                    const float r = rs[row];
                    f32x4 v0 = acc[ai][bj][m][0] * r, v1 = acc[ai][bj][m][1] * r;
                    if (isV) {
                        const int b = row / seq, s = row - b * seq;
#pragma unroll
                        for (int i = 0; i < 4; ++i) { const int c0 = cl + i, c1 = cl + 4 + i;
                            Vt[((size_t)((b * 2 + (c0 >> 6)) * 64 + (c0 & 63))) * seq + s] = (bf16_t)(cvtpk(v0[i], 0.f) & 0xffffu);
                            Vt[((size_t)((b * 2 + (c1 >> 6)) * 64 + (c1 & 63))) * seq + s] = (bf16_t)(cvtpk(v1[i], 0.f) & 0xffffu); }
                    } else {
                        if (rope) { const f32x4 c = *(const f32x4*)(cs + (size_t)row * 16 + 4 * fq), sn = *(const f32x4*)(cs + (size_t)row * 16 + 8 + 4 * fq);
                            const f32x4 n0 = v0 * c - v1 * sn, n1 = v1 * c + v0 * sn; v0 = n0; v1 = n1; }
                        v0 = v0 * sc; v1 = v1 * sc;
                        u32x4 w; w.x = cvtpk(v0[0], v0[1]); w.y = cvtpk(v0[2], v0[3]); w.z = cvtpk(v1[0], v1[1]); w.w = cvtpk(v1[2], v1[3]);
                        *(u32x4*)(Z + (size_t)row * 1280 + colh + cl) = w; }
                }
        }
    }
};
template <class Epi, class Sched, bool ALIGN_EPI = false, bool SP2 = false>
__device__ __forceinline__ void gemm_phase(PG8_LAS unsigned char* lds, const Gemm g, const Sched& S, const Epi& E) {
    const int tid = threadIdx.x, wid = __builtin_amdgcn_readfirstlane(tid >> 6), lane = tid & 63, wr = wid >> 2, wc = wid & 3, fr = lane & 15, fq = lane >> 4;
    const int K = g.K, nt = K / BK;
    unsigned voffA[2], voffB[2];
#pragma unroll
    for (int i = 0; i < 2; ++i) { int R, C; stage_rc(tid * 16 + i * 8192, R, C); const int Rb = Epi::PERM ? ((R & ~31) + perm32(R & 31)) : R;
        voffA[i] = (unsigned)(R * K + C) * 2u; voffB[i] = (unsigned)(Rb * K + C) * 2u; }
    const size_t kstep = (size_t)(BK * 2);
    const size_t hstep = (size_t)HALF * K * 2;
    const size_t tstep = 2 * hstep;
    const unsigned ldsw = (unsigned)wid * 1024u;
    const int aoff = lds_byte(wr * 64 + fr, fq * 8), boff = lds_byte(wc * 32 + fr, fq * 8);
#define PG8_SA(b, h) (((b) * 2 + (h)) * HTB)
#define PG8_SB(b, h) ((4 + (b) * 2 + (h)) * HTB)
#define PG8_STAGE(bufoff, gbase, voff) do { _Pragma("unroll") for (int _i = 0; _i < 2; ++_i) \
        __builtin_amdgcn_global_load_lds((const unsigned*)((const char*)(gbase) + (voff)[_i]), (PG8_LAS unsigned*)(lds + (bufoff) + ldsw + _i * 8192), 16, 0, 0); } while (0)
#define PG8_LDA(dst, b, h) do { _Pragma("unroll") for (int m = 0; m < 4; ++m) _Pragma("unroll") for (int k = 0; k < 2; ++k) dst[m][k] = *(const PG8_LAS bf16x8*)(lds + PG8_SA(b, h) + aoff + m * 2048 + k * 1024); } while (0)
#define PG8_LDB(dst, b, h) do { _Pragma("unroll") for (int n = 0; n < 2; ++n) _Pragma("unroll") for (int k = 0; k < 2; ++k) dst[n][k] = *(const PG8_LAS bf16x8*)(lds + PG8_SB(b, h) + boff + n * 2048 + k * 1024); } while (0)
#define PG8_MMA(ai, bj, At, Bt) do { __builtin_amdgcn_s_setprio(1); _Pragma("unroll") for (int m = 0; m < 4; ++m) _Pragma("unroll") for (int n = 0; n < 2; ++n) _Pragma("unroll") for (int k = 0; k < 2; ++k) \
        acc[ai][bj][m][n] = __builtin_amdgcn_mfma_f32_16x16x32_bf16(Bt[n][k], At[m][k], acc[ai][bj][m][n], 0, 0, 0); __builtin_amdgcn_s_setprio(0); } while (0)
#define PG8_WAIT_V(n) asm volatile("s_waitcnt vmcnt(" #n ")" ::: "memory")
#define PG8_WAIT_L(n) asm volatile("s_waitcnt lgkmcnt(" #n ")" ::: "memory")
#define PG8_BAR __builtin_amdgcn_s_barrier()
#define PG8_SCHED __builtin_amdgcn_sched_barrier(0)
    Unit cur, nxt; int ui = 0;
    if (!S.next(0, cur)) return;
    f32x4 acc[2][2][4][2];
#pragma unroll
    for (int a = 0; a < 2; ++a)
#pragma unroll
        for (int b = 0; b < 2; ++b)
#pragma unroll
            for (int m = 0; m < 4; ++m)
#pragma unroll
                for (int n = 0; n < 2; ++n) acc[a][b][m][n] = (f32x4){0.f, 0.f, 0.f, 0.f};
    bf16x8 At[4][2], B0[2][2], B1[2][2];
    const char* cA = (const char*)g.A + (size_t)cur.pm * tstep; const char* cB = (const char*)g.Bt + (size_t)cur.pn * tstep;
    S.a_ready(cur);
    if constexpr (SP2) {
        PG8_STAGE(PG8_SB(0, 0), cB, voffB); PG8_STAGE(PG8_SB(0, 1), cB + hstep, voffB); PG8_STAGE(PG8_SA(0, 0), cA, voffA); PG8_STAGE(PG8_SA(0, 1), cA + hstep, voffA);
        if (wr == 1) PG8_BAR;
        PG8_WAIT_V(2); PG8_BAR;
        PG8_STAGE(PG8_SB(1, 0), cB + kstep, voffB); PG8_STAGE(PG8_SA(1, 0), cA + kstep, voffA); PG8_STAGE(PG8_SB(1, 1), cB + hstep + kstep, voffB);
        PG8_WAIT_V(6); PG8_BAR;
    } else {
        PG8_STAGE(PG8_SB(0, 0), cB, voffB); PG8_STAGE(PG8_SA(0, 0), cA, voffA); PG8_STAGE(PG8_SB(0, 1), cB + hstep, voffB); PG8_STAGE(PG8_SA(0, 1), cA + hstep, voffA);
        if (wr == 1) PG8_BAR;
        PG8_WAIT_V(4); PG8_BAR;
        PG8_STAGE(PG8_SB(1, 0), cB + kstep, voffB); PG8_STAGE(PG8_SA(1, 0), cA + kstep, voffA); PG8_STAGE(PG8_SB(1, 1), cB + hstep + kstep, voffB);
        PG8_WAIT_V(6); PG8_BAR;
    }
    for (;;) {
        const bool has_next = S.next(ui + 1, nxt);
        const char* nA = has_next ? (const char*)g.A + (size_t)nxt.pm * tstep : cA; const char* nB = has_next ? (const char*)g.Bt + (size_t)nxt.pn * tstep : cB;
        for (int t = 0; t < nt; t += 2) {
            const bool last = (t == nt - 2);
            const char* a1 = cA + (size_t)(t + 1) * kstep;
            const char* a2 = last ? nA : cA + (size_t)(t + 2) * kstep; const char* b2 = last ? nB : cB + (size_t)(t + 2) * kstep;
            const char* a3 = a2 + kstep; const char* b3 = b2 + kstep;
            if (last && has_next) S.a_ready(nxt);
            if constexpr (SP2) {
            PG8_LDB(B0, 0, 0); PG8_LDB(B1, 0, 1); PG8_SCHED; PG8_LDA(At, 0, 0); PG8_STAGE(PG8_SA(1, 1), a1 + hstep, voffA);
            PG8_WAIT_V(8); PG8_WAIT_L(0); PG8_BAR; PG8_MMA(0, 0, At, B0); PG8_MMA(0, 1, At, B1); PG8_BAR; PG8_SCHED;
            PG8_LDA(At, 0, 1); PG8_STAGE(PG8_SB(0, 0), b2, voffB); PG8_STAGE(PG8_SB(0, 1), b2 + hstep, voffB); PG8_STAGE(PG8_SA(0, 0), a2, voffA);
            PG8_WAIT_V(8); PG8_WAIT_L(0); PG8_BAR; PG8_MMA(1, 0, At, B0); PG8_MMA(1, 1, At, B1); PG8_BAR; PG8_SCHED;
            PG8_LDB(B0, 1, 0); PG8_LDB(B1, 1, 1); PG8_SCHED; PG8_LDA(At, 1, 0); PG8_STAGE(PG8_SA(0, 1), a2 + hstep, voffA);
            PG8_WAIT_V(8); PG8_WAIT_L(0); PG8_BAR; PG8_MMA(0, 0, At, B0); PG8_MMA(0, 1, At, B1); PG8_BAR; PG8_SCHED;
            PG8_LDA(At, 1, 1); PG8_STAGE(PG8_SB(1, 0), b3, voffB); PG8_STAGE(PG8_SB(1, 1), b3 + hstep, voffB); PG8_STAGE(PG8_SA(1, 0), a3, voffA);
            PG8_WAIT_V(8); PG8_WAIT_L(0); PG8_BAR; PG8_MMA(1, 0, At, B0); PG8_MMA(1, 1, At, B1); PG8_BAR; PG8_SCHED;
            } else {
            PG8_LDB(B0, 0, 0); PG8_SCHED; PG8_LDA(At, 0, 0); PG8_STAGE(PG8_SA(1, 1), a1 + hstep, voffA);
            PG8_WAIT_L(8); PG8_BAR; PG8_WAIT_L(0); PG8_MMA(0, 0, At, B0); PG8_BAR; PG8_SCHED;
            PG8_LDB(B1, 0, 1); PG8_STAGE(PG8_SB(0, 0), b2, voffB);
            PG8_BAR; PG8_WAIT_L(0); PG8_MMA(0, 1, At, B1); PG8_BAR;
            PG8_LDA(At, 0, 1); PG8_STAGE(PG8_SA(0, 0), a2, voffA);
            PG8_BAR; PG8_WAIT_L(0); PG8_MMA(1, 0, At, B0); PG8_BAR; PG8_SCHED;
            PG8_STAGE(PG8_SB(0, 1), b2 + hstep, voffB);
            PG8_WAIT_V(6); PG8_BAR; PG8_MMA(1, 1, At, B1); PG8_BAR;
            PG8_LDB(B0, 1, 0); PG8_SCHED; PG8_LDA(At, 1, 0); PG8_STAGE(PG8_SA(0, 1), a2 + hstep, voffA);
            PG8_WAIT_L(8); PG8_BAR; PG8_WAIT_L(0); PG8_MMA(0, 0, At, B0); PG8_BAR; PG8_SCHED;
            PG8_LDB(B1, 1, 1); PG8_STAGE(PG8_SB(1, 0), b3, voffB);
            PG8_BAR; PG8_WAIT_L(0); PG8_MMA(0, 1, At, B1); PG8_BAR;
            PG8_LDA(At, 1, 1); PG8_STAGE(PG8_SA(1, 0), a3, voffA);
            PG8_BAR; PG8_WAIT_L(0); PG8_MMA(1, 0, At, B0); PG8_BAR; PG8_SCHED;
            PG8_STAGE(PG8_SB(1, 1), b3 + hstep, voffB);
            PG8_WAIT_V(6); PG8_BAR; PG8_MMA(1, 1, At, B1); PG8_BAR;
            }
        }
        if constexpr (ALIGN_EPI) { if (wr == 0) PG8_BAR; }
        if constexpr (!Epi::AFTER_DRAIN) { E(acc, cur, wr, wc, fr, fq); S.done(cur); }
        if (!has_next) break;
#pragma unroll
        for (int a = 0; a < 2; ++a)
#pragma unroll
            for (int b = 0; b < 2; ++b)
#pragma unroll
                for (int m = 0; m < 4; ++m)
#pragma unroll
                    for (int n = 0; n < 2; ++n) acc[a][b][m][n] = (f32x4){0.f, 0.f, 0.f, 0.f};
        cur = nxt; cA = nA; cB = nB; ++ui;
        if constexpr (ALIGN_EPI) { if (wr == 1) PG8_BAR; }
    }
    PG8_WAIT_V(0);
    if constexpr (!ALIGN_EPI) { if (wr == 0) PG8_BAR; }
    PG8_BAR;
    if constexpr (Epi::AFTER_DRAIN) { E.fused(acc, cur, wr, wc, fr, fq, lds, wid, lane); S.done(cur); }
#undef PG8_SA
#undef PG8_SB
#undef PG8_STAGE
#undef PG8_LDA
#undef PG8_LDB
#undef PG8_MMA
#undef PG8_WAIT_V
#undef PG8_WAIT_L
#undef PG8_BAR
#undef PG8_SCHED
}
}
constexpr int BATCH = 4, SEQ = 8192, D = 1024, M = BATCH * SEQ, FF = 2816, NGU = 2 * FF, NIN = 1280, NBLK = M / 128, NB_SEQ = SEQ / 128;
constexpr float EPS = 1e-6f;
constexpr float QSCALE = 0.125f * 1.4426950408889634f;
constexpr float LOG2E = 1.4426950408889634f;
constexpr int NWAVES = 8, NTHREADS = 512;
constexpr size_t MiB = 1u << 20;
constexpr size_t WS_WGU1 = 0, WS_WGU2 = 11 * MiB, WS_WD1 = 22 * MiB, WS_WD2 = 28 * MiB, WS_WIN = 34 * MiB, WS_WOUT = 37 * MiB, WS_WPOOL = 39 * MiB, WS_CS = 40 * MiB;
constexpr size_t WS_CTL = 46 * MiB, CTL_BYTES = 262144, WS_RA = 47 * MiB;
constexpr size_t WS_Y = 48 * MiB, WS_HD = 112 * MiB, WS_H = 176 * MiB, WS_XR = 352 * MiB, WS_Z = 416 * MiB, WS_VT = 496 * MiB, WS_END = 504 * MiB;
static_assert((size_t)NGU * D * 2 <= 11 * MiB && (size_t)D * FF * 2 <= 6 * MiB && (size_t)NIN * D * 2 <= 3 * MiB && (size_t)M * 16 * 4 <= 6 * MiB, "ws map");
static_assert(WS_Y + (size_t)M * D * 2 <= WS_HD && WS_HD + (size_t)M * D * 2 <= WS_H && WS_H + (size_t)M * FF * 2 <= WS_XR && WS_XR + (size_t)M * D * 2 <= WS_Z && WS_Z + (size_t)M * NIN * 2 <= WS_VT && WS_VT + (size_t)M * 128 * 2 <= WS_END, "ws map 2");
constexpr int LDS_BYTES = 163840;
constexpr int KL_OFF = 0, KL_PITCH = 144, VL_OFF = 36864, VL_PITCH = 520, UL_OFF = 70144, UL_PITCH = 272, UL_ROWS = 143, DL_OFF = UL_OFF + 38912, DL_PITCH = 272;
constexpr int RAL_OFF = DL_OFF + 34816, ASTG_OFF = RAL_OFF + 512, MISC_OFF = ASTG_OFF + 16384;
static_assert(UL_ROWS * UL_PITCH <= 38912 && MISC_OFF >= 131072 && MISC_OFF + 128 <= LDS_BYTES && ASTG_OFF % 16 == 0 && DL_OFF % 16 == 0, "LDS map");

#define LAS __attribute__((address_space(3)))
typedef unsigned short bf16;
typedef unsigned u32x4 __attribute__((ext_vector_type(4)));
typedef unsigned u32x2 __attribute__((ext_vector_type(2)));
typedef float f32x4 __attribute__((ext_vector_type(4)));
typedef float f32x16 __attribute__((ext_vector_type(16)));
typedef short bf16x8 __attribute__((ext_vector_type(8)));
using pg8::cvtpk;
__device__ __forceinline__ float bflo(unsigned w) { return __uint_as_float(w << 16); }
__device__ __forceinline__ float bfhi(unsigned w) { return __uint_as_float(w & 0xffff0000u); }
__device__ __forceinline__ float wave_sum(float v) {
#pragma unroll
    for (int o = 1; o < 64; o <<= 1) v += __shfl_xor(v, o);
    return v;
}
__device__ __forceinline__ float half_sum32(float v) {
#pragma unroll
    for (int o = 1; o < 32; o <<= 1) v += __shfl_xor(v, o);
    return v;
}
__device__ __forceinline__ int crow(int r, int hi) { return (r & 3) + 8 * (r >> 2) + 4 * hi; }

struct Args {
    const float* x; const int* pos;
    const float *ffn1_pre, *ffn1_wgu, *ffn1_wd, *ffn1_post, *mix_pre, *w_in, *w_pool, *pool_scale, *sinks, *g_pool, *g_attn, *w_out, *mix_post, *ffn2_pre, *ffn2_wgu, *ffn2_wd, *ffn2_post;
    float* out; unsigned char* ws; int ph_lo, ph_hi;
};

__device__ __forceinline__ int dest_row(int mode, int n) {
    if (mode == 1) { return n < FF ? ((n >> 7) * 256 + (n & 127)) : ((((n - FF) >> 7) * 256) + 128 + ((n - FF) & 127)); }
    if (mode == 2) { if (n >= 512 && n < 1152) { const int d = n & 63; const int p = (d >= 4 && d < 8) ? d + 4 : ((d >= 8 && d < 12) ? d - 4 : d); return (n - d) + p; } return n; }
    return n;
}
__device__ __forceinline__ void transpose_item(const float* W, int K, int N, bf16* WT, int mode, LAS float* scr, int item, int lane, const float* gk = nullptr, const float* gk2 = nullptr, const float* gn = nullptr) {
    const int nblk = N / 32, kb = item / nblk, nb = item % nblk, k0 = 64 * kb, n0 = 32 * nb;
#pragma unroll 8
    for (int i = 0; i < 32; ++i) { const int kk = 2 * i + (lane >> 5); const int kr = k0 + kk; float gg = gk ? ((gk2 && kr >= 512) ? gk2[kr - 512] : gk[kr]) : 1.0f; if (gn) gg *= gn[n0 + (lane & 31)]; scr[kk * 33 + (lane & 31)] = W[(size_t)kr * N + n0 + (lane & 31)] * gg; }
    asm volatile("s_waitcnt lgkmcnt(0)" ::: "memory");
    const int c = lane & 7;
#pragma unroll
    for (int j = 0; j < 4; ++j) { const int n = (lane >> 3) + 8 * j; const LAS float* s = scr + (8 * c) * 33 + n;
        u32x4 o; o.x = cvtpk(s[0 * 33], s[1 * 33]); o.y = cvtpk(s[2 * 33], s[3 * 33]); o.z = cvtpk(s[4 * 33], s[5 * 33]); o.w = cvtpk(s[6 * 33], s[7 * 33]);
        *(u32x4*)(WT + (size_t)dest_row(mode, n0 + n) * K + k0 + 8 * c) = o; }
    asm volatile("s_waitcnt lgkmcnt(0)" ::: "memory");
}
__device__ __forceinline__ void sincos_f(float a, float& sn, float& cn) {
    const double ad = (double)a; const double q = __builtin_rint(ad * 0.63661977236758134308);
    const float r = (float)__builtin_fma(-q, 1.57079632679489661923, ad); const int qi = ((int)q) & 3;
    const float z = r * r;
    const float s = r + r * z * (-1.6666654611e-1f + z * (8.3321608736e-3f + z * (-1.9515295891e-4f)));
    const float c = 1.0f - 0.5f * z + z * z * (4.166664568298827e-2f + z * (-1.388731625493765e-3f + z * 2.443315711809948e-5f));
    sn = (qi == 0) ? s : (qi == 1) ? c : (qi == 2) ? -s : -c;
    cn = (qi == 0) ? c : (qi == 1) ? -s : (qi == 2) ? -c : s;
}
__device__ __forceinline__ float inv_freq(int i) {
    return i == 0 ? 1.0f : i == 1 ? 0.19392274474868576f : i == 2 ? 0.03760603093086393f : i == 3 ? 0.007292664737217109f : i == 4 ? 0.001414213562373095f : i == 5 ? 0.0002742481756762073f : i == 6 ? 5.318295896944988e-05f : 1.031338537721246e-05f;
}
__device__ __forceinline__ void prenorm_rows(const float* x, bf16* xb, float* rs, int gw, int NGW, int lane) {
    for (int m = gw; m < M; m += NGW) {
        const f32x4* xr = (const f32x4*)(x + (size_t)m * D) + lane; f32x4 v[4]; float s = 0.f;
#pragma unroll
        for (int j = 0; j < 4; ++j) { v[j] = xr[64 * j]; s += (v[j].x * v[j].x + v[j].y * v[j].y) + (v[j].z * v[j].z + v[j].w * v[j].w); }
        u32x2* o = (u32x2*)(xb + (size_t)m * D) + lane;
#pragma unroll
        for (int j = 0; j < 4; ++j) { u32x2 w; w.x = cvtpk(v[j].x, v[j].y); w.y = cvtpk(v[j].z, v[j].w); o[64 * j] = w; }
        const float r = 1.0f / sqrtf(wave_sum(s) * (1.0f / D) + EPS);
        if (lane == 0) rs[m] = r;
    }
}
template <bool HAS_A, bool XI_BF, bool XO_BF>
__device__ __forceinline__ void thin_rows(const void* xi, void* xo, const bf16* h, const float* gpost, float* rsout, float coef, int m0, int m1, int NGW, int lane) {
    f32x4 gp[4];
#pragma unroll
    for (int j = 0; j < 4; ++j) gp[j] = *((const f32x4*)gpost + lane + 64 * j);
    for (int mb = m0; mb < m1; mb += 2 * NGW) {
        f32x4 v[2][4], hv[2][4];
#pragma unroll
        for (int q = 0; q < 2; ++q) { const int mm = mb + q * NGW; const int m = mm < m1 ? mm : mb;
            const u32x2* hr = (const u32x2*)(h + (size_t)m * D) + lane;
#pragma unroll
            for (int j = 0; j < 4; ++j) {
                if (XI_BF) { const u32x2 w = ((const u32x2*)((const bf16*)xi + (size_t)m * D) + lane)[64 * j]; v[q][j] = (f32x4){bflo(w.x), bfhi(w.x), bflo(w.y), bfhi(w.y)}; }
                else v[q][j] = ((const f32x4*)((const float*)xi + (size_t)m * D) + lane)[64 * j];
                const u32x2 w = hr[64 * j]; hv[q][j] = (f32x4){bflo(w.x), bfhi(w.x), bflo(w.y), bfhi(w.y)}; } }
#pragma unroll
        for (int q = 0; q < 2; ++q) { const int m = mb + q * NGW; if (m < m1) {
            float s = 0.f;
#pragma unroll
            for (int j = 0; j < 4; ++j) s += (hv[q][j].x * hv[q][j].x + hv[q][j].y * hv[q][j].y) + (hv[q][j].z * hv[q][j].z + hv[q][j].w * hv[q][j].w);
            const float r1 = coef / sqrtf(wave_sum(s) * (1.0f / D) + EPS);
            float s2 = 0.f;
#pragma unroll
            for (int j = 0; j < 4; ++j) { v[q][j] = v[q][j] + hv[q][j] * r1 * gp[j];
                s2 += (v[q][j].x * v[q][j].x + v[q][j].y * v[q][j].y) + (v[q][j].z * v[q][j].z + v[q][j].w * v[q][j].w); }
#pragma unroll
            for (int j = 0; j < 4; ++j) {
                if (XO_BF) { u32x2 w; w.x = cvtpk(v[q][j].x, v[q][j].y); w.y = cvtpk(v[q][j].z, v[q][j].w); ((u32x2*)((bf16*)xo + (size_t)m * D) + lane)[64 * j] = w; }
                else ((f32x4*)((float*)xo + (size_t)m * D) + lane)[64 * j] = v[q][j]; }
            if (HAS_A) { const float r2 = 1.0f / sqrtf(wave_sum(s2) * (1.0f / D) + EPS); if (lane == 0) rsout[m] = r2; } } }
    }
}

#define XB_TMO      128
#define XB_XCNT(j)  (256  + 64 * (j))
#define XB_XSUB(j)  (1280 + 64 * (j))
#define XB_XGEN(j)  (2304 + 64 * (j))
#define XB_TOP      3328
#define XB_TOPGEN   3392
#define XCD_BAR_WORDS 3456
#define XB_SPIN_CAP (1u << 18)

__device__ __forceinline__ unsigned xb_ld(unsigned* p)              { return __hip_atomic_load(p, __ATOMIC_RELAXED, __HIP_MEMORY_SCOPE_AGENT); }
__device__ __forceinline__ unsigned xb_add(unsigned* p, unsigned v) { return __hip_atomic_fetch_add(p, v, __ATOMIC_RELAXED, __HIP_MEMORY_SCOPE_AGENT); }
__device__ __forceinline__ unsigned xb_xcc_id() { return (unsigned)__builtin_amdgcn_s_getreg((3 << 11) | 20) & 0xFu; }
#define XB_SPIN(cond, bar) do { unsigned _sp = 0; while (cond) { __builtin_amdgcn_s_sleep(1); \
    if ((++_sp & 255u) == 0u) { if (xb_ld(&(bar)[XB_TMO])) break; if (_sp > XB_SPIN_CAP) { atomicAdd(&(bar)[XB_TMO], 1u); break; } } } } while (0)

struct XcdBarrier {
    unsigned* bar; unsigned x; unsigned total;
    volatile LAS unsigned* st;
};

__device__ __forceinline__ XcdBarrier xcd_barrier_post(unsigned* bar, volatile LAS unsigned* st, unsigned total) {
    XcdBarrier b; b.bar = bar; b.x = xb_xcc_id(); b.st = st; b.total = total;
    if (threadIdx.x == 0) (void)xb_add(&bar[XB_XCNT(b.x)], 1u);
    return b;
}
__device__ __forceinline__ void xcd_barrier_complete(unsigned* bar, unsigned x, unsigned G, unsigned& nloc, unsigned& nx) {
    unsigned sum, cnt, mine, sp = 0u;
    for (;;) {
        sum = 0u; cnt = 0u; mine = 0u;
#pragma unroll
        for (unsigned j = 0; j < 16; ++j) { const unsigned c = xb_ld(&bar[XB_XCNT(j)]); sum += c; cnt += (c > 0u) ? 1u : 0u; mine = (j == x) ? c : mine; }
        if (sum == G) break;
        __builtin_amdgcn_s_sleep(1);
        if ((++sp & 255u) == 0u) { if (xb_ld(&bar[XB_TMO])) break; if (sp > XB_SPIN_CAP) { atomicAdd(&bar[XB_TMO], 1u); break; } }
    }
    nloc = mine > 0u ? mine : 1u; nx = cnt > 0u ? cnt : 1u;
}

__device__ __forceinline__ void xcd_barrier(const XcdBarrier& b) {
    asm volatile("s_waitcnt vmcnt(0)" ::: "memory");
    __syncthreads();
    if (threadIdx.x == 0) {
        unsigned* bar = b.bar;
        __builtin_amdgcn_s_waitcnt(0);
        unsigned nloc = b.st[0], nx = b.st[1];
        if (nloc == 0u) { xcd_barrier_complete(bar, b.x, b.total, nloc, nx); b.st[0] = nloc; b.st[1] = nx; }
        const unsigned old = xb_add(&bar[XB_XSUB(b.x)], 1u);
        const unsigned gen = old / nloc;
        if (old + 1u == (gen + 1u) * nloc) {
            if (nx > 1u) __builtin_amdgcn_fence(__ATOMIC_RELEASE, "agent");
            asm volatile("s_waitcnt vmcnt(0)" ::: "memory");
            const unsigned og = xb_add(&bar[XB_TOP], 1u);
            const unsigned tg = og / nx;
            if (og + 1u == (tg + 1u) * nx) xb_add(&bar[XB_TOPGEN], 1u);
            else XB_SPIN(xb_ld(&bar[XB_TOPGEN]) == tg, bar);
            __builtin_amdgcn_fence(__ATOMIC_ACQUIRE, "agent");
            xb_add(&bar[XB_XGEN(b.x)], 1u);
            asm volatile("s_waitcnt vmcnt(0)" ::: "memory");
        } else {
            XB_SPIN(xb_ld(&bar[XB_XGEN(b.x)]) == gen, bar);
            __builtin_amdgcn_fence(__ATOMIC_ACQUIRE, "agent");
            asm volatile("s_waitcnt vmcnt(0)" ::: "memory");
        }
    }
    __syncthreads();
}
#define MFMA32(a, b, c) __builtin_amdgcn_mfma_f32_32x32x16_bf16((a), (b), (c), 0, 0, 0)
__device__ __forceinline__ void load8(const bf16* p, float (&f)[8]) { const u32x4 w = *(const u32x4*)p;
    f[0] = bflo(w.x); f[1] = bfhi(w.x); f[2] = bflo(w.y); f[3] = bfhi(w.y); f[4] = bflo(w.z); f[5] = bfhi(w.z); f[6] = bflo(w.w); f[7] = bfhi(w.w); }

#define OPAQUE_V(x) asm volatile("" : "+v"(x))
#define OPAQUE_S(x) asm volatile("" : "+s"(x))
struct MixCtx { LAS unsigned char* lds; const bf16* Z; const bf16* Vt; const bf16* WpT; const float* pool_scale; const float* sinks; const float* g_pool; const float* g_attn; bf16* Y; float* RA; size_t rowbase; int b, n, htid, lane, hw; };

__device__ __forceinline__ void u_load(const MixCtx& c, int g, u32x4 (&pre)[9]) {
    int htid = c.htid; OPAQUE_V(htid);
#pragma unroll
    for (int k = 0; k < 9; ++k) { const int i = htid + 256 * k, jr = i >> 4, cc = i & 15; pre[k] = (u32x4){0u, 0u, 0u, 0u};
        if (jr < UL_ROWS && c.n * 128 + jr - 15 >= 0) pre[k] = *(const u32x4*)(c.Z + (ptrdiff_t)((ptrdiff_t)c.rowbase + jr - 15) * NIN + g * 128 + cc * 8); }
}
__device__ __forceinline__ void u_store(const MixCtx& c, const u32x4 (&pre)[9]) {
    int htid = c.htid; OPAQUE_V(htid);
#pragma unroll
    for (int k = 0; k < 9; ++k) { const int i = htid + 256 * k, jr = i >> 4, cc = i & 15; if (jr < UL_ROWS) *(LAS u32x4*)(c.lds + UL_OFF + jr * UL_PITCH + cc * 16) = pre[k]; }
}
template <int G> __device__ __forceinline__ void pool_D(const MixCtx& c) {
    constexpr int w = 2 << G;
    LAS unsigned char* lds = c.lds; int htid = c.htid; OPAQUE_V(htid);
    const int c8 = htid & 15, t0 = (htid >> 4) * 8;
    const LAS unsigned char* ub = lds + UL_OFF + (15 + t0) * UL_PITCH + c8 * 16;
    float s[8], uv[8];
#pragma unroll
    for (int i = 0; i < 8; ++i) s[i] = 0.f;
#define LDU(row) do { const u32x4 w_ = *(const LAS u32x4*)(ub + (row) * UL_PITCH); uv[0] = bflo(w_.x); uv[1] = bfhi(w_.x); uv[2] = bflo(w_.y); uv[3] = bfhi(w_.y); uv[4] = bflo(w_.z); uv[5] = bfhi(w_.z); uv[6] = bflo(w_.w); uv[7] = bfhi(w_.w); } while (0)
#pragma unroll
    for (int j = 1 - w; j < 0; ++j) { LDU(j);
#pragma unroll
        for (int i = 0; i < 8; ++i) s[i] += uv[i]; }
#pragma unroll
    for (int tt = 0; tt < 8; ++tt) { const int t = t0 + tt;
        LDU(tt);
#pragma unroll
        for (int i = 0; i < 8; ++i) s[i] += uv[i];
        const int sp = c.n * 128 + t; const int cnt = (sp + 1 < w) ? sp + 1 : w; const float inv = 1.0f / (float)cnt;
        u32x4 o; o.x = cvtpk(s[0] * inv - uv[0], s[1] * inv - uv[1]); o.y = cvtpk(s[2] * inv - uv[2], s[3] * inv - uv[3]);
        o.z = cvtpk(s[4] * inv - uv[4], s[5] * inv - uv[5]); o.w = cvtpk(s[6] * inv - uv[6], s[7] * inv - uv[7]);
        *(LAS u32x4*)(lds + DL_OFF + t * DL_PITCH + c8 * 16) = o;
        LDU(tt - w + 1);
#pragma unroll
        for (int i = 0; i < 8; ++i) s[i] -= uv[i]; }
#undef LDU
}
template <int G> __device__ __forceinline__ void pool_M(const MixCtx& c, f32x16& ssacc, unsigned (&kA)[16], unsigned (&kB)[16]) {
    LAS unsigned char* lds = c.lds; int lane_ = c.lane, hw = c.hw; OPAQUE_V(lane_); OPAQUE_S(hw);
    const int r32 = lane_ & 31, hi = lane_ >> 5;
#pragma unroll
    for (int j2 = 0; j2 < 2; ++j2) {
        f32x16 a0, a1;
#pragma unroll
        for (int i = 0; i < 16; ++i) { a0[i] = 0.f; a1[i] = 0.f; }
        const bf16* wp = c.WpT + (size_t)G * 16384 + (size_t)(64 * j2 + r32) * 128 + 8 * hi;
#pragma unroll
        for (int ks = 0; ks < 8; ++ks) {
            const bf16x8 A = *(const LAS bf16x8*)(lds + DL_OFF + (32 * hw + r32) * DL_PITCH + (16 * ks + 8 * hi) * 2);
            const bf16x8 B0 = *(const bf16x8*)(wp + 16 * ks), B1 = *(const bf16x8*)(wp + 32 * 128 + 16 * ks);
            a0 = MFMA32(A, B0, a0); a1 = MFMA32(A, B1, a1);
        }
#pragma unroll
        for (int r = 0; r < 16; ++r) { const float v0 = a0[r], v1 = a1[r];
            { float q_ = ssacc[r] + (v0 * v0 + v1 * v1); asm volatile("" : "+v"(q_)); ssacc[r] = q_; }
            unsigned pk_ = cvtpk(v0, v1); asm volatile("" : "+v"(pk_));
            if (j2 == 0) kA[r] = pk_; else kB[r] = pk_; }
        __builtin_amdgcn_sched_barrier(0);
    }
}
__device__ __forceinline__ void store_item(const MixCtx& c, LAS bf16* stg, const unsigned (&kp)[16], const float (&f)[16], int colbase) {
    int lane = c.lane; OPAQUE_V(lane); const int r32 = lane & 31, hi = lane >> 5;
#pragma unroll
    for (int r = 0; r < 16; ++r) { const int ro = (r & 3) + 8 * (r >> 2) + 4 * hi;
        stg[ro * 64 + r32] = (bf16)(cvtpk(bflo(kp[r]) * f[r], 0.f) & 0xffffu); stg[ro * 64 + 32 + r32] = (bf16)(cvtpk(bfhi(kp[r]) * f[r], 0.f) & 0xffffu); }
    asm volatile("s_waitcnt lgkmcnt(0)" ::: "memory");
    size_t yo = (c.rowbase + 32 * c.hw + (lane >> 3)) * D + colbase + (lane & 7) * 8; OPAQUE_V(yo); bf16* yb = c.Y + yo;
#pragma unroll
    for (int i = 0; i < 4; ++i) { const u32x4 v = *(const LAS u32x4*)(stg + (i * 8 + (lane >> 3)) * 64 + (lane & 7) * 8); *(u32x4*)(yb + (size_t)i * 8 * D) = v; }
    asm volatile("s_waitcnt lgkmcnt(0)" ::: "memory");
}
__device__ __forceinline__ void pool_half(const MixCtx& c) {
    f32x16 ssacc;
#pragma unroll
    for (int r = 0; r < 16; ++r) ssacc[r] = 0.f;
    unsigned a0[16], b0[16], a1[16], b1[16], a2[16], b2[16], a3[16], b3[16];
    __syncthreads();
    pool_D<0>(c); __syncthreads(); pool_M<0>(c, ssacc, a0, b0); __syncthreads();
    pool_D<1>(c); __syncthreads(); pool_M<1>(c, ssacc, a1, b1); __syncthreads();
    pool_D<2>(c); __syncthreads(); pool_M<2>(c, ssacc, a2, b2); __syncthreads();
    pool_D<3>(c); __syncthreads(); pool_M<3>(c, ssacc, a3, b3); __syncthreads();
    __syncthreads();
    int lane = c.lane; OPAQUE_V(lane); const int hi = lane >> 5;
    const LAS float* RAL = (const LAS float*)(c.lds + RAL_OFF);
    float f[16];
#pragma unroll
    for (int r = 0; r < 16; ++r) { const int ro = (r & 3) + 8 * (r >> 2) + 4 * hi; const float ss = half_sum32(ssacc[r]);
        f[r] = __builtin_amdgcn_rsqf(ss * (1.0f / 512.0f) + EPS) * __builtin_amdgcn_rcpf(RAL[32 * c.hw + ro]); }
    if (c.htid < 128) c.RA[c.rowbase + c.htid] = RAL[c.htid];
    LAS bf16* stg = (LAS bf16*)(c.lds + UL_OFF) + c.hw * 2048;
    store_item(c, stg, a0, f, 0); store_item(c, stg, b0, f, 64); store_item(c, stg, a1, f, 128); store_item(c, stg, b1, f, 192);
    store_item(c, stg, a2, f, 256); store_item(c, stg, b2, f, 320); store_item(c, stg, a3, f, 384); store_item(c, stg, b3, f, 448);
    __syncthreads();
}
template <int KH, int GI> __device__ __forceinline__ void att_item(const MixCtx& c, bf16x8 (&qr)[4], const bf16* qp, f32x16& ssacc) {
    LAS unsigned char* lds = c.lds; int lane_ = c.lane, rg = c.hw; OPAQUE_V(lane_); OPAQUE_S(rg);
    const int r32 = lane_ & 31, hi = lane_ >> 5, n = c.n;
    constexpr int h = KH * 4 + GI;
    f32x16 S[5];
#pragma unroll
    for (int t = 0; t < 5; ++t) {
#pragma unroll
        for (int i = 0; i < 16; ++i) S[t][i] = 0.f;
#pragma unroll
        for (int d0 = 0; d0 < 4; ++d0) { const bf16x8 kf = *(const LAS bf16x8*)(lds + KL_OFF + (32 * (rg + t) + r32) * KL_PITCH + (16 * d0 + 8 * hi) * 2);
            S[t] = MFMA32(kf, qr[d0], S[t]); }
        if (t & 1) __builtin_amdgcn_sched_barrier(0);
    }
    if (GI < 3) {
#pragma unroll
        for (int d0 = 0; d0 < 4; ++d0) qr[d0] = *(const bf16x8*)(qp + 64 * (GI + 1) + 16 * d0);
    }
    const float sinkl = c.sinks[h] * LOG2E;
    float mx = sinkl;
#pragma unroll
    for (int t = 0; t < 5; ++t)
#pragma unroll
        for (int r = 0; r < 16; ++r) {
            const bool tv = (n > 0) || (rg + t >= 4);
            const bool valid = (t == 0) ? (tv && (crow(r, hi) > r32)) : (t == 4) ? (crow(r, hi) <= r32) : tv;
            const float sv = valid ? S[t][r] : -1e30f; S[t][r] = sv; mx = fmaxf(mx, sv); }
    mx = fmaxf(mx, __shfl_xor(mx, 32));
    float sum = 0.f;
#pragma unroll
    for (int t = 0; t < 5; ++t)
#pragma unroll
        for (int r = 0; r < 16; ++r) { const float p = __builtin_amdgcn_exp2f(S[t][r] - mx); S[t][r] = p; sum += p; }
    sum += __shfl_xor(sum, 32);
    sum += __builtin_amdgcn_exp2f(sinkl - mx);
    const float linv = 1.0f / sum;
    f32x16 o0, o1;
#pragma unroll
    for (int i = 0; i < 16; ++i) { o0[i] = 0.f; o1[i] = 0.f; }
#pragma unroll
    for (int t = 0; t < 5; ++t)
#pragma unroll
        for (int s = 0; s < 2; ++s) {
            u32x4 pw; pw.x = cvtpk(S[t][8 * s + 0], S[t][8 * s + 1]); pw.y = cvtpk(S[t][8 * s + 2], S[t][8 * s + 3]); pw.z = cvtpk(S[t][8 * s + 4], S[t][8 * s + 5]); pw.w = cvtpk(S[t][8 * s + 6], S[t][8 * s + 7]);
            const bf16x8 pa = __builtin_bit_cast(bf16x8, pw);
            const int keyb = 32 * (rg + t) + 16 * s + 4 * hi;
            const LAS unsigned char* vb = lds + VL_OFF + r32 * VL_PITCH + keyb * 2;
            const u32x2 l0 = *(const LAS u32x2*)(vb), h0 = *(const LAS u32x2*)(vb + 16);
            const u32x2 l1 = *(const LAS u32x2*)(vb + 32 * VL_PITCH), h1 = *(const LAS u32x2*)(vb + 32 * VL_PITCH + 16);
            const bf16x8 v0 = __builtin_bit_cast(bf16x8, ((u32x4){l0.x, l0.y, h0.x, h0.y})), v1 = __builtin_bit_cast(bf16x8, ((u32x4){l1.x, l1.y, h1.x, h1.y}));
            o0 = MFMA32(pa, v0, o0); o1 = MFMA32(pa, v1, o1);
            if (s == 1) __builtin_amdgcn_sched_barrier(0);
        }
    LAS bf16* stg = (LAS bf16*)(lds + ASTG_OFF) + rg * 2048;
#pragma unroll
    for (int r = 0; r < 16; ++r) { const int ro = (r & 3) + 8 * (r >> 2) + 4 * hi; const float li = __shfl(linv, ro);
        const float v0 = o0[r] * li, v1 = o1[r] * li;
        { float q_ = ssacc[r] + (v0 * v0 + v1 * v1); asm volatile("" : "+v"(q_)); ssacc[r] = q_; }
        stg[ro * 64 + r32] = (bf16)(cvtpk(v0, 0.f) & 0xffffu); stg[ro * 64 + 32 + r32] = (bf16)(cvtpk(v1, 0.f) & 0xffffu); }
    asm volatile("s_waitcnt lgkmcnt(0)" ::: "memory");
    size_t yo = (c.rowbase + 32 * rg + (lane_ >> 3)) * D + 512 + h * 64 + (lane_ & 7) * 8; OPAQUE_V(yo); bf16* yb = c.Y + yo;
#pragma unroll
    for (int i = 0; i < 4; ++i) { const u32x4 v = *(const LAS u32x4*)(stg + (i * 8 + (lane_ >> 3)) * 64 + (lane_ & 7) * 8); *(u32x4*)(yb + (size_t)i * 8 * D) = v; }
    asm volatile("s_waitcnt lgkmcnt(0)" ::: "memory");
}
template <int KH> __device__ __forceinline__ void att_fill(const MixCtx& c, bf16x8 (&qr)[4], const bf16* qp) {
    LAS unsigned char* lds = c.lds; int htid = c.htid; OPAQUE_V(htid); const int n = c.n;
#pragma unroll
    for (int d0 = 0; d0 < 4; ++d0) qr[d0] = *(const bf16x8*)(qp + 16 * d0);
#pragma unroll
    for (int k = 0; k < 8; ++k) {
        const int i = htid + 256 * k, key = i >> 3, cc = i & 7; const bool valid = (n > 0) || (key >= 128);
        u32x4 v = (u32x4){0u, 0u, 0u, 0u};
        if (valid) v = *(const u32x4*)(c.Z + (c.rowbase + key - 128) * NIN + 1024 + KH * 64 + cc * 8);
        *(LAS u32x4*)(lds + KL_OFF + key * KL_PITCH + cc * 16) = v;
    }
#pragma unroll
    for (int k = 0; k < 8; ++k) {
        const int i = htid + 256 * k, d = i >> 5, cc = i & 31; const bool valid = (n > 0) || (cc >= 16);
        u32x4 v = (u32x4){0u, 0u, 0u, 0u};
        if (valid) v = *(const u32x4*)(c.Vt + ((size_t)((c.b * 2 + KH) * 64 + d)) * SEQ + n * 128 - 128 + cc * 8);
        LAS u32x2* dst = (LAS u32x2*)(lds + VL_OFF + d * VL_PITCH + cc * 16);
        dst[0] = (u32x2){v.x, v.y}; dst[1] = (u32x2){v.z, v.w};
    }
}
__device__ __forceinline__ void att_half(const MixCtx& c) {
    f32x16 ssacc;
#pragma unroll
    for (int r = 0; r < 16; ++r) ssacc[r] = 0.f;
    const bf16* qp0 = c.Z + (c.rowbase + 32 * c.hw + (c.lane & 31)) * NIN + 512 + 8 * (c.lane >> 5);
    const bf16* qp1 = qp0 + 256;
    bf16x8 qr[4]; u32x4 pre[9];
    u_load(c, 0, pre); att_fill<0>(c, qr, qp0); u_store(c, pre);            __syncthreads();
    u_load(c, 1, pre); att_item<0, 0>(c, qr, qp0, ssacc);                  __syncthreads();
    u_store(c, pre);   att_item<0, 1>(c, qr, qp0, ssacc);                  __syncthreads();
    u_load(c, 2, pre); att_item<0, 2>(c, qr, qp0, ssacc);                  __syncthreads();
    u_store(c, pre);   att_item<0, 3>(c, qr, qp0, ssacc);                  __syncthreads();
    u_load(c, 3, pre); att_fill<1>(c, qr, qp1);                            __syncthreads();
    u_store(c, pre);   att_item<1, 0>(c, qr, qp1, ssacc);                  __syncthreads();
    att_item<1, 1>(c, qr, qp1, ssacc);                                     __syncthreads();
    att_item<1, 2>(c, qr, qp1, ssacc);                                     __syncthreads();
    att_item<1, 3>(c, qr, qp1, ssacc);
    { int lane = c.lane; OPAQUE_V(lane); const int r32 = lane & 31, hi = lane >> 5; LAS float* RAL = (LAS float*)(c.lds + RAL_OFF);
#pragma unroll
      for (int r = 0; r < 16; ++r) { const int ro = (r & 3) + 8 * (r >> 2) + 4 * hi; const float ss = half_sum32(ssacc[r]);
          if (r32 == 0) RAL[32 * c.hw + ro] = __builtin_amdgcn_rsqf(ss * (1.0f / 512.0f) + EPS); } }
    __syncthreads();
    __syncthreads();
}
__device__ __forceinline__ void mixer_block(LAS unsigned char* lds, int blk, const bf16* Z, const bf16* Vt, const bf16* WpT, const float* pool_scale, const float* sinks,
                                            const float* g_pool, const float* g_attn, bf16* Y, float* RA, int tid, int wid, int lane) {
    OPAQUE_V(tid); OPAQUE_V(lane); OPAQUE_S(wid);
    MixCtx c; c.lds = lds; c.Z = Z; c.Vt = Vt; c.WpT = WpT; c.pool_scale = pool_scale; c.sinks = sinks; c.g_pool = g_pool; c.g_attn = g_attn; c.Y = Y; c.RA = RA; c.rowbase = (size_t)blk * 128;
    c.b = blk / NB_SEQ; c.n = blk % NB_SEQ; c.htid = tid & 255; c.lane = lane; c.hw = wid & 3;
    if (wid < 4) pool_half(c); else att_half(c);
}
__global__ void __launch_bounds__(NTHREADS, 2) hybrid_fwd(Args args) {
    extern __shared__ __attribute__((aligned(16))) unsigned char lds_raw[];
    LAS unsigned char* lds = (LAS unsigned char*)lds_raw;
    cg::grid_group grid = cg::this_grid();
    const int tid = threadIdx.x, lane = tid & 63, wid = __builtin_amdgcn_readfirstlane(tid >> 6);
    const int G = gridDim.x, bx = blockIdx.x;
    const int vcu = (G % 8 == 0) ? (bx % 8) * (G / 8) + bx / 8 : bx;
    const int gw = vcu * NWAVES + wid, NGW = G * NWAVES;
    unsigned char* ws = args.ws;
    bf16 *Wgu1 = (bf16*)(ws + WS_WGU1), *Wgu2 = (bf16*)(ws + WS_WGU2), *Wd1 = (bf16*)(ws + WS_WD1), *Wd2 = (bf16*)(ws + WS_WD2), *Win = (bf16*)(ws + WS_WIN), *Wout = (bf16*)(ws + WS_WOUT), *WpT = (bf16*)(ws + WS_WPOOL);
    float* CS = (float*)(ws + WS_CS);
    bf16 *HD = (bf16*)(ws + WS_HD), *H = (bf16*)(ws + WS_H), *Z = (bf16*)(ws + WS_Z), *Vt = (bf16*)(ws + WS_VT), *Y = (bf16*)(ws + WS_Y), *XR = (bf16*)(ws + WS_XR); float* RAg = (float*)(ws + WS_RA); float* RS = (float*)(ws + WS_RA + 512 * 1024);
    const int lo = args.ph_lo, hi = args.ph_hi;
#define IN(k) (lo <= (k) && (k) < hi)
#define SEAM(k) do { if (IN(k) && IN((k) + 1)) { if ((k) == 0) grid.sync(); else xcd_barrier(bar); } } while (0)
    if (tid < 32) ((LAS unsigned*)(lds + MISC_OFF))[tid] = 0u;
    __syncthreads();
    const int grp = bx & 7, gslot = bx >> 3, GW = G >> 3;
    unsigned* ctl = (unsigned*)(ws + WS_CTL);
    XcdBarrier bar; bar.bar = ctl + (1 + grp) * XCD_BAR_WORDS; bar.x = 0; bar.st = nullptr; bar.total = (unsigned)GW;
    const bool one_launch = (hi - lo > 1);
    const int grow0 = grp * (M / 8) + gslot * NWAVES + wid, grow1 = (grp + 1) * (M / 8);
    unsigned* halo_flag = ctl + 9 * XCD_BAR_WORDS;

    if (IN(0)) {
        for (int i = vcu * NTHREADS + tid; i < (int)(CTL_BYTES / 4); i += G * NTHREADS) __hip_atomic_store(ctl + i, 0u, __ATOMIC_RELAXED, __HIP_MEMORY_SCOPE_AGENT);
        LAS float* scr = (LAS float*)(lds + wid * 16384);
        constexpr int I_GU = (D / 64) * (NGU / 32), I_DN = (FF / 64) * (D / 32), I_IN = (D / 64) * (NIN / 32), I_OUT = (D / 64) * (D / 32), I_PL = 4 * 2 * 4;
        constexpr int NITEMS = 2 * I_GU + 2 * I_DN + I_IN + I_OUT + I_PL;
        for (int it = gw; it < NITEMS; it += NGW) {
            int r = it;
            if (r < I_GU) { transpose_item(args.ffn1_wgu, D, NGU, Wgu1, 1, scr, r, lane, args.ffn1_pre); continue; } r -= I_GU;
            if (r < I_GU) { transpose_item(args.ffn2_wgu, D, NGU, Wgu2, 1, scr, r, lane, args.ffn2_pre); continue; } r -= I_GU;
            if (r < I_DN) { transpose_item(args.ffn1_wd, FF, D, Wd1, 0, scr, r, lane); continue; } r -= I_DN;
            if (r < I_DN) { transpose_item(args.ffn2_wd, FF, D, Wd2, 0, scr, r, lane); continue; } r -= I_DN;
            if (r < I_IN) { transpose_item(args.w_in, D, NIN, Win, 2, scr, r, lane, args.mix_pre); continue; } r -= I_IN;
            if (r < I_OUT) { transpose_item(args.w_out, D, D, Wout, 0, scr, r, lane, args.g_pool, args.g_attn); continue; } r -= I_OUT;
            { const int g = r >> 3; transpose_item(args.w_pool + (size_t)g * 16384, 128, 128, WpT + (size_t)g * 16384, 0, scr, r & 7, lane, nullptr, nullptr, args.pool_scale + g * 128); }
        }
        for (int idx = vcu * NTHREADS + tid; idx < M * 8; idx += G * NTHREADS) {
            const int row = idx >> 3, i = idx & 7; const float ang = (float)args.pos[row] * inv_freq(i);
            float sn, cn; sincos_f(ang, sn, cn); CS[(size_t)row * 16 + i] = cn; CS[(size_t)row * 16 + 8 + i] = sn;
        }
        prenorm_rows(args.x, XR, RS, gw, NGW, lane);
    }
    SEAM(0);
    if (one_launch) bar = xcd_barrier_post(ctl + (1 + grp) * XCD_BAR_WORDS, (volatile LAS unsigned*)(lds + MISC_OFF) + 8, (unsigned)GW);
    if (IN(1)) {
        pg8::Gemm g{XR, Wgu1, M, NGU, D}; pg8::StaticOrder S; S.init(M, NGU, G, bx); pg8::EpiSwiGLU E{H, FF, RS};
        pg8::gemm_phase<pg8::EpiSwiGLU, pg8::StaticOrder, true, true>(lds, g, S, E);
    }
    SEAM(1);
    if (IN(2)) {
        pg8::Gemm g{H, Wd1, M, D, FF}; pg8::StaticOrder S; S.init(M, D, G, bx); pg8::EpiBf16<0> E{HD, D, nullptr, 0, 0, 1.f};
        pg8::gemm_phase<pg8::EpiBf16<0>, pg8::StaticOrder, true, true>(lds, g, S, E);
    }
    SEAM(2);
    if (IN(3)) thin_rows<true, false, true>(args.x, XR, HD, args.ffn1_post, RS, 0.5f, grow0, grow1, GW * NWAVES, lane);
    SEAM(3);
    if (IN(4)) {
        pg8::Gemm g{XR, Win, M, NIN, D}; pg8::StaticOrder S; S.init(M, NIN, G, bx); pg8::EpiZ E{Z, Vt, CS, QSCALE, SEQ, RS};
        pg8::gemm_phase<pg8::EpiZ, pg8::StaticOrder, true, true>(lds, g, S, E);
    }
    SEAM(4);
    if (IN(4) && IN(5)) { if (gslot == 0 && tid == 0) { __builtin_amdgcn_fence(__ATOMIC_RELEASE, "agent"); asm volatile("s_waitcnt vmcnt(0)" ::: "memory"); } __syncthreads(); if (gslot == 0 && tid == 0) __hip_atomic_store(halo_flag + 64 * grp, 1u, __ATOMIC_RELAXED, __HIP_MEMORY_SCOPE_AGENT); }
    if (IN(5)) { for (int blk = grp * (NBLK / 8) + gslot; blk < (grp + 1) * (NBLK / 8); blk += GW) {
        if (IN(4) && (blk % NB_SEQ) != 0 && (blk % (NBLK / 8)) == 0) {
            if (tid == 0) { unsigned sp = 0; while (__hip_atomic_load(halo_flag + 64 * (grp - 1), __ATOMIC_RELAXED, __HIP_MEMORY_SCOPE_AGENT) == 0u) { __builtin_amdgcn_s_sleep(2); if (++sp > (1u << 22)) break; }
                            __builtin_amdgcn_fence(__ATOMIC_ACQUIRE, "agent"); asm volatile("s_waitcnt vmcnt(0)" ::: "memory"); }
            __syncthreads(); }
        mixer_block(lds, blk, Z, Vt, WpT, args.pool_scale, args.sinks, args.g_pool, args.g_attn, Y, RAg, tid, wid, lane); } }
    SEAM(5);
    if (IN(6)) {
        pg8::Gemm g{Y, Wout, M, D, D}; pg8::StaticOrder S; S.init(M, D, G, bx); pg8::EpiRowScale E{HD, D, RAg};
        pg8::gemm_phase<pg8::EpiRowScale, pg8::StaticOrder, true, true>(lds, g, S, E);
    }
    SEAM(6);
    if (IN(7)) thin_rows<true, true, true>(XR, XR, HD, args.mix_post, RS, 1.0f, grow0, grow1, GW * NWAVES, lane);
    SEAM(7);
    if (IN(8)) {
        pg8::Gemm g{XR, Wgu2, M, NGU, D}; pg8::StaticOrder S; S.init(M, NGU, G, bx); pg8::EpiSwiGLU E{H, FF, RS};
        pg8::gemm_phase<pg8::EpiSwiGLU, pg8::StaticOrder, true, true>(lds, g, S, E);
    }
    SEAM(8);
    if (IN(9)) {
        pg8::Gemm g{H, Wd2, M, D, FF}; pg8::StaticOrder S; S.init(M, D, G, bx); pg8::EpiBf16<0> E{HD, D, nullptr, 0, 0, 1.f};
        pg8::gemm_phase<pg8::EpiBf16<0>, pg8::StaticOrder, true, true>(lds, g, S, E);
    }
    SEAM(9);
    if (IN(10)) thin_rows<false, true, false>(XR, args.out, HD, args.ffn2_post, nullptr, 0.5f, grow0, grow1, GW * NWAVES, lane);
#undef IN
#undef SEAM
}

#ifndef MK_N_LAUNCHES
#define MK_N_LAUNCHES 1
#endif
extern "C" void kernel_launch(void* const* d_in, const int* in_sizes, int n_in, void* d_out, int out_size, void* d_ws, size_t ws_size, hipStream_t stream) {
    static int grid = 0;
    if (grid == 0) {
        if (n_in != 19 || in_sizes[0] != M * D || out_size != M * D || ws_size < WS_END) { fprintf(stderr, "kernel_launch: unexpected shapes (n_in %d, in0 %d, out %d, ws %zu)\n", n_in, n_in > 0 ? in_sizes[0] : -1, out_size, ws_size); grid = -1; return; }
        int dev = 0, cus = 0, per_cu = 0;
        if (hipGetDevice(&dev) != hipSuccess || hipDeviceGetAttribute(&cus, hipDeviceAttributeMultiprocessorCount, dev) != hipSuccess) { grid = -1; return; }
        if (hipFuncSetAttribute((const void*)hybrid_fwd, hipFuncAttributeMaxDynamicSharedMemorySize, LDS_BYTES) != hipSuccess) { fprintf(stderr, "kernel_launch: hipFuncSetAttribute failed\n"); grid = -1; return; }
        if (hipOccupancyMaxActiveBlocksPerMultiprocessor(&per_cu, (const void*)hybrid_fwd, NTHREADS, LDS_BYTES) != hipSuccess || per_cu < 1) { fprintf(stderr, "kernel_launch: occupancy query says %d\n", per_cu); per_cu = 1; }
        (void)hipGetLastError();
        grid = (cus / 8) * 8;
    }
    if (grid < 0) return;
    Args a{};
    a.x = (const float*)d_in[0]; a.pos = (const int*)d_in[1];
    a.ffn1_pre = (const float*)d_in[2]; a.ffn1_wgu = (const float*)d_in[3]; a.ffn1_wd = (const float*)d_in[4]; a.ffn1_post = (const float*)d_in[5];
    a.mix_pre = (const float*)d_in[6]; a.w_in = (const float*)d_in[7]; a.w_pool = (const float*)d_in[8]; a.pool_scale = (const float*)d_in[9]; a.sinks = (const float*)d_in[10];
    a.g_pool = (const float*)d_in[11]; a.g_attn = (const float*)d_in[12]; a.w_out = (const float*)d_in[13]; a.mix_post = (const float*)d_in[14];
    a.ffn2_pre = (const float*)d_in[15]; a.ffn2_wgu = (const float*)d_in[16]; a.ffn2_wd = (const float*)d_in[17]; a.ffn2_post = (const float*)d_in[18];
    a.out = (float*)d_out; a.ws = (unsigned char*)d_ws;
    constexpr int NPH = 11;
#if MK_N_LAUNCHES == 1
    a.ph_lo = 0; a.ph_hi = NPH;
    { void* kargs[] = {&a}; hipError_t e = hipLaunchCooperativeKernel((const void*)hybrid_fwd, dim3(grid), dim3(NTHREADS), kargs, LDS_BYTES, stream);
      if (e != hipSuccess) fprintf(stderr, "kernel_launch: cooperative launch failed: %s (grid %d)\n", hipGetErrorString(e), grid); }
#else
    for (int p = 0; p < NPH; ++p) { a.ph_lo = p; a.ph_hi = p + 1; void* kargs[] = {&a};
        hipError_t e = hipLaunchCooperativeKernel((const void*)hybrid_fwd, dim3(grid), dim3(NTHREADS), kargs, LDS_BYTES, stream);
        if (e != hipSuccess) { fprintf(stderr, "kernel_launch: launch %d failed: %s\n", p, hipGetErrorString(e)); break; } }
#endif
}
```

```cpp
#include <hip/hip_runtime.h>
#include <hip/hip_cooperative_groups.h>
#include <cstdio>
#include <cstdint>
namespace cg = cooperative_groups;
namespace pg8 {
#define PG8_LAS __attribute__((address_space(3)))
typedef unsigned short bf16_t;
typedef short bf16x8 __attribute__((ext_vector_type(8)));
typedef float f32x4 __attribute__((ext_vector_type(4)));
typedef unsigned u32x4 __attribute__((ext_vector_type(4)));
constexpr int BM = 256, BK = 64, HALF = 128, HTB = HALF * BK * 2  , STAGE_BYTES = 8 * HTB, NXCD = 8, WGM = 2;

__host__ __device__ __forceinline__ int lds_byte(int r, int c) { const int st = (r >> 4) * 2 + (c >> 5), rr = r & 15, cc = c & 31, ob = rr * 64 + cc * 2; return st * 1024 + (ob ^ (((ob >> 9) & 1) << 5)); }
__host__ __device__ __forceinline__ void stage_rc(int b, int& R, int& C) { const int st = b / 1024, sb = b % 1024, swz = sb ^ (((sb >> 9) & 1) << 5); R = (st >> 1) * 16 + swz / 64; C = (st & 1) * 32 + (swz % 64) / 2; }
__host__ __device__ __forceinline__ int perm32(int rho) { const int n = rho >> 4, i = rho & 15; return 8 * (i >> 2) + 4 * n + (i & 3); }

struct Unit { int pm, pn; };
struct Gemm { const bf16_t* A; const bf16_t* Bt; int M, N, K; };

struct StaticOrder {
    int nM, nN, nwg, G, c;
    __host__ __device__ void init(int M, int N, int G_, int c_) { nM = M / BM; nN = N / BM; nwg = nM * nN; G = G_; c = c_; }
    __host__ __device__ bool next(int i, Unit& u) const {
        const long L = (long)i * G + c; if (L >= nwg) return false;
        int wgid = (int)L; { const int q = nwg / NXCD, r = nwg % NXCD, xcd = wgid % NXCD, off = wgid / NXCD; wgid = (xcd < r ? xcd * (q + 1) : r * (q + 1) + (xcd - r) * q) + off; }
        const int nig = WGM * nN, gid = wgid / nig, fm = gid * WGM, gsz = (nM - fm) < WGM ? (nM - fm) : WGM;
        u.pm = fm + ((wgid % nig) % gsz); u.pn = (wgid % nig) / gsz; return true;
    }
    __device__ __forceinline__ void a_ready(const Unit&) const {}
    __device__ __forceinline__ void done(const Unit&) const {}
};

__device__ __forceinline__ unsigned cvt_pk_bf16(float lo, float hi) { unsigned r; asm volatile("v_cvt_pk_bf16_f32 %0, %1, %2" : "=v"(r) : "v"(lo), "v"(hi)); return r; }
typedef float f32x2 __attribute__((ext_vector_type(2)));
__device__ __forceinline__ f32x2 gelu_pk(f32x2 v) {
    const f32x2 av = __builtin_elementwise_abs(v), d = av * 0.2316418882f + 1.0f;
    f32x2 t; t.x = __builtin_amdgcn_rcpf(d.x); t.y = __builtin_amdgcn_rcpf(d.y);
    f32x2 q = t * 0.5307027145f + (-0.7265760135f); q = q * t + 0.7107068705f; q = q * t + (-0.142248368f); q = q * t + 0.127414796f; q = q * t;
    const f32x2 s = (v * v) * (-0.72134752044f);
    f32x2 e; e.x = __builtin_amdgcn_exp2f(s.x); e.y = __builtin_amdgcn_exp2f(s.y);
    const f32x2 m = v * (q * e), r = v - m;
    f32x2 o; o.x = v.x < 0.f ? m.x : r.x; o.y = v.y < 0.f ? m.y : r.y; return o;
}

template <int ACT  > struct EpiBf16 {
    static constexpr bool PERM = true, AFTER_DRAIN = false; static_assert(ACT == 0 || ACT == 1, "EpiBf16: ACT is 0 (none) or 1 (gelu_pk)");
    bf16_t* O; int ldc; const float* bias; int split_cols; size_t split_stride; float scale0;
    __device__ __forceinline__ void operator()(const f32x4 (&acc)[2][2][4][2], const Unit& u, int wr, int wc, int fr, int fq) const {
        const int row0 = u.pm * BM + wr * 64 + fr; int colt = u.pn * BM; bf16_t* base = O;
        float sc = 1.f; if (split_cols) { const int t = colt / split_cols; base += (size_t)t * split_stride; colt -= t * split_cols; if (t == 0) sc = scale0; }
        const int col0 = colt + wc * 32 + 8 * fq, bcol0 = u.pn * BM + wc * 32 + 8 * fq;
        f32x4 bv[2][2];
#pragma unroll
        for (int bj = 0; bj < 2; ++bj)
#pragma unroll
            for (int n = 0; n < 2; ++n) bv[bj][n] = bias ? *(const f32x4*)(bias + bcol0 + bj * HALF + 4 * n) : (f32x4){0.f, 0.f, 0.f, 0.f};
#pragma unroll
        for (int ai = 0; ai < 2; ++ai)
#pragma unroll
            for (int m = 0; m < 4; ++m) { bf16_t* rowp = base + (size_t)(row0 + ai * HALF + m * 16) * ldc + col0;
#pragma unroll
                for (int bj = 0; bj < 2; ++bj) { f32x4 v0 = acc[ai][bj][m][0] + bv[bj][0], v1 = acc[ai][bj][m][1] + bv[bj][1];
                    if (ACT == 1) { f32x2 a = gelu_pk((f32x2){v0[0], v0[1]}), b = gelu_pk((f32x2){v0[2], v0[3]}), c = gelu_pk((f32x2){v1[0], v1[1]}), d = gelu_pk((f32x2){v1[2], v1[3]});
                        v0 = (f32x4){a.x, a.y, b.x, b.y}; v1 = (f32x4){c.x, c.y, d.x, d.y}; }
                    v0 = v0 * sc; v1 = v1 * sc; u32x4 w; w.x = cvt_pk_bf16(v0[0], v0[1]); w.y = cvt_pk_bf16(v0[2], v0[3]); w.z = cvt_pk_bf16(v1[0], v1[1]); w.w = cvt_pk_bf16(v1[2], v1[3]);
                    *(u32x4*)(rowp + bj * HALF) = w; } }
    }
};
typedef __bf16 bf16x2_t __attribute__((ext_vector_type(2)));
__device__ __forceinline__ unsigned cvtpk(float lo, float hi) { f32x2 v = {lo, hi}; bf16x2_t b = __builtin_convertvector(v, bf16x2_t); return __builtin_bit_cast(unsigned, b); }
__device__ __forceinline__ float silu_mul(float g, float u) { const float e = __builtin_amdgcn_exp2f(-1.4426950408889634f * g); return g * __builtin_amdgcn_rcpf(1.0f + e) * u; }

struct EpiSwiGLU {
    static constexpr bool PERM = true, AFTER_DRAIN = false;
    bf16_t* O; int ldc;
    __device__ __forceinline__ void operator()(const f32x4 (&acc)[2][2][4][2], const Unit& u, int wr, int wc, int fr, int fq) const {
        const int row0 = u.pm * BM + wr * 64 + fr, col0 = u.pn * HALF + wc * 32 + 8 * fq;
#pragma unroll
        for (int ai = 0; ai < 2; ++ai)
#pragma unroll
            for (int m = 0; m < 4; ++m) { const int row = row0 + ai * HALF + m * 16; bf16_t* rowp = O + (size_t)row * ldc + col0;
                const f32x4 g0 = acc[ai][0][m][0], g1 = acc[ai][0][m][1], u0 = acc[ai][1][m][0], u1 = acc[ai][1][m][1];
                u32x4 w; w.x = cvtpk(silu_mul(g0[0], u0[0]), silu_mul(g0[1], u0[1])); w.y = cvtpk(silu_mul(g0[2], u0[2]), silu_mul(g0[3], u0[3]));
                w.z = cvtpk(silu_mul(g1[0], u1[0]), silu_mul(g1[1], u1[1])); w.w = cvtpk(silu_mul(g1[2], u1[2]), silu_mul(g1[3], u1[3]));
                *(u32x4*)rowp = w; }
    }
};
struct EpiRowScale {
    static constexpr bool PERM = true, AFTER_DRAIN = false;
    bf16_t* O; int ldc; const float* rs;
    __device__ __forceinline__ void operator()(const f32x4 (&acc)[2][2][4][2], const Unit& u, int wr, int wc, int fr, int fq) const {
        const int row0 = u.pm * BM + wr * 64 + fr, col0 = u.pn * BM + wc * 32 + 8 * fq;
#pragma unroll
        for (int ai = 0; ai < 2; ++ai)
#pragma unroll
            for (int m = 0; m < 4; ++m) { const int row = row0 + ai * HALF + m * 16; const float sc = rs[row]; bf16_t* rowp = O + (size_t)row * ldc + col0;
#pragma unroll
                for (int bj = 0; bj < 2; ++bj) { const f32x4 v0 = acc[ai][bj][m][0] * sc, v1 = acc[ai][bj][m][1] * sc;
                    u32x4 w; w.x = cvtpk(v0[0], v0[1]); w.y = cvtpk(v0[2], v0[3]); w.z = cvtpk(v1[0], v1[1]); w.w = cvtpk(v1[2], v1[3]);
                    *(u32x4*)(rowp + bj * HALF) = w; } }
    }
};
struct EpiZ {
    static constexpr bool PERM = true, AFTER_DRAIN = false;
    bf16_t* Z; bf16_t* Vt; const float* cs; float qscale; int seq;
    __device__ __forceinline__ void operator()(const f32x4 (&acc)[2][2][4][2], const Unit& u, int wr, int wc, int fr, int fq) const {
        const int row0 = u.pm * BM + wr * 64 + fr, cl = wc * 32 + 8 * fq;
#pragma unroll
        for (int bj = 0; bj < 2; ++bj) {
            const int colh = u.pn * BM + bj * HALF;
            const bool isV = (colh == 1152);
            const bool rope = (colh >= 512) && (colh < 1152) && ((wc & 1) == 0) && (fq < 2);
            const float sc = (colh >= 512 && colh < 1024) ? qscale : 1.0f;
#pragma unroll
            for (int ai = 0; ai < 2; ++ai)
#pragma unroll
                for (int m = 0; m < 4; ++m) { const int row = row0 + ai * HALF + m * 16;
                    f32x4 v0 = acc[ai][bj][m][0], v1 = acc[ai][bj][m][1];
                    if (isV) {
                        const int b = row / seq, s = row - b * seq;
#pragma unroll
                        for (int i = 0; i < 4; ++i) { const int c0 = cl + i, c1 = cl + 4 + i;
                            Vt[((size_t)((b * 2 + (c0 >> 6)) * 64 + (c0 & 63))) * seq + s] = (bf16_t)(cvtpk(v0[i], 0.f) & 0xffffu);
                            Vt[((size_t)((b * 2 + (c1 >> 6)) * 64 + (c1 & 63))) * seq + s] = (bf16_t)(cvtpk(v1[i], 0.f) & 0xffffu); }
                    } else {
                        if (rope) { const f32x4 c = *(const f32x4*)(cs + (size_t)row * 16 + 4 * fq), sn = *(const f32x4*)(cs + (size_t)row * 16 + 8 + 4 * fq);
                            const f32x4 n0 = v0 * c - v1 * sn, n1 = v1 * c + v0 * sn; v0 = n0; v1 = n1; }
                        v0 = v0 * sc; v1 = v1 * sc;
                        u32x4 w; w.x = cvtpk(v0[0], v0[1]); w.y = cvtpk(v0[2], v0[3]); w.z = cvtpk(v1[0], v1[1]); w.w = cvtpk(v1[2], v1[3]);
                        *(u32x4*)(Z + (size_t)row * 1280 + colh + cl) = w; }
                }
        }
    }
};
template <class Epi, class Sched, bool ALIGN_EPI = false, bool SP2 = false>
__device__ __forceinline__ void gemm_phase(PG8_LAS unsigned char* lds, const Gemm g, const Sched& S, const Epi& E) {
    const int tid = threadIdx.x, wid = __builtin_amdgcn_readfirstlane(tid >> 6), lane = tid & 63, wr = wid >> 2, wc = wid & 3, fr = lane & 15, fq = lane >> 4;
    const int K = g.K, nt = K / BK;
    unsigned voffA[2], voffB[2];
#pragma unroll
    for (int i = 0; i < 2; ++i) { int R, C; stage_rc(tid * 16 + i * 8192, R, C); const int Rb = Epi::PERM ? ((R & ~31) + perm32(R & 31)) : R;
        voffA[i] = (unsigned)(R * K + C) * 2u; voffB[i] = (unsigned)(Rb * K + C) * 2u; }
    const size_t kstep = (size_t)(BK * 2);
    const size_t hstep = (size_t)HALF * K * 2;
    const size_t tstep = 2 * hstep;
    const unsigned ldsw = (unsigned)wid * 1024u;
    const int aoff = lds_byte(wr * 64 + fr, fq * 8), boff = lds_byte(wc * 32 + fr, fq * 8);
#define PG8_SA(b, h) (((b) * 2 + (h)) * HTB)
#define PG8_SB(b, h) ((4 + (b) * 2 + (h)) * HTB)
#define PG8_STAGE(bufoff, gbase, voff) do { _Pragma("unroll") for (int _i = 0; _i < 2; ++_i) \
        __builtin_amdgcn_global_load_lds((const unsigned*)((const char*)(gbase) + (voff)[_i]), (PG8_LAS unsigned*)(lds + (bufoff) + ldsw + _i * 8192), 16, 0, 0); } while (0)
#define PG8_LDA(dst, b, h) do { _Pragma("unroll") for (int m = 0; m < 4; ++m) _Pragma("unroll") for (int k = 0; k < 2; ++k) dst[m][k] = *(const PG8_LAS bf16x8*)(lds + PG8_SA(b, h) + aoff + m * 2048 + k * 1024); } while (0)
#define PG8_LDB(dst, b, h) do { _Pragma("unroll") for (int n = 0; n < 2; ++n) _Pragma("unroll") for (int k = 0; k < 2; ++k) dst[n][k] = *(const PG8_LAS bf16x8*)(lds + PG8_SB(b, h) + boff + n * 2048 + k * 1024); } while (0)
#define PG8_MMA(ai, bj, At, Bt) do { __builtin_amdgcn_s_setprio(1); _Pragma("unroll") for (int m = 0; m < 4; ++m) _Pragma("unroll") for (int n = 0; n < 2; ++n) _Pragma("unroll") for (int k = 0; k < 2; ++k) \
        acc[ai][bj][m][n] = __builtin_amdgcn_mfma_f32_16x16x32_bf16(Bt[n][k], At[m][k], acc[ai][bj][m][n], 0, 0, 0); __builtin_amdgcn_s_setprio(0); } while (0)
#define PG8_WAIT_V(n) asm volatile("s_waitcnt vmcnt(" #n ")" ::: "memory")
#define PG8_WAIT_L(n) asm volatile("s_waitcnt lgkmcnt(" #n ")" ::: "memory")
#define PG8_BAR __builtin_amdgcn_s_barrier()
#define PG8_SCHED __builtin_amdgcn_sched_barrier(0)
    Unit cur, nxt; int ui = 0;
    if (!S.next(0, cur)) return;
    f32x4 acc[2][2][4][2];
#pragma unroll
    for (int a = 0; a < 2; ++a)
#pragma unroll
        for (int b = 0; b < 2; ++b)
#pragma unroll
            for (int m = 0; m < 4; ++m)
#pragma unroll
                for (int n = 0; n < 2; ++n) acc[a][b][m][n] = (f32x4){0.f, 0.f, 0.f, 0.f};
    bf16x8 At[4][2], B0[2][2], B1[2][2];
    const char* cA = (const char*)g.A + (size_t)cur.pm * tstep; const char* cB = (const char*)g.Bt + (size_t)cur.pn * tstep;
    S.a_ready(cur);
    if constexpr (SP2) {
        PG8_STAGE(PG8_SB(0, 0), cB, voffB); PG8_STAGE(PG8_SB(0, 1), cB + hstep, voffB); PG8_STAGE(PG8_SA(0, 0), cA, voffA); PG8_STAGE(PG8_SA(0, 1), cA + hstep, voffA);
        if (wr == 1) PG8_BAR;
        PG8_WAIT_V(2); PG8_BAR;
        PG8_STAGE(PG8_SB(1, 0), cB + kstep, voffB); PG8_STAGE(PG8_SA(1, 0), cA + kstep, voffA); PG8_STAGE(PG8_SB(1, 1), cB + hstep + kstep, voffB);
        PG8_WAIT_V(6); PG8_BAR;
    } else {
        PG8_STAGE(PG8_SB(0, 0), cB, voffB); PG8_STAGE(PG8_SA(0, 0), cA, voffA); PG8_STAGE(PG8_SB(0, 1), cB + hstep, voffB); PG8_STAGE(PG8_SA(0, 1), cA + hstep, voffA);
        if (wr == 1) PG8_BAR;
        PG8_WAIT_V(4); PG8_BAR;
        PG8_STAGE(PG8_SB(1, 0), cB + kstep, voffB); PG8_STAGE(PG8_SA(1, 0), cA + kstep, voffA); PG8_STAGE(PG8_SB(1, 1), cB + hstep + kstep, voffB);
        PG8_WAIT_V(6); PG8_BAR;
    }
    for (;;) {
        const bool has_next = S.next(ui + 1, nxt);
        const char* nA = has_next ? (const char*)g.A + (size_t)nxt.pm * tstep : cA; const char* nB = has_next ? (const char*)g.Bt + (size_t)nxt.pn * tstep : cB;
        for (int t = 0; t < nt; t += 2) {
            const bool last = (t == nt - 2);
            const char* a1 = cA + (size_t)(t + 1) * kstep;
            const char* a2 = last ? nA : cA + (size_t)(t + 2) * kstep; const char* b2 = last ? nB : cB + (size_t)(t + 2) * kstep;
            const char* a3 = a2 + kstep; const char* b3 = b2 + kstep;
            if (last && has_next) S.a_ready(nxt);
            if constexpr (SP2) {
            PG8_LDB(B0, 0, 0); PG8_LDB(B1, 0, 1); PG8_SCHED; PG8_LDA(At, 0, 0); PG8_STAGE(PG8_SA(1, 1), a1 + hstep, voffA);
            PG8_WAIT_V(8); PG8_WAIT_L(0); PG8_BAR; PG8_MMA(0, 0, At, B0); PG8_MMA(0, 1, At, B1); PG8_BAR; PG8_SCHED;
            PG8_LDA(At, 0, 1); PG8_STAGE(PG8_SB(0, 0), b2, voffB); PG8_STAGE(PG8_SB(0, 1), b2 + hstep, voffB); PG8_STAGE(PG8_SA(0, 0), a2, voffA);
            PG8_WAIT_V(8); PG8_WAIT_L(0); PG8_BAR; PG8_MMA(1, 0, At, B0); PG8_MMA(1, 1, At, B1); PG8_BAR; PG8_SCHED;
            PG8_LDB(B0, 1, 0); PG8_LDB(B1, 1, 1); PG8_SCHED; PG8_LDA(At, 1, 0); PG8_STAGE(PG8_SA(0, 1), a2 + hstep, voffA);
            PG8_WAIT_V(8); PG8_WAIT_L(0); PG8_BAR; PG8_MMA(0, 0, At, B0); PG8_MMA(0, 1, At, B1); PG8_BAR; PG8_SCHED;
            PG8_LDA(At, 1, 1); PG8_STAGE(PG8_SB(1, 0), b3, voffB); PG8_STAGE(PG8_SB(1, 1), b3 + hstep, voffB); PG8_STAGE(PG8_SA(1, 0), a3, voffA);
            PG8_WAIT_V(8); PG8_WAIT_L(0); PG8_BAR; PG8_MMA(1, 0, At, B0); PG8_MMA(1, 1, At, B1); PG8_BAR; PG8_SCHED;
            } else {
            PG8_LDB(B0, 0, 0); PG8_SCHED; PG8_LDA(At, 0, 0); PG8_STAGE(PG8_SA(1, 1), a1 + hstep, voffA);
            PG8_WAIT_L(8); PG8_BAR; PG8_WAIT_L(0); PG8_MMA(0, 0, At, B0); PG8_BAR; PG8_SCHED;
            PG8_LDB(B1, 0, 1); PG8_STAGE(PG8_SB(0, 0), b2, voffB);
            PG8_BAR; PG8_WAIT_L(0); PG8_MMA(0, 1, At, B1); PG8_BAR;
            PG8_LDA(At, 0, 1); PG8_STAGE(PG8_SA(0, 0), a2, voffA);
            PG8_BAR; PG8_WAIT_L(0); PG8_MMA(1, 0, At, B0); PG8_BAR; PG8_SCHED;
            PG8_STAGE(PG8_SB(0, 1), b2 + hstep, voffB);
            PG8_WAIT_V(6); PG8_BAR; PG8_MMA(1, 1, At, B1); PG8_BAR;
            PG8_LDB(B0, 1, 0); PG8_SCHED; PG8_LDA(At, 1, 0); PG8_STAGE(PG8_SA(0, 1), a2 + hstep, voffA);
            PG8_WAIT_L(8); PG8_BAR; PG8_WAIT_L(0); PG8_MMA(0, 0, At, B0); PG8_BAR; PG8_SCHED;
            PG8_LDB(B1, 1, 1); PG8_STAGE(PG8_SB(1, 0), b3, voffB);
            PG8_BAR; PG8_WAIT_L(0); PG8_MMA(0, 1, At, B1); PG8_BAR;
            PG8_LDA(At, 1, 1); PG8_STAGE(PG8_SA(1, 0), a3, voffA);
            PG8_BAR; PG8_WAIT_L(0); PG8_MMA(1, 0, At, B0); PG8_BAR; PG8_SCHED;
            PG8_STAGE(PG8_SB(1, 1), b3 + hstep, voffB);
            PG8_WAIT_V(6); PG8_BAR; PG8_MMA(1, 1, At, B1); PG8_BAR;
            }
        }
        if constexpr (ALIGN_EPI) { if (wr == 0) PG8_BAR; }
        if constexpr (!Epi::AFTER_DRAIN) { E(acc, cur, wr, wc, fr, fq); S.done(cur); }
        if (!has_next) break;
#pragma unroll
        for (int a = 0; a < 2; ++a)
#pragma unroll
            for (int b = 0; b < 2; ++b)
#pragma unroll
                for (int m = 0; m < 4; ++m)
#pragma unroll
                    for (int n = 0; n < 2; ++n) acc[a][b][m][n] = (f32x4){0.f, 0.f, 0.f, 0.f};
        cur = nxt; cA = nA; cB = nB; ++ui;
        if constexpr (ALIGN_EPI) { if (wr == 1) PG8_BAR; }
    }
    PG8_WAIT_V(0);
    if constexpr (!ALIGN_EPI) { if (wr == 0) PG8_BAR; }
    PG8_BAR;
    if constexpr (Epi::AFTER_DRAIN) { E.fused(acc, cur, wr, wc, fr, fq, lds, wid, lane); S.done(cur); }
#undef PG8_SA
#undef PG8_SB
#undef PG8_STAGE
#undef PG8_LDA
#undef PG8_LDB
#undef PG8_MMA
#undef PG8_WAIT_V
#undef PG8_WAIT_L
#undef PG8_BAR
#undef PG8_SCHED
}
}
constexpr int BATCH = 4, SEQ = 8192, D = 1024, M = BATCH * SEQ, FF = 2816, NGU = 2 * FF, NIN = 1280, NBLK = M / 128, NB_SEQ = SEQ / 128;
constexpr float EPS = 1e-6f;
constexpr float QSCALE = 0.125f * 1.4426950408889634f;
constexpr float LOG2E = 1.4426950408889634f;
constexpr int NWAVES = 8, NTHREADS = 512;
constexpr size_t MiB = 1u << 20;
constexpr size_t WS_WGU1 = 0, WS_WGU2 = 11 * MiB, WS_WD1 = 22 * MiB, WS_WD2 = 28 * MiB, WS_WIN = 34 * MiB, WS_WOUT = 37 * MiB, WS_WPOOL = 39 * MiB, WS_CS = 40 * MiB;
constexpr size_t WS_CTL = 46 * MiB, CTL_BYTES = 262144, WS_RA = 47 * MiB;
constexpr size_t WS_Y = 48 * MiB, WS_HD = 112 * MiB, WS_H = 176 * MiB, WS_XR = 352 * MiB, WS_Z = 416 * MiB, WS_VT = 496 * MiB, WS_END = 504 * MiB;
static_assert((size_t)NGU * D * 2 <= 11 * MiB && (size_t)D * FF * 2 <= 6 * MiB && (size_t)NIN * D * 2 <= 3 * MiB && (size_t)M * 16 * 4 <= 6 * MiB, "ws map");
static_assert(WS_Y + (size_t)M * D * 2 <= WS_HD && WS_HD + (size_t)M * D * 2 <= WS_H && WS_H + (size_t)M * FF * 2 <= WS_XR && WS_XR + (size_t)M * D * 2 <= WS_Z && WS_Z + (size_t)M * NIN * 2 <= WS_VT && WS_VT + (size_t)M * 128 * 2 <= WS_END, "ws map 2");
constexpr int LDS_BYTES = 163840;
constexpr int KL_OFF = 0, KL_PITCH = 144, VL_OFF = 36864, VL_PITCH = 520, UL_OFF = 70144, UL_PITCH = 272, UL_ROWS = 143, DL_OFF = UL_OFF + 38912, DL_PITCH = 272;
constexpr int RAL_OFF = DL_OFF + 34816, ASTG_OFF = RAL_OFF + 512, MISC_OFF = ASTG_OFF + 16384;
static_assert(UL_ROWS * UL_PITCH <= 38912 && MISC_OFF >= 131072 && MISC_OFF + 128 <= LDS_BYTES && ASTG_OFF % 16 == 0 && DL_OFF % 16 == 0, "LDS map");

#define LAS __attribute__((address_space(3)))
typedef unsigned short bf16;
typedef unsigned u32x4 __attribute__((ext_vector_type(4)));
typedef unsigned u32x2 __attribute__((ext_vector_type(2)));
typedef float f32x4 __attribute__((ext_vector_type(4)));
typedef float f32x16 __attribute__((ext_vector_type(16)));
typedef short bf16x8 __attribute__((ext_vector_type(8)));
using pg8::cvtpk;
__device__ __forceinline__ float bflo(unsigned w) { return __uint_as_float(w << 16); }
__device__ __forceinline__ float bfhi(unsigned w) { return __uint_as_float(w & 0xffff0000u); }
__device__ __forceinline__ float wave_sum(float v) {
#pragma unroll
    for (int o = 1; o < 64; o <<= 1) v += __shfl_xor(v, o);
    return v;
}
__device__ __forceinline__ float half_sum32(float v) {
#pragma unroll
    for (int o = 1; o < 32; o <<= 1) v += __shfl_xor(v, o);
    return v;
}
__device__ __forceinline__ int crow(int r, int hi) { return (r & 3) + 8 * (r >> 2) + 4 * hi; }

struct Args {
    const float* x; const int* pos;
    const float *ffn1_pre, *ffn1_wgu, *ffn1_wd, *ffn1_post, *mix_pre, *w_in, *w_pool, *pool_scale, *sinks, *g_pool, *g_attn, *w_out, *mix_post, *ffn2_pre, *ffn2_wgu, *ffn2_wd, *ffn2_post;
    float* out; unsigned char* ws; int ph_lo, ph_hi;
};

__device__ __forceinline__ int dest_row(int mode, int n) {
    if (mode == 1) { return n < FF ? ((n >> 7) * 256 + (n & 127)) : ((((n - FF) >> 7) * 256) + 128 + ((n - FF) & 127)); }
    if (mode == 2) { if (n >= 512 && n < 1152) { const int d = n & 63; const int p = (d >= 4 && d < 8) ? d + 4 : ((d >= 8 && d < 12) ? d - 4 : d); return (n - d) + p; } return n; }
    return n;
}
__device__ __forceinline__ void transpose_item(const float* W, int K, int N, bf16* WT, int mode, LAS float* scr, int item, int lane, const float* gk = nullptr, const float* gk2 = nullptr, const float* gn = nullptr) {
    const int nblk = N / 32, kb = item / nblk, nb = item % nblk, k0 = 64 * kb, n0 = 32 * nb;
#pragma unroll 8
    for (int i = 0; i < 32; ++i) { const int kk = 2 * i + (lane >> 5); const int kr = k0 + kk; float gg = gk ? ((gk2 && kr >= 512) ? gk2[kr - 512] : gk[kr]) : 1.0f; if (gn) gg *= gn[n0 + (lane & 31)]; scr[kk * 33 + (lane & 31)] = W[(size_t)kr * N + n0 + (lane & 31)] * gg; }
    asm volatile("s_waitcnt lgkmcnt(0)" ::: "memory");
    const int c = lane & 7;
#pragma unroll
    for (int j = 0; j < 4; ++j) { const int n = (lane >> 3) + 8 * j; const LAS float* s = scr + (8 * c) * 33 + n;
        u32x4 o; o.x = cvtpk(s[0 * 33], s[1 * 33]); o.y = cvtpk(s[2 * 33], s[3 * 33]); o.z = cvtpk(s[4 * 33], s[5 * 33]); o.w = cvtpk(s[6 * 33], s[7 * 33]);
        *(u32x4*)(WT + (size_t)dest_row(mode, n0 + n) * K + k0 + 8 * c) = o; }
    asm volatile("s_waitcnt lgkmcnt(0)" ::: "memory");
}
__device__ __forceinline__ void sincos_f(float a, float& sn, float& cn) {
    const double ad = (double)a; const double q = __builtin_rint(ad * 0.63661977236758134308);
    const float r = (float)__builtin_fma(-q, 1.57079632679489661923, ad); const int qi = ((int)q) & 3;
    const float z = r * r;
    const float s = r + r * z * (-1.6666654611e-1f + z * (8.3321608736e-3f + z * (-1.9515295891e-4f)));
    const float c = 1.0f - 0.5f * z + z * z * (4.166664568298827e-2f + z * (-1.388731625493765e-3f + z * 2.443315711809948e-5f));
    sn = (qi == 0) ? s : (qi == 1) ? c : (qi == 2) ? -s : -c;
    cn = (qi == 0) ? c : (qi == 1) ? -s : (qi == 2) ? -c : s;
}
__device__ __forceinline__ float inv_freq(int i) {
    return i == 0 ? 1.0f : i == 1 ? 0.19392274474868576f : i == 2 ? 0.03760603093086393f : i == 3 ? 0.007292664737217109f : i == 4 ? 0.001414213562373095f : i == 5 ? 0.0002742481756762073f : i == 6 ? 5.318295896944988e-05f : 1.031338537721246e-05f;
}
__device__ __forceinline__ void prenorm_rows(const float* x, bf16* xb, float* rs, int gw, int NGW, int lane) {
    for (int m = gw; m < M; m += NGW) {
        const f32x4* xr = (const f32x4*)(x + (size_t)m * D) + lane; f32x4 v[4]; float s = 0.f;
#pragma unroll
        for (int j = 0; j < 4; ++j) { v[j] = xr[64 * j]; s += (v[j].x * v[j].x + v[j].y * v[j].y) + (v[j].z * v[j].z + v[j].w * v[j].w); }
        const float r = 1.0f / sqrtf(wave_sum(s) * (1.0f / D) + EPS);
        u32x2* o = (u32x2*)(xb + (size_t)m * D) + lane;
#pragma unroll
        for (int j = 0; j < 4; ++j) { const f32x4 y = v[j] * r; u32x2 w; w.x = cvtpk(y.x, y.y); w.y = cvtpk(y.z, y.w); o[64 * j] = w; }
        if (lane == 0) rs[m] = r;
    }
}
template <bool HAS_A, bool XI_BF, bool XO_BF>
__device__ __forceinline__ void thin_rows(const void* xi, void* xo, const bf16* h, const float* gpost, float* rsio, float coef, int m0, int m1, int NGW, int lane) {
    f32x4 gp[4];
#pragma unroll
    for (int j = 0; j < 4; ++j) gp[j] = *((const f32x4*)gpost + lane + 64 * j);
    for (int mb = m0; mb < m1; mb += 2 * NGW) {
        f32x4 v[2][4], hv[2][4]; float rin[2];
#pragma unroll
        for (int q = 0; q < 2; ++q) { const int mm = mb + q * NGW; const int m = mm < m1 ? mm : mb; rin[q] = XI_BF ? 1.0f / rsio[m] : 1.0f; }
#pragma unroll
        for (int q = 0; q < 2; ++q) { const int mm = mb + q * NGW; const int m = mm < m1 ? mm : mb;
            const u32x2* hr = (const u32x2*)(h + (size_t)m * D) + lane;
#pragma unroll
            for (int j = 0; j < 4; ++j) {
                if (XI_BF) { const u32x2 w = ((const u32x2*)((const bf16*)xi + (size_t)m * D) + lane)[64 * j]; v[q][j] = (f32x4){bflo(w.x), bfhi(w.x), bflo(w.y), bfhi(w.y)} * rin[q]; }
                else v[q][j] = ((const f32x4*)((const float*)xi + (size_t)m * D) + lane)[64 * j];
                const u32x2 w = hr[64 * j]; hv[q][j] = (f32x4){bflo(w.x), bfhi(w.x), bflo(w.y), bfhi(w.y)}; } }
#pragma unroll
        for (int q = 0; q < 2; ++q) { const int m = mb + q * NGW; if (m < m1) {
            float s = 0.f;
#pragma unroll
            for (int j = 0; j < 4; ++j) s += (hv[q][j].x * hv[q][j].x + hv[q][j].y * hv[q][j].y) + (hv[q][j].z * hv[q][j].z + hv[q][j].w * hv[q][j].w);
            const float r1 = coef / sqrtf(wave_sum(s) * (1.0f / D) + EPS);
            float s2 = 0.f;
#pragma unroll
            for (int j = 0; j < 4; ++j) { v[q][j] = v[q][j] + hv[q][j] * r1 * gp[j];
                s2 += (v[q][j].x * v[q][j].x + v[q][j].y * v[q][j].y) + (v[q][j].z * v[q][j].z + v[q][j].w * v[q][j].w); }
            const float r2 = HAS_A ? 1.0f / sqrtf(wave_sum(s2) * (1.0f / D) + EPS) : 1.0f;
#pragma unroll
            for (int j = 0; j < 4; ++j) {
                if (XO_BF) { const f32x4 y = v[q][j] * r2; u32x2 w; w.x = cvtpk(y.x, y.y); w.y = cvtpk(y.z, y.w); ((u32x2*)((bf16*)xo + (size_t)m * D) + lane)[64 * j] = w; }
                else ((f32x4*)((float*)xo + (size_t)m * D) + lane)[64 * j] = v[q][j]; }
            if (HAS_A) { if (lane == 0) rsio[m] = r2; } } }
    }
}

#define XB_TMO      128
#define XB_XCNT(j)  (256  + 64 * (j))
#define XB_XSUB(j)  (1280 + 64 * (j))
#define XB_XGEN(j)  (2304 + 64 * (j))
#define XB_TOP      3328
#define XB_TOPGEN   3392
#define XCD_BAR_WORDS 3456
#define XB_SPIN_CAP (1u << 18)

__device__ __forceinline__ unsigned xb_ld(unsigned* p)              { return __hip_atomic_load(p, __ATOMIC_RELAXED, __HIP_MEMORY_SCOPE_AGENT); }
__device__ __forceinline__ unsigned xb_add(unsigned* p, unsigned v) { return __hip_atomic_fetch_add(p, v, __ATOMIC_RELAXED, __HIP_MEMORY_SCOPE_AGENT); }
__device__ __forceinline__ unsigned xb_xcc_id() { return (unsigned)__builtin_amdgcn_s_getreg((3 << 11) | 20) & 0xFu; }
#define XB_SPIN(cond, bar) do { unsigned _sp = 0; while (cond) { __builtin_amdgcn_s_sleep(1); \
    if ((++_sp & 255u) == 0u) { if (xb_ld(&(bar)[XB_TMO])) break; if (_sp > XB_SPIN_CAP) { atomicAdd(&(bar)[XB_TMO], 1u); break; } } } } while (0)

struct XcdBarrier {
    unsigned* bar; unsigned x; unsigned total;
    volatile LAS unsigned* st;
};

__device__ __forceinline__ XcdBarrier xcd_barrier_post(unsigned* bar, volatile LAS unsigned* st, unsigned total) {
    XcdBarrier b; b.bar = bar; b.x = xb_xcc_id(); b.st = st; b.total = total;
    if (threadIdx.x == 0) (void)xb_add(&bar[XB_XCNT(b.x)], 1u);
    return b;
}
__device__ __forceinline__ void xcd_barrier_complete(unsigned* bar, unsigned x, unsigned G, unsigned& nloc, unsigned& nx) {
    unsigned sum, cnt, mine, sp = 0u;
    for (;;) {
        sum = 0u; cnt = 0u; mine = 0u;
#pragma unroll
        for (unsigned j = 0; j < 16; ++j) { const unsigned c = xb_ld(&bar[XB_XCNT(j)]); sum += c; cnt += (c > 0u) ? 1u : 0u; mine = (j == x) ? c : mine; }
        if (sum == G) break;
        __builtin_amdgcn_s_sleep(1);
        if ((++sp & 255u) == 0u) { if (xb_ld(&bar[XB_TMO])) break; if (sp > XB_SPIN_CAP) { atomicAdd(&bar[XB_TMO], 1u); break; } }
    }
    nloc = mine > 0u ? mine : 1u; nx = cnt > 0u ? cnt : 1u;
}

__device__ __forceinline__ void xcd_barrier(const XcdBarrier& b) {
    asm volatile("s_waitcnt vmcnt(0)" ::: "memory");
    __syncthreads();
    if (threadIdx.x == 0) {
        unsigned* bar = b.bar;
        __builtin_amdgcn_s_waitcnt(0);
        unsigned nloc = b.st[0], nx = b.st[1];
        if (nloc == 0u) { xcd_barrier_complete(bar, b.x, b.total, nloc, nx); b.st[0] = nloc; b.st[1] = nx; }
        const unsigned old = xb_add(&bar[XB_XSUB(b.x)], 1u);
        const unsigned gen = old / nloc;
        if (old + 1u == (gen + 1u) * nloc) {
            if (nx > 1u) __builtin_amdgcn_fence(__ATOMIC_RELEASE, "agent");
            asm volatile("s_waitcnt vmcnt(0)" ::: "memory");
            const unsigned og = xb_add(&bar[XB_TOP], 1u);
            const unsigned tg = og / nx;
            if (og + 1u == (tg + 1u) * nx) xb_add(&bar[XB_TOPGEN], 1u);
            else XB_SPIN(xb_ld(&bar[XB_TOPGEN]) == tg, bar);
            __builtin_amdgcn_fence(__ATOMIC_ACQUIRE, "agent");
            xb_add(&bar[XB_XGEN(b.x)], 1u);
            asm volatile("s_waitcnt vmcnt(0)" ::: "memory");
        } else {
            XB_SPIN(xb_ld(&bar[XB_XGEN(b.x)]) == gen, bar);
            __builtin_amdgcn_fence(__ATOMIC_ACQUIRE, "agent");
            asm volatile("s_waitcnt vmcnt(0)" ::: "memory");
        }
    }
    __syncthreads();
}
#define MFMA32(a, b, c) __builtin_amdgcn_mfma_f32_32x32x16_bf16((a), (b), (c), 0, 0, 0)
__device__ __forceinline__ void load8(const bf16* p, float (&f)[8]) { const u32x4 w = *(const u32x4*)p;
    f[0] = bflo(w.x); f[1] = bfhi(w.x); f[2] = bflo(w.y); f[3] = bfhi(w.y); f[4] = bflo(w.z); f[5] = bfhi(w.z); f[6] = bflo(w.w); f[7] = bfhi(w.w); }

#define OPAQUE_V(x) asm volatile("" : "+v"(x))
#define OPAQUE_S(x) asm volatile("" : "+s"(x))
__device__ __forceinline__ void lds_barrier() { asm volatile("s_waitcnt lgkmcnt(0)" ::: "memory"); __builtin_amdgcn_s_barrier(); asm volatile("" ::: "memory"); }
struct MixCtx { LAS unsigned char* lds; const bf16* Z; const bf16* Vt; const bf16* WpT; const float* pool_scale; const float* sinks; const float* g_pool; const float* g_attn; bf16* Y; float* RA; size_t rowbase; int b, n, htid, lane, hw; };

__device__ __forceinline__ void u_load(const MixCtx& c, int g, u32x4 (&pre)[9]) {
    int htid = c.htid; OPAQUE_V(htid);
#pragma unroll
    for (int k = 0; k < 9; ++k) { const int i = htid + 256 * k, jr = i >> 4, cc = i & 15; pre[k] = (u32x4){0u, 0u, 0u, 0u};
        if (jr < UL_ROWS && c.n * 128 + jr - 15 >= 0) pre[k] = *(const u32x4*)(c.Z + (ptrdiff_t)((ptrdiff_t)c.rowbase + jr - 15) * NIN + g * 128 + cc * 8); }
}
__device__ __forceinline__ void u_store(const MixCtx& c, const u32x4 (&pre)[9]) {
    int htid = c.htid; OPAQUE_V(htid);
#pragma unroll
    for (int k = 0; k < 9; ++k) { const int i = htid + 256 * k, jr = i >> 4, cc = i & 15; if (jr < UL_ROWS) *(LAS u32x4*)(c.lds + UL_OFF + jr * UL_PITCH + cc * 16) = pre[k]; }
}
template <int G> __device__ __forceinline__ void pool_D(const MixCtx& c) {
    constexpr int w = 2 << G;
    LAS unsigned char* lds = c.lds; int htid = c.htid; OPAQUE_V(htid);
    const int c8 = htid & 15, t0 = (htid >> 4) * 8;
    const LAS unsigned char* ub = lds + UL_OFF + (15 + t0) * UL_PITCH + c8 * 16;
    float s[8], uv[8];
#pragma unroll
    for (int i = 0; i < 8; ++i) s[i] = 0.f;
#define LDU(row) do { const u32x4 w_ = *(const LAS u32x4*)(ub + (row) * UL_PITCH); uv[0] = bflo(w_.x); uv[1] = bfhi(w_.x); uv[2] = bflo(w_.y); uv[3] = bfhi(w_.y); uv[4] = bflo(w_.z); uv[5] = bfhi(w_.z); uv[6] = bflo(w_.w); uv[7] = bfhi(w_.w); } while (0)
#pragma unroll
    for (int j = 1 - w; j < 0; ++j) { LDU(j);
#pragma unroll
        for (int i = 0; i < 8; ++i) s[i] += uv[i]; }
#pragma unroll
    for (int tt = 0; tt < 8; ++tt) { const int t = t0 + tt;
        LDU(tt);
#pragma unroll
        for (int i = 0; i < 8; ++i) s[i] += uv[i];
        const int sp = c.n * 128 + t; const int cnt = (sp + 1 < w) ? sp + 1 : w; const float inv = 1.0f / (float)cnt;
        u32x4 o; o.x = cvtpk(s[0] * inv - uv[0], s[1] * inv - uv[1]); o.y = cvtpk(s[2] * inv - uv[2], s[3] * inv - uv[3]);
        o.z = cvtpk(s[4] * inv - uv[4], s[5] * inv - uv[5]); o.w = cvtpk(s[6] * inv - uv[6], s[7] * inv - uv[7]);
        *(LAS u32x4*)(lds + DL_OFF + t * DL_PITCH + c8 * 16) = o;
        LDU(tt - w + 1);
#pragma unroll
        for (int i = 0; i < 8; ++i) s[i] -= uv[i]; }
#undef LDU
}
template <int G> __device__ __forceinline__ void pool_M(const MixCtx& c, f32x16& ssacc, unsigned (&kA)[16], unsigned (&kB)[16]) {
    LAS unsigned char* lds = c.lds; int lane_ = c.lane, hw = c.hw; OPAQUE_V(lane_); OPAQUE_S(hw);
    const int r32 = lane_ & 31, hi = lane_ >> 5;
#pragma unroll
    for (int j2 = 0; j2 < 2; ++j2) {
        f32x16 a0, a1;
#pragma unroll
        for (int i = 0; i < 16; ++i) { a0[i] = 0.f; a1[i] = 0.f; }
        const bf16* wp = c.WpT + (size_t)G * 16384 + (size_t)(64 * j2 + r32) * 128 + 8 * hi;
#pragma unroll
        for (int ks = 0; ks < 8; ++ks) {
            const bf16x8 A = *(const LAS bf16x8*)(lds + DL_OFF + (32 * hw + r32) * DL_PITCH + (16 * ks + 8 * hi) * 2);
            const bf16x8 B0 = *(const bf16x8*)(wp + 16 * ks), B1 = *(const bf16x8*)(wp + 32 * 128 + 16 * ks);
            a0 = MFMA32(A, B0, a0); a1 = MFMA32(A, B1, a1);
        }
#pragma unroll
        for (int r = 0; r < 16; ++r) { const float v0 = a0[r], v1 = a1[r];
            { float q_ = ssacc[r] + (v0 * v0 + v1 * v1); asm volatile("" : "+v"(q_)); ssacc[r] = q_; }
            unsigned pk_ = cvtpk(v0, v1); asm volatile("" : "+v"(pk_));
            if (j2 == 0) kA[r] = pk_; else kB[r] = pk_; }
        __builtin_amdgcn_sched_barrier(0);
    }
}
__device__ __forceinline__ void store_item(const MixCtx& c, LAS bf16* stg, const unsigned (&kp)[16], const float (&f)[16], int colbase) {
    int lane = c.lane; OPAQUE_V(lane); const int r32 = lane & 31, hi = lane >> 5;
#pragma unroll
    for (int r = 0; r < 16; ++r) { const int ro = (r & 3) + 8 * (r >> 2) + 4 * hi;
        stg[ro * 64 + r32] = (bf16)(cvtpk(bflo(kp[r]) * f[r], 0.f) & 0xffffu); stg[ro * 64 + 32 + r32] = (bf16)(cvtpk(bfhi(kp[r]) * f[r], 0.f) & 0xffffu); }
    asm volatile("s_waitcnt lgkmcnt(0)" ::: "memory");
    size_t yo = (c.rowbase + 32 * c.hw + (lane >> 3)) * D + colbase + (lane & 7) * 8; OPAQUE_V(yo); bf16* yb = c.Y + yo;
#pragma unroll
    for (int i = 0; i < 4; ++i) { const u32x4 v = *(const LAS u32x4*)(stg + (i * 8 + (lane >> 3)) * 64 + (lane & 7) * 8); *(u32x4*)(yb + (size_t)i * 8 * D) = v; }
    asm volatile("s_waitcnt lgkmcnt(0)" ::: "memory");
}
__device__ __forceinline__ void pool_half(const MixCtx& c) {
    f32x16 ssacc;
#pragma unroll
    for (int r = 0; r < 16; ++r) ssacc[r] = 0.f;
    unsigned a0[16], b0[16], a1[16], b1[16], a2[16], b2[16], a3[16], b3[16];
    lds_barrier();
    pool_D<0>(c); lds_barrier(); pool_M<0>(c, ssacc, a0, b0); lds_barrier();
    pool_D<1>(c); lds_barrier(); pool_M<1>(c, ssacc, a1, b1); lds_barrier();
    pool_D<2>(c); lds_barrier(); pool_M<2>(c, ssacc, a2, b2); lds_barrier();
    pool_D<3>(c); lds_barrier(); pool_M<3>(c, ssacc, a3, b3); lds_barrier();
    lds_barrier();
    int lane = c.lane; OPAQUE_V(lane); const int hi = lane >> 5;
    const LAS float* RAL = (const LAS float*)(c.lds + RAL_OFF);
    float f[16];
#pragma unroll
    for (int r = 0; r < 16; ++r) { const int ro = (r & 3) + 8 * (r >> 2) + 4 * hi; const float ss = half_sum32(ssacc[r]);
        f[r] = __builtin_amdgcn_rsqf(ss * (1.0f / 512.0f) + EPS) * __builtin_amdgcn_rcpf(RAL[32 * c.hw + ro]); }
    if (c.htid < 128) c.RA[c.rowbase + c.htid] = RAL[c.htid];
    LAS bf16* stg = (LAS bf16*)(c.lds + UL_OFF) + c.hw * 2048;
    store_item(c, stg, a0, f, 0); store_item(c, stg, b0, f, 64); store_item(c, stg, a1, f, 128); store_item(c, stg, b1, f, 192);
    store_item(c, stg, a2, f, 256); store_item(c, stg, b2, f, 320); store_item(c, stg, a3, f, 384); store_item(c, stg, b3, f, 448);
    lds_barrier();
}
template <int KH, int GI> __device__ __forceinline__ void att_item(const MixCtx& c, bf16x8 (&qr)[4], const bf16* qp, f32x16& ssacc) {
    LAS unsigned char* lds = c.lds; int lane_ = c.lane, rg = c.hw; OPAQUE_V(lane_); OPAQUE_S(rg);
    const int r32 = lane_ & 31, hi = lane_ >> 5, n = c.n;
    constexpr int h = KH * 4 + GI;
    f32x16 S[5];
#pragma unroll
    for (int t = 0; t < 5; ++t) {
#pragma unroll
        for (int i = 0; i < 16; ++i) S[t][i] = 0.f;
#pragma unroll
        for (int d0 = 0; d0 < 4; ++d0) { const bf16x8 kf = *(const LAS bf16x8*)(lds + KL_OFF + (32 * (rg + t) + r32) * KL_PITCH + (16 * d0 + 8 * hi) * 2);
            S[t] = MFMA32(kf, qr[d0], S[t]); }
        if (t & 1) __builtin_amdgcn_sched_barrier(0);
    }
    if (GI < 3) {
#pragma unroll
        for (int d0 = 0; d0 < 4; ++d0) qr[d0] = *(const bf16x8*)(qp + 64 * (GI + 1) + 16 * d0);
    }
    const float sinkl = c.sinks[h] * LOG2E;
    float mx = sinkl;
#pragma unroll
    for (int t = 0; t < 5; ++t)
#pragma unroll
        for (int r = 0; r < 16; ++r) {
            const bool tv = (n > 0) || (rg + t >= 4);
            const bool valid = (t == 0) ? (tv && (crow(r, hi) > r32)) : (t == 4) ? (crow(r, hi) <= r32) : tv;
            const float sv = valid ? S[t][r] : -1e30f; S[t][r] = sv; mx = fmaxf(mx, sv); }
    mx = fmaxf(mx, __shfl_xor(mx, 32));
    float sum = 0.f;
#pragma unroll
    for (int t = 0; t < 5; ++t)
#pragma unroll
        for (int r = 0; r < 16; ++r) { const float p = __builtin_amdgcn_exp2f(S[t][r] - mx); S[t][r] = p; sum += p; }
    sum += __shfl_xor(sum, 32);
    sum += __builtin_amdgcn_exp2f(sinkl - mx);
    const float linv = 1.0f / sum;
    f32x16 o0, o1;
#pragma unroll
    for (int i = 0; i < 16; ++i) { o0[i] = 0.f; o1[i] = 0.f; }
#pragma unroll
    for (int t = 0; t < 5; ++t)
#pragma unroll
        for (int s = 0; s < 2; ++s) {
            u32x4 pw; pw.x = cvtpk(S[t][8 * s + 0], S[t][8 * s + 1]); pw.y = cvtpk(S[t][8 * s + 2], S[t][8 * s + 3]); pw.z = cvtpk(S[t][8 * s + 4], S[t][8 * s + 5]); pw.w = cvtpk(S[t][8 * s + 6], S[t][8 * s + 7]);
            const bf16x8 pa = __builtin_bit_cast(bf16x8, pw);
            const int keyb = 32 * (rg + t) + 16 * s + 4 * hi;
            const LAS unsigned char* vb = lds + VL_OFF + r32 * VL_PITCH + keyb * 2;
            const u32x2 l0 = *(const LAS u32x2*)(vb), h0 = *(const LAS u32x2*)(vb + 16);
            const u32x2 l1 = *(const LAS u32x2*)(vb + 32 * VL_PITCH), h1 = *(const LAS u32x2*)(vb + 32 * VL_PITCH + 16);
            const bf16x8 v0 = __builtin_bit_cast(bf16x8, ((u32x4){l0.x, l0.y, h0.x, h0.y})), v1 = __builtin_bit_cast(bf16x8, ((u32x4){l1.x, l1.y, h1.x, h1.y}));
            o0 = MFMA32(pa, v0, o0); o1 = MFMA32(pa, v1, o1);
            if (s == 1) __builtin_amdgcn_sched_barrier(0);
        }
    LAS bf16* stg = (LAS bf16*)(lds + ASTG_OFF) + rg * 2048;
#pragma unroll
    for (int r = 0; r < 16; ++r) { const int ro = (r & 3) + 8 * (r >> 2) + 4 * hi; const float li = __shfl(linv, ro);
        const float v0 = o0[r] * li, v1 = o1[r] * li;
        { float q_ = ssacc[r] + (v0 * v0 + v1 * v1); asm volatile("" : "+v"(q_)); ssacc[r] = q_; }
        stg[ro * 64 + r32] = (bf16)(cvtpk(v0, 0.f) & 0xffffu); stg[ro * 64 + 32 + r32] = (bf16)(cvtpk(v1, 0.f) & 0xffffu); }
    asm volatile("s_waitcnt lgkmcnt(0)" ::: "memory");
    size_t yo = (c.rowbase + 32 * rg + (lane_ >> 3)) * D + 512 + h * 64 + (lane_ & 7) * 8; OPAQUE_V(yo); bf16* yb = c.Y + yo;
#pragma unroll
    for (int i = 0; i < 4; ++i) { const u32x4 v = *(const LAS u32x4*)(stg + (i * 8 + (lane_ >> 3)) * 64 + (lane_ & 7) * 8); *(u32x4*)(yb + (size_t)i * 8 * D) = v; }
    asm volatile("s_waitcnt lgkmcnt(0)" ::: "memory");
}
template <int KH> __device__ __forceinline__ void att_fill(const MixCtx& c, bf16x8 (&qr)[4], const bf16* qp) {
    LAS unsigned char* lds = c.lds; int htid = c.htid; OPAQUE_V(htid); const int n = c.n;
#pragma unroll
    for (int d0 = 0; d0 < 4; ++d0) qr[d0] = *(const bf16x8*)(qp + 16 * d0);
#pragma unroll
    for (int k = 0; k < 8; ++k) {
        const int i = htid + 256 * k, key = i >> 3, cc = i & 7; const bool valid = (n > 0) || (key >= 128);
        u32x4 v = (u32x4){0u, 0u, 0u, 0u};
        if (valid) v = *(const u32x4*)(c.Z + (c.rowbase + key - 128) * NIN + 1024 + KH * 64 + cc * 8);
        *(LAS u32x4*)(lds + KL_OFF + key * KL_PITCH + cc * 16) = v;
    }
#pragma unroll
    for (int k = 0; k < 8; ++k) {
        const int i = htid + 256 * k, d = i >> 5, cc = i & 31; const bool valid = (n > 0) || (cc >= 16);
        u32x4 v = (u32x4){0u, 0u, 0u, 0u};
        if (valid) v = *(const u32x4*)(c.Vt + ((size_t)((c.b * 2 + KH) * 64 + d)) * SEQ + n * 128 - 128 + cc * 8);
        LAS u32x2* dst = (LAS u32x2*)(lds + VL_OFF + d * VL_PITCH + cc * 16);
        dst[0] = (u32x2){v.x, v.y}; dst[1] = (u32x2){v.z, v.w};
    }
}
__device__ __forceinline__ void att_half(const MixCtx& c) {
    f32x16 ssacc;
#pragma unroll
    for (int r = 0; r < 16; ++r) ssacc[r] = 0.f;
    const bf16* qp0 = c.Z + (c.rowbase + 32 * c.hw + (c.lane & 31)) * NIN + 512 + 8 * (c.lane >> 5);
    const bf16* qp1 = qp0 + 256;
    bf16x8 qr[4]; u32x4 pre[9];
    u_load(c, 0, pre); att_fill<0>(c, qr, qp0); u_store(c, pre);            lds_barrier();
    u_load(c, 1, pre); att_item<0, 0>(c, qr, qp0, ssacc);                  lds_barrier();
    u_store(c, pre);   att_item<0, 1>(c, qr, qp0, ssacc);                  lds_barrier();
    u_load(c, 2, pre); att_item<0, 2>(c, qr, qp0, ssacc);                  lds_barrier();
    u_store(c, pre);   att_item<0, 3>(c, qr, qp0, ssacc);                  lds_barrier();
    u_load(c, 3, pre); att_fill<1>(c, qr, qp1);                            lds_barrier();
    u_store(c, pre);   att_item<1, 0>(c, qr, qp1, ssacc);                  lds_barrier();
    att_item<1, 1>(c, qr, qp1, ssacc);                                     lds_barrier();
    att_item<1, 2>(c, qr, qp1, ssacc);                                     lds_barrier();
    att_item<1, 3>(c, qr, qp1, ssacc);
    { int lane = c.lane; OPAQUE_V(lane); const int r32 = lane & 31, hi = lane >> 5; LAS float* RAL = (LAS float*)(c.lds + RAL_OFF);
#pragma unroll
      for (int r = 0; r < 16; ++r) { const int ro = (r & 3) + 8 * (r >> 2) + 4 * hi; const float ss = half_sum32(ssacc[r]);
          if (r32 == 0) RAL[32 * c.hw + ro] = __builtin_amdgcn_rsqf(ss * (1.0f / 512.0f) + EPS); } }
    lds_barrier();
    lds_barrier();
}
__device__ __forceinline__ void mixer_block(LAS unsigned char* lds, int blk, const bf16* Z, const bf16* Vt, const bf16* WpT, const float* pool_scale, const float* sinks,
                                            const float* g_pool, const float* g_attn, bf16* Y, float* RA, int tid, int wid, int lane) {
    OPAQUE_V(tid); OPAQUE_V(lane); OPAQUE_S(wid);
    MixCtx c; c.lds = lds; c.Z = Z; c.Vt = Vt; c.WpT = WpT; c.pool_scale = pool_scale; c.sinks = sinks; c.g_pool = g_pool; c.g_attn = g_attn; c.Y = Y; c.RA = RA; c.rowbase = (size_t)blk * 128;
    c.b = blk / NB_SEQ; c.n = blk % NB_SEQ; c.htid = tid & 255; c.lane = lane; c.hw = wid & 3;
    if (wid < 4) pool_half(c); else att_half(c);
}
__global__ void __launch_bounds__(NTHREADS, 2) hybrid_fwd(Args args) {
    extern __shared__ __attribute__((aligned(16))) unsigned char lds_raw[];
    LAS unsigned char* lds = (LAS unsigned char*)lds_raw;
    cg::grid_group grid = cg::this_grid();
    const int tid = threadIdx.x, lane = tid & 63, wid = __builtin_amdgcn_readfirstlane(tid >> 6);
    const int G = gridDim.x, bx = blockIdx.x;
    const int vcu = (G % 8 == 0) ? (bx % 8) * (G / 8) + bx / 8 : bx;
    const int gw = vcu * NWAVES + wid, NGW = G * NWAVES;
    unsigned char* ws = args.ws;
    bf16 *Wgu1 = (bf16*)(ws + WS_WGU1), *Wgu2 = (bf16*)(ws + WS_WGU2), *Wd1 = (bf16*)(ws + WS_WD1), *Wd2 = (bf16*)(ws + WS_WD2), *Win = (bf16*)(ws + WS_WIN), *Wout = (bf16*)(ws + WS_WOUT), *WpT = (bf16*)(ws + WS_WPOOL);
    float* CS = (float*)(ws + WS_CS);
    bf16 *HD = (bf16*)(ws + WS_HD), *H = (bf16*)(ws + WS_H), *Z = (bf16*)(ws + WS_Z), *Vt = (bf16*)(ws + WS_VT), *Y = (bf16*)(ws + WS_Y), *XR = (bf16*)(ws + WS_XR); float* RAg = (float*)(ws + WS_RA); float* RS = (float*)(ws + WS_RA + 512 * 1024);
    const int lo = args.ph_lo, hi = args.ph_hi;
#define IN(k) (lo <= (k) && (k) < hi)
#define SEAM(k) do { if (IN(k) && IN((k) + 1)) { if ((k) == 0) grid.sync(); else xcd_barrier(bar); } } while (0)
    if (tid < 32) ((LAS unsigned*)(lds + MISC_OFF))[tid] = 0u;
    __syncthreads();
    const int grp = bx & 7, gslot = bx >> 3, GW = G >> 3;
    unsigned* ctl = (unsigned*)(ws + WS_CTL);
    XcdBarrier bar; bar.bar = ctl + (1 + grp) * XCD_BAR_WORDS; bar.x = 0; bar.st = nullptr; bar.total = (unsigned)GW;
    const bool one_launch = (hi - lo > 1);
    const int grow0 = grp * (M / 8) + gslot * NWAVES + wid, grow1 = (grp + 1) * (M / 8);
    unsigned* halo_flag = ctl + 9 * XCD_BAR_WORDS;

    if (IN(0)) {
        for (int i = vcu * NTHREADS + tid; i < (int)(CTL_BYTES / 4); i += G * NTHREADS) __hip_atomic_store(ctl + i, 0u, __ATOMIC_RELAXED, __HIP_MEMORY_SCOPE_AGENT);
        LAS float* scr = (LAS float*)(lds + wid * 16384);
        constexpr int I_GU = (D / 64) * (NGU / 32), I_DN = (FF / 64) * (D / 32), I_IN = (D / 64) * (NIN / 32), I_OUT = (D / 64) * (D / 32), I_PL = 4 * 2 * 4;
        constexpr int NITEMS = 2 * I_GU + 2 * I_DN + I_IN + I_OUT + I_PL;
        for (int it = gw; it < NITEMS; it += NGW) {
            int r = it;
            if (r < I_GU) { transpose_item(args.ffn1_wgu, D, NGU, Wgu1, 1, scr, r, lane, args.ffn1_pre); continue; } r -= I_GU;
            if (r < I_GU) { transpose_item(args.ffn2_wgu, D, NGU, Wgu2, 1, scr, r, lane, args.ffn2_pre); continue; } r -= I_GU;
            if (r < I_DN) { transpose_item(args.ffn1_wd, FF, D, Wd1, 0, scr, r, lane); continue; } r -= I_DN;
            if (r < I_DN) { transpose_item(args.ffn2_wd, FF, D, Wd2, 0, scr, r, lane); continue; } r -= I_DN;
            if (r < I_IN) { transpose_item(args.w_in, D, NIN, Win, 2, scr, r, lane, args.mix_pre); continue; } r -= I_IN;
            if (r < I_OUT) { transpose_item(args.w_out, D, D, Wout, 0, scr, r, lane, args.g_pool, args.g_attn); continue; } r -= I_OUT;
            { const int g = r >> 3; transpose_item(args.w_pool + (size_t)g * 16384, 128, 128, WpT + (size_t)g * 16384, 0, scr, r & 7, lane, nullptr, nullptr, args.pool_scale + g * 128); }
        }
        for (int idx = vcu * NTHREADS + tid; idx < M * 8; idx += G * NTHREADS) {
            const int row = idx >> 3, i = idx & 7; const float ang = (float)args.pos[row] * inv_freq(i);
            float sn, cn; sincos_f(ang, sn, cn); CS[(size_t)row * 16 + i] = cn; CS[(size_t)row * 16 + 8 + i] = sn;
        }
        prenorm_rows(args.x, XR, RS, gw, NGW, lane);
    }
    SEAM(0);
    if (one_launch) bar = xcd_barrier_post(ctl + (1 + grp) * XCD_BAR_WORDS, (volatile LAS unsigned*)(lds + MISC_OFF) + 8, (unsigned)GW);
    if (IN(1)) {
        pg8::Gemm g{XR, Wgu1, M, NGU, D}; pg8::StaticOrder S; S.init(M, NGU, G, bx); pg8::EpiSwiGLU E{H, FF};
        pg8::gemm_phase<pg8::EpiSwiGLU, pg8::StaticOrder, true, true>(lds, g, S, E);
    }
    SEAM(1);
    if (IN(2)) {
        pg8::Gemm g{H, Wd1, M, D, FF}; pg8::StaticOrder S; S.init(M, D, G, bx); pg8::EpiBf16<0> E{HD, D, nullptr, 0, 0, 1.f};
        pg8::gemm_phase<pg8::EpiBf16<0>, pg8::StaticOrder, true, true>(lds, g, S, E);
    }
    SEAM(2);
    if (IN(3)) thin_rows<true, false, true>(args.x, XR, HD, args.ffn1_post, RS, 0.5f, grow0, grow1, GW * NWAVES, lane);
    SEAM(3);
    if (IN(4)) {
        pg8::Gemm g{XR, Win, M, NIN, D}; pg8::StaticOrder S; S.init(M, NIN, G, bx); pg8::EpiZ E{Z, Vt, CS, QSCALE, SEQ};
        pg8::gemm_phase<pg8::EpiZ, pg8::StaticOrder, true, true>(lds, g, S, E);
    }
    SEAM(4);
    if (IN(4) && IN(5)) { if (gslot == 0 && tid == 0) { __builtin_amdgcn_fence(__ATOMIC_RELEASE, "agent"); asm volatile("s_waitcnt vmcnt(0)" ::: "memory"); } __syncthreads(); if (gslot == 0 && tid == 0) __hip_atomic_store(halo_flag + 64 * grp, 1u, __ATOMIC_RELAXED, __HIP_MEMORY_SCOPE_AGENT); }
    if (IN(5)) { for (int blk = grp * (NBLK / 8) + gslot; blk < (grp + 1) * (NBLK / 8); blk += GW) {
        if (IN(4) && (blk % NB_SEQ) != 0 && (blk % (NBLK / 8)) == 0) {
            if (tid == 0) { unsigned sp = 0; while (__hip_atomic_load(halo_flag + 64 * (grp - 1), __ATOMIC_RELAXED, __HIP_MEMORY_SCOPE_AGENT) == 0u) { __builtin_amdgcn_s_sleep(2); if (++sp > (1u << 22)) break; }
                            __builtin_amdgcn_fence(__ATOMIC_ACQUIRE, "agent"); asm volatile("s_waitcnt vmcnt(0)" ::: "memory"); }
            __syncthreads(); }
        mixer_block(lds, blk, Z, Vt, WpT, args.pool_scale, args.sinks, args.g_pool, args.g_attn, Y, RAg, tid, wid, lane); } }
    SEAM(5);
    if (IN(6)) {
        pg8::Gemm g{Y, Wout, M, D, D}; pg8::StaticOrder S; S.init(M, D, G, bx); pg8::EpiRowScale E{HD, D, RAg};
        pg8::gemm_phase<pg8::EpiRowScale, pg8::StaticOrder, true, true>(lds, g, S, E);
    }
    SEAM(6);
    if (IN(7)) thin_rows<true, true, true>(XR, XR, HD, args.mix_post, RS, 1.0f, grow0, grow1, GW * NWAVES, lane);
    SEAM(7);
    if (IN(8)) {
        pg8::Gemm g{XR, Wgu2, M, NGU, D}; pg8::StaticOrder S; S.init(M, NGU, G, bx); pg8::EpiSwiGLU E{H, FF};
        pg8::gemm_phase<pg8::EpiSwiGLU, pg8::StaticOrder, true, true>(lds, g, S, E);
    }
    SEAM(8);
    if (IN(9)) {
        pg8::Gemm g{H, Wd2, M, D, FF}; pg8::StaticOrder S; S.init(M, D, G, bx); pg8::EpiBf16<0> E{HD, D, nullptr, 0, 0, 1.f};
        pg8::gemm_phase<pg8::EpiBf16<0>, pg8::StaticOrder, true, true>(lds, g, S, E);
    }
    SEAM(9);
    if (IN(10)) thin_rows<false, true, false>(XR, args.out, HD, args.ffn2_post, RS, 0.5f, grow0, grow1, GW * NWAVES, lane);
#undef IN
#undef SEAM
}

#ifndef MK_N_LAUNCHES
#define MK_N_LAUNCHES 1
#endif
extern "C" void kernel_launch(void* const* d_in, const int* in_sizes, int n_in, void* d_out, int out_size, void* d_ws, size_t ws_size, hipStream_t stream) {
    static int grid = 0;
    if (grid == 0) {
        if (n_in != 19 || in_sizes[0] != M * D || out_size != M * D || ws_size < WS_END) { fprintf(stderr, "kernel_launch: unexpected shapes (n_in %d, in0 %d, out %d, ws %zu)\n", n_in, n_in > 0 ? in_sizes[0] : -1, out_size, ws_size); grid = -1; return; }
        int dev = 0, cus = 0, per_cu = 0;
        if (hipGetDevice(&dev) != hipSuccess || hipDeviceGetAttribute(&cus, hipDeviceAttributeMultiprocessorCount, dev) != hipSuccess) { grid = -1; return; }
        if (hipFuncSetAttribute((const void*)hybrid_fwd, hipFuncAttributeMaxDynamicSharedMemorySize, LDS_BYTES) != hipSuccess) { fprintf(stderr, "kernel_launch: hipFuncSetAttribute failed\n"); grid = -1; return; }
        if (hipOccupancyMaxActiveBlocksPerMultiprocessor(&per_cu, (const void*)hybrid_fwd, NTHREADS, LDS_BYTES) != hipSuccess || per_cu < 1) { fprintf(stderr, "kernel_launch: occupancy query says %d\n", per_cu); per_cu = 1; }
        (void)hipGetLastError();
        grid = (cus / 8) * 8;
    }
    if (grid < 0) return;
    Args a{};
    a.x = (const float*)d_in[0]; a.pos = (const int*)d_in[1];
    a.ffn1_pre = (const float*)d_in[2]; a.ffn1_wgu = (const float*)d_in[3]; a.ffn1_wd = (const float*)d_in[4]; a.ffn1_post = (const float*)d_in[5];
    a.mix_pre = (const float*)d_in[6]; a.w_in = (const float*)d_in[7]; a.w_pool = (const float*)d_in[8]; a.pool_scale = (const float*)d_in[9]; a.sinks = (const float*)d_in[10];
    a.g_pool = (const float*)d_in[11]; a.g_attn = (const float*)d_in[12]; a.w_out = (const float*)d_in[13]; a.mix_post = (const float*)d_in[14];
    a.ffn2_pre = (const float*)d_in[15]; a.ffn2_wgu = (const float*)d_in[16]; a.ffn2_wd = (const float*)d_in[17]; a.ffn2_post = (const float*)d_in[18];
    a.out = (float*)d_out; a.ws = (unsigned char*)d_ws;
    constexpr int NPH = 11;
#if MK_N_LAUNCHES == 1
    a.ph_lo = 0; a.ph_hi = NPH;
    { void* kargs[] = {&a}; hipError_t e = hipLaunchCooperativeKernel((const void*)hybrid_fwd, dim3(grid), dim3(NTHREADS), kargs, LDS_BYTES, stream);
      if (e != hipSuccess) fprintf(stderr, "kernel_launch: cooperative launch failed: %s (grid %d)\n", hipGetErrorString(e), grid); }
#else
    for (int p = 0; p < NPH; ++p) { a.ph_lo = p; a.ph_hi = p + 1; void* kargs[] = {&a};
        hipError_t e = hipLaunchCooperativeKernel((const void*)hybrid_fwd, dim3(grid), dim3(NTHREADS), kargs, LDS_BYTES, stream);
        if (e != hipSuccess) { fprintf(stderr, "kernel_launch: launch %d failed: %s\n", p, hipGetErrorString(e)); break; } }
#endif
}
```

```cpp
#include <hip/hip_runtime.h>
#include <hip/hip_cooperative_groups.h>
#include <cstdio>
#include <cstdint>
namespace cg = cooperative_groups;
namespace pg8 {
#define PG8_LAS __attribute__((address_space(3)))
typedef unsigned short bf16_t;
typedef short bf16x8 __attribute__((ext_vector_type(8)));
typedef float f32x4 __attribute__((ext_vector_type(4)));
typedef unsigned u32x4 __attribute__((ext_vector_type(4)));
constexpr int BM = 256, BK = 64, HALF = 128, HTB = HALF * BK * 2  , STAGE_BYTES = 8 * HTB, NXCD = 8, WGM = 2;

__host__ __device__ __forceinline__ int lds_byte(int r, int c) { const int st = (r >> 4) * 2 + (c >> 5), rr = r & 15, cc = c & 31, ob = rr * 64 + cc * 2; return st * 1024 + (ob ^ (((ob >> 9) & 1) << 5)); }
__host__ __device__ __forceinline__ void stage_rc(int b, int& R, int& C) { const int st = b / 1024, sb = b % 1024, swz = sb ^ (((sb >> 9) & 1) << 5); R = (st >> 1) * 16 + swz / 64; C = (st & 1) * 32 + (swz % 64) / 2; }
__host__ __device__ __forceinline__ int perm32(int rho) { const int n = rho >> 4, i = rho & 15; return 8 * (i >> 2) + 4 * n + (i & 3); }

struct Unit { int pm, pn; };
struct Gemm { const bf16_t* A; const bf16_t* Bt; int M, N, K; };

struct StaticOrder {
    int nM, nN, nwg, G, c;
    __host__ __device__ void init(int M, int N, int G_, int c_) { nM = M / BM; nN = N / BM; nwg = nM * nN; G = G_; c = c_; }
    __host__ __device__ bool next(int i, Unit& u) const {
        const long L = (long)i * G + c; if (L >= nwg) return false;
        int wgid = (int)L; { const int q = nwg / NXCD, r = nwg % NXCD, xcd = wgid % NXCD, off = wgid / NXCD; wgid = (xcd < r ? xcd * (q + 1) : r * (q + 1) + (xcd - r) * q) + off; }
        const int nig = WGM * nN, gid = wgid / nig, fm = gid * WGM, gsz = (nM - fm) < WGM ? (nM - fm) : WGM;
        u.pm = fm + ((wgid % nig) % gsz); u.pn = (wgid % nig) / gsz; return true;
    }
    __device__ __forceinline__ void a_ready(const Unit&) const {}
    __device__ __forceinline__ void done(const Unit&) const {}
};

__device__ __forceinline__ unsigned cvt_pk_bf16(float lo, float hi) { unsigned r; asm volatile("v_cvt_pk_bf16_f32 %0, %1, %2" : "=v"(r) : "v"(lo), "v"(hi)); return r; }
typedef float f32x2 __attribute__((ext_vector_type(2)));
__device__ __forceinline__ f32x2 gelu_pk(f32x2 v) {
    const f32x2 av = __builtin_elementwise_abs(v), d = av * 0.2316418882f + 1.0f;
    f32x2 t; t.x = __builtin_amdgcn_rcpf(d.x); t.y = __builtin_amdgcn_rcpf(d.y);
    f32x2 q = t * 0.5307027145f + (-0.7265760135f); q = q * t + 0.7107068705f; q = q * t + (-0.142248368f); q = q * t + 0.127414796f; q = q * t;
    const f32x2 s = (v * v) * (-0.72134752044f);
    f32x2 e; e.x = __builtin_amdgcn_exp2f(s.x); e.y = __builtin_amdgcn_exp2f(s.y);
    const f32x2 m = v * (q * e), r = v - m;
    f32x2 o; o.x = v.x < 0.f ? m.x : r.x; o.y = v.y < 0.f ? m.y : r.y; return o;
}

template <int ACT  > struct EpiBf16 {
    static constexpr bool PERM = true, AFTER_DRAIN = false; static_assert(ACT == 0 || ACT == 1, "EpiBf16: ACT is 0 (none) or 1 (gelu_pk)");
    bf16_t* O; int ldc; const float* bias; int split_cols; size_t split_stride; float scale0;
    __device__ __forceinline__ void operator()(const f32x4 (&acc)[2][2][4][2], const Unit& u, int wr, int wc, int fr, int fq) const {
        const int row0 = u.pm * BM + wr * 64 + fr; int colt = u.pn * BM; bf16_t* base = O;
        float sc = 1.f; if (split_cols) { const int t = colt / split_cols; base += (size_t)t * split_stride; colt -= t * split_cols; if (t == 0) sc = scale0; }
        const int col0 = colt + wc * 32 + 8 * fq, bcol0 = u.pn * BM + wc * 32 + 8 * fq;
        f32x4 bv[2][2];
#pragma unroll
        for (int bj = 0; bj < 2; ++bj)
#pragma unroll
            for (int n = 0; n < 2; ++n) bv[bj][n] = bias ? *(const f32x4*)(bias + bcol0 + bj * HALF + 4 * n) : (f32x4){0.f, 0.f, 0.f, 0.f};
#pragma unroll
        for (int ai = 0; ai < 2; ++ai)
#pragma unroll
            for (int m = 0; m < 4; ++m) { bf16_t* rowp = base + (size_t)(row0 + ai * HALF + m * 16) * ldc + col0;
#pragma unroll
                for (int bj = 0; bj < 2; ++bj) { f32x4 v0 = acc[ai][bj][m][0] + bv[bj][0], v1 = acc[ai][bj][m][1] + bv[bj][1];
                    if (ACT == 1) { f32x2 a = gelu_pk((f32x2){v0[0], v0[1]}), b = gelu_pk((f32x2){v0[2], v0[3]}), c = gelu_pk((f32x2){v1[0], v1[1]}), d = gelu_pk((f32x2){v1[2], v1[3]});
                        v0 = (f32x4){a.x, a.y, b.x, b.y}; v1 = (f32x4){c.x, c.y, d.x, d.y}; }
                    v0 = v0 * sc; v1 = v1 * sc; u32x4 w; w.x = cvt_pk_bf16(v0[0], v0[1]); w.y = cvt_pk_bf16(v0[2], v0[3]); w.z = cvt_pk_bf16(v1[0], v1[1]); w.w = cvt_pk_bf16(v1[2], v1[3]);
                    *(u32x4*)(rowp + bj * HALF) = w; } }
    }
};
typedef __bf16 bf16x2_t __attribute__((ext_vector_type(2)));
__device__ __forceinline__ unsigned cvtpk(float lo, float hi) { f32x2 v = {lo, hi}; bf16x2_t b = __builtin_convertvector(v, bf16x2_t); return __builtin_bit_cast(unsigned, b); }
__device__ __forceinline__ float silu_mul(float g, float u) { const float e = __builtin_amdgcn_exp2f(-1.4426950408889634f * g); return g * __builtin_amdgcn_rcpf(1.0f + e) * u; }

struct EpiSwiGLU {
    static constexpr bool PERM = true, AFTER_DRAIN = false;
    bf16_t* O; int ldc;
    __device__ __forceinline__ void operator()(const f32x4 (&acc)[2][2][4][2], const Unit& u, int wr, int wc, int fr, int fq) const {
        const int row0 = u.pm * BM + wr * 64 + fr, col0 = u.pn * HALF + wc * 32 + 8 * fq;
#pragma unroll
        for (int ai = 0; ai < 2; ++ai)
#pragma unroll
            for (int m = 0; m < 4; ++m) { const int row = row0 + ai * HALF + m * 16; bf16_t* rowp = O + (size_t)row * ldc + col0;
                const f32x4 g0 = acc[ai][0][m][0], g1 = acc[ai][0][m][1], u0 = acc[ai][1][m][0], u1 = acc[ai][1][m][1];
                u32x4 w; w.x = cvtpk(silu_mul(g0[0], u0[0]), silu_mul(g0[1], u0[1])); w.y = cvtpk(silu_mul(g0[2], u0[2]), silu_mul(g0[3], u0[3]));
                w.z = cvtpk(silu_mul(g1[0], u1[0]), silu_mul(g1[1], u1[1])); w.w = cvtpk(silu_mul(g1[2], u1[2]), silu_mul(g1[3], u1[3]));
                *(u32x4*)rowp = w; }
    }
};
struct EpiRowScale {
    static constexpr bool PERM = true, AFTER_DRAIN = false;
    bf16_t* O; int ldc; const float* rs;
    __device__ __forceinline__ void operator()(const f32x4 (&acc)[2][2][4][2], const Unit& u, int wr, int wc, int fr, int fq) const {
        const int row0 = u.pm * BM + wr * 64 + fr, col0 = u.pn * BM + wc * 32 + 8 * fq;
#pragma unroll
        for (int ai = 0; ai < 2; ++ai)
#pragma unroll
            for (int m = 0; m < 4; ++m) { const int row = row0 + ai * HALF + m * 16; const float sc = rs[row]; bf16_t* rowp = O + (size_t)row * ldc + col0;
#pragma unroll
                for (int bj = 0; bj < 2; ++bj) { const f32x4 v0 = acc[ai][bj][m][0] * sc, v1 = acc[ai][bj][m][1] * sc;
                    u32x4 w; w.x = cvtpk(v0[0], v0[1]); w.y = cvtpk(v0[2], v0[3]); w.z = cvtpk(v1[0], v1[1]); w.w = cvtpk(v1[2], v1[3]);
                    *(u32x4*)(rowp + bj * HALF) = w; } }
    }
};
struct EpiZ {
    static constexpr bool PERM = true, AFTER_DRAIN = false;
    bf16_t* Z; bf16_t* Vt; const float* cs; float qscale; int seq;
    __device__ __forceinline__ void operator()(const f32x4 (&acc)[2][2][4][2], const Unit& u, int wr, int wc, int fr, int fq) const {
        const int row0 = u.pm * BM + wr * 64 + fr, cl = wc * 32 + 8 * fq;
#pragma unroll
        for (int bj = 0; bj < 2; ++bj) {
            const int colh = u.pn * BM + bj * HALF;
            const bool isV = (colh == 1152);
            const bool rope = (colh >= 512) && (colh < 1152) && ((wc & 1) == 0) && (fq < 2);
            const float sc = (colh >= 512 && colh < 1024) ? qscale : 1.0f;
#pragma unroll
            for (int ai = 0; ai < 2; ++ai)
#pragma unroll
                for (int m = 0; m < 4; ++m) { const int row = row0 + ai * HALF + m * 16;
                    f32x4 v0 = acc[ai][bj][m][0], v1 = acc[ai][bj][m][1];
                    if (isV) {
                        const int b = row / seq, s = row - b * seq;
#pragma unroll
                        for (int i = 0; i < 4; ++i) { const int c0 = cl + i, c1 = cl + 4 + i;
                            Vt[((size_t)((b * 2 + (c0 >> 6)) * 64 + (c0 & 63))) * seq + s] = (bf16_t)(cvtpk(v0[i], 0.f) & 0xffffu);
                            Vt[((size_t)((b * 2 + (c1 >> 6)) * 64 + (c1 & 63))) * seq + s] = (bf16_t)(cvtpk(v1[i], 0.f) & 0xffffu); }
                    } else {
                        if (rope) { const f32x4 c = *(const f32x4*)(cs + (size_t)row * 16 + 4 * fq), sn = *(const f32x4*)(cs + (size_t)row * 16 + 8 + 4 * fq);
                            const f32x4 n0 = v0 * c - v1 * sn, n1 = v1 * c + v0 * sn; v0 = n0; v1 = n1; }
                        v0 = v0 * sc; v1 = v1 * sc;
                        u32x4 w; w.x = cvtpk(v0[0], v0[1]); w.y = cvtpk(v0[2], v0[3]); w.z = cvtpk(v1[0], v1[1]); w.w = cvtpk(v1[2], v1[3]);
                        *(u32x4*)(Z + (size_t)row * 1280 + colh + cl) = w; }
                }
        }
    }
};
template <class Epi, class Sched, bool ALIGN_EPI = false, bool SP2 = false>
__device__ __forceinline__ void gemm_phase(PG8_LAS unsigned char* lds, const Gemm g, const Sched& S, const Epi& E) {
    const int tid = threadIdx.x, wid = __builtin_amdgcn_readfirstlane(tid >> 6), lane = tid & 63, wr = wid >> 2, wc = wid & 3, fr = lane & 15, fq = lane >> 4;
    const int K = g.K, nt = K / BK;
    unsigned voffA[2], voffB[2];
#pragma unroll
    for (int i = 0; i < 2; ++i) { int R, C; stage_rc(tid * 16 + i * 8192, R, C); const int Rb = Epi::PERM ? ((R & ~31) + perm32(R & 31)) : R;
        voffA[i] = (unsigned)(R * K + C) * 2u; voffB[i] = (unsigned)(Rb * K + C) * 2u; }
    const size_t kstep = (size_t)(BK * 2);
    const size_t hstep = (size_t)HALF * K * 2;
    const size_t tstep = 2 * hstep;
    const unsigned ldsw = (unsigned)wid * 1024u;
    const int aoff = lds_byte(wr * 64 + fr, fq * 8), boff = lds_byte(wc * 32 + fr, fq * 8);
#define PG8_SA(b, h) (((b) * 2 + (h)) * HTB)
#define PG8_SB(b, h) ((4 + (b) * 2 + (h)) * HTB)
#define PG8_STAGE(bufoff, gbase, voff) do { _Pragma("unroll") for (int _i = 0; _i < 2; ++_i) \
        __builtin_amdgcn_global_load_lds((const unsigned*)((const char*)(gbase) + (voff)[_i]), (PG8_LAS unsigned*)(lds + (bufoff) + ldsw + _i * 8192), 16, 0, 0); } while (0)
#define PG8_LDA(dst, b, h) do { _Pragma("unroll") for (int m = 0; m < 4; ++m) _Pragma("unroll") for (int k = 0; k < 2; ++k) dst[m][k] = *(const PG8_LAS bf16x8*)(lds + PG8_SA(b, h) + aoff + m * 2048 + k * 1024); } while (0)
#define PG8_LDB(dst, b, h) do { _Pragma("unroll") for (int n = 0; n < 2; ++n) _Pragma("unroll") for (int k = 0; k < 2; ++k) dst[n][k] = *(const PG8_LAS bf16x8*)(lds + PG8_SB(b, h) + boff + n * 2048 + k * 1024); } while (0)
#define PG8_MMA(ai, bj, At, Bt) do { __builtin_amdgcn_s_setprio(1); _Pragma("unroll") for (int m = 0; m < 4; ++m) _Pragma("unroll") for (int n = 0; n < 2; ++n) _Pragma("unroll") for (int k = 0; k < 2; ++k) \
        acc[ai][bj][m][n] = __builtin_amdgcn_mfma_f32_16x16x32_bf16(Bt[n][k], At[m][k], acc[ai][bj][m][n], 0, 0, 0); __builtin_amdgcn_s_setprio(0); } while (0)
#define PG8_WAIT_V(n) asm volatile("s_waitcnt vmcnt(" #n ")" ::: "memory")
#define PG8_WAIT_L(n) asm volatile("s_waitcnt lgkmcnt(" #n ")" ::: "memory")
#define PG8_BAR __builtin_amdgcn_s_barrier()
#define PG8_SCHED __builtin_amdgcn_sched_barrier(0)
    Unit cur, nxt; int ui = 0;
    if (!S.next(0, cur)) return;
    f32x4 acc[2][2][4][2];
#pragma unroll
    for (int a = 0; a < 2; ++a)
#pragma unroll
        for (int b = 0; b < 2; ++b)
#pragma unroll
            for (int m = 0; m < 4; ++m)
#pragma unroll
                for (int n = 0; n < 2; ++n) acc[a][b][m][n] = (f32x4){0.f, 0.f, 0.f, 0.f};
    bf16x8 At[4][2], B0[2][2], B1[2][2];
    const char* cA = (const char*)g.A + (size_t)cur.pm * tstep; const char* cB = (const char*)g.Bt + (size_t)cur.pn * tstep;
    S.a_ready(cur);
    if constexpr (SP2) {
        PG8_STAGE(PG8_SB(0, 0), cB, voffB); PG8_STAGE(PG8_SB(0, 1), cB + hstep, voffB); PG8_STAGE(PG8_SA(0, 0), cA, voffA); PG8_STAGE(PG8_SA(0, 1), cA + hstep, voffA);
        if (wr == 1) PG8_BAR;
        PG8_WAIT_V(2); PG8_BAR;
        PG8_STAGE(PG8_SB(1, 0), cB + kstep, voffB); PG8_STAGE(PG8_SA(1, 0), cA + kstep, voffA); PG8_STAGE(PG8_SB(1, 1), cB + hstep + kstep, voffB);
        PG8_WAIT_V(6); PG8_BAR;
    } else {
        PG8_STAGE(PG8_SB(0, 0), cB, voffB); PG8_STAGE(PG8_SA(0, 0), cA, voffA); PG8_STAGE(PG8_SB(0, 1), cB + hstep, voffB); PG8_STAGE(PG8_SA(0, 1), cA + hstep, voffA);
        if (wr == 1) PG8_BAR;
        PG8_WAIT_V(4); PG8_BAR;
        PG8_STAGE(PG8_SB(1, 0), cB + kstep, voffB); PG8_STAGE(PG8_SA(1, 0), cA + kstep, voffA); PG8_STAGE(PG8_SB(1, 1), cB + hstep + kstep, voffB);
        PG8_WAIT_V(6); PG8_BAR;
    }
    for (;;) {
        const bool has_next = S.next(ui + 1, nxt);
        const char* nA = has_next ? (const char*)g.A + (size_t)nxt.pm * tstep : cA; const char* nB = has_next ? (const char*)g.Bt + (size_t)nxt.pn * tstep : cB;
        for (int t = 0; t < nt; t += 2) {
            const bool last = (t == nt - 2);
            const char* a1 = cA + (size_t)(t + 1) * kstep;
            const char* a2 = last ? nA : cA + (size_t)(t + 2) * kstep; const char* b2 = last ? nB : cB + (size_t)(t + 2) * kstep;
            const char* a3 = a2 + kstep; const char* b3 = b2 + kstep;
            if (last && has_next) S.a_ready(nxt);
            if constexpr (SP2) {
            PG8_LDB(B0, 0, 0); PG8_LDB(B1, 0, 1); PG8_SCHED; PG8_LDA(At, 0, 0); PG8_STAGE(PG8_SA(1, 1), a1 + hstep, voffA);
            PG8_WAIT_V(8); PG8_WAIT_L(0); PG8_BAR; PG8_MMA(0, 0, At, B0); PG8_MMA(0, 1, At, B1); PG8_BAR; PG8_SCHED;
            PG8_LDA(At, 0, 1); PG8_STAGE(PG8_SB(0, 0), b2, voffB); PG8_STAGE(PG8_SB(0, 1), b2 + hstep, voffB); PG8_STAGE(PG8_SA(0, 0), a2, voffA);
            PG8_WAIT_V(8); PG8_WAIT_L(0); PG8_BAR; PG8_MMA(1, 0, At, B0); PG8_MMA(1, 1, At, B1); PG8_BAR; PG8_SCHED;
            PG8_LDB(B0, 1, 0); PG8_LDB(B1, 1, 1); PG8_SCHED; PG8_LDA(At, 1, 0); PG8_STAGE(PG8_SA(0, 1), a2 + hstep, voffA);
            PG8_WAIT_V(8); PG8_WAIT_L(0); PG8_BAR; PG8_MMA(0, 0, At, B0); PG8_MMA(0, 1, At, B1); PG8_BAR; PG8_SCHED;
            PG8_LDA(At, 1, 1); PG8_STAGE(PG8_SB(1, 0), b3, voffB); PG8_STAGE(PG8_SB(1, 1), b3 + hstep, voffB); PG8_STAGE(PG8_SA(1, 0), a3, voffA);
            PG8_WAIT_V(8); PG8_WAIT_L(0); PG8_BAR; PG8_MMA(1, 0, At, B0); PG8_MMA(1, 1, At, B1); PG8_BAR; PG8_SCHED;
            } else {
            PG8_LDB(B0, 0, 0); PG8_SCHED; PG8_LDA(At, 0, 0); PG8_STAGE(PG8_SA(1, 1), a1 + hstep, voffA);
            PG8_WAIT_L(8); PG8_BAR; PG8_WAIT_L(0); PG8_MMA(0, 0, At, B0); PG8_BAR; PG8_SCHED;
            PG8_LDB(B1, 0, 1); PG8_STAGE(PG8_SB(0, 0), b2, voffB);
            PG8_BAR; PG8_WAIT_L(0); PG8_MMA(0, 1, At, B1); PG8_BAR;
            PG8_LDA(At, 0, 1); PG8_STAGE(PG8_SA(0, 0), a2, voffA);
            PG8_BAR; PG8_WAIT_L(0); PG8_MMA(1, 0, At, B0); PG8_BAR; PG8_SCHED;
            PG8_STAGE(PG8_SB(0, 1), b2 + hstep, voffB);
            PG8_WAIT_V(6); PG8_BAR; PG8_MMA(1, 1, At, B1); PG8_BAR;
            PG8_LDB(B0, 1, 0); PG8_SCHED; PG8_LDA(At, 1, 0); PG8_STAGE(PG8_SA(0, 1), a2 + hstep, voffA);
            PG8_WAIT_L(8); PG8_BAR; PG8_WAIT_L(0); PG8_MMA(0, 0, At, B0); PG8_BAR; PG8_SCHED;
            PG8_LDB(B1, 1, 1); PG8_STAGE(PG8_SB(1, 0), b3, voffB);
            PG8_BAR; PG8_WAIT_L(0); PG8_MMA(0, 1, At, B1); PG8_BAR;
            PG8_LDA(At, 1, 1); PG8_STAGE(PG8_SA(1, 0), a3, voffA);
            PG8_BAR; PG8_WAIT_L(0); PG8_MMA(1, 0, At, B0); PG8_BAR; PG8_SCHED;
            PG8_STAGE(PG8_SB(1, 1), b3 + hstep, voffB);
            PG8_WAIT_V(6); PG8_BAR; PG8_MMA(1, 1, At, B1); PG8_BAR;
            }
        }
        if constexpr (ALIGN_EPI) { if (wr == 0) PG8_BAR; }
        if constexpr (!Epi::AFTER_DRAIN) { E(acc, cur, wr, wc, fr, fq); S.done(cur); }
        if (!has_next) break;
#pragma unroll
        for (int a = 0; a < 2; ++a)
#pragma unroll
            for (int b = 0; b < 2; ++b)
#pragma unroll
                for (int m = 0; m < 4; ++m)
#pragma unroll
                    for (int n = 0; n < 2; ++n) acc[a][b][m][n] = (f32x4){0.f, 0.f, 0.f, 0.f};
        cur = nxt; cA = nA; cB = nB; ++ui;
        if constexpr (ALIGN_EPI) { if (wr == 1) PG8_BAR; }
    }
    PG8_WAIT_V(0);
    if constexpr (!ALIGN_EPI) { if (wr == 0) PG8_BAR; }
    PG8_BAR;
    if constexpr (Epi::AFTER_DRAIN) { E.fused(acc, cur, wr, wc, fr, fq, lds, wid, lane); S.done(cur); }
#undef PG8_SA
#undef PG8_SB
#undef PG8_STAGE
#undef PG8_LDA
#undef PG8_LDB
#undef PG8_MMA
#undef PG8_WAIT_V
#undef PG8_WAIT_L
#undef PG8_BAR
#undef PG8_SCHED
}
}
constexpr int BATCH = 4, SEQ = 8192, D = 1024, M = BATCH * SEQ, FF = 2816, NGU = 2 * FF, NIN = 1280, NBLK = M / 128, NB_SEQ = SEQ / 128;
constexpr float EPS = 1e-6f;
constexpr float QSCALE = 0.125f * 1.4426950408889634f;
constexpr float LOG2E = 1.4426950408889634f;
constexpr int NWAVES = 8, NTHREADS = 512;
constexpr size_t MiB = 1u << 20;
constexpr size_t WS_WGU1 = 0, WS_WGU2 = 11 * MiB, WS_WD1 = 22 * MiB, WS_WD2 = 28 * MiB, WS_WIN = 34 * MiB, WS_WOUT = 37 * MiB, WS_WPOOL = 39 * MiB, WS_CS = 40 * MiB;
constexpr size_t WS_CTL = 46 * MiB, CTL_BYTES = 262144, WS_RA = 47 * MiB;
constexpr size_t WS_Y = 48 * MiB, WS_HD = 112 * MiB, WS_H = 176 * MiB, WS_XR = 352 * MiB, WS_Z = 416 * MiB, WS_VT = 496 * MiB, WS_END = 504 * MiB;
static_assert((size_t)NGU * D * 2 <= 11 * MiB && (size_t)D * FF * 2 <= 6 * MiB && (size_t)NIN * D * 2 <= 3 * MiB && (size_t)M * 16 * 4 <= 6 * MiB, "ws map");
static_assert(WS_Y + (size_t)M * D * 2 <= WS_HD && WS_HD + (size_t)M * D * 2 <= WS_H && WS_H + (size_t)M * FF * 2 <= WS_XR && WS_XR + (size_t)M * D * 2 <= WS_Z && WS_Z + (size_t)M * NIN * 2 <= WS_VT && WS_VT + (size_t)M * 128 * 2 <= WS_END, "ws map 2");
constexpr int LDS_BYTES = 163840;
constexpr int KL_OFF = 0, KL_PITCH = 144, VL_OFF = 36864, VL_PITCH = 520, UL_OFF = 70144, UL_PITCH = 272, UL_ROWS = 143, DL_OFF = UL_OFF + 38912, DL_PITCH = 272;
constexpr int RAL_OFF = DL_OFF + 34816, ASTG_OFF = RAL_OFF + 512, MISC_OFF = ASTG_OFF + 16384;
static_assert(UL_ROWS * UL_PITCH <= 38912 && MISC_OFF >= 131072 && MISC_OFF + 128 <= LDS_BYTES && ASTG_OFF % 16 == 0 && DL_OFF % 16 == 0, "LDS map");

#define LAS __attribute__((address_space(3)))
typedef unsigned short bf16;
typedef unsigned u32x4 __attribute__((ext_vector_type(4)));
typedef unsigned u32x2 __attribute__((ext_vector_type(2)));
typedef float f32x4 __attribute__((ext_vector_type(4)));
typedef float f32x16 __attribute__((ext_vector_type(16)));
typedef short bf16x8 __attribute__((ext_vector_type(8)));
using pg8::cvtpk;
__device__ __forceinline__ float bflo(unsigned w) { return __uint_as_float(w << 16); }
__device__ __forceinline__ float bfhi(unsigned w) { return __uint_as_float(w & 0xffff0000u); }
__device__ __forceinline__ float wave_sum(float v) {
#pragma unroll
    for (int o = 1; o < 64; o <<= 1) v += __shfl_xor(v, o);
    return v;
}
__device__ __forceinline__ float half_sum32(float v) {
#pragma unroll
    for (int o = 1; o < 32; o <<= 1) v += __shfl_xor(v, o);
    return v;
}
__device__ __forceinline__ int crow(int r, int hi) { return (r & 3) + 8 * (r >> 2) + 4 * hi; }

struct Args {
    const float* x; const int* pos;
    const float *ffn1_pre, *ffn1_wgu, *ffn1_wd, *ffn1_post, *mix_pre, *w_in, *w_pool, *pool_scale, *sinks, *g_pool, *g_attn, *w_out, *mix_post, *ffn2_pre, *ffn2_wgu, *ffn2_wd, *ffn2_post;
    float* out; unsigned char* ws; int ph_lo, ph_hi;
};

__device__ __forceinline__ int dest_row(int mode, int n) {
    if (mode == 1) { return n < FF ? ((n >> 7) * 256 + (n & 127)) : ((((n - FF) >> 7) * 256) + 128 + ((n - FF) & 127)); }
    if (mode == 2) { if (n >= 512 && n < 1152) { const int d = n & 63; const int p = (d >= 4 && d < 8) ? d + 4 : ((d >= 8 && d < 12) ? d - 4 : d); return (n - d) + p; } return n; }
    return n;
}
__device__ __forceinline__ void transpose_item(const float* W, int K, int N, bf16* WT, int mode, LAS float* scr, int item, int lane, const float* gk = nullptr, const float* gk2 = nullptr, const float* gn = nullptr) {
    const int nblk = N / 32, kb = item / nblk, nb = item % nblk, k0 = 64 * kb, n0 = 32 * nb;
#pragma unroll 8
    for (int i = 0; i < 32; ++i) { const int kk = 2 * i + (lane >> 5); const int kr = k0 + kk; float gg = gk ? ((gk2 && kr >= 512) ? gk2[kr - 512] : gk[kr]) : 1.0f; if (gn) gg *= gn[n0 + (lane & 31)]; scr[kk * 33 + (lane & 31)] = W[(size_t)kr * N + n0 + (lane & 31)] * gg; }
    asm volatile("s_waitcnt lgkmcnt(0)" ::: "memory");
    const int c = lane & 7;
#pragma unroll
    for (int j = 0; j < 4; ++j) { const int n = (lane >> 3) + 8 * j; const LAS float* s = scr + (8 * c) * 33 + n;
        u32x4 o; o.x = cvtpk(s[0 * 33], s[1 * 33]); o.y = cvtpk(s[2 * 33], s[3 * 33]); o.z = cvtpk(s[4 * 33], s[5 * 33]); o.w = cvtpk(s[6 * 33], s[7 * 33]);
        *(u32x4*)(WT + (size_t)dest_row(mode, n0 + n) * K + k0 + 8 * c) = o; }
    asm volatile("s_waitcnt lgkmcnt(0)" ::: "memory");
}
__device__ __forceinline__ void sincos_f(float a, float& sn, float& cn) {
    const double ad = (double)a; const double q = __builtin_rint(ad * 0.63661977236758134308);
    const float r = (float)__builtin_fma(-q, 1.57079632679489661923, ad); const int qi = ((int)q) & 3;
    const float z = r * r;
    const float s = r + r * z * (-1.6666654611e-1f + z * (8.3321608736e-3f + z * (-1.9515295891e-4f)));
    const float c = 1.0f - 0.5f * z + z * z * (4.166664568298827e-2f + z * (-1.388731625493765e-3f + z * 2.443315711809948e-5f));
    sn = (qi == 0) ? s : (qi == 1) ? c : (qi == 2) ? -s : -c;
    cn = (qi == 0) ? c : (qi == 1) ? -s : (qi == 2) ? -c : s;
}
__device__ __forceinline__ float inv_freq(int i) {
    return i == 0 ? 1.0f : i == 1 ? 0.19392274474868576f : i == 2 ? 0.03760603093086393f : i == 3 ? 0.007292664737217109f : i == 4 ? 0.001414213562373095f : i == 5 ? 0.0002742481756762073f : i == 6 ? 5.318295896944988e-05f : 1.031338537721246e-05f;
}
__device__ __forceinline__ void prenorm_rows(const float* x, bf16* xb, float* rs, int gw, int NGW, int lane) {
    for (int m = gw; m < M; m += NGW) {
        const f32x4* xr = (const f32x4*)(x + (size_t)m * D) + lane; f32x4 v[4]; float s = 0.f;
#pragma unroll
        for (int j = 0; j < 4; ++j) { v[j] = xr[64 * j]; s += (v[j].x * v[j].x + v[j].y * v[j].y) + (v[j].z * v[j].z + v[j].w * v[j].w); }
        const float r = 1.0f / sqrtf(wave_sum(s) * (1.0f / D) + EPS);
        u32x2* o = (u32x2*)(xb + (size_t)m * D) + lane;
#pragma unroll
        for (int j = 0; j < 4; ++j) { const f32x4 y = v[j] * r; u32x2 w; w.x = cvtpk(y.x, y.y); w.y = cvtpk(y.z, y.w); o[64 * j] = w; }
        if (lane == 0) rs[m] = r;
    }
}
template <bool HAS_A, bool XI_BF, bool XO_BF>
__device__ __forceinline__ void thin_rows(const void* xi, void* xo, const bf16* h, const float* gpost, float* rsio, float coef, int m0, int m1, int NGW, int lane) {
    f32x4 gp[4];
#pragma unroll
    for (int j = 0; j < 4; ++j) gp[j] = *((const f32x4*)gpost + lane + 64 * j);
    for (int mb = m0; mb < m1; mb += 2 * NGW) {
        f32x4 v[2][4], hv[2][4]; float rin[2];
#pragma unroll
        for (int q = 0; q < 2; ++q) { const int mm = mb + q * NGW; const int m = mm < m1 ? mm : mb; rin[q] = XI_BF ? 1.0f / rsio[m] : 1.0f; }
#pragma unroll
        for (int q = 0; q < 2; ++q) { const int mm = mb + q * NGW; const int m = mm < m1 ? mm : mb;
            const u32x2* hr = (const u32x2*)(h + (size_t)m * D) + lane;
#pragma unroll
            for (int j = 0; j < 4; ++j) {
                if (XI_BF) { const u32x2 w = ((const u32x2*)((const bf16*)xi + (size_t)m * D) + lane)[64 * j]; v[q][j] = (f32x4){bflo(w.x), bfhi(w.x), bflo(w.y), bfhi(w.y)} * rin[q]; }
                else v[q][j] = ((const f32x4*)((const float*)xi + (size_t)m * D) + lane)[64 * j];
                const u32x2 w = hr[64 * j]; hv[q][j] = (f32x4){bflo(w.x), bfhi(w.x), bflo(w.y), bfhi(w.y)}; } }
#pragma unroll
        for (int q = 0; q < 2; ++q) { const int m = mb + q * NGW; if (m < m1) {
            float s = 0.f;
#pragma unroll
            for (int j = 0; j < 4; ++j) s += (hv[q][j].x * hv[q][j].x + hv[q][j].y * hv[q][j].y) + (hv[q][j].z * hv[q][j].z + hv[q][j].w * hv[q][j].w);
            const float r1 = coef / sqrtf(wave_sum(s) * (1.0f / D) + EPS);
            float s2 = 0.f;
#pragma unroll
            for (int j = 0; j < 4; ++j) { v[q][j] = v[q][j] + hv[q][j] * r1 * gp[j];
                s2 += (v[q][j].x * v[q][j].x + v[q][j].y * v[q][j].y) + (v[q][j].z * v[q][j].z + v[q][j].w * v[q][j].w); }
            const float r2 = HAS_A ? 1.0f / sqrtf(wave_sum(s2) * (1.0f / D) + EPS) : 1.0f;
#pragma unroll
            for (int j = 0; j < 4; ++j) {
                if (XO_BF) { const f32x4 y = v[q][j] * r2; u32x2 w; w.x = cvtpk(y.x, y.y); w.y = cvtpk(y.z, y.w); ((u32x2*)((bf16*)xo + (size_t)m * D) + lane)[64 * j] = w; }
                else ((f32x4*)((float*)xo + (size_t)m * D) + lane)[64 * j] = v[q][j]; }
            if (HAS_A) { if (lane == 0) rsio[m] = r2; } } }
    }
}

#define XB_TMO      128
#define XB_XCNT(j)  (256  + 64 * (j))
#define XB_XSUB(j)  (1280 + 64 * (j))
#define XB_XGEN(j)  (2304 + 64 * (j))
#define XB_TOP      3328
#define XB_TOPGEN   3392
#define XCD_BAR_WORDS 3456
#define XB_SPIN_CAP (1u << 18)

__device__ __forceinline__ unsigned xb_ld(unsigned* p)              { return __hip_atomic_load(p, __ATOMIC_RELAXED, __HIP_MEMORY_SCOPE_AGENT); }
__device__ __forceinline__ unsigned xb_add(unsigned* p, unsigned v) { return __hip_atomic_fetch_add(p, v, __ATOMIC_RELAXED, __HIP_MEMORY_SCOPE_AGENT); }
__device__ __forceinline__ unsigned xb_xcc_id() { return (unsigned)__builtin_amdgcn_s_getreg((3 << 11) | 20) & 0xFu; }
#define XB_SPIN(cond, bar) do { unsigned _sp = 0; while (cond) { __builtin_amdgcn_s_sleep(1); \
    if ((++_sp & 255u) == 0u) { if (xb_ld(&(bar)[XB_TMO])) break; if (_sp > XB_SPIN_CAP) { atomicAdd(&(bar)[XB_TMO], 1u); break; } } } } while (0)

struct XcdBarrier {
    unsigned* bar; unsigned x; unsigned total;
    volatile LAS unsigned* st;
};

__device__ __forceinline__ XcdBarrier xcd_barrier_post(unsigned* bar, volatile LAS unsigned* st, unsigned total) {
    XcdBarrier b; b.bar = bar; b.x = xb_xcc_id(); b.st = st; b.total = total;
    if (threadIdx.x == 0) (void)xb_add(&bar[XB_XCNT(b.x)], 1u);
    return b;
}
__device__ __forceinline__ void xcd_barrier_complete(unsigned* bar, unsigned x, unsigned G, unsigned& nloc, unsigned& nx) {
    unsigned sum, cnt, mine, sp = 0u;
    for (;;) {
        sum = 0u; cnt = 0u; mine = 0u;
#pragma unroll
        for (unsigned j = 0; j < 16; ++j) { const unsigned c = xb_ld(&bar[XB_XCNT(j)]); sum += c; cnt += (c > 0u) ? 1u : 0u; mine = (j == x) ? c : mine; }
        if (sum == G) break;
        __builtin_amdgcn_s_sleep(1);
        if ((++sp & 255u) == 0u) { if (xb_ld(&bar[XB_TMO])) break; if (sp > XB_SPIN_CAP) { atomicAdd(&bar[XB_TMO], 1u); break; } }
    }
    nloc = mine > 0u ? mine : 1u; nx = cnt > 0u ? cnt : 1u;
}

__device__ __forceinline__ void xcd_barrier(const XcdBarrier& b) {
    asm volatile("s_waitcnt vmcnt(0)" ::: "memory");
    __syncthreads();
    if (threadIdx.x == 0) {
        unsigned* bar = b.bar;
        __builtin_amdgcn_s_waitcnt(0);
        unsigned nloc = b.st[0], nx = b.st[1];
        if (nloc == 0u) { xcd_barrier_complete(bar, b.x, b.total, nloc, nx); b.st[0] = nloc; b.st[1] = nx; }
        const unsigned old = xb_add(&bar[XB_XSUB(b.x)], 1u);
        const unsigned gen = old / nloc;
        if (old + 1u == (gen + 1u) * nloc) {
            if (nx > 1u) __builtin_amdgcn_fence(__ATOMIC_RELEASE, "agent");
            asm volatile("s_waitcnt vmcnt(0)" ::: "memory");
            const unsigned og = xb_add(&bar[XB_TOP], 1u);
            const unsigned tg = og / nx;
            if (og + 1u == (tg + 1u) * nx) xb_add(&bar[XB_TOPGEN], 1u);
            else XB_SPIN(xb_ld(&bar[XB_TOPGEN]) == tg, bar);
            __builtin_amdgcn_fence(__ATOMIC_ACQUIRE, "agent");
            xb_add(&bar[XB_XGEN(b.x)], 1u);
            asm volatile("s_waitcnt vmcnt(0)" ::: "memory");
        } else {
            XB_SPIN(xb_ld(&bar[XB_XGEN(b.x)]) == gen, bar);
            __builtin_amdgcn_fence(__ATOMIC_ACQUIRE, "agent");
            asm volatile("s_waitcnt vmcnt(0)" ::: "memory");
        }
    }
    __syncthreads();
}
#define MFMA32(a, b, c) __builtin_amdgcn_mfma_f32_32x32x16_bf16((a), (b), (c), 0, 0, 0)
__device__ __forceinline__ void load8(const bf16* p, float (&f)[8]) { const u32x4 w = *(const u32x4*)p;
    f[0] = bflo(w.x); f[1] = bfhi(w.x); f[2] = bflo(w.y); f[3] = bfhi(w.y); f[4] = bflo(w.z); f[5] = bfhi(w.z); f[6] = bflo(w.w); f[7] = bfhi(w.w); }

#define OPAQUE_V(x) asm volatile("" : "+v"(x))
#define OPAQUE_S(x) asm volatile("" : "+s"(x))
__device__ __forceinline__ void lds_barrier() { asm volatile("s_waitcnt lgkmcnt(0)" ::: "memory"); __builtin_amdgcn_s_barrier(); asm volatile("" ::: "memory"); }
struct MixCtx { LAS unsigned char* lds; const bf16* Z; const bf16* Vt; const bf16* WpT; const float* pool_scale; const float* sinks; const float* g_pool; const float* g_attn; bf16* Y; float* RA; size_t rowbase; int b, n, htid, lane, hw; };

__device__ __forceinline__ void u_load(const MixCtx& c, int g, u32x4 (&pre)[9]) {
    int htid = c.htid; OPAQUE_V(htid);
#pragma unroll
    for (int k = 0; k < 9; ++k) { const int i = htid + 256 * k, jr = i >> 4, cc = i & 15; pre[k] = (u32x4){0u, 0u, 0u, 0u};
        if (jr < UL_ROWS && c.n * 128 + jr - 15 >= 0) pre[k] = *(const u32x4*)(c.Z + (ptrdiff_t)((ptrdiff_t)c.rowbase + jr - 15) * NIN + g * 128 + cc * 8); }
}
__device__ __forceinline__ void u_store(const MixCtx& c, const u32x4 (&pre)[9]) {
    int htid = c.htid; OPAQUE_V(htid);
#pragma unroll
    for (int k = 0; k < 9; ++k) { const int i = htid + 256 * k, jr = i >> 4, cc = i & 15; if (jr < UL_ROWS) *(LAS u32x4*)(c.lds + UL_OFF + jr * UL_PITCH + cc * 16) = pre[k]; }
}
template <int G> __device__ __forceinline__ void pool_D(const MixCtx& c) {
    constexpr int w = 2 << G;
    LAS unsigned char* lds = c.lds; int htid = c.htid; OPAQUE_V(htid);
    const int c8 = htid & 15, t0 = (htid >> 4) * 8;
    const LAS unsigned char* ub = lds + UL_OFF + (15 + t0) * UL_PITCH + c8 * 16;
    float s[8], uv[8];
#pragma unroll
    for (int i = 0; i < 8; ++i) s[i] = 0.f;
#define LDU(row) do { const u32x4 w_ = *(const LAS u32x4*)(ub + (row) * UL_PITCH); uv[0] = bflo(w_.x); uv[1] = bfhi(w_.x); uv[2] = bflo(w_.y); uv[3] = bfhi(w_.y); uv[4] = bflo(w_.z); uv[5] = bfhi(w_.z); uv[6] = bflo(w_.w); uv[7] = bfhi(w_.w); } while (0)
#pragma unroll
    for (int j = 1 - w; j < 0; ++j) { LDU(j);
#pragma unroll
        for (int i = 0; i < 8; ++i) s[i] += uv[i]; }
#pragma unroll
    for (int tt = 0; tt < 8; ++tt) { const int t = t0 + tt;
        LDU(tt);
#pragma unroll
        for (int i = 0; i < 8; ++i) s[i] += uv[i];
        const int sp = c.n * 128 + t; const int cnt = (sp + 1 < w) ? sp + 1 : w; const float inv = 1.0f / (float)cnt;
        u32x4 o; o.x = cvtpk(s[0] * inv - uv[0], s[1] * inv - uv[1]); o.y = cvtpk(s[2] * inv - uv[2], s[3] * inv - uv[3]);
        o.z = cvtpk(s[4] * inv - uv[4], s[5] * inv - uv[5]); o.w = cvtpk(s[6] * inv - uv[6], s[7] * inv - uv[7]);
        *(LAS u32x4*)(lds + DL_OFF + t * DL_PITCH + c8 * 16) = o;
        LDU(tt - w + 1);
#pragma unroll
        for (int i = 0; i < 8; ++i) s[i] -= uv[i]; }
#undef LDU
}
template <int G> __device__ __forceinline__ void pool_M(const MixCtx& c, f32x16& ssacc, unsigned (&kA)[16], unsigned (&kB)[16]) {
    LAS unsigned char* lds = c.lds; int lane_ = c.lane, hw = c.hw; OPAQUE_V(lane_); OPAQUE_S(hw);
    const int r32 = lane_ & 31, hi = lane_ >> 5;
#pragma unroll
    for (int j2 = 0; j2 < 2; ++j2) {
        f32x16 a0, a1;
#pragma unroll
        for (int i = 0; i < 16; ++i) { a0[i] = 0.f; a1[i] = 0.f; }
        const bf16* wp = c.WpT + (size_t)G * 16384 + (size_t)(64 * j2 + r32) * 128 + 8 * hi;
#pragma unroll
        for (int ks = 0; ks < 8; ++ks) {
            const bf16x8 A = *(const LAS bf16x8*)(lds + DL_OFF + (32 * hw + r32) * DL_PITCH + (16 * ks + 8 * hi) * 2);
            const bf16x8 B0 = *(const bf16x8*)(wp + 16 * ks), B1 = *(const bf16x8*)(wp + 32 * 128 + 16 * ks);
            a0 = MFMA32(A, B0, a0); a1 = MFMA32(A, B1, a1);
        }
#pragma unroll
        for (int r = 0; r < 16; ++r) { const float v0 = a0[r], v1 = a1[r];
            { float q_ = ssacc[r] + (v0 * v0 + v1 * v1); asm volatile("" : "+v"(q_)); ssacc[r] = q_; }
            unsigned pk_ = cvtpk(v0, v1); asm volatile("" : "+v"(pk_));
            if (j2 == 0) kA[r] = pk_; else kB[r] = pk_; }
        __builtin_amdgcn_sched_barrier(0);
    }
}
__device__ __forceinline__ void store_item(const MixCtx& c, LAS bf16* stg, const unsigned (&kp)[16], const float (&f)[16], int colbase) {
    int lane = c.lane; OPAQUE_V(lane); const int r32 = lane & 31, hi = lane >> 5;
#pragma unroll
    for (int r = 0; r < 16; ++r) { const int ro = (r & 3) + 8 * (r >> 2) + 4 * hi;
        stg[ro * 64 + r32] = (bf16)(cvtpk(bflo(kp[r]) * f[r], 0.f) & 0xffffu); stg[ro * 64 + 32 + r32] = (bf16)(cvtpk(bfhi(kp[r]) * f[r], 0.f) & 0xffffu); }
    asm volatile("s_waitcnt lgkmcnt(0)" ::: "memory");
    size_t yo = (c.rowbase + 32 * c.hw + (lane >> 3)) * D + colbase + (lane & 7) * 8; OPAQUE_V(yo); bf16* yb = c.Y + yo;
#pragma unroll
    for (int i = 0; i < 4; ++i) { const u32x4 v = *(const LAS u32x4*)(stg + (i * 8 + (lane >> 3)) * 64 + (lane & 7) * 8); *(u32x4*)(yb + (size_t)i * 8 * D) = v; }
    asm volatile("s_waitcnt lgkmcnt(0)" ::: "memory");
}
__device__ __forceinline__ void pool_half(const MixCtx& c) {
    f32x16 ssacc;
#pragma unroll
    for (int r = 0; r < 16; ++r) ssacc[r] = 0.f;
    unsigned a0[16], b0[16], a1[16], b1[16], a2[16], b2[16], a3[16], b3[16];
    lds_barrier();
    pool_D<0>(c); lds_barrier(); pool_M<0>(c, ssacc, a0, b0); lds_barrier();
    pool_D<1>(c); lds_barrier(); pool_M<1>(c, ssacc, a1, b1); lds_barrier();
    pool_D<2>(c); lds_barrier(); pool_M<2>(c, ssacc, a2, b2); lds_barrier();
    pool_D<3>(c); lds_barrier(); pool_M<3>(c, ssacc, a3, b3); lds_barrier();
    lds_barrier();
    int lane = c.lane; OPAQUE_V(lane); const int hi = lane >> 5;
    const LAS float* RAL = (const LAS float*)(c.lds + RAL_OFF);
    float f[16];
#pragma unroll
    for (int r = 0; r < 16; ++r) { const int ro = (r & 3) + 8 * (r >> 2) + 4 * hi; const float ss = half_sum32(ssacc[r]);
        f[r] = __builtin_amdgcn_rsqf(ss * (1.0f / 512.0f) + EPS) * __builtin_amdgcn_rcpf(RAL[32 * c.hw + ro]); }
    if (c.htid < 128) c.RA[c.rowbase + c.htid] = RAL[c.htid];
    LAS bf16* stg = (LAS bf16*)(c.lds + UL_OFF) + c.hw * 2048;
    store_item(c, stg, a0, f, 0); store_item(c, stg, b0, f, 64); store_item(c, stg, a1, f, 128); store_item(c, stg, b1, f, 192);
    store_item(c, stg, a2, f, 256); store_item(c, stg, b2, f, 320); store_item(c, stg, a3, f, 384); store_item(c, stg, b3, f, 448);
    lds_barrier();
}
template <int KH, int GI> __device__ __forceinline__ void att_item(const MixCtx& c, bf16x8 (&qr)[4], const bf16* qp, f32x16& ssacc) {
    LAS unsigned char* lds = c.lds; int lane_ = c.lane, rg = c.hw; OPAQUE_V(lane_); OPAQUE_S(rg);
    const int r32 = lane_ & 31, hi = lane_ >> 5, n = c.n;
    constexpr int h = KH * 4 + GI;
    f32x16 S[5];
#pragma unroll
    for (int t = 0; t < 5; ++t) {
#pragma unroll
        for (int i = 0; i < 16; ++i) S[t][i] = 0.f;
#pragma unroll
        for (int d0 = 0; d0 < 4; ++d0) { const bf16x8 kf = *(const LAS bf16x8*)(lds + KL_OFF + (32 * (rg + t) + r32) * KL_PITCH + (16 * d0 + 8 * hi) * 2);
            S[t] = MFMA32(kf, qr[d0], S[t]); }
        if (t & 1) __builtin_amdgcn_sched_barrier(0);
    }
    if (GI < 3) {
#pragma unroll
        for (int d0 = 0; d0 < 4; ++d0) qr[d0] = *(const bf16x8*)(qp + 64 * (GI + 1) + 16 * d0);
    }
    const float sinkl = c.sinks[h] * LOG2E;
    float mx = sinkl;
#pragma unroll
    for (int t = 0; t < 5; ++t)
#pragma unroll
        for (int r = 0; r < 16; ++r) {
            const bool tv = (n > 0) || (rg + t >= 4);
            const bool valid = (t == 0) ? (tv && (crow(r, hi) > r32)) : (t == 4) ? (crow(r, hi) <= r32) : tv;
            const float sv = valid ? S[t][r] : -1e30f; S[t][r] = sv; mx = fmaxf(mx, sv); }
    mx = fmaxf(mx, __shfl_xor(mx, 32));
    float sum = 0.f;
#pragma unroll
    for (int t = 0; t < 5; ++t)
#pragma unroll
        for (int r = 0; r < 16; ++r) { const float p = __builtin_amdgcn_exp2f(S[t][r] - mx); S[t][r] = p; sum += p; }
    sum += __shfl_xor(sum, 32);
    sum += __builtin_amdgcn_exp2f(sinkl - mx);
    const float linv = 1.0f / sum;
    f32x16 o0, o1;
#pragma unroll
    for (int i = 0; i < 16; ++i) { o0[i] = 0.f; o1[i] = 0.f; }
#pragma unroll
    for (int t = 0; t < 5; ++t)
#pragma unroll
        for (int s = 0; s < 2; ++s) {
            u32x4 pw; pw.x = cvtpk(S[t][8 * s + 0], S[t][8 * s + 1]); pw.y = cvtpk(S[t][8 * s + 2], S[t][8 * s + 3]); pw.z = cvtpk(S[t][8 * s + 4], S[t][8 * s + 5]); pw.w = cvtpk(S[t][8 * s + 6], S[t][8 * s + 7]);
            const bf16x8 pa = __builtin_bit_cast(bf16x8, pw);
            const int keyb = 32 * (rg + t) + 16 * s + 4 * hi;
            const LAS unsigned char* vb = lds + VL_OFF + r32 * VL_PITCH + keyb * 2;
            const u32x2 l0 = *(const LAS u32x2*)(vb), h0 = *(const LAS u32x2*)(vb + 16);
            const u32x2 l1 = *(const LAS u32x2*)(vb + 32 * VL_PITCH), h1 = *(const LAS u32x2*)(vb + 32 * VL_PITCH + 16);
            const bf16x8 v0 = __builtin_bit_cast(bf16x8, ((u32x4){l0.x, l0.y, h0.x, h0.y})), v1 = __builtin_bit_cast(bf16x8, ((u32x4){l1.x, l1.y, h1.x, h1.y}));
            o0 = MFMA32(pa, v0, o0); o1 = MFMA32(pa, v1, o1);
            if (s == 1) __builtin_amdgcn_sched_barrier(0);
        }
    LAS bf16* stg = (LAS bf16*)(lds + ASTG_OFF) + rg * 2048;
#pragma unroll
    for (int r = 0; r < 16; ++r) { const int ro = (r & 3) + 8 * (r >> 2) + 4 * hi; const float li = __shfl(linv, ro);
        const float v0 = o0[r] * li, v1 = o1[r] * li;
        { float q_ = ssacc[r] + (v0 * v0 + v1 * v1); asm volatile("" : "+v"(q_)); ssacc[r] = q_; }
        stg[ro * 64 + r32] = (bf16)(cvtpk(v0, 0.f) & 0xffffu); stg[ro * 64 + 32 + r32] = (bf16)(cvtpk(v1, 0.f) & 0xffffu); }
    asm volatile("s_waitcnt lgkmcnt(0)" ::: "memory");
    size_t yo = (c.rowbase + 32 * rg + (lane_ >> 3)) * D + 512 + h * 64 + (lane_ & 7) * 8; OPAQUE_V(yo); bf16* yb = c.Y + yo;
#pragma unroll
    for (int i = 0; i < 4; ++i) { const u32x4 v = *(const LAS u32x4*)(stg + (i * 8 + (lane_ >> 3)) * 64 + (lane_ & 7) * 8); *(u32x4*)(yb + (size_t)i * 8 * D) = v; }
    asm volatile("s_waitcnt lgkmcnt(0)" ::: "memory");
}
template <int KH> __device__ __forceinline__ void att_fill(const MixCtx& c, bf16x8 (&qr)[4], const bf16* qp) {
    LAS unsigned char* lds = c.lds; int htid = c.htid; OPAQUE_V(htid); const int n = c.n;
#pragma unroll
    for (int d0 = 0; d0 < 4; ++d0) qr[d0] = *(const bf16x8*)(qp + 16 * d0);
#pragma unroll
    for (int k = 0; k < 8; ++k) {
        const int i = htid + 256 * k, key = i >> 3, cc = i & 7; const bool valid = (n > 0) || (key >= 128);
        u32x4 v = (u32x4){0u, 0u, 0u, 0u};
        if (valid) v = *(const u32x4*)(c.Z + (c.rowbase + key - 128) * NIN + 1024 + KH * 64 + cc * 8);
        *(LAS u32x4*)(lds + KL_OFF + key * KL_PITCH + cc * 16) = v;
    }
#pragma unroll
    for (int k = 0; k < 8; ++k) {
        const int i = htid + 256 * k, d = i >> 5, cc = i & 31; const bool valid = (n > 0) || (cc >= 16);
        u32x4 v = (u32x4){0u, 0u, 0u, 0u};
        if (valid) v = *(const u32x4*)(c.Vt + ((size_t)((c.b * 2 + KH) * 64 + d)) * SEQ + n * 128 - 128 + cc * 8);
        LAS u32x2* dst = (LAS u32x2*)(lds + VL_OFF + d * VL_PITCH + cc * 16);
        dst[0] = (u32x2){v.x, v.y}; dst[1] = (u32x2){v.z, v.w};
    }
}
__device__ __forceinline__ void att_half(const MixCtx& c) {
    f32x16 ssacc;
#pragma unroll
    for (int r = 0; r < 16; ++r) ssacc[r] = 0.f;
    const bf16* qp0 = c.Z + (c.rowbase + 32 * c.hw + (c.lane & 31)) * NIN + 512 + 8 * (c.lane >> 5);
    const bf16* qp1 = qp0 + 256;
    bf16x8 qr[4]; u32x4 pre[9];
    u_load(c, 0, pre); att_fill<0>(c, qr, qp0); u_store(c, pre);            lds_barrier();
    u_load(c, 1, pre); att_item<0, 0>(c, qr, qp0, ssacc);                  lds_barrier();
    u_store(c, pre);   att_item<0, 1>(c, qr, qp0, ssacc);                  lds_barrier();
    u_load(c, 2, pre); att_item<0, 2>(c, qr, qp0, ssacc);                  lds_barrier();
    u_store(c, pre);   att_item<0, 3>(c, qr, qp0, ssacc);                  lds_barrier();
    u_load(c, 3, pre); att_fill<1>(c, qr, qp1);                            lds_barrier();
    u_store(c, pre);   att_item<1, 0>(c, qr, qp1, ssacc);                  lds_barrier();
    att_item<1, 1>(c, qr, qp1, ssacc);                                     lds_barrier();
    att_item<1, 2>(c, qr, qp1, ssacc);                                     lds_barrier();
    att_item<1, 3>(c, qr, qp1, ssacc);
    { int lane = c.lane; OPAQUE_V(lane); const int r32 = lane & 31, hi = lane >> 5; LAS float* RAL = (LAS float*)(c.lds + RAL_OFF);
#pragma unroll
      for (int r = 0; r < 16; ++r) { const int ro = (r & 3) + 8 * (r >> 2) + 4 * hi; const float ss = half_sum32(ssacc[r]);
          if (r32 == 0) RAL[32 * c.hw + ro] = __builtin_amdgcn_rsqf(ss * (1.0f / 512.0f) + EPS); } }
    lds_barrier();
    lds_barrier();
}
__device__ __forceinline__ void mixer_block(LAS unsigned char* lds, int blk, const bf16* Z, const bf16* Vt, const bf16* WpT, const float* pool_scale, const float* sinks,
                                            const float* g_pool, const float* g_attn, bf16* Y, float* RA, int tid, int wid, int lane) {
    OPAQUE_V(tid); OPAQUE_V(lane); OPAQUE_S(wid);
    MixCtx c; c.lds = lds; c.Z = Z; c.Vt = Vt; c.WpT = WpT; c.pool_scale = pool_scale; c.sinks = sinks; c.g_pool = g_pool; c.g_attn = g_attn; c.Y = Y; c.RA = RA; c.rowbase = (size_t)blk * 128;
    c.b = blk / NB_SEQ; c.n = blk % NB_SEQ; c.htid = tid & 255; c.lane = lane; c.hw = wid & 3;
    if (wid < 4) pool_half(c); else att_half(c);
}
__global__ void __launch_bounds__(NTHREADS, 2) hybrid_fwd(Args args) {
    extern __shared__ __attribute__((aligned(16))) unsigned char lds_raw[];
    LAS unsigned char* lds = (LAS unsigned char*)lds_raw;
    cg::grid_group grid = cg::this_grid();
    const int tid = threadIdx.x, lane = tid & 63, wid = __builtin_amdgcn_readfirstlane(tid >> 6);
    const int G = gridDim.x, bx = blockIdx.x;
    const int vcu = (G % 8 == 0) ? (bx % 8) * (G / 8) + bx / 8 : bx;
    const int gw = vcu * NWAVES + wid, NGW = G * NWAVES;
    unsigned char* ws = args.ws;
    bf16 *Wgu1 = (bf16*)(ws + WS_WGU1), *Wgu2 = (bf16*)(ws + WS_WGU2), *Wd1 = (bf16*)(ws + WS_WD1), *Wd2 = (bf16*)(ws + WS_WD2), *Win = (bf16*)(ws + WS_WIN), *Wout = (bf16*)(ws + WS_WOUT), *WpT = (bf16*)(ws + WS_WPOOL);
    float* CS = (float*)(ws + WS_CS);
    bf16 *HD = (bf16*)(ws + WS_HD), *H = (bf16*)(ws + WS_H), *Z = (bf16*)(ws + WS_Z), *Vt = (bf16*)(ws + WS_VT), *Y = (bf16*)(ws + WS_Y), *XR = (bf16*)(ws + WS_XR); float* RAg = (float*)(ws + WS_RA); float* RS = (float*)(ws + WS_RA + 512 * 1024);
    const int lo = args.ph_lo, hi = args.ph_hi;
#define IN(k) (lo <= (k) && (k) < hi)
#define SEAM(k) do { if (IN(k) && IN((k) + 1)) { if ((k) == 0) grid.sync(); else xcd_barrier(bar); } } while (0)
    if (tid < 32) ((LAS unsigned*)(lds + MISC_OFF))[tid] = 0u;
    __syncthreads();
    const int grp = bx & 7, gslot = bx >> 3, GW = G >> 3;
    unsigned* ctl = (unsigned*)(ws + WS_CTL);
    XcdBarrier bar; bar.bar = ctl + (1 + grp) * XCD_BAR_WORDS; bar.x = 0; bar.st = nullptr; bar.total = (unsigned)GW;
    const bool one_launch = (hi - lo > 1);
    const int grow0 = grp * (M / 8) + gslot * NWAVES + wid, grow1 = (grp + 1) * (M / 8);
    unsigned* halo_flag = ctl + 9 * XCD_BAR_WORDS;

    if (IN(0)) {
        for (int i = vcu * NTHREADS + tid; i < (int)(CTL_BYTES / 4); i += G * NTHREADS) __hip_atomic_store(ctl + i, 0u, __ATOMIC_RELAXED, __HIP_MEMORY_SCOPE_AGENT);
        LAS float* scr = (LAS float*)(lds + wid * 16384);
        constexpr int I_GU = (D / 64) * (NGU / 32), I_DN = (FF / 64) * (D / 32), I_IN = (D / 64) * (NIN / 32), I_OUT = (D / 64) * (D / 32), I_PL = 4 * 2 * 4;
        constexpr int NITEMS = 2 * I_GU + 2 * I_DN + I_IN + I_OUT + I_PL;
        for (int it = gw; it < NITEMS; it += NGW) {
            int r = it;
            if (r < I_GU) { transpose_item(args.ffn1_wgu, D, NGU, Wgu1, 1, scr, r, lane, args.ffn1_pre); continue; } r -= I_GU;
            if (r < I_GU) { transpose_item(args.ffn2_wgu, D, NGU, Wgu2, 1, scr, r, lane, args.ffn2_pre); continue; } r -= I_GU;
            if (r < I_DN) { transpose_item(args.ffn1_wd, FF, D, Wd1, 0, scr, r, lane); continue; } r -= I_DN;
            if (r < I_DN) { transpose_item(args.ffn2_wd, FF, D, Wd2, 0, scr, r, lane); continue; } r -= I_DN;
            if (r < I_IN) { transpose_item(args.w_in, D, NIN, Win, 2, scr, r, lane, args.mix_pre); continue; } r -= I_IN;
            if (r < I_OUT) { transpose_item(args.w_out, D, D, Wout, 0, scr, r, lane, args.g_pool, args.g_attn); continue; } r -= I_OUT;
            { const int g = r >> 3; transpose_item(args.w_pool + (size_t)g * 16384, 128, 128, WpT + (size_t)g * 16384, 0, scr, r & 7, lane, nullptr, nullptr, args.pool_scale + g * 128); }
        }
        for (int idx = vcu * NTHREADS + tid; idx < M * 8; idx += G * NTHREADS) {
            const int row = idx >> 3, i = idx & 7; const float ang = (float)args.pos[row] * inv_freq(i);
            float sn, cn; sincos_f(ang, sn, cn); CS[(size_t)row * 16 + i] = cn; CS[(size_t)row * 16 + 8 + i] = sn;
        }
        prenorm_rows(args.x, XR, RS, gw, NGW, lane);
    }
    SEAM(0);
    if (one_launch) bar = xcd_barrier_post(ctl + (1 + grp) * XCD_BAR_WORDS, (volatile LAS unsigned*)(lds + MISC_OFF) + 8, (unsigned)GW);
    if (IN(1)) {
        pg8::Gemm g{XR, Wgu1, M, NGU, D}; pg8::StaticOrder S; S.init(M, NGU, G, bx); pg8::EpiSwiGLU E{H, FF};
        pg8::gemm_phase<pg8::EpiSwiGLU, pg8::StaticOrder, true, true>(lds, g, S, E);
    }
    SEAM(1);
    if (IN(2)) {
        pg8::Gemm g{H, Wd1, M, D, FF}; pg8::StaticOrder S; S.init(M, D, G, bx); pg8::EpiBf16<0> E{HD, D, nullptr, 0, 0, 1.f};
        pg8::gemm_phase<pg8::EpiBf16<0>, pg8::StaticOrder, true, true>(lds, g, S, E);
    }
    SEAM(2);
    if (IN(3)) thin_rows<true, true, true>(XR, XR, HD, args.ffn1_post, RS, 0.5f, grow0, grow1, GW * NWAVES, lane);
    SEAM(3);
    if (IN(4)) {
        pg8::Gemm g{XR, Win, M, NIN, D}; pg8::StaticOrder S; S.init(M, NIN, G, bx); pg8::EpiZ E{Z, Vt, CS, QSCALE, SEQ};
        pg8::gemm_phase<pg8::EpiZ, pg8::StaticOrder, true, true>(lds, g, S, E);
    }
    SEAM(4);
    if (IN(4) && IN(5)) { if (gslot == 0 && tid == 0) { __builtin_amdgcn_fence(__ATOMIC_RELEASE, "agent"); asm volatile("s_waitcnt vmcnt(0)" ::: "memory"); } __syncthreads(); if (gslot == 0 && tid == 0) __hip_atomic_store(halo_flag + 64 * grp, 1u, __ATOMIC_RELAXED, __HIP_MEMORY_SCOPE_AGENT); }
    if (IN(5)) { for (int blk = grp * (NBLK / 8) + gslot; blk < (grp + 1) * (NBLK / 8); blk += GW) {
        if (IN(4) && (blk % NB_SEQ) != 0 && (blk % (NBLK / 8)) == 0) {
            if (tid == 0) { unsigned sp = 0; while (__hip_atomic_load(halo_flag + 64 * (grp - 1), __ATOMIC_RELAXED, __HIP_MEMORY_SCOPE_AGENT) == 0u) { __builtin_amdgcn_s_sleep(2); if (++sp > (1u << 22)) break; }
                            __builtin_amdgcn_fence(__ATOMIC_ACQUIRE, "agent"); asm volatile("s_waitcnt vmcnt(0)" ::: "memory"); }
            __syncthreads(); }
        mixer_block(lds, blk, Z, Vt, WpT, args.pool_scale, args.sinks, args.g_pool, args.g_attn, Y, RAg, tid, wid, lane); } }
    SEAM(5);
    if (IN(6)) {
        pg8::Gemm g{Y, Wout, M, D, D}; pg8::StaticOrder S; S.init(M, D, G, bx); pg8::EpiRowScale E{HD, D, RAg};
        pg8::gemm_phase<pg8::EpiRowScale, pg8::StaticOrder, true, true>(lds, g, S, E);
    }
    SEAM(6);
    if (IN(7)) thin_rows<true, true, true>(XR, XR, HD, args.mix_post, RS, 1.0f, grow0, grow1, GW * NWAVES, lane);
    SEAM(7);
    if (IN(8)) {
        pg8::Gemm g{XR, Wgu2, M, NGU, D}; pg8::StaticOrder S; S.init(M, NGU, G, bx); pg8::EpiSwiGLU E{H, FF};
        pg8::gemm_phase<pg8::EpiSwiGLU, pg8::StaticOrder, true, true>(lds, g, S, E);
    }
    SEAM(8);
    if (IN(9)) {
        pg8::Gemm g{H, Wd2, M, D, FF}; pg8::StaticOrder S; S.init(M, D, G, bx); pg8::EpiBf16<0> E{HD, D, nullptr, 0, 0, 1.f};
        pg8::gemm_phase<pg8::EpiBf16<0>, pg8::StaticOrder, true, true>(lds, g, S, E);
    }
    SEAM(9);
    if (IN(10)) thin_rows<false, true, false>(XR, args.out, HD, args.ffn2_post, RS, 0.5f, grow0, grow1, GW * NWAVES, lane);
#undef IN
#undef SEAM
}

#ifndef MK_N_LAUNCHES
#define MK_N_LAUNCHES 1
#endif
extern "C" void kernel_launch(void* const* d_in, const int* in_sizes, int n_in, void* d_out, int out_size, void* d_ws, size_t ws_size, hipStream_t stream) {
    static int grid = 0;
    if (grid == 0) {
        if (n_in != 19 || in_sizes[0] != M * D || out_size != M * D || ws_size < WS_END) { fprintf(stderr, "kernel_launch: unexpected shapes (n_in %d, in0 %d, out %d, ws %zu)\n", n_in, n_in > 0 ? in_sizes[0] : -1, out_size, ws_size); grid = -1; return; }
        int dev = 0, cus = 0, per_cu = 0;
        if (hipGetDevice(&dev) != hipSuccess || hipDeviceGetAttribute(&cus, hipDeviceAttributeMultiprocessorCount, dev) != hipSuccess) { grid = -1; return; }
        if (hipFuncSetAttribute((const void*)hybrid_fwd, hipFuncAttributeMaxDynamicSharedMemorySize, LDS_BYTES) != hipSuccess) { fprintf(stderr, "kernel_launch: hipFuncSetAttribute failed\n"); grid = -1; return; }
        if (hipOccupancyMaxActiveBlocksPerMultiprocessor(&per_cu, (const void*)hybrid_fwd, NTHREADS, LDS_BYTES) != hipSuccess || per_cu < 1) { fprintf(stderr, "kernel_launch: occupancy query says %d\n", per_cu); per_cu = 1; }
        (void)hipGetLastError();
        grid = (cus / 8) * 8;
    }
    if (grid < 0) return;
    Args a{};
    a.x = (const float*)d_in[0]; a.pos = (const int*)d_in[1];
    a.ffn1_pre = (const float*)d_in[2]; a.ffn1_wgu = (const float*)d_in[3]; a.ffn1_wd = (const float*)d_in[4]; a.ffn1_post = (const float*)d_in[5];
    a.mix_pre = (const float*)d_in[6]; a.w_in = (const float*)d_in[7]; a.w_pool = (const float*)d_in[8]; a.pool_scale = (const float*)d_in[9]; a.sinks = (const float*)d_in[10];
    a.g_pool = (const float*)d_in[11]; a.g_attn = (const float*)d_in[12]; a.w_out = (const float*)d_in[13]; a.mix_post = (const float*)d_in[14];
    a.ffn2_pre = (const float*)d_in[15]; a.ffn2_wgu = (const float*)d_in[16]; a.ffn2_wd = (const float*)d_in[17]; a.ffn2_post = (const float*)d_in[18];
    a.out = (float*)d_out; a.ws = (unsigned char*)d_ws;
    constexpr int NPH = 11;
#if MK_N_LAUNCHES == 1
    a.ph_lo = 0; a.ph_hi = NPH;
    { void* kargs[] = {&a}; hipError_t e = hipLaunchCooperativeKernel((const void*)hybrid_fwd, dim3(grid), dim3(NTHREADS), kargs, LDS_BYTES, stream);
      if (e != hipSuccess) fprintf(stderr, "kernel_launch: cooperative launch failed: %s (grid %d)\n", hipGetErrorString(e), grid); }
#else
    for (int p = 0; p < NPH; ++p) { a.ph_lo = p; a.ph_hi = p + 1; void* kargs[] = {&a};
        hipError_t e = hipLaunchCooperativeKernel((const void*)hybrid_fwd, dim3(grid), dim3(NTHREADS), kargs, LDS_BYTES, stream);
        if (e != hipSuccess) { fprintf(stderr, "kernel_launch: launch %d failed: %s\n", p, hipGetErrorString(e)); break; } }
#endif
}
```

```cpp
#include <hip/hip_runtime.h>
#include <hip/hip_cooperative_groups.h>
#include <cstdio>
#include <cstdint>
namespace cg = cooperative_groups;
namespace pg8 {
#define PG8_LAS __attribute__((address_space(3)))
typedef unsigned short bf16_t;
typedef short bf16x8 __attribute__((ext_vector_type(8)));
typedef float f32x4 __attribute__((ext_vector_type(4)));
typedef unsigned u32x4 __attribute__((ext_vector_type(4)));
constexpr int BM = 256, BK = 64, HALF = 128, HTB = HALF * BK * 2  , STAGE_BYTES = 8 * HTB, NXCD = 8, WGM = 2;

__host__ __device__ __forceinline__ int lds_byte(int r, int c) { const int st = (r >> 4) * 2 + (c >> 5), rr = r & 15, cc = c & 31, ob = rr * 64 + cc * 2; return st * 1024 + (ob ^ (((ob >> 9) & 1) << 5)); }
__host__ __device__ __forceinline__ void stage_rc(int b, int& R, int& C) { const int st = b / 1024, sb = b % 1024, swz = sb ^ (((sb >> 9) & 1) << 5); R = (st >> 1) * 16 + swz / 64; C = (st & 1) * 32 + (swz % 64) / 2; }
__host__ __device__ __forceinline__ int perm32(int rho) { const int n = rho >> 4, i = rho & 15; return 8 * (i >> 2) + 4 * n + (i & 3); }

struct Unit { int pm, pn; };
struct Gemm { const bf16_t* A; const bf16_t* Bt; int M, N, K; };

struct StaticOrder {
    int nM, nN, nwg, G, c;
    __host__ __device__ void init(int M, int N, int G_, int c_) { nM = M / BM; nN = N / BM; nwg = nM * nN; G = G_; c = c_; }
    __host__ __device__ bool next(int i, Unit& u) const {
        const long L = (long)i * G + c; if (L >= nwg) return false;
        int wgid = (int)L; { const int q = nwg / NXCD, r = nwg % NXCD, xcd = wgid % NXCD, off = wgid / NXCD; wgid = (xcd < r ? xcd * (q + 1) : r * (q + 1) + (xcd - r) * q) + off; }
        const int nig = WGM * nN, gid = wgid / nig, fm = gid * WGM, gsz = (nM - fm) < WGM ? (nM - fm) : WGM;
        u.pm = fm + ((wgid % nig) % gsz); u.pn = (wgid % nig) / gsz; return true;
    }
    __device__ __forceinline__ void a_ready(const Unit&) const {}
    __device__ __forceinline__ void done(const Unit&) const {}
};

__device__ __forceinline__ unsigned cvt_pk_bf16(float lo, float hi) { unsigned r; asm volatile("v_cvt_pk_bf16_f32 %0, %1, %2" : "=v"(r) : "v"(lo), "v"(hi)); return r; }
typedef float f32x2 __attribute__((ext_vector_type(2)));
__device__ __forceinline__ f32x2 gelu_pk(f32x2 v) {
    const f32x2 av = __builtin_elementwise_abs(v), d = av * 0.2316418882f + 1.0f;
    f32x2 t; t.x = __builtin_amdgcn_rcpf(d.x); t.y = __builtin_amdgcn_rcpf(d.y);
    f32x2 q = t * 0.5307027145f + (-0.7265760135f); q = q * t + 0.7107068705f; q = q * t + (-0.142248368f); q = q * t + 0.127414796f; q = q * t;
    const f32x2 s = (v * v) * (-0.72134752044f);
    f32x2 e; e.x = __builtin_amdgcn_exp2f(s.x); e.y = __builtin_amdgcn_exp2f(s.y);
    const f32x2 m = v * (q * e), r = v - m;
    f32x2 o; o.x = v.x < 0.f ? m.x : r.x; o.y = v.y < 0.f ? m.y : r.y; return o;
}

template <int ACT  > struct EpiBf16 {
    static constexpr bool PERM = true, AFTER_DRAIN = false; static_assert(ACT == 0 || ACT == 1, "EpiBf16: ACT is 0 (none) or 1 (gelu_pk)");
    bf16_t* O; int ldc; const float* bias; int split_cols; size_t split_stride; float scale0;
    __device__ __forceinline__ void operator()(const f32x4 (&acc)[2][2][4][2], const Unit& u, int wr, int wc, int fr, int fq) const {
        const int row0 = u.pm * BM + wr * 64 + fr; int colt = u.pn * BM; bf16_t* base = O;
        float sc = 1.f; if (split_cols) { const int t = colt / split_cols; base += (size_t)t * split_stride; colt -= t * split_cols; if (t == 0) sc = scale0; }
        const int col0 = colt + wc * 32 + 8 * fq, bcol0 = u.pn * BM + wc * 32 + 8 * fq;
        f32x4 bv[2][2];
#pragma unroll
        for (int bj = 0; bj < 2; ++bj)
#pragma unroll
            for (int n = 0; n < 2; ++n) bv[bj][n] = bias ? *(const f32x4*)(bias + bcol0 + bj * HALF + 4 * n) : (f32x4){0.f, 0.f, 0.f, 0.f};
#pragma unroll
        for (int ai = 0; ai < 2; ++ai)
#pragma unroll
            for (int m = 0; m < 4; ++m) { bf16_t* rowp = base + (size_t)(row0 + ai * HALF + m * 16) * ldc + col0;
#pragma unroll
                for (int bj = 0; bj < 2; ++bj) { f32x4 v0 = acc[ai][bj][m][0] + bv[bj][0], v1 = acc[ai][bj][m][1] + bv[bj][1];
                    if (ACT == 1) { f32x2 a = gelu_pk((f32x2){v0[0], v0[1]}), b = gelu_pk((f32x2){v0[2], v0[3]}), c = gelu_pk((f32x2){v1[0], v1[1]}), d = gelu_pk((f32x2){v1[2], v1[3]});
                        v0 = (f32x4){a.x, a.y, b.x, b.y}; v1 = (f32x4){c.x, c.y, d.x, d.y}; }
                    v0 = v0 * sc; v1 = v1 * sc; u32x4 w; w.x = cvt_pk_bf16(v0[0], v0[1]); w.y = cvt_pk_bf16(v0[2], v0[3]); w.z = cvt_pk_bf16(v1[0], v1[1]); w.w = cvt_pk_bf16(v1[2], v1[3]);
                    *(u32x4*)(rowp + bj * HALF) = w; } }
    }
};
typedef __bf16 bf16x2_t __attribute__((ext_vector_type(2)));
__device__ __forceinline__ unsigned cvtpk(float lo, float hi) { f32x2 v = {lo, hi}; bf16x2_t b = __builtin_convertvector(v, bf16x2_t); return __builtin_bit_cast(unsigned, b); }
__device__ __forceinline__ float silu_mul(float g, float u) { const float e = __builtin_amdgcn_exp2f(-1.4426950408889634f * g); return g * __builtin_amdgcn_rcpf(1.0f + e) * u; }

struct EpiSwiGLU {
    static constexpr bool PERM = true, AFTER_DRAIN = false;
    bf16_t* O; int ldc;
    __device__ __forceinline__ void operator()(const f32x4 (&acc)[2][2][4][2], const Unit& u, int wr, int wc, int fr, int fq) const {
        const int row0 = u.pm * BM + wr * 64 + fr, col0 = u.pn * HALF + wc * 32 + 8 * fq;
#pragma unroll
        for (int ai = 0; ai < 2; ++ai)
#pragma unroll
            for (int m = 0; m < 4; ++m) { const int row = row0 + ai * HALF + m * 16; bf16_t* rowp = O + (size_t)row * ldc + col0;
                const f32x4 g0 = acc[ai][0][m][0], g1 = acc[ai][0][m][1], u0 = acc[ai][1][m][0], u1 = acc[ai][1][m][1];
                u32x4 w; w.x = cvtpk(silu_mul(g0[0], u0[0]), silu_mul(g0[1], u0[1])); w.y = cvtpk(silu_mul(g0[2], u0[2]), silu_mul(g0[3], u0[3]));
                w.z = cvtpk(silu_mul(g1[0], u1[0]), silu_mul(g1[1], u1[1])); w.w = cvtpk(silu_mul(g1[2], u1[2]), silu_mul(g1[3], u1[3]));
                *(u32x4*)rowp = w; }
    }
};
struct EpiRowScale {
    static constexpr bool PERM = true, AFTER_DRAIN = false;
    bf16_t* O; int ldc; const float* rs;
    __device__ __forceinline__ void operator()(const f32x4 (&acc)[2][2][4][2], const Unit& u, int wr, int wc, int fr, int fq) const {
        const int row0 = u.pm * BM + wr * 64 + fr, col0 = u.pn * BM + wc * 32 + 8 * fq;
#pragma unroll
        for (int ai = 0; ai < 2; ++ai)
#pragma unroll
            for (int m = 0; m < 4; ++m) { const int row = row0 + ai * HALF + m * 16; const float sc = rs[row]; bf16_t* rowp = O + (size_t)row * ldc + col0;
#pragma unroll
                for (int bj = 0; bj < 2; ++bj) { const f32x4 v0 = acc[ai][bj][m][0] * sc, v1 = acc[ai][bj][m][1] * sc;
                    u32x4 w; w.x = cvtpk(v0[0], v0[1]); w.y = cvtpk(v0[2], v0[3]); w.z = cvtpk(v1[0], v1[1]); w.w = cvtpk(v1[2], v1[3]);
                    *(u32x4*)(rowp + bj * HALF) = w; } }
    }
};
struct EpiZ {
    static constexpr bool PERM = true, AFTER_DRAIN = false;
    bf16_t* Z; bf16_t* Vt; const float* cs; float qscale; int seq;
    __device__ __forceinline__ void operator()(const f32x4 (&acc)[2][2][4][2], const Unit& u, int wr, int wc, int fr, int fq) const {
        const int row0 = u.pm * BM + wr * 64 + fr, cl = wc * 32 + 8 * fq;
#pragma unroll
        for (int bj = 0; bj < 2; ++bj) {
            const int colh = u.pn * BM + bj * HALF;
            const bool isV = (colh == 1152);
            const bool rope = (colh >= 512) && (colh < 1152) && ((wc & 1) == 0) && (fq < 2);
            const float sc = (colh >= 512 && colh < 1024) ? qscale : 1.0f;
#pragma unroll
            for (int ai = 0; ai < 2; ++ai)
#pragma unroll
                for (int m = 0; m < 4; ++m) { const int row = row0 + ai * HALF + m * 16;
                    f32x4 v0 = acc[ai][bj][m][0], v1 = acc[ai][bj][m][1];
                    if (isV) {
                        const int b = row / seq, s = row - b * seq;
#pragma unroll
                        for (int i = 0; i < 4; ++i) { const int c0 = cl + i, c1 = cl + 4 + i;
                            Vt[((size_t)((b * 2 + (c0 >> 6)) * 64 + (c0 & 63))) * seq + s] = (bf16_t)(cvtpk(v0[i], 0.f) & 0xffffu);
                            Vt[((size_t)((b * 2 + (c1 >> 6)) * 64 + (c1 & 63))) * seq + s] = (bf16_t)(cvtpk(v1[i], 0.f) & 0xffffu); }
                    } else {
                        if (rope) { const f32x4 c = *(const f32x4*)(cs + (size_t)row * 16 + 4 * fq), sn = *(const f32x4*)(cs + (size_t)row * 16 + 8 + 4 * fq);
                            const f32x4 n0 = v0 * c - v1 * sn, n1 = v1 * c + v0 * sn; v0 = n0; v1 = n1; }
                        v0 = v0 * sc; v1 = v1 * sc;
                        u32x4 w; w.x = cvtpk(v0[0], v0[1]); w.y = cvtpk(v0[2], v0[3]); w.z = cvtpk(v1[0], v1[1]); w.w = cvtpk(v1[2], v1[3]);
                        *(u32x4*)(Z + (size_t)row * 1280 + colh + cl) = w; }
                }
        }
    }
};
template <class Epi, class Sched, bool ALIGN_EPI = false, bool SP2 = false>
__device__ __forceinline__ void gemm_phase(PG8_LAS unsigned char* lds, const Gemm g, const Sched& S, const Epi& E) {
    const int tid = threadIdx.x, wid = __builtin_amdgcn_readfirstlane(tid >> 6), lane = tid & 63, wr = wid >> 2, wc = wid & 3, fr = lane & 15, fq = lane >> 4;
    const int K = g.K, nt = K / BK;
    unsigned voffA[2], voffB[2];
#pragma unroll
    for (int i = 0; i < 2; ++i) { int R, C; stage_rc(tid * 16 + i * 8192, R, C); const int Rb = Epi::PERM ? ((R & ~31) + perm32(R & 31)) : R;
        voffA[i] = (unsigned)(R * K + C) * 2u; voffB[i] = (unsigned)(Rb * K + C) * 2u; }
    const size_t kstep = (size_t)(BK * 2);
    const size_t hstep = (size_t)HALF * K * 2;
    const size_t tstep = 2 * hstep;
    const unsigned ldsw = (unsigned)wid * 1024u;
    const int aoff = lds_byte(wr * 64 + fr, fq * 8), boff = lds_byte(wc * 32 + fr, fq * 8);
#define PG8_SA(b, h) (((b) * 2 + (h)) * HTB)
#define PG8_SB(b, h) ((4 + (b) * 2 + (h)) * HTB)
#define PG8_STAGE(bufoff, gbase, voff) do { _Pragma("unroll") for (int _i = 0; _i < 2; ++_i) \
        __builtin_amdgcn_global_load_lds((const unsigned*)((const char*)(gbase) + (voff)[_i]), (PG8_LAS unsigned*)(lds + (bufoff) + ldsw + _i * 8192), 16, 0, 0); } while (0)
#define PG8_LDA(dst, b, h) do { _Pragma("unroll") for (int m = 0; m < 4; ++m) _Pragma("unroll") for (int k = 0; k < 2; ++k) dst[m][k] = *(const PG8_LAS bf16x8*)(lds + PG8_SA(b, h) + aoff + m * 2048 + k * 1024); } while (0)
#define PG8_LDB(dst, b, h) do { _Pragma("unroll") for (int n = 0; n < 2; ++n) _Pragma("unroll") for (int k = 0; k < 2; ++k) dst[n][k] = *(const PG8_LAS bf16x8*)(lds + PG8_SB(b, h) + boff + n * 2048 + k * 1024); } while (0)
#define PG8_MMA(ai, bj, At, Bt) do { __builtin_amdgcn_s_setprio(1); _Pragma("unroll") for (int m = 0; m < 4; ++m) _Pragma("unroll") for (int n = 0; n < 2; ++n) _Pragma("unroll") for (int k = 0; k < 2; ++k) \
        acc[ai][bj][m][n] = __builtin_amdgcn_mfma_f32_16x16x32_bf16(Bt[n][k], At[m][k], acc[ai][bj][m][n], 0, 0, 0); __builtin_amdgcn_s_setprio(0); } while (0)
#define PG8_WAIT_V(n) asm volatile("s_waitcnt vmcnt(" #n ")" ::: "memory")
#define PG8_WAIT_L(n) asm volatile("s_waitcnt lgkmcnt(" #n ")" ::: "memory")
#define PG8_BAR __builtin_amdgcn_s_barrier()
#define PG8_SCHED __builtin_amdgcn_sched_barrier(0)
    Unit cur, nxt; int ui = 0;
    if (!S.next(0, cur)) return;
    f32x4 acc[2][2][4][2];
#pragma unroll
    for (int a = 0; a < 2; ++a)
#pragma unroll
        for (int b = 0; b < 2; ++b)
#pragma unroll
            for (int m = 0; m < 4; ++m)
#pragma unroll
                for (int n = 0; n < 2; ++n) acc[a][b][m][n] = (f32x4){0.f, 0.f, 0.f, 0.f};
    bf16x8 At[4][2], B0[2][2], B1[2][2];
    const char* cA = (const char*)g.A + (size_t)cur.pm * tstep; const char* cB = (const char*)g.Bt + (size_t)cur.pn * tstep;
    S.a_ready(cur);
    if constexpr (SP2) {
        PG8_STAGE(PG8_SB(0, 0), cB, voffB); PG8_STAGE(PG8_SB(0, 1), cB + hstep, voffB); PG8_STAGE(PG8_SA(0, 0), cA, voffA); PG8_STAGE(PG8_SA(0, 1), cA + hstep, voffA);
        if (wr == 1) PG8_BAR;
        PG8_WAIT_V(2); PG8_BAR;
        PG8_STAGE(PG8_SB(1, 0), cB + kstep, voffB); PG8_STAGE(PG8_SA(1, 0), cA + kstep, voffA); PG8_STAGE(PG8_SB(1, 1), cB + hstep + kstep, voffB);
        PG8_WAIT_V(6); PG8_BAR;
    } else {
        PG8_STAGE(PG8_SB(0, 0), cB, voffB); PG8_STAGE(PG8_SA(0, 0), cA, voffA); PG8_STAGE(PG8_SB(0, 1), cB + hstep, voffB); PG8_STAGE(PG8_SA(0, 1), cA + hstep, voffA);
        if (wr == 1) PG8_BAR;
        PG8_WAIT_V(4); PG8_BAR;
        PG8_STAGE(PG8_SB(1, 0), cB + kstep, voffB); PG8_STAGE(PG8_SA(1, 0), cA + kstep, voffA); PG8_STAGE(PG8_SB(1, 1), cB + hstep + kstep, voffB);
        PG8_WAIT_V(6); PG8_BAR;
    }
    for (;;) {
        const bool has_next = S.next(ui + 1, nxt);
        const char* nA = has_next ? (const char*)g.A + (size_t)nxt.pm * tstep : cA; const char* nB = has_next ? (const char*)g.Bt + (size_t)nxt.pn * tstep : cB;
        for (int t = 0; t < nt; t += 2) {
            const bool last = (t == nt - 2);
            const char* a1 = cA + (size_t)(t + 1) * kstep;
            const char* a2 = last ? nA : cA + (size_t)(t + 2) * kstep; const char* b2 = last ? nB : cB + (size_t)(t + 2) * kstep;
            const char* a3 = a2 + kstep; const char* b3 = b2 + kstep;
            if (last && has_next) S.a_ready(nxt);
            if constexpr (SP2) {
            PG8_LDB(B0, 0, 0); PG8_LDB(B1, 0, 1); PG8_SCHED; PG8_LDA(At, 0, 0); PG8_STAGE(PG8_SA(1, 1), a1 + hstep, voffA);
            PG8_WAIT_V(8); PG8_WAIT_L(0); PG8_BAR; PG8_MMA(0, 0, At, B0); PG8_MMA(0, 1, At, B1); PG8_BAR; PG8_SCHED;
            PG8_LDA(At, 0, 1); PG8_STAGE(PG8_SB(0, 0), b2, voffB); PG8_STAGE(PG8_SB(0, 1), b2 + hstep, voffB); PG8_STAGE(PG8_SA(0, 0), a2, voffA);
            PG8_WAIT_V(8); PG8_WAIT_L(0); PG8_BAR; PG8_MMA(1, 0, At, B0); PG8_MMA(1, 1, At, B1); PG8_BAR; PG8_SCHED;
            PG8_LDB(B0, 1, 0); PG8_LDB(B1, 1, 1); PG8_SCHED; PG8_LDA(At, 1, 0); PG8_STAGE(PG8_SA(0, 1), a2 + hstep, voffA);
            PG8_WAIT_V(8); PG8_WAIT_L(0); PG8_BAR; PG8_MMA(0, 0, At, B0); PG8_MMA(0, 1, At, B1); PG8_BAR; PG8_SCHED;
            PG8_LDA(At, 1, 1); PG8_STAGE(PG8_SB(1, 0), b3, voffB); PG8_STAGE(PG8_SB(1, 1), b3 + hstep, voffB); PG8_STAGE(PG8_SA(1, 0), a3, voffA);
            PG8_WAIT_V(8); PG8_WAIT_L(0); PG8_BAR; PG8_MMA(1, 0, At, B0); PG8_MMA(1, 1, At, B1); PG8_BAR; PG8_SCHED;
            } else {
            PG8_LDB(B0, 0, 0); PG8_SCHED; PG8_LDA(At, 0, 0); PG8_STAGE(PG8_SA(1, 1), a1 + hstep, voffA);
            PG8_WAIT_L(8); PG8_BAR; PG8_WAIT_L(0); PG8_MMA(0, 0, At, B0); PG8_BAR; PG8_SCHED;
            PG8_LDB(B1, 0, 1); PG8_STAGE(PG8_SB(0, 0), b2, voffB);
            PG8_BAR; PG8_WAIT_L(0); PG8_MMA(0, 1, At, B1); PG8_BAR;
            PG8_LDA(At, 0, 1); PG8_STAGE(PG8_SA(0, 0), a2, voffA);
            PG8_BAR; PG8_WAIT_L(0); PG8_MMA(1, 0, At, B0); PG8_BAR; PG8_SCHED;
            PG8_STAGE(PG8_SB(0, 1), b2 + hstep, voffB);
            PG8_WAIT_V(6); PG8_BAR; PG8_MMA(1, 1, At, B1); PG8_BAR;
            PG8_LDB(B0, 1, 0); PG8_SCHED; PG8_LDA(At, 1, 0); PG8_STAGE(PG8_SA(0, 1), a2 + hstep, voffA);
            PG8_WAIT_L(8); PG8_BAR; PG8_WAIT_L(0); PG8_MMA(0, 0, At, B0); PG8_BAR; PG8_SCHED;
            PG8_LDB(B1, 1, 1); PG8_STAGE(PG8_SB(1, 0), b3, voffB);
            PG8_BAR; PG8_WAIT_L(0); PG8_MMA(0, 1, At, B1); PG8_BAR;
            PG8_LDA(At, 1, 1); PG8_STAGE(PG8_SA(1, 0), a3, voffA);
            PG8_BAR; PG8_WAIT_L(0); PG8_MMA(1, 0, At, B0); PG8_BAR; PG8_SCHED;
            PG8_STAGE(PG8_SB(1, 1), b3 + hstep, voffB);
            PG8_WAIT_V(6); PG8_BAR; PG8_MMA(1, 1, At, B1); PG8_BAR;
            }
        }
        if constexpr (ALIGN_EPI) { if (wr == 0) PG8_BAR; }
        if constexpr (!Epi::AFTER_DRAIN) { E(acc, cur, wr, wc, fr, fq); S.done(cur); }
        if (!has_next) break;
#pragma unroll
        for (int a = 0; a < 2; ++a)
#pragma unroll
            for (int b = 0; b < 2; ++b)
#pragma unroll
                for (int m = 0; m < 4; ++m)
#pragma unroll
                    for (int n = 0; n < 2; ++n) acc[a][b][m][n] = (f32x4){0.f, 0.f, 0.f, 0.f};
        cur = nxt; cA = nA; cB = nB; ++ui;
        if constexpr (ALIGN_EPI) { if (wr == 1) PG8_BAR; }
    }
    PG8_WAIT_V(0);
    if constexpr (!ALIGN_EPI) { if (wr == 0) PG8_BAR; }
    PG8_BAR;
    if constexpr (Epi::AFTER_DRAIN) { E.fused(acc, cur, wr, wc, fr, fq, lds, wid, lane); S.done(cur); }
#undef PG8_SA
#undef PG8_SB
#undef PG8_STAGE
#undef PG8_LDA
#undef PG8_LDB
#undef PG8_MMA
#undef PG8_WAIT_V
#undef PG8_WAIT_L
#undef PG8_BAR
#undef PG8_SCHED
}
}
constexpr int BATCH = 4, SEQ = 8192, D = 1024, M = BATCH * SEQ, FF = 2816, NGU = 2 * FF, NIN = 1280, NBLK = M / 128, NB_SEQ = SEQ / 128;
constexpr float EPS = 1e-6f;
constexpr float QSCALE = 0.125f * 1.4426950408889634f;
constexpr float LOG2E = 1.4426950408889634f;
constexpr int NWAVES = 8, NTHREADS = 512;
constexpr size_t MiB = 1u << 20;
constexpr size_t WS_WGU1 = 0, WS_WGU2 = 11 * MiB, WS_WD1 = 22 * MiB, WS_WD2 = 28 * MiB, WS_WIN = 34 * MiB, WS_WOUT = 37 * MiB, WS_WPOOL = 39 * MiB, WS_CS = 40 * MiB;
constexpr size_t WS_CTL = 46 * MiB, CTL_BYTES = 262144, WS_RA = 47 * MiB;
constexpr size_t WS_Y = 48 * MiB, WS_HD = 112 * MiB, WS_H = 176 * MiB, WS_XR = 352 * MiB, WS_Z = 416 * MiB, WS_VT = 496 * MiB, WS_END = 504 * MiB;
static_assert((size_t)NGU * D * 2 <= 11 * MiB && (size_t)D * FF * 2 <= 6 * MiB && (size_t)NIN * D * 2 <= 3 * MiB && (size_t)M * 16 * 4 <= 6 * MiB, "ws map");
static_assert(WS_Y + (size_t)M * D * 2 <= WS_HD && WS_HD + (size_t)M * D * 2 <= WS_H && WS_H + (size_t)M * FF * 2 <= WS_XR && WS_XR + (size_t)M * D * 2 <= WS_Z && WS_Z + (size_t)M * NIN * 2 <= WS_VT && WS_VT + (size_t)M * 128 * 2 <= WS_END, "ws map 2");
constexpr int LDS_BYTES = 163840;
constexpr int KL_OFF = 0, KL_PITCH = 144, VL_OFF = 36864, VL_PITCH = 520, UL_OFF = 70144, UL_PITCH = 272, UL_ROWS = 143, DL_OFF = UL_OFF + 38912, DL_PITCH = 272;
constexpr int RAL_OFF = DL_OFF + 34816, ASTG_OFF = RAL_OFF + 512, MISC_OFF = ASTG_OFF + 16384;
static_assert(UL_ROWS * UL_PITCH <= 38912 && MISC_OFF >= 131072 && MISC_OFF + 128 <= LDS_BYTES && ASTG_OFF % 16 == 0 && DL_OFF % 16 == 0, "LDS map");

#define LAS __attribute__((address_space(3)))
typedef unsigned short bf16;
typedef unsigned u32x4 __attribute__((ext_vector_type(4)));
typedef unsigned u32x2 __attribute__((ext_vector_type(2)));
typedef float f32x4 __attribute__((ext_vector_type(4)));
typedef float f32x16 __attribute__((ext_vector_type(16)));
typedef short bf16x8 __attribute__((ext_vector_type(8)));
using pg8::cvtpk;
__device__ __forceinline__ float bflo(unsigned w) { return __uint_as_float(w << 16); }
__device__ __forceinline__ float bfhi(unsigned w) { return __uint_as_float(w & 0xffff0000u); }
__device__ __forceinline__ float wave_sum(float v) {
#pragma unroll
    for (int o = 1; o < 64; o <<= 1) v += __shfl_xor(v, o);
    return v;
}
__device__ __forceinline__ float half_sum32(float v) {
#pragma unroll
    for (int o = 1; o < 32; o <<= 1) v += __shfl_xor(v, o);
    return v;
}
__device__ __forceinline__ int crow(int r, int hi) { return (r & 3) + 8 * (r >> 2) + 4 * hi; }

struct Args {
    const float* x; const int* pos;
    const float *ffn1_pre, *ffn1_wgu, *ffn1_wd, *ffn1_post, *mix_pre, *w_in, *w_pool, *pool_scale, *sinks, *g_pool, *g_attn, *w_out, *mix_post, *ffn2_pre, *ffn2_wgu, *ffn2_wd, *ffn2_post;
    float* out; unsigned char* ws; int ph_lo, ph_hi;
};

__device__ __forceinline__ int dest_row(int mode, int n) {
    if (mode == 1) { return n < FF ? ((n >> 7) * 256 + (n & 127)) : ((((n - FF) >> 7) * 256) + 128 + ((n - FF) & 127)); }
    if (mode == 2) { if (n >= 512 && n < 1152) { const int d = n & 63; const int p = (d >= 4 && d < 8) ? d + 4 : ((d >= 8 && d < 12) ? d - 4 : d); return (n - d) + p; } return n; }
    return n;
}
__device__ __forceinline__ void transpose_item(const float* W, int K, int N, bf16* WT, int mode, LAS float* scr, int item, int lane, const float* gk = nullptr, const float* gk2 = nullptr, const float* gn = nullptr) {
    const int nblk = N / 32, kb = item / nblk, nb = item % nblk, k0 = 64 * kb, n0 = 32 * nb;
#pragma unroll 16
    for (int i = 0; i < 32; ++i) { const int kk = 2 * i + (lane >> 5); const int kr = k0 + kk; float gg = gk ? ((gk2 && kr >= 512) ? gk2[kr - 512] : gk[kr]) : 1.0f; if (gn) gg *= gn[n0 + (lane & 31)]; scr[kk * 33 + (lane & 31)] = W[(size_t)kr * N + n0 + (lane & 31)] * gg; }
    asm volatile("s_waitcnt lgkmcnt(0)" ::: "memory");
    const int c = lane & 7;
#pragma unroll
    for (int j = 0; j < 4; ++j) { const int n = (lane >> 3) + 8 * j; const LAS float* s = scr + (8 * c) * 33 + n;
        u32x4 o; o.x = cvtpk(s[0 * 33], s[1 * 33]); o.y = cvtpk(s[2 * 33], s[3 * 33]); o.z = cvtpk(s[4 * 33], s[5 * 33]); o.w = cvtpk(s[6 * 33], s[7 * 33]);
        *(u32x4*)(WT + (size_t)dest_row(mode, n0 + n) * K + k0 + 8 * c) = o; }
    asm volatile("s_waitcnt lgkmcnt(0)" ::: "memory");
}
__device__ __forceinline__ void sincos_f(float a, float& sn, float& cn) {
    const double ad = (double)a; const double q = __builtin_rint(ad * 0.63661977236758134308);
    const float r = (float)__builtin_fma(-q, 1.57079632679489661923, ad); const int qi = ((int)q) & 3;
    const float z = r * r;
    const float s = r + r * z * (-1.6666654611e-1f + z * (8.3321608736e-3f + z * (-1.9515295891e-4f)));
    const float c = 1.0f - 0.5f * z + z * z * (4.166664568298827e-2f + z * (-1.388731625493765e-3f + z * 2.443315711809948e-5f));
    sn = (qi == 0) ? s : (qi == 1) ? c : (qi == 2) ? -s : -c;
    cn = (qi == 0) ? c : (qi == 1) ? -s : (qi == 2) ? -c : s;
}
__device__ __forceinline__ float inv_freq(int i) {
    return i == 0 ? 1.0f : i == 1 ? 0.19392274474868576f : i == 2 ? 0.03760603093086393f : i == 3 ? 0.007292664737217109f : i == 4 ? 0.001414213562373095f : i == 5 ? 0.0002742481756762073f : i == 6 ? 5.318295896944988e-05f : 1.031338537721246e-05f;
}
__device__ __forceinline__ void prenorm_rows(const float* x, bf16* xb, float* rs, int gw, int NGW, int lane) {
    for (int m = gw; m < M; m += 2 * NGW) {
        f32x4 v[2][4]; float s[2];
#pragma unroll
        for (int q = 0; q < 2; ++q) { const int mm = m + q * NGW; const f32x4* xr = (const f32x4*)(x + (size_t)(mm < M ? mm : m) * D) + lane;
#pragma unroll
            for (int j = 0; j < 4; ++j) v[q][j] = xr[64 * j]; }
#pragma unroll
        for (int q = 0; q < 2; ++q) { const int mm = m + q * NGW; if (mm < M) { s[q] = 0.f;
#pragma unroll
            for (int j = 0; j < 4; ++j) s[q] += (v[q][j].x * v[q][j].x + v[q][j].y * v[q][j].y) + (v[q][j].z * v[q][j].z + v[q][j].w * v[q][j].w);
            const float r = 1.0f / sqrtf(wave_sum(s[q]) * (1.0f / D) + EPS);
            u32x2* o = (u32x2*)(xb + (size_t)mm * D) + lane;
#pragma unroll
            for (int j = 0; j < 4; ++j) { const f32x4 y = v[q][j] * r; u32x2 w; w.x = cvtpk(y.x, y.y); w.y = cvtpk(y.z, y.w); o[64 * j] = w; }
            if (lane == 0) rs[mm] = r; } }
    }
}
template <bool HAS_A, bool XI_BF, bool XO_BF>
__device__ __forceinline__ void thin_rows(const void* xi, void* xo, const bf16* h, const float* gpost, float* rsio, float coef, int m0, int m1, int NGW, int lane) {
    f32x4 gp[4];
#pragma unroll
    for (int j = 0; j < 4; ++j) gp[j] = *((const f32x4*)gpost + lane + 64 * j);
    for (int mb = m0; mb < m1; mb += 2 * NGW) {
        f32x4 v[2][4], hv[2][4]; float rin[2];
#pragma unroll
        for (int q = 0; q < 2; ++q) { const int mm = mb + q * NGW; const int m = mm < m1 ? mm : mb; rin[q] = XI_BF ? 1.0f / rsio[m] : 1.0f; }
#pragma unroll
        for (int q = 0; q < 2; ++q) { const int mm = mb + q * NGW; const int m = mm < m1 ? mm : mb;
            const u32x2* hr = (const u32x2*)(h + (size_t)m * D) + lane;
#pragma unroll
            for (int j = 0; j < 4; ++j) {
                if (XI_BF) { const u32x2 w = ((const u32x2*)((const bf16*)xi + (size_t)m * D) + lane)[64 * j]; v[q][j] = (f32x4){bflo(w.x), bfhi(w.x), bflo(w.y), bfhi(w.y)} * rin[q]; }
                else v[q][j] = ((const f32x4*)((const float*)xi + (size_t)m * D) + lane)[64 * j];
                const u32x2 w = hr[64 * j]; hv[q][j] = (f32x4){bflo(w.x), bfhi(w.x), bflo(w.y), bfhi(w.y)}; } }
#pragma unroll
        for (int q = 0; q < 2; ++q) { const int m = mb + q * NGW; if (m < m1) {
            float s = 0.f;
#pragma unroll
            for (int j = 0; j < 4; ++j) s += (hv[q][j].x * hv[q][j].x + hv[q][j].y * hv[q][j].y) + (hv[q][j].z * hv[q][j].z + hv[q][j].w * hv[q][j].w);
            const float r1 = coef / sqrtf(wave_sum(s) * (1.0f / D) + EPS);
            float s2 = 0.f;
#pragma unroll
            for (int j = 0; j < 4; ++j) { v[q][j] = v[q][j] + hv[q][j] * r1 * gp[j];
                s2 += (v[q][j].x * v[q][j].x + v[q][j].y * v[q][j].y) + (v[q][j].z * v[q][j].z + v[q][j].w * v[q][j].w); }
            const float r2 = HAS_A ? 1.0f / sqrtf(wave_sum(s2) * (1.0f / D) + EPS) : 1.0f;
#pragma unroll
            for (int j = 0; j < 4; ++j) {
                if (XO_BF) { const f32x4 y = v[q][j] * r2; u32x2 w; w.x = cvtpk(y.x, y.y); w.y = cvtpk(y.z, y.w); ((u32x2*)((bf16*)xo + (size_t)m * D) + lane)[64 * j] = w; }
                else ((f32x4*)((float*)xo + (size_t)m * D) + lane)[64 * j] = v[q][j]; }
            if (HAS_A) { if (lane == 0) rsio[m] = r2; } } }
    }
}

#define XB_TMO      128
#define XB_XCNT(j)  (256  + 64 * (j))
#define XB_XSUB(j)  (1280 + 64 * (j))
#define XB_XGEN(j)  (2304 + 64 * (j))
#define XB_TOP      3328
#define XB_TOPGEN   3392
#define XCD_BAR_WORDS 3456
#define XB_SPIN_CAP (1u << 18)

__device__ __forceinline__ unsigned xb_ld(unsigned* p)              { return __hip_atomic_load(p, __ATOMIC_RELAXED, __HIP_MEMORY_SCOPE_AGENT); }
__device__ __forceinline__ unsigned xb_add(unsigned* p, unsigned v) { return __hip_atomic_fetch_add(p, v, __ATOMIC_RELAXED, __HIP_MEMORY_SCOPE_AGENT); }
__device__ __forceinline__ unsigned xb_xcc_id() { return (unsigned)__builtin_amdgcn_s_getreg((3 << 11) | 20) & 0xFu; }
#define XB_SPIN(cond, bar) do { unsigned _sp = 0; while (cond) { __builtin_amdgcn_s_sleep(1); \
    if ((++_sp & 255u) == 0u) { if (xb_ld(&(bar)[XB_TMO])) break; if (_sp > XB_SPIN_CAP) { atomicAdd(&(bar)[XB_TMO], 1u); break; } } } } while (0)

struct XcdBarrier {
    unsigned* bar; unsigned x; unsigned total;
    volatile LAS unsigned* st;
};

__device__ __forceinline__ XcdBarrier xcd_barrier_post(unsigned* bar, volatile LAS unsigned* st, unsigned total) {
    XcdBarrier b; b.bar = bar; b.x = xb_xcc_id(); b.st = st; b.total = total;
    if (threadIdx.x == 0) (void)xb_add(&bar[XB_XCNT(b.x)], 1u);
    return b;
}
__device__ __forceinline__ void xcd_barrier_complete(unsigned* bar, unsigned x, unsigned G, unsigned& nloc, unsigned& nx) {
    unsigned sum, cnt, mine, sp = 0u;
    for (;;) {
        sum = 0u; cnt = 0u; mine = 0u;
#pragma unroll
        for (unsigned j = 0; j < 16; ++j) { const unsigned c = xb_ld(&bar[XB_XCNT(j)]); sum += c; cnt += (c > 0u) ? 1u : 0u; mine = (j == x) ? c : mine; }
        if (sum == G) break;
        __builtin_amdgcn_s_sleep(1);
        if ((++sp & 255u) == 0u) { if (xb_ld(&bar[XB_TMO])) break; if (sp > XB_SPIN_CAP) { atomicAdd(&bar[XB_TMO], 1u); break; } }
    }
    nloc = mine > 0u ? mine : 1u; nx = cnt > 0u ? cnt : 1u;
}

__device__ __forceinline__ void xcd_barrier(const XcdBarrier& b) {
    asm volatile("s_waitcnt vmcnt(0)" ::: "memory");
    __syncthreads();
    if (threadIdx.x == 0) {
        unsigned* bar = b.bar;
        __builtin_amdgcn_s_waitcnt(0);
        unsigned nloc = b.st[0], nx = b.st[1];
        if (nloc == 0u) { xcd_barrier_complete(bar, b.x, b.total, nloc, nx); b.st[0] = nloc; b.st[1] = nx; }
        const unsigned old = xb_add(&bar[XB_XSUB(b.x)], 1u);
        const unsigned gen = old / nloc;
        if (old + 1u == (gen + 1u) * nloc) {
            if (nx > 1u) __builtin_amdgcn_fence(__ATOMIC_RELEASE, "agent");
            asm volatile("s_waitcnt vmcnt(0)" ::: "memory");
            const unsigned og = xb_add(&bar[XB_TOP], 1u);
            const unsigned tg = og / nx;
            if (og + 1u == (tg + 1u) * nx) xb_add(&bar[XB_TOPGEN], 1u);
            else XB_SPIN(xb_ld(&bar[XB_TOPGEN]) == tg, bar);
            __builtin_amdgcn_fence(__ATOMIC_ACQUIRE, "agent");
            xb_add(&bar[XB_XGEN(b.x)], 1u);
            asm volatile("s_waitcnt vmcnt(0)" ::: "memory");
        } else {
            XB_SPIN(xb_ld(&bar[XB_XGEN(b.x)]) == gen, bar);
            __builtin_amdgcn_fence(__ATOMIC_ACQUIRE, "agent");
            asm volatile("s_waitcnt vmcnt(0)" ::: "memory");
        }
    }
    __syncthreads();
}
#define MFMA32(a, b, c) __builtin_amdgcn_mfma_f32_32x32x16_bf16((a), (b), (c), 0, 0, 0)
__device__ __forceinline__ void load8(const bf16* p, float (&f)[8]) { const u32x4 w = *(const u32x4*)p;
    f[0] = bflo(w.x); f[1] = bfhi(w.x); f[2] = bflo(w.y); f[3] = bfhi(w.y); f[4] = bflo(w.z); f[5] = bfhi(w.z); f[6] = bflo(w.w); f[7] = bfhi(w.w); }

#define OPAQUE_V(x) asm volatile("" : "+v"(x))
#define OPAQUE_S(x) asm volatile("" : "+s"(x))
__device__ __forceinline__ void lds_barrier() { asm volatile("s_waitcnt lgkmcnt(0)" ::: "memory"); __builtin_amdgcn_s_barrier(); asm volatile("" ::: "memory"); }
struct MixCtx { LAS unsigned char* lds; const bf16* Z; const bf16* Vt; const bf16* WpT; const float* pool_scale; const float* sinks; const float* g_pool; const float* g_attn; bf16* Y; float* RA; size_t rowbase; int b, n, htid, lane, hw; };

__device__ __forceinline__ void u_load(const MixCtx& c, int g, u32x4 (&pre)[9]) {
    int htid = c.htid; OPAQUE_V(htid);
#pragma unroll
    for (int k = 0; k < 9; ++k) { const int i = htid + 256 * k, jr = i >> 4, cc = i & 15; pre[k] = (u32x4){0u, 0u, 0u, 0u};
        if (jr < UL_ROWS && c.n * 128 + jr - 15 >= 0) pre[k] = *(const u32x4*)(c.Z + (ptrdiff_t)((ptrdiff_t)c.rowbase + jr - 15) * NIN + g * 128 + cc * 8); }
}
__device__ __forceinline__ void u_store(const MixCtx& c, const u32x4 (&pre)[9]) {
    int htid = c.htid; OPAQUE_V(htid);
#pragma unroll
    for (int k = 0; k < 9; ++k) { const int i = htid + 256 * k, jr = i >> 4, cc = i & 15; if (jr < UL_ROWS) *(LAS u32x4*)(c.lds + UL_OFF + jr * UL_PITCH + cc * 16) = pre[k]; }
}
template <int G> __device__ __forceinline__ void pool_D(const MixCtx& c) {
    constexpr int w = 2 << G;
    LAS unsigned char* lds = c.lds; int htid = c.htid; OPAQUE_V(htid);
    const int c8 = htid & 15, t0 = (htid >> 4) * 8;
    const LAS unsigned char* ub = lds + UL_OFF + (15 + t0) * UL_PITCH + c8 * 16;
    float s[8], uv[8];
#pragma unroll
    for (int i = 0; i < 8; ++i) s[i] = 0.f;
#define LDU(row) do { const u32x4 w_ = *(const LAS u32x4*)(ub + (row) * UL_PITCH); uv[0] = bflo(w_.x); uv[1] = bfhi(w_.x); uv[2] = bflo(w_.y); uv[3] = bfhi(w_.y); uv[4] = bflo(w_.z); uv[5] = bfhi(w_.z); uv[6] = bflo(w_.w); uv[7] = bfhi(w_.w); } while (0)
#pragma unroll
    for (int j = 1 - w; j < 0; ++j) { LDU(j);
#pragma unroll
        for (int i = 0; i < 8; ++i) s[i] += uv[i]; }
#pragma unroll
    for (int tt = 0; tt < 8; ++tt) { const int t = t0 + tt;
        LDU(tt);
#pragma unroll
        for (int i = 0; i < 8; ++i) s[i] += uv[i];
        const int sp = c.n * 128 + t; const int cnt = (sp + 1 < w) ? sp + 1 : w; const float inv = 1.0f / (float)cnt;
        u32x4 o; o.x = cvtpk(s[0] * inv - uv[0], s[1] * inv - uv[1]); o.y = cvtpk(s[2] * inv - uv[2], s[3] * inv - uv[3]);
        o.z = cvtpk(s[4] * inv - uv[4], s[5] * inv - uv[5]); o.w = cvtpk(s[6] * inv - uv[6], s[7] * inv - uv[7]);
        *(LAS u32x4*)(lds + DL_OFF + t * DL_PITCH + c8 * 16) = o;
        LDU(tt - w + 1);
#pragma unroll
        for (int i = 0; i < 8; ++i) s[i] -= uv[i]; }
#undef LDU
}
template <int G> __device__ __forceinline__ void pool_M(const MixCtx& c, f32x16& ssacc, unsigned (&kA)[16], unsigned (&kB)[16]) {
    LAS unsigned char* lds = c.lds; int lane_ = c.lane, hw = c.hw; OPAQUE_V(lane_); OPAQUE_S(hw);
    const int r32 = lane_ & 31, hi = lane_ >> 5;
#pragma unroll
    for (int j2 = 0; j2 < 2; ++j2) {
        f32x16 a0, a1;
#pragma unroll
        for (int i = 0; i < 16; ++i) { a0[i] = 0.f; a1[i] = 0.f; }
        const bf16* wp = c.WpT + (size_t)G * 16384 + (size_t)(64 * j2 + r32) * 128 + 8 * hi;
#pragma unroll
        for (int ks = 0; ks < 8; ++ks) {
            const bf16x8 A = *(const LAS bf16x8*)(lds + DL_OFF + (32 * hw + r32) * DL_PITCH + (16 * ks + 8 * hi) * 2);
            const bf16x8 B0 = *(const bf16x8*)(wp + 16 * ks), B1 = *(const bf16x8*)(wp + 32 * 128 + 16 * ks);
            a0 = MFMA32(A, B0, a0); a1 = MFMA32(A, B1, a1);
        }
#pragma unroll
        for (int r = 0; r < 16; ++r) { const float v0 = a0[r], v1 = a1[r];
            { float q_ = ssacc[r] + (v0 * v0 + v1 * v1); asm volatile("" : "+v"(q_)); ssacc[r] = q_; }
            unsigned pk_ = cvtpk(v0, v1); asm volatile("" : "+v"(pk_));
            if (j2 == 0) kA[r] = pk_; else kB[r] = pk_; }
        __builtin_amdgcn_sched_barrier(0);
    }
}
__device__ __forceinline__ void store_item(const MixCtx& c, LAS bf16* stg, const unsigned (&kp)[16], const float (&f)[16], int colbase) {
    int lane = c.lane; OPAQUE_V(lane); const int r32 = lane & 31, hi = lane >> 5;
#pragma unroll
    for (int r = 0; r < 16; ++r) { const int ro = (r & 3) + 8 * (r >> 2) + 4 * hi;
        stg[ro * 64 + r32] = (bf16)(cvtpk(bflo(kp[r]) * f[r], 0.f) & 0xffffu); stg[ro * 64 + 32 + r32] = (bf16)(cvtpk(bfhi(kp[r]) * f[r], 0.f) & 0xffffu); }
    asm volatile("s_waitcnt lgkmcnt(0)" ::: "memory");
    size_t yo = (c.rowbase + 32 * c.hw + (lane >> 3)) * D + colbase + (lane & 7) * 8; OPAQUE_V(yo); bf16* yb = c.Y + yo;
#pragma unroll
    for (int i = 0; i < 4; ++i) { const u32x4 v = *(const LAS u32x4*)(stg + (i * 8 + (lane >> 3)) * 64 + (lane & 7) * 8); *(u32x4*)(yb + (size_t)i * 8 * D) = v; }
    asm volatile("s_waitcnt lgkmcnt(0)" ::: "memory");
}
__device__ __forceinline__ void pool_half(const MixCtx& c) {
    f32x16 ssacc;
#pragma unroll
    for (int r = 0; r < 16; ++r) ssacc[r] = 0.f;
    unsigned a0[16], b0[16], a1[16], b1[16], a2[16], b2[16], a3[16], b3[16];
    lds_barrier();
    pool_D<0>(c); lds_barrier(); pool_M<0>(c, ssacc, a0, b0); lds_barrier();
    pool_D<1>(c); lds_barrier(); pool_M<1>(c, ssacc, a1, b1); lds_barrier();
    pool_D<2>(c); lds_barrier(); pool_M<2>(c, ssacc, a2, b2); lds_barrier();
    pool_D<3>(c); lds_barrier(); pool_M<3>(c, ssacc, a3, b3); lds_barrier();
    lds_barrier();
    int lane = c.lane; OPAQUE_V(lane); const int hi = lane >> 5;
    const LAS float* RAL = (const LAS float*)(c.lds + RAL_OFF);
    float f[16];
#pragma unroll
    for (int r = 0; r < 16; ++r) { const int ro = (r & 3) + 8 * (r >> 2) + 4 * hi; const float ss = half_sum32(ssacc[r]);
        f[r] = __builtin_amdgcn_rsqf(ss * (1.0f / 512.0f) + EPS) * __builtin_amdgcn_rcpf(RAL[32 * c.hw + ro]); }
    if (c.htid < 128) c.RA[c.rowbase + c.htid] = RAL[c.htid];
    LAS bf16* stg = (LAS bf16*)(c.lds + UL_OFF) + c.hw * 2048;
    store_item(c, stg, a0, f, 0); store_item(c, stg, b0, f, 64); store_item(c, stg, a1, f, 128); store_item(c, stg, b1, f, 192);
    store_item(c, stg, a2, f, 256); store_item(c, stg, b2, f, 320); store_item(c, stg, a3, f, 384); store_item(c, stg, b3, f, 448);
    lds_barrier();
}
template <int KH, int GI> __device__ __forceinline__ void att_item(const MixCtx& c, bf16x8 (&qr)[4], const bf16* qp, f32x16& ssacc) {
    LAS unsigned char* lds = c.lds; int lane_ = c.lane, rg = c.hw; OPAQUE_V(lane_); OPAQUE_S(rg);
    const int r32 = lane_ & 31, hi = lane_ >> 5, n = c.n;
    constexpr int h = KH * 4 + GI;
    f32x16 S[5];
#pragma unroll
    for (int t = 0; t < 5; ++t) {
#pragma unroll
        for (int i = 0; i < 16; ++i) S[t][i] = 0.f;
#pragma unroll
        for (int d0 = 0; d0 < 4; ++d0) { const bf16x8 kf = *(const LAS bf16x8*)(lds + KL_OFF + (32 * (rg + t) + r32) * KL_PITCH + (16 * d0 + 8 * hi) * 2);
            S[t] = MFMA32(kf, qr[d0], S[t]); }
        if (t & 1) __builtin_amdgcn_sched_barrier(0);
    }
    if (GI < 3) {
#pragma unroll
        for (int d0 = 0; d0 < 4; ++d0) qr[d0] = *(const bf16x8*)(qp + 64 * (GI + 1) + 16 * d0);
    }
    const float sinkl = c.sinks[h] * LOG2E;
    float mx = sinkl;
#pragma unroll
    for (int t = 0; t < 5; ++t)
#pragma unroll
        for (int r = 0; r < 16; ++r) {
            const bool tv = (n > 0) || (rg + t >= 4);
            const bool valid = (t == 0) ? (tv && (crow(r, hi) > r32)) : (t == 4) ? (crow(r, hi) <= r32) : tv;
            const float sv = valid ? S[t][r] : -1e30f; S[t][r] = sv; mx = fmaxf(mx, sv); }
    mx = fmaxf(mx, __shfl_xor(mx, 32));
    float sum = 0.f;
#pragma unroll
    for (int t = 0; t < 5; ++t)
#pragma unroll
        for (int r = 0; r < 16; ++r) { const float p = __builtin_amdgcn_exp2f(S[t][r] - mx); S[t][r] = p; sum += p; }
    sum += __shfl_xor(sum, 32);
    sum += __builtin_amdgcn_exp2f(sinkl - mx);
    const float linv = 1.0f / sum;
    f32x16 o0, o1;
#pragma unroll
    for (int i = 0; i < 16; ++i) { o0[i] = 0.f; o1[i] = 0.f; }
#pragma unroll
    for (int t = 0; t < 5; ++t)
#pragma unroll
        for (int s = 0; s < 2; ++s) {
            u32x4 pw; pw.x = cvtpk(S[t][8 * s + 0], S[t][8 * s + 1]); pw.y = cvtpk(S[t][8 * s + 2], S[t][8 * s + 3]); pw.z = cvtpk(S[t][8 * s + 4], S[t][8 * s + 5]); pw.w = cvtpk(S[t][8 * s + 6], S[t][8 * s + 7]);
            const bf16x8 pa = __builtin_bit_cast(bf16x8, pw);
            const int keyb = 32 * (rg + t) + 16 * s + 4 * hi;
            const LAS unsigned char* vb = lds + VL_OFF + r32 * VL_PITCH + keyb * 2;
            const u32x2 l0 = *(const LAS u32x2*)(vb), h0 = *(const LAS u32x2*)(vb + 16);
            const u32x2 l1 = *(const LAS u32x2*)(vb + 32 * VL_PITCH), h1 = *(const LAS u32x2*)(vb + 32 * VL_PITCH + 16);
            const bf16x8 v0 = __builtin_bit_cast(bf16x8, ((u32x4){l0.x, l0.y, h0.x, h0.y})), v1 = __builtin_bit_cast(bf16x8, ((u32x4){l1.x, l1.y, h1.x, h1.y}));
            o0 = MFMA32(pa, v0, o0); o1 = MFMA32(pa, v1, o1);
            if (s == 1) __builtin_amdgcn_sched_barrier(0);
        }
    LAS bf16* stg = (LAS bf16*)(lds + ASTG_OFF) + rg * 2048;
#pragma unroll
    for (int r = 0; r < 16; ++r) { const int ro = (r & 3) + 8 * (r >> 2) + 4 * hi; const float li = __shfl(linv, ro);
        const float v0 = o0[r] * li, v1 = o1[r] * li;
        { float q_ = ssacc[r] + (v0 * v0 + v1 * v1); asm volatile("" : "+v"(q_)); ssacc[r] = q_; }
        stg[ro * 64 + r32] = (bf16)(cvtpk(v0, 0.f) & 0xffffu); stg[ro * 64 + 32 + r32] = (bf16)(cvtpk(v1, 0.f) & 0xffffu); }
    asm volatile("s_waitcnt lgkmcnt(0)" ::: "memory");
    size_t yo = (c.rowbase + 32 * rg + (lane_ >> 3)) * D + 512 + h * 64 + (lane_ & 7) * 8; OPAQUE_V(yo); bf16* yb = c.Y + yo;
#pragma unroll
    for (int i = 0; i < 4; ++i) { const u32x4 v = *(const LAS u32x4*)(stg + (i * 8 + (lane_ >> 3)) * 64 + (lane_ & 7) * 8); *(u32x4*)(yb + (size_t)i * 8 * D) = v; }
    asm volatile("s_waitcnt lgkmcnt(0)" ::: "memory");
}
template <int KH> __device__ __forceinline__ void att_fill(const MixCtx& c, bf16x8 (&qr)[4], const bf16* qp) {
    LAS unsigned char* lds = c.lds; int htid = c.htid; OPAQUE_V(htid); const int n = c.n;
#pragma unroll
    for (int d0 = 0; d0 < 4; ++d0) qr[d0] = *(const bf16x8*)(qp + 16 * d0);
#pragma unroll
    for (int k = 0; k < 8; ++k) {
        const int i = htid + 256 * k, key = i >> 3, cc = i & 7; const bool valid = (n > 0) || (key >= 128);
        u32x4 v = (u32x4){0u, 0u, 0u, 0u};
        if (valid) v = *(const u32x4*)(c.Z + (c.rowbase + key - 128) * NIN + 1024 + KH * 64 + cc * 8);
        *(LAS u32x4*)(lds + KL_OFF + key * KL_PITCH + cc * 16) = v;
    }
#pragma unroll
    for (int k = 0; k < 8; ++k) {
        const int i = htid + 256 * k, d = i >> 5, cc = i & 31; const bool valid = (n > 0) || (cc >= 16);
        u32x4 v = (u32x4){0u, 0u, 0u, 0u};
        if (valid) v = *(const u32x4*)(c.Vt + ((size_t)((c.b * 2 + KH) * 64 + d)) * SEQ + n * 128 - 128 + cc * 8);
        LAS u32x2* dst = (LAS u32x2*)(lds + VL_OFF + d * VL_PITCH + cc * 16);
        dst[0] = (u32x2){v.x, v.y}; dst[1] = (u32x2){v.z, v.w};
    }
}
__device__ __forceinline__ void att_half(const MixCtx& c) {
    f32x16 ssacc;
#pragma unroll
    for (int r = 0; r < 16; ++r) ssacc[r] = 0.f;
    const bf16* qp0 = c.Z + (c.rowbase + 32 * c.hw + (c.lane & 31)) * NIN + 512 + 8 * (c.lane >> 5);
    const bf16* qp1 = qp0 + 256;
    bf16x8 qr[4]; u32x4 pre[9];
    u_load(c, 0, pre); att_fill<0>(c, qr, qp0); u_store(c, pre);            lds_barrier();
    u_load(c, 1, pre); att_item<0, 0>(c, qr, qp0, ssacc);                  lds_barrier();
    u_store(c, pre);   att_item<0, 1>(c, qr, qp0, ssacc);                  lds_barrier();
    u_load(c, 2, pre); att_item<0, 2>(c, qr, qp0, ssacc);                  lds_barrier();
    u_store(c, pre);   att_item<0, 3>(c, qr, qp0, ssacc);                  lds_barrier();
    u_load(c, 3, pre); att_fill<1>(c, qr, qp1);                            lds_barrier();
    u_store(c, pre);   att_item<1, 0>(c, qr, qp1, ssacc);                  lds_barrier();
    att_item<1, 1>(c, qr, qp1, ssacc);                                     lds_barrier();
    att_item<1, 2>(c, qr, qp1, ssacc);                                     lds_barrier();
    att_item<1, 3>(c, qr, qp1, ssacc);
    { int lane = c.lane; OPAQUE_V(lane); const int r32 = lane & 31, hi = lane >> 5; LAS float* RAL = (LAS float*)(c.lds + RAL_OFF);
#pragma unroll
      for (int r = 0; r < 16; ++r) { const int ro = (r & 3) + 8 * (r >> 2) + 4 * hi; const float ss = half_sum32(ssacc[r]);
          if (r32 == 0) RAL[32 * c.hw + ro] = __builtin_amdgcn_rsqf(ss * (1.0f / 512.0f) + EPS); } }
    lds_barrier();
    lds_barrier();
}
__device__ __forceinline__ void mixer_block(LAS unsigned char* lds, int blk, const bf16* Z, const bf16* Vt, const bf16* WpT, const float* pool_scale, const float* sinks,
                                            const float* g_pool, const float* g_attn, bf16* Y, float* RA, int tid, int wid, int lane) {
    OPAQUE_V(tid); OPAQUE_V(lane); OPAQUE_S(wid);
    MixCtx c; c.lds = lds; c.Z = Z; c.Vt = Vt; c.WpT = WpT; c.pool_scale = pool_scale; c.sinks = sinks; c.g_pool = g_pool; c.g_attn = g_attn; c.Y = Y; c.RA = RA; c.rowbase = (size_t)blk * 128;
    c.b = blk / NB_SEQ; c.n = blk % NB_SEQ; c.htid = tid & 255; c.lane = lane; c.hw = wid & 3;
    if (wid < 4) pool_half(c); else att_half(c);
}
__global__ void __launch_bounds__(NTHREADS, 2) hybrid_fwd(Args args) {
    extern __shared__ __attribute__((aligned(16))) unsigned char lds_raw[];
    LAS unsigned char* lds = (LAS unsigned char*)lds_raw;
    cg::grid_group grid = cg::this_grid();
    const int tid = threadIdx.x, lane = tid & 63, wid = __builtin_amdgcn_readfirstlane(tid >> 6);
    const int G = gridDim.x, bx = blockIdx.x;
    const int vcu = (G % 8 == 0) ? (bx % 8) * (G / 8) + bx / 8 : bx;
    const int gw = vcu * NWAVES + wid, NGW = G * NWAVES;
    unsigned char* ws = args.ws;
    bf16 *Wgu1 = (bf16*)(ws + WS_WGU1), *Wgu2 = (bf16*)(ws + WS_WGU2), *Wd1 = (bf16*)(ws + WS_WD1), *Wd2 = (bf16*)(ws + WS_WD2), *Win = (bf16*)(ws + WS_WIN), *Wout = (bf16*)(ws + WS_WOUT), *WpT = (bf16*)(ws + WS_WPOOL);
    float* CS = (float*)(ws + WS_CS);
    bf16 *HD = (bf16*)(ws + WS_HD), *H = (bf16*)(ws + WS_H), *Z = (bf16*)(ws + WS_Z), *Vt = (bf16*)(ws + WS_VT), *Y = (bf16*)(ws + WS_Y), *XR = (bf16*)(ws + WS_XR); float* RAg = (float*)(ws + WS_RA); float* RS = (float*)(ws + WS_RA + 512 * 1024);
    const int lo = args.ph_lo, hi = args.ph_hi;
#define IN(k) (lo <= (k) && (k) < hi)
#define SEAM(k) do { if (IN(k) && IN((k) + 1)) { if ((k) == 0) grid.sync(); else xcd_barrier(bar); } } while (0)
    if (tid < 32) ((LAS unsigned*)(lds + MISC_OFF))[tid] = 0u;
    __syncthreads();
    const int grp = bx & 7, gslot = bx >> 3, GW = G >> 3;
    unsigned* ctl = (unsigned*)(ws + WS_CTL);
    XcdBarrier bar; bar.bar = ctl + (1 + grp) * XCD_BAR_WORDS; bar.x = 0; bar.st = nullptr; bar.total = (unsigned)GW;
    const bool one_launch = (hi - lo > 1);
    const int grow0 = grp * (M / 8) + gslot * NWAVES + wid, grow1 = (grp + 1) * (M / 8);
    unsigned* halo_flag = ctl + 9 * XCD_BAR_WORDS;

    if (IN(0)) {
        for (int i = vcu * NTHREADS + tid; i < (int)(CTL_BYTES / 4); i += G * NTHREADS) __hip_atomic_store(ctl + i, 0u, __ATOMIC_RELAXED, __HIP_MEMORY_SCOPE_AGENT);
        LAS float* scr = (LAS float*)(lds + wid * 16384);
        constexpr int I_GU = (D / 64) * (NGU / 32), I_DN = (FF / 64) * (D / 32), I_IN = (D / 64) * (NIN / 32), I_OUT = (D / 64) * (D / 32), I_PL = 4 * 2 * 4;
        constexpr int NITEMS = 2 * I_GU + 2 * I_DN + I_IN + I_OUT + I_PL;
        for (int it = gw; it < NITEMS; it += NGW) {
            int r = it;
            if (r < I_GU) { transpose_item(args.ffn1_wgu, D, NGU, Wgu1, 1, scr, r, lane, args.ffn1_pre); continue; } r -= I_GU;
            if (r < I_GU) { transpose_item(args.ffn2_wgu, D, NGU, Wgu2, 1, scr, r, lane, args.ffn2_pre); continue; } r -= I_GU;
            if (r < I_DN) { transpose_item(args.ffn1_wd, FF, D, Wd1, 0, scr, r, lane); continue; } r -= I_DN;
            if (r < I_DN) { transpose_item(args.ffn2_wd, FF, D, Wd2, 0, scr, r, lane); continue; } r -= I_DN;
            if (r < I_IN) { transpose_item(args.w_in, D, NIN, Win, 2, scr, r, lane, args.mix_pre); continue; } r -= I_IN;
            if (r < I_OUT) { transpose_item(args.w_out, D, D, Wout, 0, scr, r, lane, args.g_pool, args.g_attn); continue; } r -= I_OUT;
            { const int g = r >> 3; transpose_item(args.w_pool + (size_t)g * 16384, 128, 128, WpT + (size_t)g * 16384, 0, scr, r & 7, lane, nullptr, nullptr, args.pool_scale + g * 128); }
        }
        for (int idx = vcu * NTHREADS + tid; idx < M * 8; idx += G * NTHREADS) {
            const int row = idx >> 3, i = idx & 7; const float ang = (float)args.pos[row] * inv_freq(i);
            float sn, cn; sincos_f(ang, sn, cn); CS[(size_t)row * 16 + i] = cn; CS[(size_t)row * 16 + 8 + i] = sn;
        }
        prenorm_rows(args.x, XR, RS, gw, NGW, lane);
    }
    SEAM(0);
    if (one_launch) bar = xcd_barrier_post(ctl + (1 + grp) * XCD_BAR_WORDS, (volatile LAS unsigned*)(lds + MISC_OFF) + 8, (unsigned)GW);
    if (IN(1)) {
        pg8::Gemm g{XR, Wgu1, M, NGU, D}; pg8::StaticOrder S; S.init(M, NGU, G, bx); pg8::EpiSwiGLU E{H, FF};
        pg8::gemm_phase<pg8::EpiSwiGLU, pg8::StaticOrder, true, true>(lds, g, S, E);
    }
    SEAM(1);
    if (IN(2)) {
        pg8::Gemm g{H, Wd1, M, D, FF}; pg8::StaticOrder S; S.init(M, D, G, bx); pg8::EpiBf16<0> E{HD, D, nullptr, 0, 0, 1.f};
        pg8::gemm_phase<pg8::EpiBf16<0>, pg8::StaticOrder, true, true>(lds, g, S, E);
    }
    SEAM(2);
    if (IN(3)) thin_rows<true, true, true>(XR, XR, HD, args.ffn1_post, RS, 0.5f, grow0, grow1, GW * NWAVES, lane);
    SEAM(3);
    if (IN(4)) {
        pg8::Gemm g{XR, Win, M, NIN, D}; pg8::StaticOrder S; S.init(M, NIN, G, bx); pg8::EpiZ E{Z, Vt, CS, QSCALE, SEQ};
        pg8::gemm_phase<pg8::EpiZ, pg8::StaticOrder, true, true>(lds, g, S, E);
    }
    SEAM(4);
    if (IN(4) && IN(5)) { if (gslot == 0 && tid == 0) { __builtin_amdgcn_fence(__ATOMIC_RELEASE, "agent"); asm volatile("s_waitcnt vmcnt(0)" ::: "memory"); } __syncthreads(); if (gslot == 0 && tid == 0) __hip_atomic_store(halo_flag + 64 * grp, 1u, __ATOMIC_RELAXED, __HIP_MEMORY_SCOPE_AGENT); }
    if (IN(5)) { for (int blk = grp * (NBLK / 8) + gslot; blk < (grp + 1) * (NBLK / 8); blk += GW) {
        if (IN(4) && (blk % NB_SEQ) != 0 && (blk % (NBLK / 8)) == 0) {
            if (tid == 0) { unsigned sp = 0; while (__hip_atomic_load(halo_flag + 64 * (grp - 1), __ATOMIC_RELAXED, __HIP_MEMORY_SCOPE_AGENT) == 0u) { __builtin_amdgcn_s_sleep(2); if (++sp > (1u << 22)) break; }
                            __builtin_amdgcn_fence(__ATOMIC_ACQUIRE, "agent"); asm volatile("s_waitcnt vmcnt(0)" ::: "memory"); }
            __syncthreads(); }
        mixer_block(lds, blk, Z, Vt, WpT, args.pool_scale, args.sinks, args.g_pool, args.g_attn, Y, RAg, tid, wid, lane); } }
    SEAM(5);
    if (IN(6)) {
        pg8::Gemm g{Y, Wout, M, D, D}; pg8::StaticOrder S; S.init(M, D, G, bx); pg8::EpiRowScale E{HD, D, RAg};
        pg8::gemm_phase<pg8::EpiRowScale, pg8::StaticOrder, true, true>(lds, g, S, E);
    }
    SEAM(6);
    if (IN(7)) thin_rows<true, true, true>(XR, XR, HD, args.mix_post, RS, 1.0f, grow0, grow1, GW * NWAVES, lane);
    SEAM(7);
    if (IN(8)) {
        pg8::Gemm g{XR, Wgu2, M, NGU, D}; pg8::StaticOrder S; S.init(M, NGU, G, bx); pg8::EpiSwiGLU E{H, FF};
        pg8::gemm_phase<pg8::EpiSwiGLU, pg8::StaticOrder, true, true>(lds, g, S, E);
    }
    SEAM(8);
    if (IN(9)) {
        pg8::Gemm g{H, Wd2, M, D, FF}; pg8::StaticOrder S; S.init(M, D, G, bx); pg8::EpiBf16<0> E{HD, D, nullptr, 0, 0, 1.f};
        pg8::gemm_phase<pg8::EpiBf16<0>, pg8::StaticOrder, true, true>(lds, g, S, E);
    }
    SEAM(9);
    if (IN(10)) thin_rows<false, true, false>(XR, args.out, HD, args.ffn2_post, RS, 0.5f, grow0, grow1, GW * NWAVES, lane);
#undef IN
#undef SEAM
}

#ifndef MK_N_LAUNCHES
#define MK_N_LAUNCHES 1
#endif
extern "C" void kernel_launch(void* const* d_in, const int* in_sizes, int n_in, void* d_out, int out_size, void* d_ws, size_t ws_size, hipStream_t stream) {
    static int grid = 0;
    if (grid == 0) {
        if (n_in != 19 || in_sizes[0] != M * D || out_size != M * D || ws_size < WS_END) { fprintf(stderr, "kernel_launch: unexpected shapes (n_in %d, in0 %d, out %d, ws %zu)\n", n_in, n_in > 0 ? in_sizes[0] : -1, out_size, ws_size); grid = -1; return; }
        int dev = 0, cus = 0, per_cu = 0;
        if (hipGetDevice(&dev) != hipSuccess || hipDeviceGetAttribute(&cus, hipDeviceAttributeMultiprocessorCount, dev) != hipSuccess) { grid = -1; return; }
        if (hipFuncSetAttribute((const void*)hybrid_fwd, hipFuncAttributeMaxDynamicSharedMemorySize, LDS_BYTES) != hipSuccess) { fprintf(stderr, "kernel_launch: hipFuncSetAttribute failed\n"); grid = -1; return; }
        if (hipOccupancyMaxActiveBlocksPerMultiprocessor(&per_cu, (const void*)hybrid_fwd, NTHREADS, LDS_BYTES) != hipSuccess || per_cu < 1) { fprintf(stderr, "kernel_launch: occupancy query says %d\n", per_cu); per_cu = 1; }
        (void)hipGetLastError();
        grid = (cus / 8) * 8;
    }
    if (grid < 0) return;
    Args a{};
    a.x = (const float*)d_in[0]; a.pos = (const int*)d_in[1];
    a.ffn1_pre = (const float*)d_in[2]; a.ffn1_wgu = (const float*)d_in[3]; a.ffn1_wd = (const float*)d_in[4]; a.ffn1_post = (const float*)d_in[5];
    a.mix_pre = (const float*)d_in[6]; a.w_in = (const float*)d_in[7]; a.w_pool = (const float*)d_in[8]; a.pool_scale = (const float*)d_in[9]; a.sinks = (const float*)d_in[10];
    a.g_pool = (const float*)d_in[11]; a.g_attn = (const float*)d_in[12]; a.w_out = (const float*)d_in[13]; a.mix_post = (const float*)d_in[14];
    a.ffn2_pre = (const float*)d_in[15]; a.ffn2_wgu = (const float*)d_in[16]; a.ffn2_wd = (const float*)d_in[17]; a.ffn2_post = (const float*)d_in[18];
    a.out = (float*)d_out; a.ws = (unsigned char*)d_ws;
    constexpr int NPH = 11;
#if MK_N_LAUNCHES == 1
    a.ph_lo = 0; a.ph_hi = NPH;
    { void* kargs[] = {&a}; hipError_t e = hipLaunchCooperativeKernel((const void*)hybrid_fwd, dim3(grid), dim3(NTHREADS), kargs, LDS_BYTES, stream);
      if (e != hipSuccess) fprintf(stderr, "kernel_launch: cooperative launch failed: %s (grid %d)\n", hipGetErrorString(e), grid); }
#else
    for (int p = 0; p < NPH; ++p) { a.ph_lo = p; a.ph_hi = p + 1; void* kargs[] = {&a};
        hipError_t e = hipLaunchCooperativeKernel((const void*)hybrid_fwd, dim3(grid), dim3(NTHREADS), kargs, LDS_BYTES, stream);
        if (e != hipSuccess) { fprintf(stderr, "kernel_launch: launch %d failed: %s\n", p, hipGetErrorString(e)); break; } }
#endif
}
```
